# Optimizing an MI355X kernel written in HIP

```python
import jax, jax.numpy as jnp
from jax import lax
import numpy as np

D_MODEL = 1024
BATCH = 2
SEQ = 8192
DEPTH = 1
DEC_BATCH = 32
DEC_SEQ = 8
PAST_LEN = 8192
PAGE_SIZE = 128

SB_HEADS = 8
SB_HEAD_DIM = 64
SB_WIDTH = SB_HEADS * SB_HEAD_DIM
SB_BLOCK = 128
SB_BIAS_INIT = -6.0
GLA_HEADS = 4
GLA_KEY_DIM = 64
GLA_VAL_DIM = 128
GLA_QK_WIDTH = GLA_HEADS * GLA_KEY_DIM
GLA_V_WIDTH = GLA_HEADS * GLA_VAL_DIM
GLA_GATE_RANK = 16
GLA_GATE_TEMP = 16.0
GLA_CHUNK = 16
MIX_WIDTH = SB_WIDTH + GLA_V_WIDTH
D_FF = 4 * D_MODEL
NORM_EPS = 1e-6
IN_SPLITS = (SB_WIDTH, SB_WIDTH, SB_WIDTH, GLA_QK_WIDTH, GLA_QK_WIDTH, GLA_V_WIDTH, GLA_V_WIDTH, GLA_GATE_RANK)
IN_WIDTH = 3 * SB_WIDTH + 2 * GLA_QK_WIDTH + 2 * GLA_V_WIDTH + GLA_GATE_RANK

kernel_name = "stickbreak_gla_hybrid_step"


def rms_norm(x, gain):
    xf = x.astype(jnp.float32)
    y = xf * lax.rsqrt(jnp.mean(xf * xf, axis=-1, keepdims=True) + NORM_EPS)
    return (y * gain.astype(jnp.float32)).astype(x.dtype)


def split_columns(p):
    parts, start = [], 0
    for w in IN_SPLITS:
        parts.append(p[..., start:start + w])
        start += w
    return parts


def sb_block(q, k, v, q_pos, k_pos, bias):
    z = (jnp.einsum("bqhd,bkhd->bhqk", q, k).astype(jnp.float32) * (SB_HEAD_DIM ** -0.5)
         + bias.astype(jnp.float32)[None, :, None, None])
    causal = (k_pos[None, :] < q_pos[:, None])[None, None]
    log_stay = jnp.where(causal, jax.nn.log_sigmoid(-z), 0.0)
    log_after = lax.cumsum(log_stay, axis=3, reverse=True) - log_stay
    w = jnp.where(causal, jnp.exp(jax.nn.log_sigmoid(z) + log_after), 0.0)
    return jnp.einsum("bhqk,bkhd->bqhd", w.astype(v.dtype), v)


def stick_breaking_attention(q, k, v, q_offset, bias):
    B, Tq, H, Dh = q.shape
    Tk = k.shape[1]
    blk = SB_BLOCK if Tq % SB_BLOCK == 0 else Tq
    n = Tq // blk
    k_pos = jnp.arange(Tk, dtype=jnp.int32)
    q_pos = (q_offset + jnp.arange(Tq, dtype=jnp.int32)).reshape(n, blk)
    qb = q.reshape(B, n, blk, H, Dh).transpose(1, 0, 2, 3, 4)
    ob = lax.map(lambda a: sb_block(a[0], k, v, a[1], k_pos, bias), (qb, q_pos))
    return ob.transpose(1, 0, 2, 3, 4).reshape(B, Tq, H, Dh)


def gla_chunked(q, k, v, log_a, s0):
    B, T, H, DK = q.shape
    DV = v.shape[-1]
    C = GLA_CHUNK if T % GLA_CHUNK == 0 else T
    n = T // C

    def blocks(t):
        return t.astype(jnp.float32).reshape(B, n, C, H, t.shape[-1]).transpose(0, 3, 1, 2, 4)

    qc = blocks(q) * (DK ** -0.5)
    kc, vc, ac = blocks(k), blocks(v), blocks(log_a)
    b = jnp.cumsum(ac, axis=3)
    b_end = b[:, :, :, -1:, :]
    q_dec = qc * jnp.exp(b)
    k_inv = kc * jnp.exp(-b)
    tri = jnp.tril(jnp.ones((C, C), dtype=bool))
    scores = jnp.where(tri, jnp.einsum("bhncd,bhnsd->bhncs", q_dec, k_inv), 0.0)
    o_intra = jnp.einsum("bhncs,bhnsv->bhncv", scores, vc)
    ds = jnp.einsum("bhncd,bhncv->nbhdv", kc * jnp.exp(b_end - b), vc)
    decay = jnp.exp(b_end[:, :, :, 0, :]).transpose(2, 0, 1, 3)

    def step(s, inp):
        dec, d = inp
        return dec[..., None] * s + d, s

    s_final, s_start = lax.scan(step, s0.astype(jnp.float32), (decay, ds))
    o_inter = jnp.einsum("bhncd,nbhdv->bhncv", q_dec, s_start)
    o = (o_intra + o_inter).transpose(0, 2, 3, 1, 4).reshape(B, T, H, DV)
    return o.astype(v.dtype), s_final


def hybrid_layer(x, c, k_past, v_past, gla_s0, q_offset, w_ada, b_ada, g_mix, w_in, b_sb,
                 w_gla_gate, b_gla_gate, g_gla_out, w_out, g_ffn, w_up, w_down):
    B, T, _ = x.shape
    mod = jax.nn.silu(c) @ w_ada + b_ada
    sh1, sc1, ga1, sh2, sc2, ga2 = [m[:, None, :] for m in jnp.split(mod, 6, axis=-1)]
    h = rms_norm(x, g_mix) * (1.0 + sc1) + sh1
    q_sb, k_sb, v_sb, q_g, k_g, v_g, r_g, a_low = split_columns(h @ w_in)
    q_sb = q_sb.reshape(B, T, SB_HEADS, SB_HEAD_DIM)
    k_sb = k_sb.reshape(B, T, SB_HEADS, SB_HEAD_DIM)
    v_sb = v_sb.reshape(B, T, SB_HEADS, SB_HEAD_DIM)
    k_all = k_sb if k_past is None else jnp.concatenate([k_past, k_sb], axis=1)
    v_all = v_sb if v_past is None else jnp.concatenate([v_past, v_sb], axis=1)
    o_sb = stick_breaking_attention(q_sb, k_all, v_all, q_offset, b_sb).reshape(B, T, SB_WIDTH)
    log_a = jax.nn.log_sigmoid((a_low @ w_gla_gate + b_gla_gate).astype(jnp.float32)) / GLA_GATE_TEMP
    o_g, s_new = gla_chunked(q_g.reshape(B, T, GLA_HEADS, GLA_KEY_DIM),
                             k_g.reshape(B, T, GLA_HEADS, GLA_KEY_DIM),
                             v_g.reshape(B, T, GLA_HEADS, GLA_VAL_DIM),
                             log_a.reshape(B, T, GLA_HEADS, GLA_KEY_DIM), gla_s0)
    o_g = rms_norm(o_g, g_gla_out).reshape(B, T, GLA_V_WIDTH) * jax.nn.silu(r_g)
    x = x + ga1 * (jnp.concatenate([o_sb, o_g], axis=-1) @ w_out)
    h2 = rms_norm(x, g_ffn) * (1.0 + sc2) + sh2
    x = x + ga2 * (jnp.square(jax.nn.relu(h2 @ w_up)) @ w_down)
    return x, k_sb, v_sb, s_new


def setup_inputs(seed: int = 0) -> dict:
    key = jax.random.key(seed)
    ks = jax.random.split(key, 24)
    n_pages = PAST_LEN // PAGE_SIZE
    n_used = DEC_BATCH * n_pages
    n_phys = n_used + max(1, n_used // 4)
    f32 = jnp.float32
    nrm = lambda k, s, sc: jax.random.normal(k, s, f32) * sc
    perm = jax.random.permutation(ks[7], n_phys)[:n_used].astype(jnp.int32)
    return {
        "x_prompt": nrm(ks[0], (BATCH, SEQ, D_MODEL), 1.0),
        "x_sample": nrm(ks[1], (DEC_BATCH, DEC_SEQ, D_MODEL), 1.0),
        "c_prompt": nrm(ks[2], (BATCH, D_MODEL), 1.0),
        "c_sample": nrm(ks[3], (DEC_BATCH, D_MODEL), 1.0),
        "cache_k": nrm(ks[4], (DEPTH, n_phys, PAGE_SIZE, SB_HEADS, SB_HEAD_DIM), 1.0),
        "cache_v": nrm(ks[5], (DEPTH, n_phys, PAGE_SIZE, SB_HEADS, SB_HEAD_DIM), 1.0),
        "state_gla": nrm(ks[6], (DEPTH, DEC_BATCH, GLA_HEADS, GLA_KEY_DIM, GLA_VAL_DIM), 0.3),
        "page_table": perm.reshape(DEC_BATCH, n_pages),
        "w_ada": nrm(ks[8], (DEPTH, D_MODEL, 6 * D_MODEL), 0.5 * D_MODEL ** -0.5),
        "b_ada": nrm(ks[9], (DEPTH, 6 * D_MODEL), 0.01),
        "g_mix": 1.0 + nrm(ks[10], (DEPTH, D_MODEL), 0.02),
        "w_in": nrm(ks[11], (DEPTH, D_MODEL, IN_WIDTH), D_MODEL ** -0.5),
        "b_sb": SB_BIAS_INIT + nrm(ks[20], (DEPTH, SB_HEADS), 0.5),
        "w_gla_gate": nrm(ks[12], (DEPTH, GLA_GATE_RANK, GLA_QK_WIDTH), GLA_GATE_RANK ** -0.5),
        "b_gla_gate": nrm(ks[13], (DEPTH, GLA_QK_WIDTH), 0.01),
        "g_gla_out": 1.0 + nrm(ks[14], (DEPTH, GLA_VAL_DIM), 0.02),
        "w_out": nrm(ks[15], (DEPTH, MIX_WIDTH, D_MODEL), MIX_WIDTH ** -0.5),
        "g_ffn": 1.0 + nrm(ks[16], (DEPTH, D_MODEL), 0.02),
        "w_up": nrm(ks[17], (DEPTH, D_MODEL, D_FF), D_MODEL ** -0.5),
        "w_down": nrm(ks[18], (DEPTH, D_FF, D_MODEL), D_FF ** -0.5),
        "g_final": 1.0 + nrm(ks[19], (D_MODEL,), 0.02),
    }


def reference(x_prompt, x_sample, c_prompt, c_sample, cache_k, cache_v, state_gla, page_table,
              w_ada, b_ada, g_mix, w_in, b_sb, w_gla_gate, b_gla_gate, g_gla_out, w_out,
              g_ffn, w_up, w_down, g_final):
    n_dec = x_sample.shape[0]
    past_len = page_table.shape[1] * cache_k.shape[2]
    xp, xs = x_prompt, x_sample
    kp_l, vp_l, sp_l, ks_l, vs_l, ss_l = [], [], [], [], [], []
    for l in range(DEPTH):
        wl = (w_ada[l], b_ada[l], g_mix[l], w_in[l], b_sb[l], w_gla_gate[l], b_gla_gate[l],
              g_gla_out[l], w_out[l], g_ffn[l], w_up[l], w_down[l])
        s0 = jnp.zeros((xp.shape[0], GLA_HEADS, GLA_KEY_DIM, GLA_VAL_DIM), jnp.float32)
        xp, kp, vp, sp = hybrid_layer(xp, c_prompt, None, None, s0, 0, *wl)
        k_past = cache_k[l][page_table].reshape(n_dec, past_len, SB_HEADS, SB_HEAD_DIM)
        v_past = cache_v[l][page_table].reshape(n_dec, past_len, SB_HEADS, SB_HEAD_DIM)
        xs, kn, vn, sn = hybrid_layer(xs, c_sample, k_past, v_past, state_gla[l], past_len, *wl)
        kp_l.append(kp); vp_l.append(vp); sp_l.append(sp)
        ks_l.append(kn); vs_l.append(vn); ss_l.append(sn)
    y_prompt = rms_norm(xp, g_final)
    y_sample = rms_norm(xs, g_final)
    return (y_prompt, y_sample, jnp.stack(kp_l), jnp.stack(vp_l), jnp.stack(sp_l),
            jnp.stack(ks_l), jnp.stack(vs_l), jnp.stack(ss_l))
```

```cpp
#include <hip/hip_runtime.h>
#include <hip/hip_bf16.h>
#include <cstdio>
#include <cstdint>
namespace pg8 {
#define PG8_LAS __attribute__((address_space(3)))
typedef unsigned short bf16_t;
typedef short bf16x8 __attribute__((ext_vector_type(8)));
typedef float f32x4 __attribute__((ext_vector_type(4)));
typedef unsigned u32x4 __attribute__((ext_vector_type(4)));
constexpr int BM = 256, BK = 64, HALF = 128, HTB = HALF * BK * 2  , STAGE_BYTES = 8 * HTB, NXCD = 8, WGM = 8;

__host__ __device__ __forceinline__ int lds_byte(int r, int c) { const int st = (r >> 4) * 2 + (c >> 5), rr = r & 15, cc = c & 31, ob = rr * 64 + cc * 2; return st * 1024 + (ob ^ (((ob >> 9) & 1) << 5)); }
__host__ __device__ __forceinline__ void stage_rc(int b, int& R, int& C) { const int st = b / 1024, sb = b % 1024, swz = sb ^ (((sb >> 9) & 1) << 5); R = (st >> 1) * 16 + swz / 64; C = (st & 1) * 32 + (swz % 64) / 2; }
__host__ __device__ __forceinline__ int perm32(int rho) { const int n = rho >> 4, i = rho & 15; return 8 * (i >> 2) + 4 * n + (i & 3); }

struct Unit { int pm, pn; };
struct Gemm { const bf16_t* A; const bf16_t* Bt; int M, N, K; };

struct StaticOrder {
    int nM, nN, nwg, G, c;
    __host__ __device__ void init(int M, int N, int G_, int c_) { nM = M / BM; nN = N / BM; nwg = nM * nN; G = G_; c = c_; }
    __host__ __device__ bool next(int i, Unit& u) const {
        const long L = (long)i * G + c; if (L >= nwg) return false;
        int wgid = (int)L; { const int q = nwg / NXCD, r = nwg % NXCD, xcd = wgid % NXCD, off = wgid / NXCD; wgid = (xcd < r ? xcd * (q + 1) : r * (q + 1) + (xcd - r) * q) + off; }
        const int nig = WGM * nN, gid = wgid / nig, fm = gid * WGM, gsz = (nM - fm) < WGM ? (nM - fm) : WGM;
        u.pm = fm + ((wgid % nig) % gsz); u.pn = (wgid % nig) / gsz; return true;
    }
    __device__ __forceinline__ void a_ready(const Unit&) const {}
    __device__ __forceinline__ void done(const Unit&) const {}
};

__device__ __forceinline__ unsigned cvt_pk_bf16(float lo, float hi) { unsigned r; asm volatile("v_cvt_pk_bf16_f32 %0, %1, %2" : "=v"(r) : "v"(lo), "v"(hi)); return r; }

struct EpiInProj {
    static constexpr bool PERM = true, AFTER_DRAIN = false;
    bf16_t *Q, *K, *V, *G; float *kP, *vP, *kS, *vS; float qscale;
    __device__ __forceinline__ void operator()(const f32x4 (&acc)[2][2][4][2], const Unit& u, int wr, int wc, int fr, int fq) const {
        const int pn = u.pn, pm = u.pm;
        bf16_t* dst; int ldc, colbase; float sc = 1.f; float* fo = nullptr;
        if (pn < 2)      { dst = Q; ldc = 512; colbase = pn * 256; sc = qscale; }
        else if (pn < 4) { dst = K; ldc = 512; colbase = (pn - 2) * 256; fo = pm < 64 ? kP : kS; }
        else if (pn < 6) { dst = V; ldc = 512; colbase = (pn - 4) * 256; fo = pm < 64 ? vP : vS; }
        else             { dst = G; ldc = 1792; colbase = (pn - 6) * 256; }
        const int row0 = pm * BM + wr * 64 + fr, cl = colbase + wc * 32 + 8 * fq;
#pragma unroll
        for (int ai = 0; ai < 2; ++ai)
#pragma unroll
            for (int m = 0; m < 4; ++m) { const size_t row = (size_t)(row0 + ai * HALF + m * 16);
#pragma unroll
                for (int bj = 0; bj < 2; ++bj) { const f32x4 a0 = acc[ai][bj][m][0], a1 = acc[ai][bj][m][1]; const int col = cl + bj * HALF;
                    const f32x4 v0 = a0 * sc, v1 = a1 * sc; u32x4 w; w.x = cvt_pk_bf16(v0[0], v0[1]); w.y = cvt_pk_bf16(v0[2], v0[3]); w.z = cvt_pk_bf16(v1[0], v1[1]); w.w = cvt_pk_bf16(v1[2], v1[3]);
                    *(u32x4*)(dst + row * ldc + col) = w;
                    if (fo) { *(f32x4*)(fo + row * 512 + col) = a0; *(f32x4*)(fo + row * 512 + col + 4) = a1; } } }
    }
};
struct EpiRelu2 {
    static constexpr bool PERM = true, AFTER_DRAIN = false;
    bf16_t* O; int ldc;
    __device__ __forceinline__ void operator()(const f32x4 (&acc)[2][2][4][2], const Unit& u, int wr, int wc, int fr, int fq) const {
        const int row0 = u.pm * BM + wr * 64 + fr, col0 = u.pn * BM + wc * 32 + 8 * fq;
#pragma unroll
        for (int ai = 0; ai < 2; ++ai)
#pragma unroll
            for (int m = 0; m < 4; ++m) { bf16_t* rowp = O + (size_t)(row0 + ai * HALF + m * 16) * ldc + col0;
#pragma unroll
                for (int bj = 0; bj < 2; ++bj) { f32x4 v0 = acc[ai][bj][m][0], v1 = acc[ai][bj][m][1];
#pragma unroll
                    for (int e = 0; e < 4; ++e) { const float a = fmaxf(v0[e], 0.f), b = fmaxf(v1[e], 0.f); v0[e] = a * a; v1[e] = b * b; }
                    u32x4 w; w.x = cvt_pk_bf16(v0[0], v0[1]); w.y = cvt_pk_bf16(v0[2], v0[3]); w.z = cvt_pk_bf16(v1[0], v1[1]); w.w = cvt_pk_bf16(v1[2], v1[3]);
                    *(u32x4*)(rowp + bj * HALF) = w; } }
    }
};
struct EpiResGate {
    static constexpr bool PERM = false, AFTER_DRAIN = false;
    const float* baseP; const float* baseS; float* out; const float* gate;
    __device__ __forceinline__ void operator()(const f32x4 (&acc)[2][2][4][2], const Unit& u, int wr, int wc, int fr, int fq) const {
        const int col0 = u.pn * BM + wc * 32 + 4 * fq;
#pragma unroll
        for (int ai = 0; ai < 2; ++ai)
#pragma unroll
            for (int m = 0; m < 4; ++m) { const int row = u.pm * BM + ai * HALF + wr * 64 + m * 16 + fr; const int bidx = row < 16384 ? (row >> 13) : 2 + ((row - 16384) >> 3);
                const float* b = (row < 16384 ? baseP : baseS) + (size_t)row * 1024 + col0; const float* g = gate + (size_t)bidx * 6144 + col0; float* o = out + (size_t)row * 1024 + col0;
#pragma unroll
                for (int bj = 0; bj < 2; ++bj)
#pragma unroll
                    for (int n = 0; n < 2; ++n) { const int c = bj * HALF + n * 16; const f32x4 bs = *(const f32x4*)(b + c), gv = *(const f32x4*)(g + c); *(f32x4*)(o + c) = bs + gv * acc[ai][bj][m][n]; } }
    }
};
template <class Epi, class Sched, bool ALIGN_EPI = false, bool SP2 = false>
__device__ __forceinline__ void gemm_phase(PG8_LAS unsigned char* lds, const Gemm g, const Sched& S, const Epi& E) {
    int tid_ = threadIdx.x; asm volatile("" : "+v"(tid_)); const int tid = tid_, wid = __builtin_amdgcn_readfirstlane(tid >> 6), lane = tid & 63, wr = wid >> 2, wc = wid & 3, fr = lane & 15, fq = lane >> 4;
    const int K = g.K, nt = K / BK;
    unsigned voffA[2], voffB[2];
#pragma unroll
    for (int i = 0; i < 2; ++i) { int R, C; stage_rc(tid * 16 + i * 8192, R, C); const int Rb = Epi::PERM ? ((R & ~31) + perm32(R & 31)) : R;
        voffA[i] = (unsigned)(R * K + C) * 2u; voffB[i] = (unsigned)(Rb * K + C) * 2u; }
    const size_t kstep = (size_t)(BK * 2);
    const size_t hstep = (size_t)HALF * K * 2;
    const size_t tstep = 2 * hstep;
    const unsigned ldsw = (unsigned)wid * 1024u;
    const int aoff = lds_byte(wr * 64 + fr, fq * 8), boff = lds_byte(wc * 32 + fr, fq * 8);
#define PG8_SA(b, h) (((b) * 2 + (h)) * HTB)
#define PG8_SB(b, h) ((4 + (b) * 2 + (h)) * HTB)
#define PG8_STAGE(bufoff, gbase, voff) do { _Pragma("unroll") for (int _i = 0; _i < 2; ++_i) \
        __builtin_amdgcn_global_load_lds((const unsigned*)((const char*)(gbase) + (voff)[_i]), (PG8_LAS unsigned*)(lds + (bufoff) + ldsw + _i * 8192), 16, 0, 0); } while (0)
#define PG8_LDA(dst, b, h) do { _Pragma("unroll") for (int m = 0; m < 4; ++m) _Pragma("unroll") for (int k = 0; k < 2; ++k) dst[m][k] = *(const PG8_LAS bf16x8*)(lds + PG8_SA(b, h) + aoff + m * 2048 + k * 1024); } while (0)
#define PG8_LDB(dst, b, h) do { _Pragma("unroll") for (int n = 0; n < 2; ++n) _Pragma("unroll") for (int k = 0; k < 2; ++k) dst[n][k] = *(const PG8_LAS bf16x8*)(lds + PG8_SB(b, h) + boff + n * 2048 + k * 1024); } while (0)
#define PG8_MMA(ai, bj, At, Bt) do { __builtin_amdgcn_s_setprio(1); _Pragma("unroll") for (int m = 0; m < 4; ++m) _Pragma("unroll") for (int n = 0; n < 2; ++n) _Pragma("unroll") for (int k = 0; k < 2; ++k) \
        acc[ai][bj][m][n] = __builtin_amdgcn_mfma_f32_16x16x32_bf16(Bt[n][k], At[m][k], acc[ai][bj][m][n], 0, 0, 0); __builtin_amdgcn_s_setprio(0); } while (0)
#define PG8_WAIT_V(n) asm volatile("s_waitcnt vmcnt(" #n ")" ::: "memory")
#define PG8_WAIT_L(n) asm volatile("s_waitcnt lgkmcnt(" #n ")" ::: "memory")
#define PG8_BAR __builtin_amdgcn_s_barrier()
#define PG8_SCHED __builtin_amdgcn_sched_barrier(0)
    Unit cur, nxt; int ui = 0;
    if (!S.next(0, cur)) return;
    f32x4 acc[2][2][4][2];
#pragma unroll
    for (int a = 0; a < 2; ++a)
#pragma unroll
        for (int b = 0; b < 2; ++b)
#pragma unroll
            for (int m = 0; m < 4; ++m)
#pragma unroll
                for (int n = 0; n < 2; ++n) acc[a][b][m][n] = (f32x4){0.f, 0.f, 0.f, 0.f};
    bf16x8 At[4][2], B0[2][2], B1[2][2];
    const char* cA = (const char*)g.A + (size_t)cur.pm * tstep; const char* cB = (const char*)g.Bt + (size_t)cur.pn * tstep;
    S.a_ready(cur);
    if constexpr (SP2) {
        PG8_STAGE(PG8_SB(0, 0), cB, voffB); PG8_STAGE(PG8_SB(0, 1), cB + hstep, voffB); PG8_STAGE(PG8_SA(0, 0), cA, voffA); PG8_STAGE(PG8_SA(0, 1), cA + hstep, voffA);
        if (wr == 1) PG8_BAR;
        PG8_WAIT_V(2); PG8_BAR;
        PG8_STAGE(PG8_SB(1, 0), cB + kstep, voffB); PG8_STAGE(PG8_SA(1, 0), cA + kstep, voffA); PG8_STAGE(PG8_SB(1, 1), cB + hstep + kstep, voffB);
        PG8_WAIT_V(6); PG8_BAR;
    } else {
        PG8_STAGE(PG8_SB(0, 0), cB, voffB); PG8_STAGE(PG8_SA(0, 0), cA, voffA); PG8_STAGE(PG8_SB(0, 1), cB + hstep, voffB); PG8_STAGE(PG8_SA(0, 1), cA + hstep, voffA);
        if (wr == 1) PG8_BAR;
        PG8_WAIT_V(4); PG8_BAR;
        PG8_STAGE(PG8_SB(1, 0), cB + kstep, voffB); PG8_STAGE(PG8_SA(1, 0), cA + kstep, voffA); PG8_STAGE(PG8_SB(1, 1), cB + hstep + kstep, voffB);
        PG8_WAIT_V(6); PG8_BAR;
    }
    for (;;) {
        const bool has_next = S.next(ui + 1, nxt);
        const char* nA = has_next ? (const char*)g.A + (size_t)nxt.pm * tstep : cA; const char* nB = has_next ? (const char*)g.Bt + (size_t)nxt.pn * tstep : cB;
        for (int t = 0; t < nt; t += 2) {
            const bool last = (t == nt - 2);
            const char* a1 = cA + (size_t)(t + 1) * kstep;
            const char* a2 = last ? nA : cA + (size_t)(t + 2) * kstep; const char* b2 = last ? nB : cB + (size_t)(t + 2) * kstep;
            const char* a3 = a2 + kstep; const char* b3 = b2 + kstep;
            if (last && has_next) S.a_ready(nxt);
            if constexpr (SP2) {
            PG8_LDB(B0, 0, 0); PG8_LDB(B1, 0, 1); PG8_SCHED; PG8_LDA(At, 0, 0); PG8_STAGE(PG8_SA(1, 1), a1 + hstep, voffA);
            PG8_WAIT_V(8); PG8_WAIT_L(0); PG8_BAR; PG8_MMA(0, 0, At, B0); PG8_MMA(0, 1, At, B1); PG8_BAR; PG8_SCHED;
            PG8_LDA(At, 0, 1); PG8_STAGE(PG8_SB(0, 0), b2, voffB); PG8_STAGE(PG8_SB(0, 1), b2 + hstep, voffB); PG8_STAGE(PG8_SA(0, 0), a2, voffA);
            PG8_WAIT_V(8); PG8_WAIT_L(0); PG8_BAR; PG8_MMA(1, 0, At, B0); PG8_MMA(1, 1, At, B1); PG8_BAR; PG8_SCHED;
            PG8_LDB(B0, 1, 0); PG8_LDB(B1, 1, 1); PG8_SCHED; PG8_LDA(At, 1, 0); PG8_STAGE(PG8_SA(0, 1), a2 + hstep, voffA);
            PG8_WAIT_V(8); PG8_WAIT_L(0); PG8_BAR; PG8_MMA(0, 0, At, B0); PG8_MMA(0, 1, At, B1); PG8_BAR; PG8_SCHED;
            PG8_LDA(At, 1, 1); PG8_STAGE(PG8_SB(1, 0), b3, voffB); PG8_STAGE(PG8_SB(1, 1), b3 + hstep, voffB); PG8_STAGE(PG8_SA(1, 0), a3, voffA);
            PG8_WAIT_V(8); PG8_WAIT_L(0); PG8_BAR; PG8_MMA(1, 0, At, B0); PG8_MMA(1, 1, At, B1); PG8_BAR; PG8_SCHED;
            } else {
            PG8_LDB(B0, 0, 0); PG8_SCHED; PG8_LDA(At, 0, 0); PG8_STAGE(PG8_SA(1, 1), a1 + hstep, voffA);
            PG8_WAIT_L(8); PG8_BAR; PG8_WAIT_L(0); PG8_MMA(0, 0, At, B0); PG8_BAR; PG8_SCHED;
            PG8_LDB(B1, 0, 1); PG8_STAGE(PG8_SB(0, 0), b2, voffB);
            PG8_BAR; PG8_WAIT_L(0); PG8_MMA(0, 1, At, B1); PG8_BAR;
            PG8_LDA(At, 0, 1); PG8_STAGE(PG8_SA(0, 0), a2, voffA);
            PG8_BAR; PG8_WAIT_L(0); PG8_MMA(1, 0, At, B0); PG8_BAR; PG8_SCHED;
            PG8_STAGE(PG8_SB(0, 1), b2 + hstep, voffB);
            PG8_WAIT_V(6); PG8_BAR; PG8_MMA(1, 1, At, B1); PG8_BAR;
            PG8_LDB(B0, 1, 0); PG8_SCHED; PG8_LDA(At, 1, 0); PG8_STAGE(PG8_SA(0, 1), a2 + hstep, voffA);
            PG8_WAIT_L(8); PG8_BAR; PG8_WAIT_L(0); PG8_MMA(0, 0, At, B0); PG8_BAR; PG8_SCHED;
            PG8_LDB(B1, 1, 1); PG8_STAGE(PG8_SB(1, 0), b3, voffB);
            PG8_BAR; PG8_WAIT_L(0); PG8_MMA(0, 1, At, B1); PG8_BAR;
            PG8_LDA(At, 1, 1); PG8_STAGE(PG8_SA(1, 0), a3, voffA);
            PG8_BAR; PG8_WAIT_L(0); PG8_MMA(1, 0, At, B0); PG8_BAR; PG8_SCHED;
            PG8_STAGE(PG8_SB(1, 1), b3 + hstep, voffB);
            PG8_WAIT_V(6); PG8_BAR; PG8_MMA(1, 1, At, B1); PG8_BAR;
            }
        }
        if constexpr (ALIGN_EPI) { if (wr == 0) PG8_BAR; }
        if constexpr (!Epi::AFTER_DRAIN) { E(acc, cur, wr, wc, fr, fq); S.done(cur); }
        if (!has_next) break;
#pragma unroll
        for (int a = 0; a < 2; ++a)
#pragma unroll
            for (int b = 0; b < 2; ++b)
#pragma unroll
                for (int m = 0; m < 4; ++m)
#pragma unroll
                    for (int n = 0; n < 2; ++n) acc[a][b][m][n] = (f32x4){0.f, 0.f, 0.f, 0.f};
        cur = nxt; cA = nA; cB = nB; ++ui;
        if constexpr (ALIGN_EPI) { if (wr == 1) PG8_BAR; }
    }
    PG8_WAIT_V(0);
    if constexpr (!ALIGN_EPI) { if (wr == 0) PG8_BAR; }
    PG8_BAR;
    if constexpr (Epi::AFTER_DRAIN) { E.fused(acc, cur, wr, wc, fr, fq, lds, wid, lane); S.done(cur); }
#undef PG8_SA
#undef PG8_SB
#undef PG8_STAGE
#undef PG8_LDA
#undef PG8_LDB
#undef PG8_MMA
#undef PG8_WAIT_V
#undef PG8_WAIT_L
#undef PG8_BAR
#undef PG8_SCHED
}
}
constexpr int NWAVES = 8;
constexpr int D = 1024, TP = 8192, MP = 16384, MS = 256, M = MP + MS, FF = 4096, NIN = 3328, NIN_REAL = 3088, NMODR = 34, MODW = 6144;
constexpr float NORM_EPS = 1e-6f;
constexpr float QSCALE = 0.125f * 1.4426950408889634f;
constexpr size_t OY = 0, OK_P = 17039360, OV_P = 25427968, OSG_P = 33816576, OK_S = 33882112, OV_S = 34013184, OSG_S = 34144256, OUT_TOTAL = 35192832;
constexpr size_t MiB = 1u << 20;
constexpr size_t WS_CTL = 0, CTL_ZERO_BYTES = 1 * MiB;
constexpr size_t WS_MOD = 1 * MiB, WS_WIN = 2 * MiB, WS_WO = 9 * MiB, WS_WUP = 11 * MiB, WS_WDN = 19 * MiB;
constexpr size_t WS_SLOC = 27 * MiB, WS_DSEG = 35 * MiB, WS_DPART = 36 * MiB, WS_DRTOT = 40 * MiB;
constexpr size_t WS_XN = 48 * MiB, WS_Q = 82 * MiB, WS_K = 99 * MiB, WS_V = 116 * MiB, WS_G = 133 * MiB, WS_MIX = 190 * MiB, WS_X1 = 224 * MiB, WS_H = 290 * MiB, WS_END = 421 * MiB;
static_assert(WS_WIN + (size_t)NIN * D * 2 <= WS_WO && WS_G + (size_t)M * 1792 * 2 <= WS_MIX && WS_MIX + (size_t)M * D * 2 <= WS_X1 && WS_X1 + (size_t)M * D * 4 <= WS_H && WS_H + (size_t)M * FF * 2 <= WS_END, "d_ws map");
static_assert(WS_XN + (size_t)M * D * 2 <= WS_Q && WS_Q + (size_t)M * 512 * 2 <= WS_K && WS_K + (size_t)M * 512 * 2 <= WS_V && WS_V + (size_t)M * 512 * 2 <= WS_G, "d_ws map 2");
constexpr int CW_BAR = 4096, CW_DEC = 16384;
constexpr int RING_BYTES = 139264, MISC_OFF = 146944, LDS_BYTES = 147456;

#define GAS __attribute__((address_space(1)))
#define LAS __attribute__((address_space(3)))
typedef unsigned short bf16;
typedef unsigned v4u __attribute__((ext_vector_type(4)));
typedef float f32x4 __attribute__((ext_vector_type(4)));
#define LDS_WAIT() asm volatile("s_waitcnt lgkmcnt(0)" ::: "memory")
__device__ __forceinline__ unsigned f2bf(float f) { unsigned u = __builtin_bit_cast(unsigned, f); return (u + 0x7fffu + ((u >> 16) & 1u)) >> 16; }
__device__ __forceinline__ unsigned pk2(float lo, float hi) { return f2bf(lo) | (f2bf(hi) << 16); }
#define XB_TMO      128
#define XB_XCNT(j)  (256  + 64 * (j))
#define XB_XSUB(j)  (1280 + 64 * (j))
#define XB_XGEN(j)  (2304 + 64 * (j))
#define XB_TOP      3328
#define XB_TOPGEN   3392
#define XCD_BAR_WORDS 3456
#define XB_SPIN_CAP (1u << 18)

__device__ __forceinline__ unsigned xb_ld(unsigned* p)              { return __hip_atomic_load(p, __ATOMIC_RELAXED, __HIP_MEMORY_SCOPE_AGENT); }
__device__ __forceinline__ unsigned xb_add(unsigned* p, unsigned v) { return __hip_atomic_fetch_add(p, v, __ATOMIC_RELAXED, __HIP_MEMORY_SCOPE_AGENT); }
__device__ __forceinline__ unsigned xb_xcc_id() { return (unsigned)__builtin_amdgcn_s_getreg((3 << 11) | 20) & 0xFu; }
#define XB_SPIN(cond, bar) do { unsigned _sp = 0; while (cond) { __builtin_amdgcn_s_sleep(1); \
    if ((++_sp & 255u) == 0u) { if (xb_ld(&(bar)[XB_TMO])) break; if (_sp > XB_SPIN_CAP) { atomicAdd(&(bar)[XB_TMO], 1u); break; } } } } while (0)

struct XcdBarrier {
    unsigned* bar; unsigned x;
    volatile LAS unsigned* st;
};

__device__ __forceinline__ XcdBarrier xcd_barrier_post(unsigned* bar, volatile LAS unsigned* st) {
    XcdBarrier b; b.bar = bar; b.x = xb_xcc_id(); b.st = st;
    if (threadIdx.x == 0) (void)xb_add(&bar[XB_XCNT(b.x)], 1u);
    return b;
}
__device__ __forceinline__ void xcd_barrier_complete(unsigned* bar, unsigned x, unsigned& nloc, unsigned& nx) {
    const unsigned G = gridDim.x * gridDim.y * gridDim.z;
    unsigned sum, cnt, mine, sp = 0u;
    for (;;) {
        sum = 0u; cnt = 0u; mine = 0u;
#pragma unroll
        for (unsigned j = 0; j < 16; ++j) { const unsigned c = xb_ld(&bar[XB_XCNT(j)]); sum += c; cnt += (c > 0u) ? 1u : 0u; mine = (j == x) ? c : mine; }
        if (sum == G) break;
        __builtin_amdgcn_s_sleep(1);
        if ((++sp & 255u) == 0u) { if (xb_ld(&bar[XB_TMO])) break; if (sp > XB_SPIN_CAP) { atomicAdd(&bar[XB_TMO], 1u); break; } }
    }
    nloc = mine > 0u ? mine : 1u; nx = cnt > 0u ? cnt : 1u;
}

__device__ __forceinline__ void xcd_barrier(const XcdBarrier& b) {
    asm volatile("s_waitcnt vmcnt(0)" ::: "memory");
    __syncthreads();
    if (threadIdx.x == 0) {
        unsigned* bar = b.bar;
        __builtin_amdgcn_s_waitcnt(0);
        unsigned nloc = b.st[0], nx = b.st[1];
        if (nloc == 0u) { xcd_barrier_complete(bar, b.x, nloc, nx); b.st[0] = nloc; b.st[1] = nx; }
        const unsigned old = xb_add(&bar[XB_XSUB(b.x)], 1u);
        const unsigned gen = old / nloc;
        if (old + 1u == (gen + 1u) * nloc) {
            __builtin_amdgcn_fence(__ATOMIC_RELEASE, "agent");
            asm volatile("s_waitcnt vmcnt(0)" ::: "memory");
            const unsigned og = xb_add(&bar[XB_TOP], 1u);
            const unsigned tg = og / nx;
            if (og + 1u == (tg + 1u) * nx) xb_add(&bar[XB_TOPGEN], 1u);
            else XB_SPIN(xb_ld(&bar[XB_TOPGEN]) == tg, bar);
            __builtin_amdgcn_fence(__ATOMIC_ACQUIRE, "agent");
            xb_add(&bar[XB_XGEN(b.x)], 1u);
            asm volatile("s_waitcnt vmcnt(0)" ::: "memory");
        } else {
            XB_SPIN(xb_ld(&bar[XB_XGEN(b.x)]) == gen, bar);
            __builtin_amdgcn_fence(__ATOMIC_ACQUIRE, "agent");
            asm volatile("s_waitcnt vmcnt(0)" ::: "memory");
        }
    }
    __syncthreads();
}
namespace sba {
using bf16x8=__attribute__((ext_vector_type(8)))short;
using s16x4=__attribute__((ext_vector_type(4)))short;
using f32x16=__attribute__((ext_vector_type(16)))float;
using u32x4=__attribute__((ext_vector_type(4)))unsigned;
typedef __hip_bfloat16 bf16;
constexpr int SEQ=8192,D=64,DM=512,OP=1024;
constexpr int NW=8,QBLK=32,QB=QBLK*NW,KVBLK=64;
constexpr int NSLOT=3,SLOTB=8192;
constexpr int LDS_K=0,LDS_V=NSLOT*SLOTB,LDS_OST=2*NSLOT*SLOTB,LDS_BYTES=LDS_OST+NW*4096;
__device__ __forceinline__ int crow(int r,int hi){return (r&3)+8*(r>>2)+4*hi;}
__device__ __forceinline__ void glds16(const void*gsrc,unsigned lds_dst){unsigned keep;
  asm volatile("s_mov_b32 %0, m0\n\ts_mov_b32 m0, %2\n\ts_nop 0\n\tglobal_load_lds_dwordx4 %1, off\n\ts_mov_b32 m0, %0":"=&s"(keep):"v"(gsrc),"s"(lds_dst):"memory");}
typedef float f32x2_t __attribute__((ext_vector_type(2))); typedef __bf16 bf16x2_t __attribute__((ext_vector_type(2)));
__device__ __forceinline__ unsigned cvtpk_s(float lo,float hi){f32x2_t v={lo,hi};bf16x2_t b=__builtin_convertvector(v,bf16x2_t);return __builtin_bit_cast(unsigned,b);}
typedef __attribute__((address_space(3))) const char* lds_cptr;
typedef short v4i16_t __attribute__((ext_vector_type(4)));
__device__ __forceinline__ s16x4 vtr(lds_cptr p){ return __builtin_bit_cast(s16x4,__builtin_amdgcn_ds_read_tr16_b64_v4i16((__attribute__((address_space(3))) v4i16_t*)p)); }
#define SBA_MFMA(a,b,c) __builtin_amdgcn_mfma_f32_32x32x16_bf16((a),(b),(c),0,0,0)
template<bool MASK> __device__ __forceinline__ void sb_weights(f32x16&c0,f32x16&c1,float&carry,int hi,int jb,int qrel){
  f32x16 r0,r1;
  #pragma unroll
  for(int r=0;r<16;++r){
    float e0=__builtin_amdgcn_exp2f(fminf(c0[r],64.f)), e1=__builtin_amdgcn_exp2f(fminf(c1[r],64.f));
    float q0=__builtin_amdgcn_rcpf(1.f+e0), q1=__builtin_amdgcn_rcpf(1.f+e1);
    if(MASK){ const int kv=64*jb+crow(r,hi); if(kv>=qrel){e0=0.f;q0=1.f;} if(kv+32>=qrel){e1=0.f;q1=1.f;} }
    c0[r]=e0;c1[r]=e1;r0[r]=q0;r1[r]=q1; }
  float T[8];
  #pragma unroll
  for(int c=0;c<4;++c){ r0[4*c+2]*=r0[4*c+3]; r0[4*c+1]*=r0[4*c+2]; r0[4*c]*=r0[4*c+1]; T[c]=r0[4*c];
                        r1[4*c+2]*=r1[4*c+3]; r1[4*c+1]*=r1[4*c+2]; r1[4*c]*=r1[4*c+1]; T[4+c]=r1[4*c]; }
  float Tl[8],Th[8];
  #pragma unroll
  for(int c=0;c<8;++c){ auto rr=__builtin_amdgcn_permlane32_swap(__float_as_uint(T[c]),__float_as_uint(T[c]),false,false); Tl[c]=__uint_as_float(rr[0]); Th[c]=__uint_as_float(rr[1]); }
  float E=carry;
  float off[8];
  #pragma unroll
  for(int c=7;c>=0;--c){ off[c]=hi?E:E*Th[c]; E=E*(Tl[c]*Th[c]); }
  carry=E;
  #pragma unroll
  for(int r=0;r<16;++r){ c0[r]=c0[r]*(r0[r]*off[r>>2]); c1[r]=c1[r]*(r1[r]*off[4+(r>>2)]); }
}
__device__ __forceinline__ void pv(f32x16*o,lds_cptr vp,const f32x16&w0,const f32x16&w1){
  u32x4 pw[4];
  #pragma unroll
  for(int k=0;k<2;++k)
    #pragma unroll
    for(int j=0;j<4;++j){ pw[k][j]=cvtpk_s(w0[8*k+2*j],w0[8*k+2*j+1]); pw[2+k][j]=cvtpk_s(w1[8*k+2*j],w1[8*k+2*j+1]); }
  #pragma unroll
  for(int d0=0;d0<2;++d0)
    #pragma unroll
    for(int ks=0;ks<4;++ks){ const s16x4 lo=vtr(vp+d0*4096+ks*1024), hh=vtr(vp+d0*4096+ks*1024+512);
      const bf16x8 vf={lo[0],lo[1],lo[2],lo[3],hh[0],hh[1],hh[2],hh[3]};
      o[d0]=SBA_MFMA(__builtin_bit_cast(bf16x8,pw[ks]),vf,o[d0]); }
}
__device__ __forceinline__ void attn_unit(int b,int h,int qb,const bf16*Q,const bf16*__restrict__ K,const bf16*__restrict__ V,bf16*O,char*shm,float bias2){
  int tid_=threadIdx.x; asm volatile("":"+v"(tid_)); const int tid=tid_,lane=tid&63,r32=lane&31,hi=lane>>5; const int wid=__builtin_amdgcn_readfirstlane(tid>>6);
  const long rowbase=(long)b*SEQ; const int q0=qb*QB;
  const bf16*Qw=Q+(rowbase+q0+wid*QBLK)*DM+h*D;
  const bf16*Kh=K+rowbase*DM+h*D,*Vh=V+rowbase*DM+h*D;
  const unsigned lds0=(unsigned)(uintptr_t)shm;
  const bf16*ksrc=Kh+(long)lane*DM+wid*8;
  const bf16*vsrc=Vh+(long)(16*(wid&3)+(lane>>2))*DM+(wid>>2)*32+(lane&3)*8;
  const unsigned kdst=lds0+LDS_K+wid*1024, vdst=lds0+LDS_V+wid*1024;
  const int NT=(q0+QB)/KVBLK;
  #define DMA_KV(s_,slot_) do{ const long t_=(long)(NT-1-(s_))*KVBLK*DM; glds16(ksrc+t_,(unsigned)__builtin_amdgcn_readfirstlane(kdst+(slot_)*SLOTB)); glds16(vsrc+t_,(unsigned)__builtin_amdgcn_readfirstlane(vdst+(slot_)*SLOTB)); }while(0)
  bf16x8 qr[4];
  #pragma unroll
  for(int d0=0;d0<4;++d0)qr[d0]=*reinterpret_cast<const bf16x8*>(&Qw[(long)r32*DM+d0*16+hi*8]);
  DMA_KV(0,0); DMA_KV(1,1);
  const lds_cptr shm3=(lds_cptr)shm; const lds_cptr kp0=shm3+LDS_K+hi*1024+r32*16; const lds_cptr vp0=shm3+LDS_V+((lane>>4)&1)*32+(lane&3)*8+(4*hi+((lane&15)>>2))*64;
  f32x16 o[2];o[0]=f32x16{};o[1]=f32x16{}; f32x16 bv;
  #pragma unroll
  for(int r=0;r<16;++r)bv[r]=bias2;
  asm volatile("":"+v"(bv));
  float carry=1.f; const int qrel=wid*QBLK+r32;
  int slot=0;
  for(int s=0;s<NT;++s){
    if(s+1<NT) asm volatile("s_waitcnt vmcnt(2) lgkmcnt(0)\n\ts_barrier":::"memory"); else asm volatile("s_waitcnt vmcnt(0) lgkmcnt(0)\n\ts_barrier":::"memory");
    if(s+2<NT){ const int ns=(slot==0)?2:slot-1; DMA_KV(s+2,ns); }
    const lds_cptr kp=kp0+slot*SLOTB;
    f32x16 c0=bv,c1=bv;
    #pragma unroll
    for(int d0=0;d0<4;++d0){
      const bf16x8 k0=*(const __attribute__((address_space(3))) bf16x8*)(kp+d0*2048), k1=*(const __attribute__((address_space(3))) bf16x8*)(kp+d0*2048+512);
      c0=SBA_MFMA(k0,qr[d0],c0); c1=SBA_MFMA(k1,qr[d0],c1); }
    if(s<4) sb_weights<true>(c0,c1,carry,hi,3-s,qrel); else sb_weights<false>(c0,c1,carry,hi,0,0);
    pv(o,vp0+slot*SLOTB,c0,c1);
    slot=(slot==2)?0:slot+1;
  }
  #undef DMA_KV
  bf16*Ow=O+(rowbase+q0+wid*QBLK)*OP+h*D;
  { bf16*stg=(bf16*)(shm+LDS_OST)+wid*2048;
    #pragma unroll
    for(int r=0;r<16;++r){const int orow=crow(r,hi);
      #pragma unroll
      for(int d0=0;d0<2;++d0)stg[orow*64+d0*32+r32]=__float2bfloat16(o[d0][r]);}
    asm volatile("s_waitcnt lgkmcnt(0)":::"memory");
    #pragma unroll
    for(int i=0;i<4;++i){const int row=i*8+(lane>>3),ch=lane&7; const u32x4 v=*(const u32x4*)(stg+row*64+ch*8); *(u32x4*)(Ow+(long)row*OP+ch*8)=v;} }
  asm volatile("s_waitcnt vmcnt(0) lgkmcnt(0)\n\ts_barrier":::"memory");
}
}
namespace sbd {
using sba::bf16x8; using sba::f32x16; using sba::u32x4; using sba::bf16; using sba::crow; using sba::cvtpk_s;
typedef float f32x4 __attribute__((ext_vector_type(4)));
#define RLXA __ATOMIC_RELAXED, __HIP_MEMORY_SCOPE_AGENT
template<bool NEWK> __device__ __forceinline__ void weights32(f32x16&c,float&carry,int hi,int q){
  f32x16 rr;
  #pragma unroll
  for(int r=0;r<16;++r){ float e=__builtin_amdgcn_exp2f(fminf(c[r],64.f)); float x=__builtin_amdgcn_rcpf(1.f+e);
    if(NEWK){ const int kv=crow(r,hi); if(kv>=8||kv>=q){e=0.f;x=1.f;} }
    c[r]=e; rr[r]=x; }
  float T[4],Tl[4],Th[4],off[4];
  #pragma unroll
  for(int k=0;k<4;++k){ rr[4*k+2]*=rr[4*k+3]; rr[4*k+1]*=rr[4*k+2]; rr[4*k]*=rr[4*k+1]; T[k]=rr[4*k]; }
  #pragma unroll
  for(int k=0;k<4;++k){ auto s=__builtin_amdgcn_permlane32_swap(__float_as_uint(T[k]),__float_as_uint(T[k]),false,false); Tl[k]=__uint_as_float(s[0]); Th[k]=__uint_as_float(s[1]); }
  float E=carry;
  #pragma unroll
  for(int k=3;k>=0;--k){ off[k]=hi?E:E*Th[k]; E=E*(Tl[k]*Th[k]); }
  carry=E;
  #pragma unroll
  for(int r=0;r<16;++r) c[r]=c[r]*(rr[r]*off[r>>2]);
}
struct Raw { f32x4 k[8]; float v[32]; };
__device__ __forceinline__ void load_tile(Raw&R,const float*kb,const float*vb){
  #pragma unroll
  for(int d0=0;d0<4;++d0){ R.k[2*d0]=__builtin_nontemporal_load((const f32x4*)(kb+16*d0)); R.k[2*d0+1]=__builtin_nontemporal_load((const f32x4*)(kb+16*d0+4)); }
  #pragma unroll
  for(int d0=0;d0<2;++d0)
    #pragma unroll
    for(int ks=0;ks<2;++ks)
      #pragma unroll
      for(int j=0;j<8;++j) R.v[(d0*2+ks)*8+j]=__builtin_nontemporal_load(vb+(size_t)(16*ks+8*(j>>2)+(j&3))*512+32*d0);
}
struct Frag { bf16x8 k[4]; bf16x8 v[4]; };
__device__ __forceinline__ void cvt_tile(Frag&F,const Raw&R){
  #pragma unroll
  for(int d0=0;d0<4;++d0){ u32x4 p; p[0]=cvtpk_s(R.k[2*d0][0],R.k[2*d0][1]); p[1]=cvtpk_s(R.k[2*d0][2],R.k[2*d0][3]); p[2]=cvtpk_s(R.k[2*d0+1][0],R.k[2*d0+1][1]); p[3]=cvtpk_s(R.k[2*d0+1][2],R.k[2*d0+1][3]); F.k[d0]=__builtin_bit_cast(bf16x8,p); }
  #pragma unroll
  for(int i=0;i<4;++i){ u32x4 p;
    #pragma unroll
    for(int j=0;j<4;++j) p[j]=cvtpk_s(R.v[8*i+2*j],R.v[8*i+2*j+1]);
    F.v[i]=__builtin_bit_cast(bf16x8,p); }
}
template<bool NEWK> __device__ __forceinline__ void tile_step(const Frag&F,const bf16x8*qr,const f32x16&bv,f32x16*o,float&carry,int hi,int q){
  f32x16 c=bv;
  #pragma unroll
  for(int d0=0;d0<4;++d0) c=SBA_MFMA(F.k[d0],qr[d0],c);
  weights32<NEWK>(c,carry,hi,q);
  u32x4 pw[2];
  #pragma unroll
  for(int k=0;k<2;++k)
    #pragma unroll
    for(int j=0;j<4;++j) pw[k][j]=cvtpk_s(c[8*k+2*j],c[8*k+2*j+1]);
  #pragma unroll
  for(int d0=0;d0<2;++d0)
    #pragma unroll
    for(int ks=0;ks<2;++ks) o[d0]=SBA_MFMA(__builtin_bit_cast(bf16x8,pw[ks]),F.v[d0*2+ks],o[d0]);
}
__device__ __forceinline__ void decode_unit(int smp,int j,const float*cache_k,const float*cache_v,const int*page_table,const bf16*Q,const bf16*Kn,const bf16*Vn,const float*b_sb,
                                            float*part,float*rtot,unsigned*cnt,bf16*MIX,volatile __attribute__((address_space(3))) unsigned*flag){
  int tid_=threadIdx.x; asm volatile("":"+v"(tid_)); const int tid=tid_,lane=tid&63,r32=lane&31,hi=lane>>5; const int h=__builtin_amdgcn_readfirstlane(tid>>6);
  const float bias2=b_sb[h]*1.4426950408889634f;
  f32x16 bv;
  #pragma unroll
  for(int r=0;r<16;++r)bv[r]=bias2;
  const long srow=16384+8*smp;
  bf16x8 qr[4];
  #pragma unroll
  for(int d0=0;d0<4;++d0){ bf16x8 z={0,0,0,0,0,0,0,0}; if(r32<8) z=*reinterpret_cast<const bf16x8*>(Q+(srow+r32)*512+h*64+d0*16+hi*8); qr[d0]=z; }
  f32x16 o[2]; o[0]=f32x16{}; o[1]=f32x16{}; float carry=1.f;
  if(j==7){
    Frag F;
    #pragma unroll
    for(int d0=0;d0<4;++d0){ bf16x8 z={0,0,0,0,0,0,0,0}; if(r32<8) z=*reinterpret_cast<const bf16x8*>(Kn+(srow+r32)*512+h*64+d0*16+hi*8); F.k[d0]=z; }
    #pragma unroll
    for(int d0=0;d0<2;++d0){
      bf16x8 z={0,0,0,0,0,0,0,0};
      #pragma unroll
      for(int jj=0;jj<4;++jj) z[jj]=*reinterpret_cast<const short*>(Vn+(srow+4*hi+jj)*512+h*64+32*d0+r32);
      F.v[d0*2]=z; F.v[d0*2+1]=(bf16x8){0,0,0,0,0,0,0,0}; }
    tile_step<true>(F,qr,bv,o,carry,hi,r32);
  }
  const int*pt=page_table+smp*64+8*j;
  Raw R; Frag F;
  #define ROWK(tt) (cache_k+(((size_t)pt[(tt)>>2]*128+(size_t)(((tt)&3)*32+r32))*8+h)*64+8*hi)
  #define ROWV(tt) (cache_v+(((size_t)pt[(tt)>>2]*128+(size_t)(((tt)&3)*32+4*hi))*8+h)*64+r32)
  load_tile(R,ROWK(31),ROWV(31)); cvt_tile(F,R);
  for(int tt=31;tt>=0;--tt){
    if(tt>0) load_tile(R,ROWK(tt-1),ROWV(tt-1));
    tile_step<false>(F,qr,bv,o,carry,hi,r32);
    if(tt>0) cvt_tile(F,R);
  }
  #undef ROWK
  #undef ROWV
  const int unit=smp*8+j;
  int l2_=threadIdx.x; asm volatile("":"+v"(l2_)); const int lane2=l2_&63, r32b=lane2&31, hib=lane2>>5;
  unsigned*pp=(unsigned*)part+((size_t)unit*8+h)*512;
  #pragma unroll
  for(int r=0;r<4;++r)
    #pragma unroll
    for(int d0=0;d0<2;++d0) __hip_atomic_store(pp+(r+4*hib)*64+32*d0+r32b,__float_as_uint(o[d0][r]),RLXA);
  if(lane2<8) __hip_atomic_store((unsigned*)rtot+((size_t)unit*8+h)*8+lane2,__float_as_uint(carry),RLXA);
  asm volatile("s_waitcnt vmcnt(0)":::"memory");
  __syncthreads();
  if(tid==0){ const unsigned old=__hip_atomic_fetch_add(cnt+64*smp,1u,RLXA); flag[0]=(old==7u)?1u:0u; }
  __syncthreads();
  const bool last=flag[0]!=0u;
  __syncthreads();
  if(last){
    const int q=lane2>>3,dc=(lane2&7)*8; float acc[8];
    #pragma unroll
    for(int i=0;i<8;++i)acc[i]=0.f;
    float f=1.f;
    for(int jj=7;jj>=0;--jj){ const size_t u=(size_t)smp*8+jj; const unsigned*src=(const unsigned*)part+(u*8+h)*512+q*64+dc;
      #pragma unroll
      for(int i=0;i<8;++i) acc[i]+=f*__uint_as_float(__hip_atomic_load(src+i,RLXA));
      f*=__uint_as_float(__hip_atomic_load((const unsigned*)rtot+(u*8+h)*8+q,RLXA)); }
    u32x4 w; w[0]=cvtpk_s(acc[0],acc[1]); w[1]=cvtpk_s(acc[2],acc[3]); w[2]=cvtpk_s(acc[4],acc[5]); w[3]=cvtpk_s(acc[6],acc[7]);
    *(u32x4*)(MIX+(srow+q)*1024+h*64+dc)=w;
  }
}
}
namespace gla {
using sba::bf16; using sba::cvtpk_s;
typedef short bf16x8 __attribute__((ext_vector_type(8)));
typedef short bf16x4 __attribute__((ext_vector_type(4)));
typedef float f32x4 __attribute__((ext_vector_type(4)));
typedef unsigned u32x4 __attribute__((ext_vector_type(4)));
typedef unsigned u32x2 __attribute__((ext_vector_type(2)));
#define GLAS __attribute__((address_space(3)))
constexpr int GP=1792;
constexpr int L_QD=0,L_KI=9216,L_KET=18432,L_VT=27648,L_DEC=46080,L_EXR=46336,L_TOT=46592,L_SSQ=48640,L_END=50688;
#define GMFMA(a,b,c) __builtin_amdgcn_mfma_f32_16x16x32_bf16((a),(b),(c),0,0,0)
__device__ __forceinline__ float bf2f(short s){ return __uint_as_float(((unsigned)(unsigned short)s)<<16); }
__device__ __forceinline__ short f2bf(float f){ return (short)(cvtpk_s(f,0.f)&0xffffu); }
template<int MODE> __device__ __forceinline__ void chunk(const bf16*G,bf16*MIX,long m0,int ntok,int h,GLAS char*L,f32x4(&S)[4],const float(&wg)[16],float bg,float gain,float&dseg){
  int tid_=threadIdx.x; asm volatile("":"+v"(tid_)); const int tid=tid_,lane=tid&63,c=lane,fr=lane&15,fq=lane>>4; const int w=__builtin_amdgcn_readfirstlane(tid>>6); const int g=w;
  const short*Gs=(const short*)G;
  float bl[8]; float run=0.f;
  #pragma unroll
  for(int i=0;i<8;++i){ const int t=8*g+i; float la=0.f;
    if(t<ntok){ const bf16x8*ap=(const bf16x8*)(Gs+(m0+t)*GP+1536); const bf16x8 a0=ap[0],a1=ap[1]; float x=bg;
      #pragma unroll
      for(int j=0;j<8;++j){ x+=bf2f(a0[j])*wg[j]; x+=bf2f(a1[j])*wg[8+j]; }
      la=(fminf(x,0.f)-__logf(1.f+__expf(-fabsf(x))))*0.0625f; }
    run+=la; bl[i]=run; }
  GLAS float*TOT=(GLAS float*)(L+L_TOT);
  TOT[g*64+c]=run;
  __syncthreads();
  float prefix=0.f,total=0.f;
  #pragma unroll
  for(int gg=0;gg<8;++gg){ const float v=TOT[gg*64+c]; total+=v; if(gg<g)prefix+=v; }
  const float bref=0.5f*total;
  float ke[8];
  #pragma unroll
  for(int i=0;i<8;++i){ const int t=8*g+i; const float b=prefix+bl[i]; float kk=0.f,qq=0.f;
    if(t<ntok){ kk=bf2f(Gs[(m0+t)*GP+256+64*h+c]); if(MODE==1) qq=bf2f(Gs[(m0+t)*GP+64*h+c]); }
    ke[i]=kk*__expf(total-b);
    if(MODE==1){ *(GLAS short*)(L+L_QD+t*144+c*2)=f2bf(qq*0.125f*__expf(b-bref)); *(GLAS short*)(L+L_KI+t*144+c*2)=f2bf(kk*__expf(bref-b)); } }
  { u32x4 p; p[0]=cvtpk_s(ke[0],ke[1]); p[1]=cvtpk_s(ke[2],ke[3]); p[2]=cvtpk_s(ke[4],ke[5]); p[3]=cvtpk_s(ke[6],ke[7]); *(GLAS u32x4*)(L+L_KET+c*144+g*16)=p; }
  if(g==0){ const float d=__expf(total); ((GLAS float*)(L+L_DEC))[c]=d; ((GLAS float*)(L+L_EXR))[c]=__expf(bref); dseg*=d; }
  { const int dv=tid&127,tg=tid>>7; float vv[16];
    #pragma unroll
    for(int i=0;i<16;++i){ const int t=16*tg+i; vv[i]=(t<ntok)?bf2f(Gs[(m0+t)*GP+512+128*h+dv]):0.f; }
    u32x4 p0,p1;
    #pragma unroll
    for(int j=0;j<4;++j){ p0[j]=cvtpk_s(vv[2*j],vv[2*j+1]); p1[j]=cvtpk_s(vv[8+2*j],vv[8+2*j+1]); }
    *(GLAS u32x4*)(L+L_VT+dv*144+tg*32)=p0; *(GLAS u32x4*)(L+L_VT+dv*144+tg*32+16)=p1; }
  __syncthreads();
  const int dvl=16*w+fr;
  f32x4 O[4];
  if(MODE==1){
    f32x4 PT[4][4];
    #pragma unroll
    for(int st=0;st<4;++st)
      #pragma unroll
      for(int tt=0;tt<4;++tt){ f32x4 acc={0.f,0.f,0.f,0.f};
        if(st<=tt){
          #pragma unroll
          for(int kk=0;kk<2;++kk){ const bf16x8 a=*(GLAS const bf16x8*)(L+L_KI+(16*st+fr)*144+(32*kk+8*fq)*2), b=*(GLAS const bf16x8*)(L+L_QD+(16*tt+fr)*144+(32*kk+8*fq)*2); acc=GMFMA(a,b,acc); }
          if(st==tt){
            #pragma unroll
            for(int i=0;i<4;++i) if(4*fq+i>fr) acc[i]=0.f; } }
        PT[st][tt]=acc; }
    #pragma unroll
    for(int tt=0;tt<4;++tt){ O[tt]=(f32x4){0.f,0.f,0.f,0.f};
      #pragma unroll
      for(int pr=0;pr<2;++pr){ if(2*pr<=tt){
        u32x4 pa; pa[0]=cvtpk_s(PT[2*pr][tt][0],PT[2*pr][tt][1]); pa[1]=cvtpk_s(PT[2*pr][tt][2],PT[2*pr][tt][3]); pa[2]=cvtpk_s(PT[2*pr+1][tt][0],PT[2*pr+1][tt][1]); pa[3]=cvtpk_s(PT[2*pr+1][tt][2],PT[2*pr+1][tt][3]);
        const u32x2 b0=*(GLAS const u32x2*)(L+L_VT+dvl*144+(32*pr+4*fq)*2), b1=*(GLAS const u32x2*)(L+L_VT+dvl*144+(32*pr+16+4*fq)*2);
        const u32x4 pb={b0[0],b0[1],b1[0],b1[1]};
        O[tt]=GMFMA(__builtin_bit_cast(bf16x8,pa),__builtin_bit_cast(bf16x8,pb),O[tt]); } } }
    #pragma unroll
    for(int kk=0;kk<2;++kk){
      const f32x4 e0=*(GLAS const f32x4*)(L+L_EXR+(32*kk+4*fq)*4), e1=*(GLAS const f32x4*)(L+L_EXR+(32*kk+16+4*fq)*4);
      const f32x4 s0=S[2*kk]*e0, s1=S[2*kk+1]*e1;
      u32x4 pb; pb[0]=cvtpk_s(s0[0],s0[1]); pb[1]=cvtpk_s(s0[2],s0[3]); pb[2]=cvtpk_s(s1[0],s1[1]); pb[3]=cvtpk_s(s1[2],s1[3]);
      #pragma unroll
      for(int tt=0;tt<4;++tt){ const u32x2 a0=*(GLAS const u32x2*)(L+L_QD+(16*tt+fr)*144+(32*kk+4*fq)*2), a1=*(GLAS const u32x2*)(L+L_QD+(16*tt+fr)*144+(32*kk+16+4*fq)*2);
        const u32x4 pa={a0[0],a0[1],a1[0],a1[1]};
        O[tt]=GMFMA(__builtin_bit_cast(bf16x8,pa),__builtin_bit_cast(bf16x8,pb),O[tt]); } }
  }
  #pragma unroll
  for(int mt=0;mt<4;++mt){ const f32x4 d4=*(GLAS const f32x4*)(L+L_DEC+(16*mt+4*fq)*4); S[mt]=S[mt]*d4;
    #pragma unroll
    for(int kk=0;kk<2;++kk){ const bf16x8 a=*(GLAS const bf16x8*)(L+L_KET+(16*mt+fr)*144+(32*kk+8*fq)*2), b=*(GLAS const bf16x8*)(L+L_VT+dvl*144+(32*kk+8*fq)*2); S[mt]=GMFMA(a,b,S[mt]); } }
  if(MODE==1){
    GLAS float*SSQ=(GLAS float*)(L+L_SSQ);
    #pragma unroll
    for(int tt=0;tt<4;++tt)
      #pragma unroll
      for(int i=0;i<4;++i){ float ss=O[tt][i]*O[tt][i]; ss+=__shfl_xor(ss,1); ss+=__shfl_xor(ss,2); ss+=__shfl_xor(ss,4); ss+=__shfl_xor(ss,8); if(fr==0) SSQ[w*64+16*tt+4*fq+i]=ss; }
    __syncthreads();
    #pragma unroll
    for(int tt=0;tt<4;++tt)
      #pragma unroll
      for(int i=0;i<4;++i){ const int t=16*tt+4*fq+i; float tot=0.f;
        #pragma unroll
        for(int ww=0;ww<8;++ww) tot+=SSQ[ww*64+t];
        if(t<ntok){ const float rstd=rsqrtf(tot*(1.f/128.f)+1e-6f); const float rg=bf2f(Gs[(m0+t)*GP+1024+128*h+dvl]); const float sl=rg/(1.f+__expf(-rg));
          ((short*)MIX)[(m0+t)*1024+512+128*h+dvl]=f2bf(O[tt][i]*rstd*gain*sl); } }
  }
  __syncthreads();
}
__device__ __forceinline__ void load_consts(int h,const float*w_gate,const float*b_gate,const float*g_out,float(&wg)[16],float&bg,float&gain){
  const int lane=threadIdx.x&63, w=threadIdx.x>>6;
  #pragma unroll
  for(int j=0;j<16;++j) wg[j]=w_gate[j*256+64*h+lane];
  bg=b_gate[64*h+lane]; gain=g_out[16*w+(lane&15)];
}
__device__ __forceinline__ void pass1_unit(int unit,const bf16*G,const float*w_gate,const float*b_gate,const float*g_out,float*SLOC,float*DSEG,GLAS char*L){
  const int bh=unit>>5,sseg=unit&31,b=bh>>2,h=bh&3; const int tid=threadIdx.x;
  float wg[16],bg,gain; load_consts(h,w_gate,b_gate,g_out,wg,bg,gain);
  f32x4 S[4];
  #pragma unroll
  for(int mt=0;mt<4;++mt)S[mt]=(f32x4){0.f,0.f,0.f,0.f};
  float dseg=1.f; const long m0=(long)b*8192+256*sseg;
  for(int ch=0;ch<4;++ch) chunk<0>(G,nullptr,m0+64*ch,64,h,L,S,wg,bg,gain,dseg);
  f32x4*dst=(f32x4*)(SLOC+((size_t)unit*512+tid)*16);
  #pragma unroll
  for(int mt=0;mt<4;++mt)dst[mt]=S[mt];
  if(tid<64)DSEG[unit*64+tid]=dseg;
}
__device__ __forceinline__ void pass3_unit(int unit,const bf16*G,bf16*MIX,const float*w_gate,const float*b_gate,const float*g_out,const float*SLOC,const float*DSEG,float*sfin_base,GLAS char*L){
  const int bh=unit>>5,sseg=unit&31,b=bh>>2,h=bh&3; const int tid=threadIdx.x,lane=tid&63,fr=lane&15,fq=lane>>4,w=tid>>6;
  float wg[16],bg,gain; load_consts(h,w_gate,b_gate,g_out,wg,bg,gain);
  f32x4 S[4];
  #pragma unroll
  for(int mt=0;mt<4;++mt)S[mt]=(f32x4){0.f,0.f,0.f,0.f};
  for(int j=0;j<sseg;++j){ const int uj=bh*32+j; const f32x4*src=(const f32x4*)(SLOC+((size_t)uj*512+tid)*16);
    #pragma unroll
    for(int mt=0;mt<4;++mt){ const f32x4 d4=*(const f32x4*)(DSEG+uj*64+16*mt+4*fq); S[mt]=S[mt]*d4+src[mt]; } }
  float dseg=1.f; const long m0=(long)b*8192+256*sseg;
  for(int ch=0;ch<4;++ch) chunk<1>(G,MIX,m0+64*ch,64,h,L,S,wg,bg,gain,dseg);
  if(sseg==31){ float*o=sfin_base+(size_t)bh*8192;
    #pragma unroll
    for(int mt=0;mt<4;++mt)
      #pragma unroll
      for(int i=0;i<4;++i) o[(16*mt+4*fq+i)*128+16*w+fr]=S[mt][i]; }
}
__device__ __forceinline__ void sample_unit(int unit,const bf16*G,bf16*MIX,const float*w_gate,const float*b_gate,const float*g_out,const float*s0,float*sout,GLAS char*L){
  const int smp=unit>>2,h=unit&3; const int tid=threadIdx.x,lane=tid&63,fr=lane&15,fq=lane>>4,w=tid>>6;
  float wg[16],bg,gain; load_consts(h,w_gate,b_gate,g_out,wg,bg,gain);
  f32x4 S[4]; const float*si=s0+(size_t)unit*8192; float*so=sout+(size_t)unit*8192;
  #pragma unroll
  for(int mt=0;mt<4;++mt)
    #pragma unroll
    for(int i=0;i<4;++i) S[mt][i]=si[(16*mt+4*fq+i)*128+16*w+fr];
  float dseg=1.f;
  chunk<1>(G,MIX,16384+8*(long)smp,8,h,L,S,wg,bg,gain,dseg);
  #pragma unroll
  for(int mt=0;mt<4;++mt)
    #pragma unroll
    for(int i=0;i<4;++i) so[(16*mt+4*fq+i)*128+16*w+fr]=S[mt][i];
}
}
__device__ __forceinline__ float wave_sum(float v) {
#pragma unroll
    for (int o = 1; o < 64; o <<= 1) v += __shfl_xor(v, o);
    return v;
}
__device__ __forceinline__ void p0_transpose_item(const float* W, int K, int Nreal, int Npad, bf16* WT, LAS float* scr, int item, int lane) {
    const int nblk = Npad / 32, kb = item / nblk, nb = item % nblk, k0 = 64 * kb, n0 = 32 * nb;
    const int n = n0 + (lane & 31);
#pragma unroll 8
    for (int i = 0; i < 32; ++i) { const int kk = 2 * i + (lane >> 5); scr[kk * 33 + (lane & 31)] = (n < Nreal) ? W[(size_t)(k0 + kk) * Nreal + n] : 0.f; }
    LDS_WAIT(); asm volatile("" ::: "memory");
    const int c = lane & 7;
#pragma unroll
    for (int j = 0; j < 4; ++j) { const int nn = (lane >> 3) + 8 * j; const LAS float* s = scr + (8 * c) * 33 + nn;
        v4u o; o.x = pk2(s[0 * 33], s[1 * 33]); o.y = pk2(s[2 * 33], s[3 * 33]); o.z = pk2(s[4 * 33], s[5 * 33]); o.w = pk2(s[6 * 33], s[7 * 33]);
        *(GAS v4u*)(WT + (size_t)(n0 + nn) * K + k0 + 8 * c) = o; }
    LDS_WAIT(); asm volatile("" ::: "memory");
}
__device__ __forceinline__ void norm_mod_row_bf16(int lane, const float* xrow, const float* gain, const float* sc, const float* sh, bf16* orow) {
    const f32x4* xr = (const f32x4*)xrow + lane; f32x4 v[4]; float s = 0.f;
#pragma unroll
    for (int j = 0; j < 4; ++j) { v[j] = xr[64 * j]; s += (v[j].x * v[j].x + v[j].y * v[j].y) + (v[j].z * v[j].z + v[j].w * v[j].w); }
    const float rstd = rsqrtf(wave_sum(s) * (1.f / D) + NORM_EPS);
    unsigned long long* o8 = (unsigned long long*)orow + lane;
#pragma unroll
    for (int j = 0; j < 4; ++j) { const f32x4 g = ((const f32x4*)gain)[lane + 64 * j], a = ((const f32x4*)sc)[lane + 64 * j], b = ((const f32x4*)sh)[lane + 64 * j];
        const f32x4 y = v[j] * rstd * g * (a + 1.f) + b;
        o8[64 * j] = (unsigned long long)pk2(y.x, y.y) | ((unsigned long long)pk2(y.z, y.w) << 32); }
}
__device__ __forceinline__ void norm_row_f32_inplace(int lane, float* xrow, const float* gain) {
    f32x4* xr = (f32x4*)xrow + lane; f32x4 v[4]; float s = 0.f;
#pragma unroll
    for (int j = 0; j < 4; ++j) { v[j] = xr[64 * j]; s += (v[j].x * v[j].x + v[j].y * v[j].y) + (v[j].z * v[j].z + v[j].w * v[j].w); }
    const float rstd = rsqrtf(wave_sum(s) * (1.f / D) + NORM_EPS);
#pragma unroll
    for (int j = 0; j < 4; ++j) { const f32x4 g = ((const f32x4*)gain)[lane + 64 * j]; xr[64 * j] = v[j] * rstd * g; }
}
__device__ __forceinline__ int bidx_of_row(int m) { return m < MP ? (m >> 13) : 2 + ((m - MP) >> 3); }

struct Args { const float* in[21]; const int* page_table; float* out; unsigned char* ws; };
static_assert(sizeof(Args) == 24 * 8, "Args has no padding");

__global__ void __launch_bounds__(NWAVES * 64, 2) mk_fwd(Args args) {
    extern __shared__ __attribute__((aligned(16))) unsigned char lds[];
    LAS unsigned char* L = (LAS unsigned char*)lds;
    volatile LAS unsigned* MISC = (volatile LAS unsigned*)(L + MISC_OFF);
    const int tid = threadIdx.x, lane = tid & 63, wave = __builtin_amdgcn_readfirstlane(tid >> 6);
    const int G = gridDim.x; const int bx = blockIdx.x; const int vcu = (G % 8 == 0) ? (bx % 8) * (G / 8) + bx / 8 : bx;
    unsigned char* ws = args.ws;
    unsigned* ctl = (unsigned*)(ws + WS_CTL);
    const float *x_prompt = args.in[0], *x_sample = args.in[1], *c_prompt = args.in[2], *c_sample = args.in[3], *cache_k = args.in[4], *cache_v = args.in[5], *state_gla = args.in[6];
    const float *w_ada = args.in[8], *b_ada = args.in[9], *g_mix = args.in[10], *w_in = args.in[11], *b_sb = args.in[12], *w_gate = args.in[13], *b_gate = args.in[14], *g_gla_out = args.in[15];
    const float *w_out = args.in[16], *g_ffn = args.in[17], *w_up = args.in[18], *w_down = args.in[19], *g_final = args.in[20];
    float* out = args.out;
    float* MOD = (float*)(ws + WS_MOD);
    bf16 *Win_t = (bf16*)(ws + WS_WIN), *Wo_t = (bf16*)(ws + WS_WO), *Wup_t = (bf16*)(ws + WS_WUP), *Wdn_t = (bf16*)(ws + WS_WDN);
    bf16 *XN = (bf16*)(ws + WS_XN), *QB = (bf16*)(ws + WS_Q), *KB = (bf16*)(ws + WS_K), *VB = (bf16*)(ws + WS_V), *GB = (bf16*)(ws + WS_G), *MIX = (bf16*)(ws + WS_MIX), *HB = (bf16*)(ws + WS_H);
    float* X1 = (float*)(ws + WS_X1);
    float *SLOC = (float*)(ws + WS_SLOC), *DSEG = (float*)(ws + WS_DSEG), *DPART = (float*)(ws + WS_DPART), *DRTOT = (float*)(ws + WS_DRTOT);
    for (int u = tid; u < (LDS_BYTES - MISC_OFF) / 4; u += NWAVES * 64) ((LAS unsigned*)(L + MISC_OFF))[u] = 0u;
    __syncthreads();
    XcdBarrier bar = xcd_barrier_post(ctl + CW_BAR, MISC + 8);
    const int gw = vcu * NWAVES + wave, NGW = G * NWAVES;

    if (vcu < 96) {
        LAS float* s = (LAS float*)L;
        for (int i = tid; i < NMODR * D; i += NWAVES * 64) { const int r = i >> 10, k = i & 1023; const float c = r < 2 ? c_prompt[r * D + k] : c_sample[(r - 2) * D + k]; s[k * NMODR + r] = c / (1.f + __expf(-c)); }
        __syncthreads();
        const int col = 64 * vcu + lane, k0 = 128 * wave;
        float acc[NMODR];
#pragma unroll
        for (int r = 0; r < NMODR; ++r) acc[r] = 0.f;
#pragma unroll 4
        for (int kk = 0; kk < 128; ++kk) { const int k = k0 + kk; const float w = w_ada[(size_t)k * MODW + col];
#pragma unroll
            for (int r = 0; r < NMODR; ++r) acc[r] += s[k * NMODR + r] * w; }
        __syncthreads();
        LAS float* red = (LAS float*)L;
#pragma unroll
        for (int r = 0; r < NMODR; ++r) red[(wave * NMODR + r) * 64 + lane] = acc[r];
        __syncthreads();
        for (int o = tid; o < NMODR * 64; o += NWAVES * 64) { const int r = o >> 6, l = o & 63; float t = b_ada[64 * vcu + l];
#pragma unroll
            for (int w8 = 0; w8 < 8; ++w8) t += red[(w8 * NMODR + r) * 64 + l];
            MOD[r * MODW + 64 * vcu + l] = t; }
        __syncthreads();
    }
    {
        LAS float* scr = (LAS float*)(L + wave * 16384);
        constexpr int I_IN = (D / 64) * (NIN / 32), I_O = (D / 64) * (D / 32), I_UP = (D / 64) * (FF / 32), I_DN = (FF / 64) * (D / 32);
        constexpr int NITEMS = I_IN + I_O + I_UP + I_DN;
        for (int it = gw; it < NITEMS; it += NGW) {
            int r = it;
            if (r < I_IN) { p0_transpose_item(w_in, D, NIN_REAL, NIN, Win_t, scr, r, lane); continue; } r -= I_IN;
            if (r < I_O) { p0_transpose_item(w_out, D, D, D, Wo_t, scr, r, lane); continue; } r -= I_O;
            if (r < I_UP) { p0_transpose_item(w_up, D, FF, FF, Wup_t, scr, r, lane); continue; } r -= I_UP;
            p0_transpose_item(w_down, FF, D, D, Wdn_t, scr, r, lane);
        }
    }
    xcd_barrier(bar);
    for (int m = gw; m < M; m += NGW) { const float* xr = m < MP ? x_prompt + (size_t)m * D : x_sample + (size_t)(m - MP) * D; const float* md = MOD + (size_t)bidx_of_row(m) * MODW;
        norm_mod_row_bf16(lane, xr, g_mix, md + 1024, md, XN + (size_t)m * D); }
    xcd_barrier(bar);
    {
        pg8::Gemm g{XN, Win_t, M, NIN, D}; pg8::StaticOrder S; S.init(M, NIN, G, bx);
        pg8::EpiInProj E{QB, KB, VB, GB, out + OK_P, out + OV_P, out + OK_S - (size_t)MP * 512, out + OV_S - (size_t)MP * 512, QSCALE};
        pg8::gemm_phase<pg8::EpiInProj, pg8::StaticOrder, true, true>(L, g, S, E);
    }
    xcd_barrier(bar);
    for (int u = vcu; u < 256; u += G) gla::pass1_unit(u, (const gla::bf16*)GB, w_gate, b_gate, g_gla_out, SLOC, DSEG, (LAS char*)L);
    xcd_barrier(bar);
    for (int v = vcu; v < 256; v += G) {
        const int bh = v >> 4, s = v & 15, b = bh >> 3, h = bh & 7; const float bias2 = b_sb[h] * 1.4426950408889634f;
        sba::attn_unit(b, h, 31 - s, (const sba::bf16*)QB, (const sba::bf16*)KB, (const sba::bf16*)VB, (sba::bf16*)MIX, (char*)lds, bias2);
        sba::attn_unit(b, h, s, (const sba::bf16*)QB, (const sba::bf16*)KB, (const sba::bf16*)VB, (sba::bf16*)MIX, (char*)lds, bias2);
    }
    for (int u = vcu; u < 256; u += G) gla::pass3_unit(u, (const gla::bf16*)GB, (gla::bf16*)MIX, w_gate, b_gate, g_gla_out, SLOC, DSEG, out + OSG_P, (LAS char*)L);
    for (int u = vcu; u < 256; u += G) sbd::decode_unit(u >> 3, u & 7, cache_k, cache_v, args.page_table, (const sba::bf16*)QB, (const sba::bf16*)KB, (const sba::bf16*)VB, b_sb, DPART, DRTOT, ctl + CW_DEC, (sba::bf16*)MIX, MISC + 16);
    for (int u = vcu; u < 128; u += G) gla::sample_unit(u, (const gla::bf16*)GB, (gla::bf16*)MIX, w_gate, b_gate, g_gla_out, state_gla, out + OSG_S, (LAS char*)L);
    xcd_barrier(bar);
    {
        pg8::Gemm g{MIX, Wo_t, M, D, D}; pg8::StaticOrder S; S.init(M, D, G, bx);
        pg8::EpiResGate E{x_prompt, x_sample - (size_t)MP * D, X1, MOD + 2048};
        pg8::gemm_phase<pg8::EpiResGate, pg8::StaticOrder, true, true>(L, g, S, E);
    }
    xcd_barrier(bar);
    for (int m = gw; m < M; m += NGW) { const float* md = MOD + (size_t)bidx_of_row(m) * MODW; norm_mod_row_bf16(lane, X1 + (size_t)m * D, g_ffn, md + 4096, md + 3072, XN + (size_t)m * D); }
    xcd_barrier(bar);
    {
        pg8::Gemm g{XN, Wup_t, M, FF, D}; pg8::StaticOrder S; S.init(M, FF, G, bx);
        pg8::EpiRelu2 E{HB, FF};
        pg8::gemm_phase<pg8::EpiRelu2, pg8::StaticOrder, true, true>(L, g, S, E);
    }
    xcd_barrier(bar);
    {
        pg8::Gemm g{HB, Wdn_t, M, D, FF}; pg8::StaticOrder S; S.init(M, D, G, bx);
        pg8::EpiResGate E{X1, X1, out + OY, MOD + 5120};
        pg8::gemm_phase<pg8::EpiResGate, pg8::StaticOrder, true, true>(L, g, S, E);
    }
    xcd_barrier(bar);
    for (int m = gw; m < M; m += NGW) norm_row_f32_inplace(lane, out + OY + (size_t)m * D, g_final);
}

extern "C" void kernel_launch(void* const* d_in, const int* in_sizes, int n_in, void* d_out, int out_size, void* d_ws, size_t ws_size, hipStream_t stream) {
    static int grid = 0;
    if (grid == 0) {
        if (n_in != 21 || (size_t)out_size != OUT_TOTAL || ws_size < WS_END) { fprintf(stderr, "kernel_launch: unexpected sizes: n_in %d out %d ws %zu\n", n_in, out_size, ws_size); grid = -1; return; }
        int dev = 0, cus = 0, per_cu = 0;
        if (hipGetDevice(&dev) != hipSuccess || hipDeviceGetAttribute(&cus, hipDeviceAttributeMultiprocessorCount, dev) != hipSuccess) { grid = -1; return; }
        if (hipFuncSetAttribute((const void*)mk_fwd, hipFuncAttributeMaxDynamicSharedMemorySize, LDS_BYTES) != hipSuccess) { fprintf(stderr, "kernel_launch: hipFuncSetAttribute failed\n"); grid = -1; return; }
        if (hipOccupancyMaxActiveBlocksPerMultiprocessor(&per_cu, (const void*)mk_fwd, NWAVES * 64, LDS_BYTES) != hipSuccess || per_cu < 1) { fprintf(stderr, "kernel_launch: occupancy query says %d\n", per_cu); }
        (void)hipGetLastError();
        grid = cus;
    }
    if (grid < 0) return;
    if (hipMemsetAsync((char*)d_ws + WS_CTL, 0, CTL_ZERO_BYTES, stream) != hipSuccess) return;
    Args a{};
    for (int i = 0; i < 21; ++i) a.in[i] = (const float*)d_in[i];
    a.page_table = (const int*)d_in[7]; a.out = (float*)d_out; a.ws = (unsigned char*)d_ws;
    hipLaunchKernelGGL(mk_fwd, dim3(grid), dim3(NWAVES * 64), LDS_BYTES, stream, a);
    const hipError_t le = hipPeekAtLastError();
    if (le != hipSuccess) fprintf(stderr, "kernel_launch: launch failed: %s\n", hipGetErrorName(le));
}
```

```cpp
#include <hip/hip_runtime.h>
#include <hip/hip_bf16.h>
#include <cstdio>
#include <cstdint>
namespace pg8 {
#define PG8_LAS __attribute__((address_space(3)))
typedef unsigned short bf16_t;
typedef short bf16x8 __attribute__((ext_vector_type(8)));
typedef float f32x4 __attribute__((ext_vector_type(4)));
typedef unsigned u32x4 __attribute__((ext_vector_type(4)));
constexpr int BM = 256, BK = 64, HALF = 128, HTB = HALF * BK * 2  , STAGE_BYTES = 8 * HTB, NXCD = 8, WGM = 8;

__host__ __device__ __forceinline__ int lds_byte(int r, int c) { const int st = (r >> 4) * 2 + (c >> 5), rr = r & 15, cc = c & 31, ob = rr * 64 + cc * 2; return st * 1024 + (ob ^ (((ob >> 9) & 1) << 5)); }
__host__ __device__ __forceinline__ void stage_rc(int b, int& R, int& C) { const int st = b / 1024, sb = b % 1024, swz = sb ^ (((sb >> 9) & 1) << 5); R = (st >> 1) * 16 + swz / 64; C = (st & 1) * 32 + (swz % 64) / 2; }
__host__ __device__ __forceinline__ int perm32(int rho) { const int n = rho >> 4, i = rho & 15; return 8 * (i >> 2) + 4 * n + (i & 3); }

struct Unit { int pm, pn; };
struct Gemm { const bf16_t* A; const bf16_t* Bt; int M, N, K; };

struct StaticOrder {
    int nM, nN, nwg, G, c;
    __host__ __device__ void init(int M, int N, int G_, int c_) { nM = M / BM; nN = N / BM; nwg = nM * nN; G = G_; c = c_; }
    __host__ __device__ bool next(int i, Unit& u) const {
        const long L = (long)i * G + c; if (L >= nwg) return false;
        int wgid = (int)L; { const int q = nwg / NXCD, r = nwg % NXCD, xcd = wgid % NXCD, off = wgid / NXCD; wgid = (xcd < r ? xcd * (q + 1) : r * (q + 1) + (xcd - r) * q) + off; }
        const int nig = WGM * nN, gid = wgid / nig, fm = gid * WGM, gsz = (nM - fm) < WGM ? (nM - fm) : WGM;
        u.pm = fm + ((wgid % nig) % gsz); u.pn = (wgid % nig) / gsz; return true;
    }
    __device__ __forceinline__ void a_ready(const Unit&) const {}
    __device__ __forceinline__ void done(const Unit&) const {}
};

__device__ __forceinline__ unsigned cvt_pk_bf16(float lo, float hi) { unsigned r; asm volatile("v_cvt_pk_bf16_f32 %0, %1, %2" : "=v"(r) : "v"(lo), "v"(hi)); return r; }

struct EpiInProj {
    static constexpr bool PERM = true, AFTER_DRAIN = false;
    bf16_t *Q, *K, *V, *G; float *kP, *vP, *kS, *vS; float qscale;
    __device__ __forceinline__ void operator()(const f32x4 (&acc)[2][2][4][2], const Unit& u, int wr, int wc, int fr, int fq) const {
        const int pn = u.pn, pm = u.pm;
        bf16_t* dst; int ldc, colbase; float sc = 1.f; float* fo = nullptr;
        if (pn < 2)      { dst = Q; ldc = 512; colbase = pn * 256; sc = qscale; }
        else if (pn < 4) { dst = K; ldc = 512; colbase = (pn - 2) * 256; fo = pm < 64 ? kP : kS; }
        else if (pn < 6) { dst = V; ldc = 512; colbase = (pn - 4) * 256; fo = pm < 64 ? vP : vS; }
        else             { dst = G; ldc = 1792; colbase = (pn - 6) * 256; }
        const int row0 = pm * BM + wr * 64 + fr, cl = colbase + wc * 32 + 8 * fq;
#pragma unroll
        for (int ai = 0; ai < 2; ++ai)
#pragma unroll
            for (int m = 0; m < 4; ++m) { const size_t row = (size_t)(row0 + ai * HALF + m * 16);
#pragma unroll
                for (int bj = 0; bj < 2; ++bj) { const f32x4 a0 = acc[ai][bj][m][0], a1 = acc[ai][bj][m][1]; const int col = cl + bj * HALF;
                    const f32x4 v0 = a0 * sc, v1 = a1 * sc; u32x4 w; w.x = cvt_pk_bf16(v0[0], v0[1]); w.y = cvt_pk_bf16(v0[2], v0[3]); w.z = cvt_pk_bf16(v1[0], v1[1]); w.w = cvt_pk_bf16(v1[2], v1[3]);
                    *(u32x4*)(dst + row * ldc + col) = w;
                    if (fo) { *(f32x4*)(fo + row * 512 + col) = a0; *(f32x4*)(fo + row * 512 + col + 4) = a1; } } }
    }
};
struct EpiRelu2 {
    static constexpr bool PERM = true, AFTER_DRAIN = false;
    bf16_t* O; int ldc;
    __device__ __forceinline__ void operator()(const f32x4 (&acc)[2][2][4][2], const Unit& u, int wr, int wc, int fr, int fq) const {
        const int row0 = u.pm * BM + wr * 64 + fr, col0 = u.pn * BM + wc * 32 + 8 * fq;
#pragma unroll
        for (int ai = 0; ai < 2; ++ai)
#pragma unroll
            for (int m = 0; m < 4; ++m) { bf16_t* rowp = O + (size_t)(row0 + ai * HALF + m * 16) * ldc + col0;
#pragma unroll
                for (int bj = 0; bj < 2; ++bj) { f32x4 v0 = acc[ai][bj][m][0], v1 = acc[ai][bj][m][1];
#pragma unroll
                    for (int e = 0; e < 4; ++e) { const float a = fmaxf(v0[e], 0.f), b = fmaxf(v1[e], 0.f); v0[e] = a * a; v1[e] = b * b; }
                    u32x4 w; w.x = cvt_pk_bf16(v0[0], v0[1]); w.y = cvt_pk_bf16(v0[2], v0[3]); w.z = cvt_pk_bf16(v1[0], v1[1]); w.w = cvt_pk_bf16(v1[2], v1[3]);
                    *(u32x4*)(rowp + bj * HALF) = w; } }
    }
};
struct EpiResGate {
    static constexpr bool PERM = false, AFTER_DRAIN = false;
    const float* baseP; const float* baseS; float* out; const float* gate;
    __device__ __forceinline__ void operator()(const f32x4 (&acc)[2][2][4][2], const Unit& u, int wr, int wc, int fr, int fq) const {
        const int col0 = u.pn * BM + wc * 32 + 4 * fq;
#pragma unroll
        for (int ai = 0; ai < 2; ++ai)
#pragma unroll
            for (int m = 0; m < 4; ++m) { const int row = u.pm * BM + ai * HALF + wr * 64 + m * 16 + fr; const int bidx = row < 16384 ? (row >> 13) : 2 + ((row - 16384) >> 3);
                const float* b = (row < 16384 ? baseP : baseS) + (size_t)row * 1024 + col0; const float* g = gate + (size_t)bidx * 6144 + col0; float* o = out + (size_t)row * 1024 + col0;
#pragma unroll
                for (int bj = 0; bj < 2; ++bj)
#pragma unroll
                    for (int n = 0; n < 2; ++n) { const int c = bj * HALF + n * 16; const f32x4 bs = *(const f32x4*)(b + c), gv = *(const f32x4*)(g + c); *(f32x4*)(o + c) = bs + gv * acc[ai][bj][m][n]; } }
    }
};
template <class Epi, class Sched, bool ALIGN_EPI = false, bool SP2 = false>
__device__ __forceinline__ void gemm_phase(PG8_LAS unsigned char* lds, const Gemm g, const Sched& S, const Epi& E) {
    int tid_ = threadIdx.x; asm volatile("" : "+v"(tid_)); const int tid = tid_, wid = __builtin_amdgcn_readfirstlane(tid >> 6), lane = tid & 63, wr = wid >> 2, wc = wid & 3, fr = lane & 15, fq = lane >> 4;
    const int K = g.K, nt = K / BK;
    unsigned voffA[2], voffB[2];
#pragma unroll
    for (int i = 0; i < 2; ++i) { int R, C; stage_rc(tid * 16 + i * 8192, R, C); const int Rb = Epi::PERM ? ((R & ~31) + perm32(R & 31)) : R;
        voffA[i] = (unsigned)(R * K + C) * 2u; voffB[i] = (unsigned)(Rb * K + C) * 2u; }
    const size_t kstep = (size_t)(BK * 2);
    const size_t hstep = (size_t)HALF * K * 2;
    const size_t tstep = 2 * hstep;
    const unsigned ldsw = (unsigned)wid * 1024u;
    const int aoff = lds_byte(wr * 64 + fr, fq * 8), boff = lds_byte(wc * 32 + fr, fq * 8);
#define PG8_SA(b, h) (((b) * 2 + (h)) * HTB)
#define PG8_SB(b, h) ((4 + (b) * 2 + (h)) * HTB)
#define PG8_STAGE(bufoff, gbase, voff) do { _Pragma("unroll") for (int _i = 0; _i < 2; ++_i) \
        __builtin_amdgcn_global_load_lds((const unsigned*)((const char*)(gbase) + (voff)[_i]), (PG8_LAS unsigned*)(lds + (bufoff) + ldsw + _i * 8192), 16, 0, 0); } while (0)
#define PG8_LDA(dst, b, h) do { _Pragma("unroll") for (int m = 0; m < 4; ++m) _Pragma("unroll") for (int k = 0; k < 2; ++k) dst[m][k] = *(const PG8_LAS bf16x8*)(lds + PG8_SA(b, h) + aoff + m * 2048 + k * 1024); } while (0)
#define PG8_LDB(dst, b, h) do { _Pragma("unroll") for (int n = 0; n < 2; ++n) _Pragma("unroll") for (int k = 0; k < 2; ++k) dst[n][k] = *(const PG8_LAS bf16x8*)(lds + PG8_SB(b, h) + boff + n * 2048 + k * 1024); } while (0)
#define PG8_MMA(ai, bj, At, Bt) do { __builtin_amdgcn_s_setprio(1); _Pragma("unroll") for (int m = 0; m < 4; ++m) _Pragma("unroll") for (int n = 0; n < 2; ++n) _Pragma("unroll") for (int k = 0; k < 2; ++k) \
        acc[ai][bj][m][n] = __builtin_amdgcn_mfma_f32_16x16x32_bf16(Bt[n][k], At[m][k], acc[ai][bj][m][n], 0, 0, 0); __builtin_amdgcn_s_setprio(0); } while (0)
#define PG8_WAIT_V(n) asm volatile("s_waitcnt vmcnt(" #n ")" ::: "memory")
#define PG8_WAIT_L(n) asm volatile("s_waitcnt lgkmcnt(" #n ")" ::: "memory")
#define PG8_BAR __builtin_amdgcn_s_barrier()
#define PG8_SCHED __builtin_amdgcn_sched_barrier(0)
    Unit cur, nxt; int ui = 0;
    if (!S.next(0, cur)) return;
    f32x4 acc[2][2][4][2];
#pragma unroll
    for (int a = 0; a < 2; ++a)
#pragma unroll
        for (int b = 0; b < 2; ++b)
#pragma unroll
            for (int m = 0; m < 4; ++m)
#pragma unroll
                for (int n = 0; n < 2; ++n) acc[a][b][m][n] = (f32x4){0.f, 0.f, 0.f, 0.f};
    bf16x8 At[4][2], B0[2][2], B1[2][2];
    const char* cA = (const char*)g.A + (size_t)cur.pm * tstep; const char* cB = (const char*)g.Bt + (size_t)cur.pn * tstep;
    S.a_ready(cur);
    if constexpr (SP2) {
        PG8_STAGE(PG8_SB(0, 0), cB, voffB); PG8_STAGE(PG8_SB(0, 1), cB + hstep, voffB); PG8_STAGE(PG8_SA(0, 0), cA, voffA); PG8_STAGE(PG8_SA(0, 1), cA + hstep, voffA);
        if (wr == 1) PG8_BAR;
        PG8_WAIT_V(2); PG8_BAR;
        PG8_STAGE(PG8_SB(1, 0), cB + kstep, voffB); PG8_STAGE(PG8_SA(1, 0), cA + kstep, voffA); PG8_STAGE(PG8_SB(1, 1), cB + hstep + kstep, voffB);
        PG8_WAIT_V(6); PG8_BAR;
    } else {
        PG8_STAGE(PG8_SB(0, 0), cB, voffB); PG8_STAGE(PG8_SA(0, 0), cA, voffA); PG8_STAGE(PG8_SB(0, 1), cB + hstep, voffB); PG8_STAGE(PG8_SA(0, 1), cA + hstep, voffA);
        if (wr == 1) PG8_BAR;
        PG8_WAIT_V(4); PG8_BAR;
        PG8_STAGE(PG8_SB(1, 0), cB + kstep, voffB); PG8_STAGE(PG8_SA(1, 0), cA + kstep, voffA); PG8_STAGE(PG8_SB(1, 1), cB + hstep + kstep, voffB);
        PG8_WAIT_V(6); PG8_BAR;
    }
    for (;;) {
        const bool has_next = S.next(ui + 1, nxt);
        const char* nA = has_next ? (const char*)g.A + (size_t)nxt.pm * tstep : cA; const char* nB = has_next ? (const char*)g.Bt + (size_t)nxt.pn * tstep : cB;
        for (int t = 0; t < nt; t += 2) {
            const bool last = (t == nt - 2);
            const char* a1 = cA + (size_t)(t + 1) * kstep;
            const char* a2 = last ? nA : cA + (size_t)(t + 2) * kstep; const char* b2 = last ? nB : cB + (size_t)(t + 2) * kstep;
            const char* a3 = a2 + kstep; const char* b3 = b2 + kstep;
            if (last && has_next) S.a_ready(nxt);
            if constexpr (SP2) {
            PG8_LDB(B0, 0, 0); PG8_LDB(B1, 0, 1); PG8_SCHED; PG8_LDA(At, 0, 0); PG8_STAGE(PG8_SA(1, 1), a1 + hstep, voffA);
            PG8_WAIT_V(8); PG8_WAIT_L(0); PG8_BAR; PG8_MMA(0, 0, At, B0); PG8_MMA(0, 1, At, B1); PG8_BAR; PG8_SCHED;
            PG8_LDA(At, 0, 1); PG8_STAGE(PG8_SB(0, 0), b2, voffB); PG8_STAGE(PG8_SB(0, 1), b2 + hstep, voffB); PG8_STAGE(PG8_SA(0, 0), a2, voffA);
            PG8_WAIT_V(8); PG8_WAIT_L(0); PG8_BAR; PG8_MMA(1, 0, At, B0); PG8_MMA(1, 1, At, B1); PG8_BAR; PG8_SCHED;
            PG8_LDB(B0, 1, 0); PG8_LDB(B1, 1, 1); PG8_SCHED; PG8_LDA(At, 1, 0); PG8_STAGE(PG8_SA(0, 1), a2 + hstep, voffA);
            PG8_WAIT_V(8); PG8_WAIT_L(0); PG8_BAR; PG8_MMA(0, 0, At, B0); PG8_MMA(0, 1, At, B1); PG8_BAR; PG8_SCHED;
            PG8_LDA(At, 1, 1); PG8_STAGE(PG8_SB(1, 0), b3, voffB); PG8_STAGE(PG8_SB(1, 1), b3 + hstep, voffB); PG8_STAGE(PG8_SA(1, 0), a3, voffA);
            PG8_WAIT_V(8); PG8_WAIT_L(0); PG8_BAR; PG8_MMA(1, 0, At, B0); PG8_MMA(1, 1, At, B1); PG8_BAR; PG8_SCHED;
            } else {
            PG8_LDB(B0, 0, 0); PG8_SCHED; PG8_LDA(At, 0, 0); PG8_STAGE(PG8_SA(1, 1), a1 + hstep, voffA);
            PG8_WAIT_L(8); PG8_BAR; PG8_WAIT_L(0); PG8_MMA(0, 0, At, B0); PG8_BAR; PG8_SCHED;
            PG8_LDB(B1, 0, 1); PG8_STAGE(PG8_SB(0, 0), b2, voffB);
            PG8_BAR; PG8_WAIT_L(0); PG8_MMA(0, 1, At, B1); PG8_BAR;
            PG8_LDA(At, 0, 1); PG8_STAGE(PG8_SA(0, 0), a2, voffA);
            PG8_BAR; PG8_WAIT_L(0); PG8_MMA(1, 0, At, B0); PG8_BAR; PG8_SCHED;
            PG8_STAGE(PG8_SB(0, 1), b2 + hstep, voffB);
            PG8_WAIT_V(6); PG8_BAR; PG8_MMA(1, 1, At, B1); PG8_BAR;
            PG8_LDB(B0, 1, 0); PG8_SCHED; PG8_LDA(At, 1, 0); PG8_STAGE(PG8_SA(0, 1), a2 + hstep, voffA);
            PG8_WAIT_L(8); PG8_BAR; PG8_WAIT_L(0); PG8_MMA(0, 0, At, B0); PG8_BAR; PG8_SCHED;
            PG8_LDB(B1, 1, 1); PG8_STAGE(PG8_SB(1, 0), b3, voffB);
            PG8_BAR; PG8_WAIT_L(0); PG8_MMA(0, 1, At, B1); PG8_BAR;
            PG8_LDA(At, 1, 1); PG8_STAGE(PG8_SA(1, 0), a3, voffA);
            PG8_BAR; PG8_WAIT_L(0); PG8_MMA(1, 0, At, B0); PG8_BAR; PG8_SCHED;
            PG8_STAGE(PG8_SB(1, 1), b3 + hstep, voffB);
            PG8_WAIT_V(6); PG8_BAR; PG8_MMA(1, 1, At, B1); PG8_BAR;
            }
        }
        if constexpr (ALIGN_EPI) { if (wr == 0) PG8_BAR; }
        if constexpr (!Epi::AFTER_DRAIN) { E(acc, cur, wr, wc, fr, fq); S.done(cur); }
        if (!has_next) break;
#pragma unroll
        for (int a = 0; a < 2; ++a)
#pragma unroll
            for (int b = 0; b < 2; ++b)
#pragma unroll
                for (int m = 0; m < 4; ++m)
#pragma unroll
                    for (int n = 0; n < 2; ++n) acc[a][b][m][n] = (f32x4){0.f, 0.f, 0.f, 0.f};
        cur = nxt; cA = nA; cB = nB; ++ui;
        if constexpr (ALIGN_EPI) { if (wr == 1) PG8_BAR; }
    }
    PG8_WAIT_V(0);
    if constexpr (!ALIGN_EPI) { if (wr == 0) PG8_BAR; }
    PG8_BAR;
    if constexpr (Epi::AFTER_DRAIN) { E.fused(acc, cur, wr, wc, fr, fq, lds, wid, lane); S.done(cur); }
#undef PG8_SA
#undef PG8_SB
#undef PG8_STAGE
#undef PG8_LDA
#undef PG8_LDB
#undef PG8_MMA
#undef PG8_WAIT_V
#undef PG8_WAIT_L
#undef PG8_BAR
#undef PG8_SCHED
}
}
constexpr int NWAVES = 8;
constexpr int D = 1024, TP = 8192, MP = 16384, MS = 256, M = MP + MS, FF = 4096, NIN = 3328, NIN_REAL = 3088, NMODR = 34, MODW = 6144;
constexpr float NORM_EPS = 1e-6f;
constexpr float QSCALE = 0.125f * 1.4426950408889634f;
constexpr size_t OY = 0, OK_P = 17039360, OV_P = 25427968, OSG_P = 33816576, OK_S = 33882112, OV_S = 34013184, OSG_S = 34144256, OUT_TOTAL = 35192832;
constexpr size_t MiB = 1u << 20;
constexpr size_t WS_CTL = 0, CTL_ZERO_BYTES = 1 * MiB;
constexpr size_t WS_MOD = 1 * MiB, WS_WIN = 2 * MiB, WS_WO = 9 * MiB, WS_WUP = 11 * MiB, WS_WDN = 19 * MiB;
constexpr size_t WS_SLOC = 27 * MiB, WS_DSEG = 35 * MiB, WS_DPART = 36 * MiB, WS_DRTOT = 40 * MiB;
constexpr size_t WS_XN = 48 * MiB, WS_Q = 82 * MiB, WS_K = 99 * MiB, WS_V = 116 * MiB, WS_G = 133 * MiB, WS_MIX = 190 * MiB, WS_X1 = 224 * MiB, WS_H = 290 * MiB, WS_END = 421 * MiB;
static_assert(WS_WIN + (size_t)NIN * D * 2 <= WS_WO && WS_G + (size_t)M * 1792 * 2 <= WS_MIX && WS_MIX + (size_t)M * D * 2 <= WS_X1 && WS_X1 + (size_t)M * D * 4 <= WS_H && WS_H + (size_t)M * FF * 2 <= WS_END, "d_ws map");
static_assert(WS_XN + (size_t)M * D * 2 <= WS_Q && WS_Q + (size_t)M * 512 * 2 <= WS_K && WS_K + (size_t)M * 512 * 2 <= WS_V && WS_V + (size_t)M * 512 * 2 <= WS_G, "d_ws map 2");
constexpr int CW_BAR = 4096, CW_DEC = 16384;
constexpr int RING_BYTES = 139264, MISC_OFF = 146944, LDS_BYTES = 147456;

#define GAS __attribute__((address_space(1)))
#define LAS __attribute__((address_space(3)))
typedef unsigned short bf16;
typedef unsigned v4u __attribute__((ext_vector_type(4)));
typedef float f32x4 __attribute__((ext_vector_type(4)));
#define LDS_WAIT() asm volatile("s_waitcnt lgkmcnt(0)" ::: "memory")
__device__ __forceinline__ unsigned f2bf(float f) { unsigned u = __builtin_bit_cast(unsigned, f); return (u + 0x7fffu + ((u >> 16) & 1u)) >> 16; }
__device__ __forceinline__ unsigned pk2(float lo, float hi) { return f2bf(lo) | (f2bf(hi) << 16); }
#define XB_TMO      128
#define XB_XCNT(j)  (256  + 64 * (j))
#define XB_XSUB(j)  (1280 + 64 * (j))
#define XB_XGEN(j)  (2304 + 64 * (j))
#define XB_TOP      3328
#define XB_TOPGEN   3392
#define XCD_BAR_WORDS 3456
#define XB_SPIN_CAP (1u << 18)

__device__ __forceinline__ unsigned xb_ld(unsigned* p)              { return __hip_atomic_load(p, __ATOMIC_RELAXED, __HIP_MEMORY_SCOPE_AGENT); }
__device__ __forceinline__ unsigned xb_add(unsigned* p, unsigned v) { return __hip_atomic_fetch_add(p, v, __ATOMIC_RELAXED, __HIP_MEMORY_SCOPE_AGENT); }
__device__ __forceinline__ unsigned xb_xcc_id() { return (unsigned)__builtin_amdgcn_s_getreg((3 << 11) | 20) & 0xFu; }
#define XB_SPIN(cond, bar) do { unsigned _sp = 0; while (cond) { __builtin_amdgcn_s_sleep(1); \
    if ((++_sp & 255u) == 0u) { if (xb_ld(&(bar)[XB_TMO])) break; if (_sp > XB_SPIN_CAP) { atomicAdd(&(bar)[XB_TMO], 1u); break; } } } } while (0)

struct XcdBarrier {
    unsigned* bar; unsigned x;
    volatile LAS unsigned* st;
};

__device__ __forceinline__ XcdBarrier xcd_barrier_post(unsigned* bar, volatile LAS unsigned* st) {
    XcdBarrier b; b.bar = bar; b.x = xb_xcc_id(); b.st = st;
    if (threadIdx.x == 0) (void)xb_add(&bar[XB_XCNT(b.x)], 1u);
    return b;
}
__device__ __forceinline__ void xcd_barrier_complete(unsigned* bar, unsigned x, unsigned& nloc, unsigned& nx) {
    const unsigned G = gridDim.x * gridDim.y * gridDim.z;
    unsigned sum, cnt, mine, sp = 0u;
    for (;;) {
        sum = 0u; cnt = 0u; mine = 0u;
#pragma unroll
        for (unsigned j = 0; j < 16; ++j) { const unsigned c = xb_ld(&bar[XB_XCNT(j)]); sum += c; cnt += (c > 0u) ? 1u : 0u; mine = (j == x) ? c : mine; }
        if (sum == G) break;
        __builtin_amdgcn_s_sleep(1);
        if ((++sp & 255u) == 0u) { if (xb_ld(&bar[XB_TMO])) break; if (sp > XB_SPIN_CAP) { atomicAdd(&bar[XB_TMO], 1u); break; } }
    }
    nloc = mine > 0u ? mine : 1u; nx = cnt > 0u ? cnt : 1u;
}

__device__ __forceinline__ void xcd_barrier(const XcdBarrier& b) {
    asm volatile("s_waitcnt vmcnt(0)" ::: "memory");
    __syncthreads();
    if (threadIdx.x == 0) {
        unsigned* bar = b.bar;
        __builtin_amdgcn_s_waitcnt(0);
        unsigned nloc = b.st[0], nx = b.st[1];
        if (nloc == 0u) { xcd_barrier_complete(bar, b.x, nloc, nx); b.st[0] = nloc; b.st[1] = nx; }
        const unsigned old = xb_add(&bar[XB_XSUB(b.x)], 1u);
        const unsigned gen = old / nloc;
        if (old + 1u == (gen + 1u) * nloc) {
            __builtin_amdgcn_fence(__ATOMIC_RELEASE, "agent");
            asm volatile("s_waitcnt vmcnt(0)" ::: "memory");
            const unsigned og = xb_add(&bar[XB_TOP], 1u);
            const unsigned tg = og / nx;
            if (og + 1u == (tg + 1u) * nx) xb_add(&bar[XB_TOPGEN], 1u);
            else XB_SPIN(xb_ld(&bar[XB_TOPGEN]) == tg, bar);
            __builtin_amdgcn_fence(__ATOMIC_ACQUIRE, "agent");
            xb_add(&bar[XB_XGEN(b.x)], 1u);
            asm volatile("s_waitcnt vmcnt(0)" ::: "memory");
        } else {
            XB_SPIN(xb_ld(&bar[XB_XGEN(b.x)]) == gen, bar);
            __builtin_amdgcn_fence(__ATOMIC_ACQUIRE, "agent");
            asm volatile("s_waitcnt vmcnt(0)" ::: "memory");
        }
    }
    __syncthreads();
}
namespace sba {
using bf16x8=__attribute__((ext_vector_type(8)))short;
using s16x4=__attribute__((ext_vector_type(4)))short;
using f32x16=__attribute__((ext_vector_type(16)))float;
using u32x4=__attribute__((ext_vector_type(4)))unsigned;
typedef __hip_bfloat16 bf16;
constexpr int SEQ=8192,D=64,DM=512,OP=1024;
constexpr int NW=8,QBLK=32,QB=QBLK*NW,KVBLK=64;
constexpr int NSLOT=3,SLOTB=8192;
constexpr int LDS_K=0,LDS_V=NSLOT*SLOTB,LDS_OST=2*NSLOT*SLOTB,LDS_BYTES=LDS_OST+NW*4096;
__device__ __forceinline__ int crow(int r,int hi){return (r&3)+8*(r>>2)+4*hi;}
__device__ __forceinline__ void glds16(const void*gsrc,unsigned lds_dst){unsigned keep;
  asm volatile("s_mov_b32 %0, m0\n\ts_mov_b32 m0, %2\n\ts_nop 0\n\tglobal_load_lds_dwordx4 %1, off\n\ts_mov_b32 m0, %0":"=&s"(keep):"v"(gsrc),"s"(lds_dst):"memory");}
typedef float f32x2_t __attribute__((ext_vector_type(2))); typedef __bf16 bf16x2_t __attribute__((ext_vector_type(2)));
__device__ __forceinline__ unsigned cvtpk_s(float lo,float hi){f32x2_t v={lo,hi};bf16x2_t b=__builtin_convertvector(v,bf16x2_t);return __builtin_bit_cast(unsigned,b);}
typedef __attribute__((address_space(3))) const char* lds_cptr;
typedef short v4i16_t __attribute__((ext_vector_type(4)));
__device__ __forceinline__ s16x4 vtr(lds_cptr p){ return __builtin_bit_cast(s16x4,__builtin_amdgcn_ds_read_tr16_b64_v4i16((__attribute__((address_space(3))) v4i16_t*)p)); }
#define SBA_MFMA(a,b,c) __builtin_amdgcn_mfma_f32_32x32x16_bf16((a),(b),(c),0,0,0)
template<bool MASK> __device__ __forceinline__ void sb_weights(f32x16&c0,f32x16&c1,float&carry,int hi,int jb,int qrel){
  #pragma unroll
  for(int r=0;r<16;++r){
    float e0=__builtin_amdgcn_exp2f(c0[r]), e1=__builtin_amdgcn_exp2f(c1[r]);
    if(MASK){ const int kv=64*jb+crow(r,hi); if(kv>=qrel)e0=0.f; if(kv+32>=qrel)e1=0.f; }
    c0[r]=1.f+e0; c1[r]=1.f+e1; }
  float P2[8],P3[8],T[8];
  #pragma unroll
  for(int c=0;c<4;++c){ P2[c]=c0[4*c]*c0[4*c+1]; P3[c]=P2[c]*c0[4*c+2]; T[c]=__builtin_amdgcn_rcpf(P3[c]*c0[4*c+3]);
                        P2[4+c]=c1[4*c]*c1[4*c+1]; P3[4+c]=P2[4+c]*c1[4*c+2]; T[4+c]=__builtin_amdgcn_rcpf(P3[4+c]*c1[4*c+3]); }
  float Tl[8],Th[8];
  #pragma unroll
  for(int c=0;c<8;++c){ auto rr=__builtin_amdgcn_permlane32_swap(__float_as_uint(T[c]),__float_as_uint(T[c]),false,false); Tl[c]=__uint_as_float(rr[0]); Th[c]=__uint_as_float(rr[1]); }
  float E=carry;
  float off[8];
  #pragma unroll
  for(int c=7;c>=0;--c){ off[c]=hi?E:E*Th[c]; E=E*(Tl[c]*Th[c]); }
  carry=E;
  #pragma unroll
  for(int c=0;c<4;++c){
    { const float g=T[c]*off[c], R1=c0[4*c]*g, R2=P2[c]*g, R3=P3[c]*g; c0[4*c]=R1-g; c0[4*c+1]=R2-R1; c0[4*c+2]=R3-R2; c0[4*c+3]=off[c]-R3; }
    { const float g=T[4+c]*off[4+c], R1=c1[4*c]*g, R2=P2[4+c]*g, R3=P3[4+c]*g; c1[4*c]=R1-g; c1[4*c+1]=R2-R1; c1[4*c+2]=R3-R2; c1[4*c+3]=off[4+c]-R3; } }
}
__device__ __forceinline__ void pv(f32x16*o,lds_cptr vp,const f32x16&w0,const f32x16&w1){
  u32x4 pw[4];
  #pragma unroll
  for(int k=0;k<2;++k)
    #pragma unroll
    for(int j=0;j<4;++j){ pw[k][j]=cvtpk_s(w0[8*k+2*j],w0[8*k+2*j+1]); pw[2+k][j]=cvtpk_s(w1[8*k+2*j],w1[8*k+2*j+1]); }
  #pragma unroll
  for(int d0=0;d0<2;++d0)
    #pragma unroll
    for(int ks=0;ks<4;++ks){ const s16x4 lo=vtr(vp+d0*4096+ks*1024), hh=vtr(vp+d0*4096+ks*1024+512);
      const bf16x8 vf={lo[0],lo[1],lo[2],lo[3],hh[0],hh[1],hh[2],hh[3]};
      o[d0]=SBA_MFMA(__builtin_bit_cast(bf16x8,pw[ks]),vf,o[d0]); }
}
__device__ __forceinline__ void attn_unit(int b,int h,int qb,const bf16*Q,const bf16*__restrict__ K,const bf16*__restrict__ V,bf16*O,char*shm,float bias2){
  int tid_=threadIdx.x; asm volatile("":"+v"(tid_)); const int tid=tid_,lane=tid&63,r32=lane&31,hi=lane>>5; const int wid=__builtin_amdgcn_readfirstlane(tid>>6);
  const long rowbase=(long)b*SEQ; const int q0=qb*QB;
  const bf16*Qw=Q+(rowbase+q0+wid*QBLK)*DM+h*D;
  const bf16*Kh=K+rowbase*DM+h*D,*Vh=V+rowbase*DM+h*D;
  const unsigned lds0=(unsigned)(uintptr_t)shm;
  const bf16*ksrc=Kh+(long)lane*DM+wid*8;
  const bf16*vsrc=Vh+(long)(16*(wid&3)+(lane>>2))*DM+(wid>>2)*32+(lane&3)*8;
  const unsigned kdst=lds0+LDS_K+wid*1024, vdst=lds0+LDS_V+wid*1024;
  const int NT=(q0+QB)/KVBLK;
  #define DMA_KV(s_,slot_) do{ const long t_=(long)(NT-1-(s_))*KVBLK*DM; glds16(ksrc+t_,(unsigned)__builtin_amdgcn_readfirstlane(kdst+(slot_)*SLOTB)); glds16(vsrc+t_,(unsigned)__builtin_amdgcn_readfirstlane(vdst+(slot_)*SLOTB)); }while(0)
  bf16x8 qr[4];
  #pragma unroll
  for(int d0=0;d0<4;++d0)qr[d0]=*reinterpret_cast<const bf16x8*>(&Qw[(long)r32*DM+d0*16+hi*8]);
  DMA_KV(0,0); DMA_KV(1,1);
  const lds_cptr shm3=(lds_cptr)shm; const lds_cptr kp0=shm3+LDS_K+hi*1024+r32*16; const lds_cptr vp0=shm3+LDS_V+((lane>>4)&1)*32+(lane&3)*8+(4*hi+((lane&15)>>2))*64;
  f32x16 o[2];o[0]=f32x16{};o[1]=f32x16{}; f32x16 bv;
  #pragma unroll
  for(int r=0;r<16;++r)bv[r]=bias2;
  asm volatile("":"+v"(bv));
  float carry=1.f; const int qrel=wid*QBLK+r32;
  int slot=0;
  for(int s=0;s<NT;++s){
    if(s+1<NT) asm volatile("s_waitcnt vmcnt(2) lgkmcnt(0)\n\ts_barrier":::"memory"); else asm volatile("s_waitcnt vmcnt(0) lgkmcnt(0)\n\ts_barrier":::"memory");
    if(s+2<NT){ const int ns=(slot==0)?2:slot-1; DMA_KV(s+2,ns); }
    const lds_cptr kp=kp0+slot*SLOTB;
    f32x16 c0=bv,c1=bv;
    #pragma unroll
    for(int d0=0;d0<4;++d0){
      const bf16x8 k0=*(const __attribute__((address_space(3))) bf16x8*)(kp+d0*2048), k1=*(const __attribute__((address_space(3))) bf16x8*)(kp+d0*2048+512);
      c0=SBA_MFMA(k0,qr[d0],c0); c1=SBA_MFMA(k1,qr[d0],c1); }
    if(s<4) sb_weights<true>(c0,c1,carry,hi,3-s,qrel); else sb_weights<false>(c0,c1,carry,hi,0,0);
    pv(o,vp0+slot*SLOTB,c0,c1);
    slot=(slot==2)?0:slot+1;
  }
  #undef DMA_KV
  bf16*Ow=O+(rowbase+q0+wid*QBLK)*OP+h*D;
  { bf16*stg=(bf16*)(shm+LDS_OST)+wid*2048;
    #pragma unroll
    for(int r=0;r<16;++r){const int orow=crow(r,hi);
      #pragma unroll
      for(int d0=0;d0<2;++d0)stg[orow*64+d0*32+r32]=__float2bfloat16(o[d0][r]);}
    asm volatile("s_waitcnt lgkmcnt(0)":::"memory");
    #pragma unroll
    for(int i=0;i<4;++i){const int row=i*8+(lane>>3),ch=lane&7; const u32x4 v=*(const u32x4*)(stg+row*64+ch*8); *(u32x4*)(Ow+(long)row*OP+ch*8)=v;} }
  asm volatile("s_waitcnt vmcnt(0) lgkmcnt(0)\n\ts_barrier":::"memory");
}
}
namespace sbd {
using sba::bf16x8; using sba::f32x16; using sba::u32x4; using sba::bf16; using sba::crow; using sba::cvtpk_s;
typedef float f32x4 __attribute__((ext_vector_type(4)));
#define RLXA __ATOMIC_RELAXED, __HIP_MEMORY_SCOPE_AGENT
template<bool NEWK> __device__ __forceinline__ void weights32(f32x16&c,float&carry,int hi,int q){
  #pragma unroll
  for(int r=0;r<16;++r){ float e=__builtin_amdgcn_exp2f(c[r]);
    if(NEWK){ const int kv=crow(r,hi); if(kv>=8||kv>=q)e=0.f; }
    c[r]=1.f+e; }
  float P2[4],P3[4],T[4],Tl[4],Th[4],off[4];
  #pragma unroll
  for(int k=0;k<4;++k){ P2[k]=c[4*k]*c[4*k+1]; P3[k]=P2[k]*c[4*k+2]; T[k]=__builtin_amdgcn_rcpf(P3[k]*c[4*k+3]); }
  #pragma unroll
  for(int k=0;k<4;++k){ auto s=__builtin_amdgcn_permlane32_swap(__float_as_uint(T[k]),__float_as_uint(T[k]),false,false); Tl[k]=__uint_as_float(s[0]); Th[k]=__uint_as_float(s[1]); }
  float E=carry;
  #pragma unroll
  for(int k=3;k>=0;--k){ off[k]=hi?E:E*Th[k]; E=E*(Tl[k]*Th[k]); }
  carry=E;
  #pragma unroll
  for(int k=0;k<4;++k){ const float g=T[k]*off[k], R1=c[4*k]*g, R2=P2[k]*g, R3=P3[k]*g; c[4*k]=R1-g; c[4*k+1]=R2-R1; c[4*k+2]=R3-R2; c[4*k+3]=off[k]-R3; }
}
struct Raw { f32x4 k[8]; float v[32]; };
__device__ __forceinline__ void load_tile(Raw&R,const float*kb,const float*vb){
  #pragma unroll
  for(int d0=0;d0<4;++d0){ R.k[2*d0]=__builtin_nontemporal_load((const f32x4*)(kb+16*d0)); R.k[2*d0+1]=__builtin_nontemporal_load((const f32x4*)(kb+16*d0+4)); }
  #pragma unroll
  for(int d0=0;d0<2;++d0)
    #pragma unroll
    for(int ks=0;ks<2;++ks)
      #pragma unroll
      for(int j=0;j<8;++j) R.v[(d0*2+ks)*8+j]=__builtin_nontemporal_load(vb+(size_t)(16*ks+8*(j>>2)+(j&3))*512+32*d0);
}
struct Frag { bf16x8 k[4]; bf16x8 v[4]; };
__device__ __forceinline__ void cvt_tile(Frag&F,const Raw&R){
  #pragma unroll
  for(int d0=0;d0<4;++d0){ u32x4 p; p[0]=cvtpk_s(R.k[2*d0][0],R.k[2*d0][1]); p[1]=cvtpk_s(R.k[2*d0][2],R.k[2*d0][3]); p[2]=cvtpk_s(R.k[2*d0+1][0],R.k[2*d0+1][1]); p[3]=cvtpk_s(R.k[2*d0+1][2],R.k[2*d0+1][3]); F.k[d0]=__builtin_bit_cast(bf16x8,p); }
  #pragma unroll
  for(int i=0;i<4;++i){ u32x4 p;
    #pragma unroll
    for(int j=0;j<4;++j) p[j]=cvtpk_s(R.v[8*i+2*j],R.v[8*i+2*j+1]);
    F.v[i]=__builtin_bit_cast(bf16x8,p); }
}
template<bool NEWK> __device__ __forceinline__ void tile_step(const Frag&F,const bf16x8*qr,const f32x16&bv,f32x16*o,float&carry,int hi,int q){
  f32x16 c=bv;
  #pragma unroll
  for(int d0=0;d0<4;++d0) c=SBA_MFMA(F.k[d0],qr[d0],c);
  weights32<NEWK>(c,carry,hi,q);
  u32x4 pw[2];
  #pragma unroll
  for(int k=0;k<2;++k)
    #pragma unroll
    for(int j=0;j<4;++j) pw[k][j]=cvtpk_s(c[8*k+2*j],c[8*k+2*j+1]);
  #pragma unroll
  for(int d0=0;d0<2;++d0)
    #pragma unroll
    for(int ks=0;ks<2;++ks) o[d0]=SBA_MFMA(__builtin_bit_cast(bf16x8,pw[ks]),F.v[d0*2+ks],o[d0]);
}
__device__ __forceinline__ void decode_unit(int smp,int j,const float*cache_k,const float*cache_v,const int*page_table,const bf16*Q,const bf16*Kn,const bf16*Vn,const float*b_sb,
                                            float*part,float*rtot,unsigned*cnt,bf16*MIX,volatile __attribute__((address_space(3))) unsigned*flag){
  int tid_=threadIdx.x; asm volatile("":"+v"(tid_)); const int tid=tid_,lane=tid&63,r32=lane&31,hi=lane>>5; const int h=__builtin_amdgcn_readfirstlane(tid>>6);
  const float bias2=b_sb[h]*1.4426950408889634f;
  f32x16 bv;
  #pragma unroll
  for(int r=0;r<16;++r)bv[r]=bias2;
  const long srow=16384+8*smp;
  bf16x8 qr[4];
  #pragma unroll
  for(int d0=0;d0<4;++d0){ bf16x8 z={0,0,0,0,0,0,0,0}; if(r32<8) z=*reinterpret_cast<const bf16x8*>(Q+(srow+r32)*512+h*64+d0*16+hi*8); qr[d0]=z; }
  f32x16 o[2]; o[0]=f32x16{}; o[1]=f32x16{}; float carry=1.f;
  if(j==7){
    Frag F;
    #pragma unroll
    for(int d0=0;d0<4;++d0){ bf16x8 z={0,0,0,0,0,0,0,0}; if(r32<8) z=*reinterpret_cast<const bf16x8*>(Kn+(srow+r32)*512+h*64+d0*16+hi*8); F.k[d0]=z; }
    #pragma unroll
    for(int d0=0;d0<2;++d0){
      bf16x8 z={0,0,0,0,0,0,0,0};
      #pragma unroll
      for(int jj=0;jj<4;++jj) z[jj]=*reinterpret_cast<const short*>(Vn+(srow+4*hi+jj)*512+h*64+32*d0+r32);
      F.v[d0*2]=z; F.v[d0*2+1]=(bf16x8){0,0,0,0,0,0,0,0}; }
    tile_step<true>(F,qr,bv,o,carry,hi,r32);
  }
  const int*pt=page_table+smp*64+8*j;
  Raw R; Frag F;
  #define ROWK(tt) (cache_k+(((size_t)pt[(tt)>>2]*128+(size_t)(((tt)&3)*32+r32))*8+h)*64+8*hi)
  #define ROWV(tt) (cache_v+(((size_t)pt[(tt)>>2]*128+(size_t)(((tt)&3)*32+4*hi))*8+h)*64+r32)
  load_tile(R,ROWK(31),ROWV(31)); cvt_tile(F,R);
  for(int tt=31;tt>=0;--tt){
    if(tt>0) load_tile(R,ROWK(tt-1),ROWV(tt-1));
    tile_step<false>(F,qr,bv,o,carry,hi,r32);
    if(tt>0) cvt_tile(F,R);
  }
  #undef ROWK
  #undef ROWV
  const int unit=smp*8+j;
  int l2_=threadIdx.x; asm volatile("":"+v"(l2_)); const int lane2=l2_&63, r32b=lane2&31, hib=lane2>>5;
  unsigned*pp=(unsigned*)part+((size_t)unit*8+h)*512;
  #pragma unroll
  for(int r=0;r<4;++r)
    #pragma unroll
    for(int d0=0;d0<2;++d0) __hip_atomic_store(pp+(r+4*hib)*64+32*d0+r32b,__float_as_uint(o[d0][r]),RLXA);
  if(lane2<8) __hip_atomic_store((unsigned*)rtot+((size_t)unit*8+h)*8+lane2,__float_as_uint(carry),RLXA);
  asm volatile("s_waitcnt vmcnt(0)":::"memory");
  __syncthreads();
  if(tid==0){ const unsigned old=__hip_atomic_fetch_add(cnt+64*smp,1u,RLXA); flag[0]=(old==7u)?1u:0u; }
  __syncthreads();
  const bool last=flag[0]!=0u;
  __syncthreads();
  if(last){
    const int q=lane2>>3,dc=(lane2&7)*8; float acc[8];
    #pragma unroll
    for(int i=0;i<8;++i)acc[i]=0.f;
    float f=1.f;
    for(int jj=7;jj>=0;--jj){ const size_t u=(size_t)smp*8+jj; const unsigned*src=(const unsigned*)part+(u*8+h)*512+q*64+dc;
      #pragma unroll
      for(int i=0;i<8;++i) acc[i]+=f*__uint_as_float(__hip_atomic_load(src+i,RLXA));
      f*=__uint_as_float(__hip_atomic_load((const unsigned*)rtot+(u*8+h)*8+q,RLXA)); }
    u32x4 w; w[0]=cvtpk_s(acc[0],acc[1]); w[1]=cvtpk_s(acc[2],acc[3]); w[2]=cvtpk_s(acc[4],acc[5]); w[3]=cvtpk_s(acc[6],acc[7]);
    *(u32x4*)(MIX+(srow+q)*1024+h*64+dc)=w;
  }
}
}
namespace gla {
using sba::bf16; using sba::cvtpk_s;
typedef short bf16x8 __attribute__((ext_vector_type(8)));
typedef short bf16x4 __attribute__((ext_vector_type(4)));
typedef float f32x4 __attribute__((ext_vector_type(4)));
typedef unsigned u32x4 __attribute__((ext_vector_type(4)));
typedef unsigned u32x2 __attribute__((ext_vector_type(2)));
#define GLAS __attribute__((address_space(3)))
constexpr int GP=1792;
constexpr int L_QD=0,L_KI=9216,L_KET=18432,L_VT=27648,L_DEC=46080,L_EXR=46336,L_TOT=46592,L_SSQ=48640,L_END=50688;
#define GMFMA(a,b,c) __builtin_amdgcn_mfma_f32_16x16x32_bf16((a),(b),(c),0,0,0)
__device__ __forceinline__ float bf2f(short s){ return __uint_as_float(((unsigned)(unsigned short)s)<<16); }
__device__ __forceinline__ short f2bf(float f){ return (short)(cvtpk_s(f,0.f)&0xffffu); }
template<int MODE> __device__ __forceinline__ void chunk(const bf16*G,bf16*MIX,long m0,int ntok,int h,GLAS char*L,f32x4(&S)[4],const float(&wg)[16],float bg,float gain,float&dseg){
  int tid_=threadIdx.x; asm volatile("":"+v"(tid_)); const int tid=tid_,lane=tid&63,c=lane,fr=lane&15,fq=lane>>4; const int w=__builtin_amdgcn_readfirstlane(tid>>6); const int g=w;
  const short*Gs=(const short*)G;
  float bl[8]; float run=0.f;
  #pragma unroll
  for(int i=0;i<8;++i){ const int t=8*g+i; float la=0.f;
    if(t<ntok){ const bf16x8*ap=(const bf16x8*)(Gs+(m0+t)*GP+1536); const bf16x8 a0=ap[0],a1=ap[1]; float x=bg;
      #pragma unroll
      for(int j=0;j<8;++j){ x+=bf2f(a0[j])*wg[j]; x+=bf2f(a1[j])*wg[8+j]; }
      la=(fminf(x,0.f)-__logf(1.f+__expf(-fabsf(x))))*0.0625f; }
    run+=la; bl[i]=run; }
  GLAS float*TOT=(GLAS float*)(L+L_TOT);
  TOT[g*64+c]=run;
  __syncthreads();
  float prefix=0.f,total=0.f;
  #pragma unroll
  for(int gg=0;gg<8;++gg){ const float v=TOT[gg*64+c]; total+=v; if(gg<g)prefix+=v; }
  const float bref=0.5f*total;
  float ke[8];
  #pragma unroll
  for(int i=0;i<8;++i){ const int t=8*g+i; const float b=prefix+bl[i]; float kk=0.f,qq=0.f;
    if(t<ntok){ kk=bf2f(Gs[(m0+t)*GP+256+64*h+c]); if(MODE==1) qq=bf2f(Gs[(m0+t)*GP+64*h+c]); }
    ke[i]=kk*__expf(total-b);
    if(MODE==1){ *(GLAS short*)(L+L_QD+t*144+c*2)=f2bf(qq*0.125f*__expf(b-bref)); *(GLAS short*)(L+L_KI+t*144+c*2)=f2bf(kk*__expf(bref-b)); } }
  { u32x4 p; p[0]=cvtpk_s(ke[0],ke[1]); p[1]=cvtpk_s(ke[2],ke[3]); p[2]=cvtpk_s(ke[4],ke[5]); p[3]=cvtpk_s(ke[6],ke[7]); *(GLAS u32x4*)(L+L_KET+c*144+g*16)=p; }
  if(g==0){ const float d=__expf(total); ((GLAS float*)(L+L_DEC))[c]=d; ((GLAS float*)(L+L_EXR))[c]=__expf(bref); dseg*=d; }
  { const int dv=tid&127,tg=tid>>7; float vv[16];
    #pragma unroll
    for(int i=0;i<16;++i){ const int t=16*tg+i; vv[i]=(t<ntok)?bf2f(Gs[(m0+t)*GP+512+128*h+dv]):0.f; }
    u32x4 p0,p1;
    #pragma unroll
    for(int j=0;j<4;++j){ p0[j]=cvtpk_s(vv[2*j],vv[2*j+1]); p1[j]=cvtpk_s(vv[8+2*j],vv[8+2*j+1]); }
    *(GLAS u32x4*)(L+L_VT+dv*144+tg*32)=p0; *(GLAS u32x4*)(L+L_VT+dv*144+tg*32+16)=p1; }
  __syncthreads();
  const int dvl=16*w+fr;
  f32x4 O[4];
  if(MODE==1){
    f32x4 PT[4][4];
    #pragma unroll
    for(int st=0;st<4;++st)
      #pragma unroll
      for(int tt=0;tt<4;++tt){ f32x4 acc={0.f,0.f,0.f,0.f};
        if(st<=tt){
          #pragma unroll
          for(int kk=0;kk<2;++kk){ const bf16x8 a=*(GLAS const bf16x8*)(L+L_KI+(16*st+fr)*144+(32*kk+8*fq)*2), b=*(GLAS const bf16x8*)(L+L_QD+(16*tt+fr)*144+(32*kk+8*fq)*2); acc=GMFMA(a,b,acc); }
          if(st==tt){
            #pragma unroll
            for(int i=0;i<4;++i) if(4*fq+i>fr) acc[i]=0.f; } }
        PT[st][tt]=acc; }
    #pragma unroll
    for(int tt=0;tt<4;++tt){ O[tt]=(f32x4){0.f,0.f,0.f,0.f};
      #pragma unroll
      for(int pr=0;pr<2;++pr){ if(2*pr<=tt){
        u32x4 pa; pa[0]=cvtpk_s(PT[2*pr][tt][0],PT[2*pr][tt][1]); pa[1]=cvtpk_s(PT[2*pr][tt][2],PT[2*pr][tt][3]); pa[2]=cvtpk_s(PT[2*pr+1][tt][0],PT[2*pr+1][tt][1]); pa[3]=cvtpk_s(PT[2*pr+1][tt][2],PT[2*pr+1][tt][3]);
        const u32x2 b0=*(GLAS const u32x2*)(L+L_VT+dvl*144+(32*pr+4*fq)*2), b1=*(GLAS const u32x2*)(L+L_VT+dvl*144+(32*pr+16+4*fq)*2);
        const u32x4 pb={b0[0],b0[1],b1[0],b1[1]};
        O[tt]=GMFMA(__builtin_bit_cast(bf16x8,pa),__builtin_bit_cast(bf16x8,pb),O[tt]); } } }
    #pragma unroll
    for(int kk=0;kk<2;++kk){
      const f32x4 e0=*(GLAS const f32x4*)(L+L_EXR+(32*kk+4*fq)*4), e1=*(GLAS const f32x4*)(L+L_EXR+(32*kk+16+4*fq)*4);
      const f32x4 s0=S[2*kk]*e0, s1=S[2*kk+1]*e1;
      u32x4 pb; pb[0]=cvtpk_s(s0[0],s0[1]); pb[1]=cvtpk_s(s0[2],s0[3]); pb[2]=cvtpk_s(s1[0],s1[1]); pb[3]=cvtpk_s(s1[2],s1[3]);
      #pragma unroll
      for(int tt=0;tt<4;++tt){ const u32x2 a0=*(GLAS const u32x2*)(L+L_QD+(16*tt+fr)*144+(32*kk+4*fq)*2), a1=*(GLAS const u32x2*)(L+L_QD+(16*tt+fr)*144+(32*kk+16+4*fq)*2);
        const u32x4 pa={a0[0],a0[1],a1[0],a1[1]};
        O[tt]=GMFMA(__builtin_bit_cast(bf16x8,pa),__builtin_bit_cast(bf16x8,pb),O[tt]); } }
  }
  #pragma unroll
  for(int mt=0;mt<4;++mt){ const f32x4 d4=*(GLAS const f32x4*)(L+L_DEC+(16*mt+4*fq)*4); S[mt]=S[mt]*d4;
    #pragma unroll
    for(int kk=0;kk<2;++kk){ const bf16x8 a=*(GLAS const bf16x8*)(L+L_KET+(16*mt+fr)*144+(32*kk+8*fq)*2), b=*(GLAS const bf16x8*)(L+L_VT+dvl*144+(32*kk+8*fq)*2); S[mt]=GMFMA(a,b,S[mt]); } }
  if(MODE==1){
    GLAS float*SSQ=(GLAS float*)(L+L_SSQ);
    #pragma unroll
    for(int tt=0;tt<4;++tt)
      #pragma unroll
      for(int i=0;i<4;++i){ float ss=O[tt][i]*O[tt][i]; ss+=__shfl_xor(ss,1); ss+=__shfl_xor(ss,2); ss+=__shfl_xor(ss,4); ss+=__shfl_xor(ss,8); if(fr==0) SSQ[w*64+16*tt+4*fq+i]=ss; }
    __syncthreads();
    #pragma unroll
    for(int tt=0;tt<4;++tt)
      #pragma unroll
      for(int i=0;i<4;++i){ const int t=16*tt+4*fq+i; float tot=0.f;
        #pragma unroll
        for(int ww=0;ww<8;++ww) tot+=SSQ[ww*64+t];
        if(t<ntok){ const float rstd=rsqrtf(tot*(1.f/128.f)+1e-6f); const float rg=bf2f(Gs[(m0+t)*GP+1024+128*h+dvl]); const float sl=rg/(1.f+__expf(-rg));
          ((short*)MIX)[(m0+t)*1024+512+128*h+dvl]=f2bf(O[tt][i]*rstd*gain*sl); } }
  }
  __syncthreads();
}
__device__ __forceinline__ void load_consts(int h,const float*w_gate,const float*b_gate,const float*g_out,float(&wg)[16],float&bg,float&gain){
  const int lane=threadIdx.x&63, w=threadIdx.x>>6;
  #pragma unroll
  for(int j=0;j<16;++j) wg[j]=w_gate[j*256+64*h+lane];
  bg=b_gate[64*h+lane]; gain=g_out[16*w+(lane&15)];
}
__device__ __forceinline__ void pass1_unit(int unit,const bf16*G,const float*w_gate,const float*b_gate,const float*g_out,float*SLOC,float*DSEG,GLAS char*L){
  const int bh=unit>>5,sseg=unit&31,b=bh>>2,h=bh&3; const int tid=threadIdx.x;
  float wg[16],bg,gain; load_consts(h,w_gate,b_gate,g_out,wg,bg,gain);
  f32x4 S[4];
  #pragma unroll
  for(int mt=0;mt<4;++mt)S[mt]=(f32x4){0.f,0.f,0.f,0.f};
  float dseg=1.f; const long m0=(long)b*8192+256*sseg;
  for(int ch=0;ch<4;++ch) chunk<0>(G,nullptr,m0+64*ch,64,h,L,S,wg,bg,gain,dseg);
  f32x4*dst=(f32x4*)(SLOC+((size_t)unit*512+tid)*16);
  #pragma unroll
  for(int mt=0;mt<4;++mt)dst[mt]=S[mt];
  if(tid<64)DSEG[unit*64+tid]=dseg;
}
__device__ __forceinline__ void pass3_unit(int unit,const bf16*G,bf16*MIX,const float*w_gate,const float*b_gate,const float*g_out,const float*SLOC,const float*DSEG,float*sfin_base,GLAS char*L){
  const int bh=unit>>5,sseg=unit&31,b=bh>>2,h=bh&3; const int tid=threadIdx.x,lane=tid&63,fr=lane&15,fq=lane>>4,w=tid>>6;
  float wg[16],bg,gain; load_consts(h,w_gate,b_gate,g_out,wg,bg,gain);
  f32x4 S[4];
  #pragma unroll
  for(int mt=0;mt<4;++mt)S[mt]=(f32x4){0.f,0.f,0.f,0.f};
  for(int j=0;j<sseg;++j){ const int uj=bh*32+j; const f32x4*src=(const f32x4*)(SLOC+((size_t)uj*512+tid)*16);
    #pragma unroll
    for(int mt=0;mt<4;++mt){ const f32x4 d4=*(const f32x4*)(DSEG+uj*64+16*mt+4*fq); S[mt]=S[mt]*d4+src[mt]; } }
  float dseg=1.f; const long m0=(long)b*8192+256*sseg;
  for(int ch=0;ch<4;++ch) chunk<1>(G,MIX,m0+64*ch,64,h,L,S,wg,bg,gain,dseg);
  if(sseg==31){ float*o=sfin_base+(size_t)bh*8192;
    #pragma unroll
    for(int mt=0;mt<4;++mt)
      #pragma unroll
      for(int i=0;i<4;++i) o[(16*mt+4*fq+i)*128+16*w+fr]=S[mt][i]; }
}
__device__ __forceinline__ void sample_unit(int unit,const bf16*G,bf16*MIX,const float*w_gate,const float*b_gate,const float*g_out,const float*s0,float*sout,GLAS char*L){
  const int smp=unit>>2,h=unit&3; const int tid=threadIdx.x,lane=tid&63,fr=lane&15,fq=lane>>4,w=tid>>6;
  float wg[16],bg,gain; load_consts(h,w_gate,b_gate,g_out,wg,bg,gain);
  f32x4 S[4]; const float*si=s0+(size_t)unit*8192; float*so=sout+(size_t)unit*8192;
  #pragma unroll
  for(int mt=0;mt<4;++mt)
    #pragma unroll
    for(int i=0;i<4;++i) S[mt][i]=si[(16*mt+4*fq+i)*128+16*w+fr];
  float dseg=1.f;
  chunk<1>(G,MIX,16384+8*(long)smp,8,h,L,S,wg,bg,gain,dseg);
  #pragma unroll
  for(int mt=0;mt<4;++mt)
    #pragma unroll
    for(int i=0;i<4;++i) so[(16*mt+4*fq+i)*128+16*w+fr]=S[mt][i];
}
}
__device__ __forceinline__ float wave_sum(float v) {
#pragma unroll
    for (int o = 1; o < 64; o <<= 1) v += __shfl_xor(v, o);
    return v;
}
__device__ __forceinline__ void p0_transpose_item(const float* W, int K, int Nreal, int Npad, bf16* WT, LAS float* scr, int item, int lane) {
    const int nblk = Npad / 32, kb = item / nblk, nb = item % nblk, k0 = 64 * kb, n0 = 32 * nb;
    const int n = n0 + (lane & 31);
#pragma unroll 8
    for (int i = 0; i < 32; ++i) { const int kk = 2 * i + (lane >> 5); scr[kk * 33 + (lane & 31)] = (n < Nreal) ? W[(size_t)(k0 + kk) * Nreal + n] : 0.f; }
    LDS_WAIT(); asm volatile("" ::: "memory");
    const int c = lane & 7;
#pragma unroll
    for (int j = 0; j < 4; ++j) { const int nn = (lane >> 3) + 8 * j; const LAS float* s = scr + (8 * c) * 33 + nn;
        v4u o; o.x = pk2(s[0 * 33], s[1 * 33]); o.y = pk2(s[2 * 33], s[3 * 33]); o.z = pk2(s[4 * 33], s[5 * 33]); o.w = pk2(s[6 * 33], s[7 * 33]);
        *(GAS v4u*)(WT + (size_t)(n0 + nn) * K + k0 + 8 * c) = o; }
    LDS_WAIT(); asm volatile("" ::: "memory");
}
__device__ __forceinline__ void norm_mod_row_bf16(int lane, const float* xrow, const float* gain, const float* sc, const float* sh, bf16* orow) {
    const f32x4* xr = (const f32x4*)xrow + lane; f32x4 v[4]; float s = 0.f;
#pragma unroll
    for (int j = 0; j < 4; ++j) { v[j] = xr[64 * j]; s += (v[j].x * v[j].x + v[j].y * v[j].y) + (v[j].z * v[j].z + v[j].w * v[j].w); }
    const float rstd = rsqrtf(wave_sum(s) * (1.f / D) + NORM_EPS);
    unsigned long long* o8 = (unsigned long long*)orow + lane;
#pragma unroll
    for (int j = 0; j < 4; ++j) { const f32x4 g = ((const f32x4*)gain)[lane + 64 * j], a = ((const f32x4*)sc)[lane + 64 * j], b = ((const f32x4*)sh)[lane + 64 * j];
        const f32x4 y = v[j] * rstd * g * (a + 1.f) + b;
        o8[64 * j] = (unsigned long long)pk2(y.x, y.y) | ((unsigned long long)pk2(y.z, y.w) << 32); }
}
__device__ __forceinline__ void norm_row_f32_inplace(int lane, float* xrow, const float* gain) {
    f32x4* xr = (f32x4*)xrow + lane; f32x4 v[4]; float s = 0.f;
#pragma unroll
    for (int j = 0; j < 4; ++j) { v[j] = xr[64 * j]; s += (v[j].x * v[j].x + v[j].y * v[j].y) + (v[j].z * v[j].z + v[j].w * v[j].w); }
    const float rstd = rsqrtf(wave_sum(s) * (1.f / D) + NORM_EPS);
#pragma unroll
    for (int j = 0; j < 4; ++j) { const f32x4 g = ((const f32x4*)gain)[lane + 64 * j]; xr[64 * j] = v[j] * rstd * g; }
}
__device__ __forceinline__ int bidx_of_row(int m) { return m < MP ? (m >> 13) : 2 + ((m - MP) >> 3); }

struct Args { const float* in[21]; const int* page_table; float* out; unsigned char* ws; };
static_assert(sizeof(Args) == 24 * 8, "Args has no padding");

__global__ void __launch_bounds__(NWAVES * 64, 2) mk_fwd(Args args) {
    extern __shared__ __attribute__((aligned(16))) unsigned char lds[];
    LAS unsigned char* L = (LAS unsigned char*)lds;
    volatile LAS unsigned* MISC = (volatile LAS unsigned*)(L + MISC_OFF);
    const int tid = threadIdx.x, lane = tid & 63, wave = __builtin_amdgcn_readfirstlane(tid >> 6);
    const int G = gridDim.x; const int bx = blockIdx.x; const int vcu = (G % 8 == 0) ? (bx % 8) * (G / 8) + bx / 8 : bx;
    unsigned char* ws = args.ws;
    unsigned* ctl = (unsigned*)(ws + WS_CTL);
    const float *x_prompt = args.in[0], *x_sample = args.in[1], *c_prompt = args.in[2], *c_sample = args.in[3], *cache_k = args.in[4], *cache_v = args.in[5], *state_gla = args.in[6];
    const float *w_ada = args.in[8], *b_ada = args.in[9], *g_mix = args.in[10], *w_in = args.in[11], *b_sb = args.in[12], *w_gate = args.in[13], *b_gate = args.in[14], *g_gla_out = args.in[15];
    const float *w_out = args.in[16], *g_ffn = args.in[17], *w_up = args.in[18], *w_down = args.in[19], *g_final = args.in[20];
    float* out = args.out;
    float* MOD = (float*)(ws + WS_MOD);
    bf16 *Win_t = (bf16*)(ws + WS_WIN), *Wo_t = (bf16*)(ws + WS_WO), *Wup_t = (bf16*)(ws + WS_WUP), *Wdn_t = (bf16*)(ws + WS_WDN);
    bf16 *XN = (bf16*)(ws + WS_XN), *QB = (bf16*)(ws + WS_Q), *KB = (bf16*)(ws + WS_K), *VB = (bf16*)(ws + WS_V), *GB = (bf16*)(ws + WS_G), *MIX = (bf16*)(ws + WS_MIX), *HB = (bf16*)(ws + WS_H);
    float* X1 = (float*)(ws + WS_X1);
    float *SLOC = (float*)(ws + WS_SLOC), *DSEG = (float*)(ws + WS_DSEG), *DPART = (float*)(ws + WS_DPART), *DRTOT = (float*)(ws + WS_DRTOT);
    for (int u = tid; u < (LDS_BYTES - MISC_OFF) / 4; u += NWAVES * 64) ((LAS unsigned*)(L + MISC_OFF))[u] = 0u;
    __syncthreads();
    XcdBarrier bar = xcd_barrier_post(ctl + CW_BAR, MISC + 8);
    const int gw = vcu * NWAVES + wave, NGW = G * NWAVES;

    if (vcu < 96) {
        LAS float* s = (LAS float*)L;
        for (int i = tid; i < NMODR * D; i += NWAVES * 64) { const int r = i >> 10, k = i & 1023; const float c = r < 2 ? c_prompt[r * D + k] : c_sample[(r - 2) * D + k]; s[k * NMODR + r] = c / (1.f + __expf(-c)); }
        __syncthreads();
        const int col = 64 * vcu + lane, k0 = 128 * wave;
        float acc[NMODR];
#pragma unroll
        for (int r = 0; r < NMODR; ++r) acc[r] = 0.f;
#pragma unroll 4
        for (int kk = 0; kk < 128; ++kk) { const int k = k0 + kk; const float w = w_ada[(size_t)k * MODW + col];
#pragma unroll
            for (int r = 0; r < NMODR; ++r) acc[r] += s[k * NMODR + r] * w; }
        __syncthreads();
        LAS float* red = (LAS float*)L;
#pragma unroll
        for (int r = 0; r < NMODR; ++r) red[(wave * NMODR + r) * 64 + lane] = acc[r];
        __syncthreads();
        for (int o = tid; o < NMODR * 64; o += NWAVES * 64) { const int r = o >> 6, l = o & 63; float t = b_ada[64 * vcu + l];
#pragma unroll
            for (int w8 = 0; w8 < 8; ++w8) t += red[(w8 * NMODR + r) * 64 + l];
            MOD[r * MODW + 64 * vcu + l] = t; }
        __syncthreads();
    }
    {
        LAS float* scr = (LAS float*)(L + wave * 16384);
        constexpr int I_IN = (D / 64) * (NIN / 32), I_O = (D / 64) * (D / 32), I_UP = (D / 64) * (FF / 32), I_DN = (FF / 64) * (D / 32);
        constexpr int NITEMS = I_IN + I_O + I_UP + I_DN;
        for (int it = gw; it < NITEMS; it += NGW) {
            int r = it;
            if (r < I_IN) { p0_transpose_item(w_in, D, NIN_REAL, NIN, Win_t, scr, r, lane); continue; } r -= I_IN;
            if (r < I_O) { p0_transpose_item(w_out, D, D, D, Wo_t, scr, r, lane); continue; } r -= I_O;
            if (r < I_UP) { p0_transpose_item(w_up, D, FF, FF, Wup_t, scr, r, lane); continue; } r -= I_UP;
            p0_transpose_item(w_down, FF, D, D, Wdn_t, scr, r, lane);
        }
    }
    xcd_barrier(bar);
    for (int m = gw; m < M; m += NGW) { const float* xr = m < MP ? x_prompt + (size_t)m * D : x_sample + (size_t)(m - MP) * D; const float* md = MOD + (size_t)bidx_of_row(m) * MODW;
        norm_mod_row_bf16(lane, xr, g_mix, md + 1024, md, XN + (size_t)m * D); }
    xcd_barrier(bar);
    {
        pg8::Gemm g{XN, Win_t, M, NIN, D}; pg8::StaticOrder S; S.init(M, NIN, G, bx);
        pg8::EpiInProj E{QB, KB, VB, GB, out + OK_P, out + OV_P, out + OK_S - (size_t)MP * 512, out + OV_S - (size_t)MP * 512, QSCALE};
        pg8::gemm_phase<pg8::EpiInProj, pg8::StaticOrder, true, true>(L, g, S, E);
    }
    xcd_barrier(bar);
    for (int u = vcu; u < 256; u += G) gla::pass1_unit(u, (const gla::bf16*)GB, w_gate, b_gate, g_gla_out, SLOC, DSEG, (LAS char*)L);
    xcd_barrier(bar);
#ifdef PROBE_SB2
    for (int rep_ = 0; rep_ < 2; ++rep_)
#endif
    for (int v = vcu; v < 256; v += G) {
        const int bh = v >> 4, s = v & 15, b = bh >> 3, h = bh & 7; const float bias2 = b_sb[h] * 1.4426950408889634f;
        sba::attn_unit(b, h, 31 - s, (const sba::bf16*)QB, (const sba::bf16*)KB, (const sba::bf16*)VB, (sba::bf16*)MIX, (char*)lds, bias2);
        sba::attn_unit(b, h, s, (const sba::bf16*)QB, (const sba::bf16*)KB, (const sba::bf16*)VB, (sba::bf16*)MIX, (char*)lds, bias2);
    }
    for (int u = vcu; u < 256; u += G) gla::pass3_unit(u, (const gla::bf16*)GB, (gla::bf16*)MIX, w_gate, b_gate, g_gla_out, SLOC, DSEG, out + OSG_P, (LAS char*)L);
#ifdef PROBE_DEC2
    for (int rep_ = 0; rep_ < 2; ++rep_)
#endif
    for (int u = vcu; u < 256; u += G) sbd::decode_unit(u >> 3, u & 7, cache_k, cache_v, args.page_table, (const sba::bf16*)QB, (const sba::bf16*)KB, (const sba::bf16*)VB, b_sb, DPART, DRTOT, ctl + CW_DEC, (sba::bf16*)MIX, MISC + 16);
    for (int u = vcu; u < 128; u += G) gla::sample_unit(u, (const gla::bf16*)GB, (gla::bf16*)MIX, w_gate, b_gate, g_gla_out, state_gla, out + OSG_S, (LAS char*)L);
    xcd_barrier(bar);
    {
        pg8::Gemm g{MIX, Wo_t, M, D, D}; pg8::StaticOrder S; S.init(M, D, G, bx);
        pg8::EpiResGate E{x_prompt, x_sample - (size_t)MP * D, X1, MOD + 2048};
        pg8::gemm_phase<pg8::EpiResGate, pg8::StaticOrder, true, true>(L, g, S, E);
    }
    xcd_barrier(bar);
    for (int m = gw; m < M; m += NGW) { const float* md = MOD + (size_t)bidx_of_row(m) * MODW; norm_mod_row_bf16(lane, X1 + (size_t)m * D, g_ffn, md + 4096, md + 3072, XN + (size_t)m * D); }
    xcd_barrier(bar);
    {
        pg8::Gemm g{XN, Wup_t, M, FF, D}; pg8::StaticOrder S; S.init(M, FF, G, bx);
        pg8::EpiRelu2 E{HB, FF};
        pg8::gemm_phase<pg8::EpiRelu2, pg8::StaticOrder, true, true>(L, g, S, E);
    }
    xcd_barrier(bar);
    {
        pg8::Gemm g{HB, Wdn_t, M, D, FF}; pg8::StaticOrder S; S.init(M, D, G, bx);
        pg8::EpiResGate E{X1, X1, out + OY, MOD + 5120};
        pg8::gemm_phase<pg8::EpiResGate, pg8::StaticOrder, true, true>(L, g, S, E);
    }
    xcd_barrier(bar);
    for (int m = gw; m < M; m += NGW) norm_row_f32_inplace(lane, out + OY + (size_t)m * D, g_final);
}

extern "C" void kernel_launch(void* const* d_in, const int* in_sizes, int n_in, void* d_out, int out_size, void* d_ws, size_t ws_size, hipStream_t stream) {
    static int grid = 0;
    if (grid == 0) {
        if (n_in != 21 || (size_t)out_size != OUT_TOTAL || ws_size < WS_END) { fprintf(stderr, "kernel_launch: unexpected sizes: n_in %d out %d ws %zu\n", n_in, out_size, ws_size); grid = -1; return; }
        int dev = 0, cus = 0, per_cu = 0;
        if (hipGetDevice(&dev) != hipSuccess || hipDeviceGetAttribute(&cus, hipDeviceAttributeMultiprocessorCount, dev) != hipSuccess) { grid = -1; return; }
        if (hipFuncSetAttribute((const void*)mk_fwd, hipFuncAttributeMaxDynamicSharedMemorySize, LDS_BYTES) != hipSuccess) { fprintf(stderr, "kernel_launch: hipFuncSetAttribute failed\n"); grid = -1; return; }
        if (hipOccupancyMaxActiveBlocksPerMultiprocessor(&per_cu, (const void*)mk_fwd, NWAVES * 64, LDS_BYTES) != hipSuccess || per_cu < 1) { fprintf(stderr, "kernel_launch: occupancy query says %d\n", per_cu); }
        (void)hipGetLastError();
        grid = cus;
    }
    if (grid < 0) return;
    if (hipMemsetAsync((char*)d_ws + WS_CTL, 0, CTL_ZERO_BYTES, stream) != hipSuccess) return;
    Args a{};
    for (int i = 0; i < 21; ++i) a.in[i] = (const float*)d_in[i];
    a.page_table = (const int*)d_in[7]; a.out = (float*)d_out; a.ws = (unsigned char*)d_ws;
    hipLaunchKernelGGL(mk_fwd, dim3(grid), dim3(NWAVES * 64), LDS_BYTES, stream, a);
    const hipError_t le = hipPeekAtLastError();
    if (le != hipSuccess) fprintf(stderr, "kernel_launch: launch failed: %s\n", hipGetErrorName(le));
}
```

```cpp
#include <hip/hip_runtime.h>
#include <hip/hip_bf16.h>
#include <cstdio>
#include <cstdint>
namespace pg8 {
#define PG8_LAS __attribute__((address_space(3)))
typedef unsigned short bf16_t;
typedef short bf16x8 __attribute__((ext_vector_type(8)));
typedef float f32x4 __attribute__((ext_vector_type(4)));
typedef unsigned u32x4 __attribute__((ext_vector_type(4)));
constexpr int BM = 256, BK = 64, HALF = 128, HTB = HALF * BK * 2  , STAGE_BYTES = 8 * HTB, NXCD = 8, WGM = 8;

__host__ __device__ __forceinline__ int lds_byte(int r, int c) { const int st = (r >> 4) * 2 + (c >> 5), rr = r & 15, cc = c & 31, ob = rr * 64 + cc * 2; return st * 1024 + (ob ^ (((ob >> 9) & 1) << 5)); }
__host__ __device__ __forceinline__ void stage_rc(int b, int& R, int& C) { const int st = b / 1024, sb = b % 1024, swz = sb ^ (((sb >> 9) & 1) << 5); R = (st >> 1) * 16 + swz / 64; C = (st & 1) * 32 + (swz % 64) / 2; }
__host__ __device__ __forceinline__ int perm32(int rho) { const int n = rho >> 4, i = rho & 15; return 8 * (i >> 2) + 4 * n + (i & 3); }

struct Unit { int pm, pn; };
struct Gemm { const bf16_t* A; const bf16_t* Bt; int M, N, K; };

struct StaticOrder {
    int nM, nN, nwg, G, c;
    __host__ __device__ void init(int M, int N, int G_, int c_) { nM = M / BM; nN = N / BM; nwg = nM * nN; G = G_; c = c_; }
    __host__ __device__ bool next(int i, Unit& u) const {
        const long L = (long)i * G + c; if (L >= nwg) return false;
        int wgid = (int)L; { const int q = nwg / NXCD, r = nwg % NXCD, xcd = wgid % NXCD, off = wgid / NXCD; wgid = (xcd < r ? xcd * (q + 1) : r * (q + 1) + (xcd - r) * q) + off; }
        const int nig = WGM * nN, gid = wgid / nig, fm = gid * WGM, gsz = (nM - fm) < WGM ? (nM - fm) : WGM;
        u.pm = fm + ((wgid % nig) % gsz); u.pn = (wgid % nig) / gsz; return true;
    }
    __device__ __forceinline__ void a_ready(const Unit&) const {}
    __device__ __forceinline__ void done(const Unit&) const {}
};

__device__ __forceinline__ unsigned cvt_pk_bf16(float lo, float hi) { unsigned r; asm volatile("v_cvt_pk_bf16_f32 %0, %1, %2" : "=v"(r) : "v"(lo), "v"(hi)); return r; }

struct EpiInProj {
    static constexpr bool PERM = true, AFTER_DRAIN = false;
    bf16_t *Q, *K, *V, *G; float *kP, *vP, *kS, *vS; float qscale;
    __device__ __forceinline__ void operator()(const f32x4 (&acc)[2][2][4][2], const Unit& u, int wr, int wc, int fr, int fq) const {
        const int pn = u.pn, pm = u.pm;
        bf16_t* dst; int ldc, colbase; float sc = 1.f; float* fo = nullptr;
        if (pn < 2)      { dst = Q; ldc = 512; colbase = pn * 256; sc = qscale; }
        else if (pn < 4) { dst = K; ldc = 512; colbase = (pn - 2) * 256; fo = pm < 64 ? kP : kS; }
        else if (pn < 6) { dst = V; ldc = 512; colbase = (pn - 4) * 256; fo = pm < 64 ? vP : vS; }
        else             { dst = G; ldc = 1792; colbase = (pn - 6) * 256; }
        const int row0 = pm * BM + wr * 64 + fr, cl = colbase + wc * 32 + 8 * fq;
#pragma unroll
        for (int ai = 0; ai < 2; ++ai)
#pragma unroll
            for (int m = 0; m < 4; ++m) { const size_t row = (size_t)(row0 + ai * HALF + m * 16);
#pragma unroll
                for (int bj = 0; bj < 2; ++bj) { const f32x4 a0 = acc[ai][bj][m][0], a1 = acc[ai][bj][m][1]; const int col = cl + bj * HALF;
                    const f32x4 v0 = a0 * sc, v1 = a1 * sc; u32x4 w; w.x = cvt_pk_bf16(v0[0], v0[1]); w.y = cvt_pk_bf16(v0[2], v0[3]); w.z = cvt_pk_bf16(v1[0], v1[1]); w.w = cvt_pk_bf16(v1[2], v1[3]);
                    *(u32x4*)(dst + row * ldc + col) = w;
                    if (fo) { *(f32x4*)(fo + row * 512 + col) = a0; *(f32x4*)(fo + row * 512 + col + 4) = a1; } } }
    }
};
struct EpiRelu2 {
    static constexpr bool PERM = true, AFTER_DRAIN = false;
    bf16_t* O; int ldc;
    __device__ __forceinline__ void operator()(const f32x4 (&acc)[2][2][4][2], const Unit& u, int wr, int wc, int fr, int fq) const {
        const int row0 = u.pm * BM + wr * 64 + fr, col0 = u.pn * BM + wc * 32 + 8 * fq;
#pragma unroll
        for (int ai = 0; ai < 2; ++ai)
#pragma unroll
            for (int m = 0; m < 4; ++m) { bf16_t* rowp = O + (size_t)(row0 + ai * HALF + m * 16) * ldc + col0;
#pragma unroll
                for (int bj = 0; bj < 2; ++bj) { f32x4 v0 = acc[ai][bj][m][0], v1 = acc[ai][bj][m][1];
#pragma unroll
                    for (int e = 0; e < 4; ++e) { const float a = fmaxf(v0[e], 0.f), b = fmaxf(v1[e], 0.f); v0[e] = a * a; v1[e] = b * b; }
                    u32x4 w; w.x = cvt_pk_bf16(v0[0], v0[1]); w.y = cvt_pk_bf16(v0[2], v0[3]); w.z = cvt_pk_bf16(v1[0], v1[1]); w.w = cvt_pk_bf16(v1[2], v1[3]);
                    *(u32x4*)(rowp + bj * HALF) = w; } }
    }
};
struct EpiResGate {
    static constexpr bool PERM = false, AFTER_DRAIN = false;
    const float* baseP; const float* baseS; float* out; const float* gate;
    __device__ __forceinline__ void operator()(const f32x4 (&acc)[2][2][4][2], const Unit& u, int wr, int wc, int fr, int fq) const {
        const int col0 = u.pn * BM + wc * 32 + 4 * fq;
#pragma unroll
        for (int ai = 0; ai < 2; ++ai)
#pragma unroll
            for (int m = 0; m < 4; ++m) { const int row = u.pm * BM + ai * HALF + wr * 64 + m * 16 + fr; const int bidx = row < 16384 ? (row >> 13) : 2 + ((row - 16384) >> 3);
                const float* b = (row < 16384 ? baseP : baseS) + (size_t)row * 1024 + col0; const float* g = gate + (size_t)bidx * 6144 + col0; float* o = out + (size_t)row * 1024 + col0;
#pragma unroll
                for (int bj = 0; bj < 2; ++bj)
#pragma unroll
                    for (int n = 0; n < 2; ++n) { const int c = bj * HALF + n * 16; const f32x4 bs = *(const f32x4*)(b + c), gv = *(const f32x4*)(g + c); *(f32x4*)(o + c) = bs + gv * acc[ai][bj][m][n]; } }
    }
};
template <class Epi, class Sched, bool ALIGN_EPI = false, bool SP2 = false>
__device__ __forceinline__ void gemm_phase(PG8_LAS unsigned char* lds, const Gemm g, const Sched& S, const Epi& E) {
    int tid_ = threadIdx.x; asm volatile("" : "+v"(tid_)); const int tid = tid_, wid = __builtin_amdgcn_readfirstlane(tid >> 6), lane = tid & 63, wr = wid >> 2, wc = wid & 3, fr = lane & 15, fq = lane >> 4;
    const int K = g.K, nt = K / BK;
    unsigned voffA[2], voffB[2];
#pragma unroll
    for (int i = 0; i < 2; ++i) { int R, C; stage_rc(tid * 16 + i * 8192, R, C); const int Rb = Epi::PERM ? ((R & ~31) + perm32(R & 31)) : R;
        voffA[i] = (unsigned)(R * K + C) * 2u; voffB[i] = (unsigned)(Rb * K + C) * 2u; }
    const size_t kstep = (size_t)(BK * 2);
    const size_t hstep = (size_t)HALF * K * 2;
    const size_t tstep = 2 * hstep;
    const unsigned ldsw = (unsigned)wid * 1024u;
    const int aoff = lds_byte(wr * 64 + fr, fq * 8), boff = lds_byte(wc * 32 + fr, fq * 8);
#define PG8_SA(b, h) (((b) * 2 + (h)) * HTB)
#define PG8_SB(b, h) ((4 + (b) * 2 + (h)) * HTB)
#define PG8_STAGE(bufoff, gbase, voff) do { _Pragma("unroll") for (int _i = 0; _i < 2; ++_i) \
        __builtin_amdgcn_global_load_lds((const unsigned*)((const char*)(gbase) + (voff)[_i]), (PG8_LAS unsigned*)(lds + (bufoff) + ldsw + _i * 8192), 16, 0, 0); } while (0)
#define PG8_LDA(dst, b, h) do { _Pragma("unroll") for (int m = 0; m < 4; ++m) _Pragma("unroll") for (int k = 0; k < 2; ++k) dst[m][k] = *(const PG8_LAS bf16x8*)(lds + PG8_SA(b, h) + aoff + m * 2048 + k * 1024); } while (0)
#define PG8_LDB(dst, b, h) do { _Pragma("unroll") for (int n = 0; n < 2; ++n) _Pragma("unroll") for (int k = 0; k < 2; ++k) dst[n][k] = *(const PG8_LAS bf16x8*)(lds + PG8_SB(b, h) + boff + n * 2048 + k * 1024); } while (0)
#define PG8_MMA(ai, bj, At, Bt) do { __builtin_amdgcn_s_setprio(1); _Pragma("unroll") for (int m = 0; m < 4; ++m) _Pragma("unroll") for (int n = 0; n < 2; ++n) _Pragma("unroll") for (int k = 0; k < 2; ++k) \
        acc[ai][bj][m][n] = __builtin_amdgcn_mfma_f32_16x16x32_bf16(Bt[n][k], At[m][k], acc[ai][bj][m][n], 0, 0, 0); __builtin_amdgcn_s_setprio(0); } while (0)
#define PG8_WAIT_V(n) asm volatile("s_waitcnt vmcnt(" #n ")" ::: "memory")
#define PG8_WAIT_L(n) asm volatile("s_waitcnt lgkmcnt(" #n ")" ::: "memory")
#define PG8_BAR __builtin_amdgcn_s_barrier()
#define PG8_SCHED __builtin_amdgcn_sched_barrier(0)
    Unit cur, nxt; int ui = 0;
    if (!S.next(0, cur)) return;
    f32x4 acc[2][2][4][2];
#pragma unroll
    for (int a = 0; a < 2; ++a)
#pragma unroll
        for (int b = 0; b < 2; ++b)
#pragma unroll
            for (int m = 0; m < 4; ++m)
#pragma unroll
                for (int n = 0; n < 2; ++n) acc[a][b][m][n] = (f32x4){0.f, 0.f, 0.f, 0.f};
    bf16x8 At[4][2], B0[2][2], B1[2][2];
    const char* cA = (const char*)g.A + (size_t)cur.pm * tstep; const char* cB = (const char*)g.Bt + (size_t)cur.pn * tstep;
    S.a_ready(cur);
    if constexpr (SP2) {
        PG8_STAGE(PG8_SB(0, 0), cB, voffB); PG8_STAGE(PG8_SB(0, 1), cB + hstep, voffB); PG8_STAGE(PG8_SA(0, 0), cA, voffA); PG8_STAGE(PG8_SA(0, 1), cA + hstep, voffA);
        if (wr == 1) PG8_BAR;
        PG8_WAIT_V(2); PG8_BAR;
        PG8_STAGE(PG8_SB(1, 0), cB + kstep, voffB); PG8_STAGE(PG8_SA(1, 0), cA + kstep, voffA); PG8_STAGE(PG8_SB(1, 1), cB + hstep + kstep, voffB);
        PG8_WAIT_V(6); PG8_BAR;
    } else {
        PG8_STAGE(PG8_SB(0, 0), cB, voffB); PG8_STAGE(PG8_SA(0, 0), cA, voffA); PG8_STAGE(PG8_SB(0, 1), cB + hstep, voffB); PG8_STAGE(PG8_SA(0, 1), cA + hstep, voffA);
        if (wr == 1) PG8_BAR;
        PG8_WAIT_V(4); PG8_BAR;
        PG8_STAGE(PG8_SB(1, 0), cB + kstep, voffB); PG8_STAGE(PG8_SA(1, 0), cA + kstep, voffA); PG8_STAGE(PG8_SB(1, 1), cB + hstep + kstep, voffB);
        PG8_WAIT_V(6); PG8_BAR;
    }
    for (;;) {
        const bool has_next = S.next(ui + 1, nxt);
        const char* nA = has_next ? (const char*)g.A + (size_t)nxt.pm * tstep : cA; const char* nB = has_next ? (const char*)g.Bt + (size_t)nxt.pn * tstep : cB;
        for (int t = 0; t < nt; t += 2) {
            const bool last = (t == nt - 2);
            const char* a1 = cA + (size_t)(t + 1) * kstep;
            const char* a2 = last ? nA : cA + (size_t)(t + 2) * kstep; const char* b2 = last ? nB : cB + (size_t)(t + 2) * kstep;
            const char* a3 = a2 + kstep; const char* b3 = b2 + kstep;
            if (last && has_next) S.a_ready(nxt);
            if constexpr (SP2) {
            PG8_LDB(B0, 0, 0); PG8_LDB(B1, 0, 1); PG8_SCHED; PG8_LDA(At, 0, 0); PG8_STAGE(PG8_SA(1, 1), a1 + hstep, voffA);
            PG8_WAIT_V(8); PG8_WAIT_L(0); PG8_BAR; PG8_MMA(0, 0, At, B0); PG8_MMA(0, 1, At, B1); PG8_BAR; PG8_SCHED;
            PG8_LDA(At, 0, 1); PG8_STAGE(PG8_SB(0, 0), b2, voffB); PG8_STAGE(PG8_SB(0, 1), b2 + hstep, voffB); PG8_STAGE(PG8_SA(0, 0), a2, voffA);
            PG8_WAIT_V(8); PG8_WAIT_L(0); PG8_BAR; PG8_MMA(1, 0, At, B0); PG8_MMA(1, 1, At, B1); PG8_BAR; PG8_SCHED;
            PG8_LDB(B0, 1, 0); PG8_LDB(B1, 1, 1); PG8_SCHED; PG8_LDA(At, 1, 0); PG8_STAGE(PG8_SA(0, 1), a2 + hstep, voffA);
            PG8_WAIT_V(8); PG8_WAIT_L(0); PG8_BAR; PG8_MMA(0, 0, At, B0); PG8_MMA(0, 1, At, B1); PG8_BAR; PG8_SCHED;
            PG8_LDA(At, 1, 1); PG8_STAGE(PG8_SB(1, 0), b3, voffB); PG8_STAGE(PG8_SB(1, 1), b3 + hstep, voffB); PG8_STAGE(PG8_SA(1, 0), a3, voffA);
            PG8_WAIT_V(8); PG8_WAIT_L(0); PG8_BAR; PG8_MMA(1, 0, At, B0); PG8_MMA(1, 1, At, B1); PG8_BAR; PG8_SCHED;
            } else {
            PG8_LDB(B0, 0, 0); PG8_SCHED; PG8_LDA(At, 0, 0); PG8_STAGE(PG8_SA(1, 1), a1 + hstep, voffA);
            PG8_WAIT_L(8); PG8_BAR; PG8_WAIT_L(0); PG8_MMA(0, 0, At, B0); PG8_BAR; PG8_SCHED;
            PG8_LDB(B1, 0, 1); PG8_STAGE(PG8_SB(0, 0), b2, voffB);
            PG8_BAR; PG8_WAIT_L(0); PG8_MMA(0, 1, At, B1); PG8_BAR;
            PG8_LDA(At, 0, 1); PG8_STAGE(PG8_SA(0, 0), a2, voffA);
            PG8_BAR; PG8_WAIT_L(0); PG8_MMA(1, 0, At, B0); PG8_BAR; PG8_SCHED;
            PG8_STAGE(PG8_SB(0, 1), b2 + hstep, voffB);
            PG8_WAIT_V(6); PG8_BAR; PG8_MMA(1, 1, At, B1); PG8_BAR;
            PG8_LDB(B0, 1, 0); PG8_SCHED; PG8_LDA(At, 1, 0); PG8_STAGE(PG8_SA(0, 1), a2 + hstep, voffA);
            PG8_WAIT_L(8); PG8_BAR; PG8_WAIT_L(0); PG8_MMA(0, 0, At, B0); PG8_BAR; PG8_SCHED;
            PG8_LDB(B1, 1, 1); PG8_STAGE(PG8_SB(1, 0), b3, voffB);
            PG8_BAR; PG8_WAIT_L(0); PG8_MMA(0, 1, At, B1); PG8_BAR;
            PG8_LDA(At, 1, 1); PG8_STAGE(PG8_SA(1, 0), a3, voffA);
            PG8_BAR; PG8_WAIT_L(0); PG8_MMA(1, 0, At, B0); PG8_BAR; PG8_SCHED;
            PG8_STAGE(PG8_SB(1, 1), b3 + hstep, voffB);
            PG8_WAIT_V(6); PG8_BAR; PG8_MMA(1, 1, At, B1); PG8_BAR;
            }
        }
        if constexpr (ALIGN_EPI) { if (wr == 0) PG8_BAR; }
        if constexpr (!Epi::AFTER_DRAIN) { E(acc, cur, wr, wc, fr, fq); S.done(cur); }
        if (!has_next) break;
#pragma unroll
        for (int a = 0; a < 2; ++a)
#pragma unroll
            for (int b = 0; b < 2; ++b)
#pragma unroll
                for (int m = 0; m < 4; ++m)
#pragma unroll
                    for (int n = 0; n < 2; ++n) acc[a][b][m][n] = (f32x4){0.f, 0.f, 0.f, 0.f};
        cur = nxt; cA = nA; cB = nB; ++ui;
        if constexpr (ALIGN_EPI) { if (wr == 1) PG8_BAR; }
    }
    PG8_WAIT_V(0);
    if constexpr (!ALIGN_EPI) { if (wr == 0) PG8_BAR; }
    PG8_BAR;
    if constexpr (Epi::AFTER_DRAIN) { E.fused(acc, cur, wr, wc, fr, fq, lds, wid, lane); S.done(cur); }
#undef PG8_SA
#undef PG8_SB
#undef PG8_STAGE
#undef PG8_LDA
#undef PG8_LDB
#undef PG8_MMA
#undef PG8_WAIT_V
#undef PG8_WAIT_L
#undef PG8_BAR
#undef PG8_SCHED
}
}
constexpr int NWAVES = 8;
constexpr int D = 1024, TP = 8192, MP = 16384, MS = 256, M = MP + MS, FF = 4096, NIN = 3328, NIN_REAL = 3088, NMODR = 34, MODW = 6144;
constexpr float NORM_EPS = 1e-6f;
constexpr float QSCALE = 0.125f * 1.4426950408889634f;
constexpr size_t OY = 0, OK_P = 17039360, OV_P = 25427968, OSG_P = 33816576, OK_S = 33882112, OV_S = 34013184, OSG_S = 34144256, OUT_TOTAL = 35192832;
constexpr size_t MiB = 1u << 20;
constexpr size_t WS_CTL = 0, CTL_ZERO_BYTES = 1 * MiB;
constexpr size_t WS_MOD = 1 * MiB, WS_WIN = 2 * MiB, WS_WO = 9 * MiB, WS_WUP = 11 * MiB, WS_WDN = 19 * MiB;
constexpr size_t WS_SLOC = 27 * MiB, WS_DSEG = 35 * MiB, WS_DPART = 36 * MiB, WS_DRTOT = 40 * MiB;
constexpr size_t WS_XN = 48 * MiB, WS_Q = 82 * MiB, WS_K = 99 * MiB, WS_V = 116 * MiB, WS_G = 133 * MiB, WS_MIX = 190 * MiB, WS_X1 = 224 * MiB, WS_H = 290 * MiB, WS_END = 421 * MiB;
static_assert(WS_WIN + (size_t)NIN * D * 2 <= WS_WO && WS_G + (size_t)M * 1792 * 2 <= WS_MIX && WS_MIX + (size_t)M * D * 2 <= WS_X1 && WS_X1 + (size_t)M * D * 4 <= WS_H && WS_H + (size_t)M * FF * 2 <= WS_END, "d_ws map");
static_assert(WS_XN + (size_t)M * D * 2 <= WS_Q && WS_Q + (size_t)M * 512 * 2 <= WS_K && WS_K + (size_t)M * 512 * 2 <= WS_V && WS_V + (size_t)M * 512 * 2 <= WS_G, "d_ws map 2");
constexpr int CW_BAR = 4096, CW_DEC = 16384;
constexpr int RING_BYTES = 139264, MISC_OFF = 146944, LDS_BYTES = 147456;

#define GAS __attribute__((address_space(1)))
#define LAS __attribute__((address_space(3)))
typedef unsigned short bf16;
typedef unsigned v4u __attribute__((ext_vector_type(4)));
typedef float f32x4 __attribute__((ext_vector_type(4)));
#define LDS_WAIT() asm volatile("s_waitcnt lgkmcnt(0)" ::: "memory")
__device__ __forceinline__ unsigned f2bf(float f) { unsigned u = __builtin_bit_cast(unsigned, f); return (u + 0x7fffu + ((u >> 16) & 1u)) >> 16; }
__device__ __forceinline__ unsigned pk2(float lo, float hi) { return f2bf(lo) | (f2bf(hi) << 16); }
#define XB_TMO      128
#define XB_XCNT(j)  (256  + 64 * (j))
#define XB_XSUB(j)  (1280 + 64 * (j))
#define XB_XGEN(j)  (2304 + 64 * (j))
#define XB_TOP      3328
#define XB_TOPGEN   3392
#define XCD_BAR_WORDS 3456
#define XB_SPIN_CAP (1u << 18)

__device__ __forceinline__ unsigned xb_ld(unsigned* p)              { return __hip_atomic_load(p, __ATOMIC_RELAXED, __HIP_MEMORY_SCOPE_AGENT); }
__device__ __forceinline__ unsigned xb_add(unsigned* p, unsigned v) { return __hip_atomic_fetch_add(p, v, __ATOMIC_RELAXED, __HIP_MEMORY_SCOPE_AGENT); }
__device__ __forceinline__ unsigned xb_xcc_id() { return (unsigned)__builtin_amdgcn_s_getreg((3 << 11) | 20) & 0xFu; }
#define XB_SPIN(cond, bar) do { unsigned _sp = 0; while (cond) { __builtin_amdgcn_s_sleep(1); \
    if ((++_sp & 255u) == 0u) { if (xb_ld(&(bar)[XB_TMO])) break; if (_sp > XB_SPIN_CAP) { atomicAdd(&(bar)[XB_TMO], 1u); break; } } } } while (0)

struct XcdBarrier {
    unsigned* bar; unsigned x;
    volatile LAS unsigned* st;
};

__device__ __forceinline__ XcdBarrier xcd_barrier_post(unsigned* bar, volatile LAS unsigned* st) {
    XcdBarrier b; b.bar = bar; b.x = xb_xcc_id(); b.st = st;
    if (threadIdx.x == 0) (void)xb_add(&bar[XB_XCNT(b.x)], 1u);
    return b;
}
__device__ __forceinline__ void xcd_barrier_complete(unsigned* bar, unsigned x, unsigned& nloc, unsigned& nx) {
    const unsigned G = gridDim.x * gridDim.y * gridDim.z;
    unsigned sum, cnt, mine, sp = 0u;
    for (;;) {
        sum = 0u; cnt = 0u; mine = 0u;
#pragma unroll
        for (unsigned j = 0; j < 16; ++j) { const unsigned c = xb_ld(&bar[XB_XCNT(j)]); sum += c; cnt += (c > 0u) ? 1u : 0u; mine = (j == x) ? c : mine; }
        if (sum == G) break;
        __builtin_amdgcn_s_sleep(1);
        if ((++sp & 255u) == 0u) { if (xb_ld(&bar[XB_TMO])) break; if (sp > XB_SPIN_CAP) { atomicAdd(&bar[XB_TMO], 1u); break; } }
    }
    nloc = mine > 0u ? mine : 1u; nx = cnt > 0u ? cnt : 1u;
}

__device__ __forceinline__ void xcd_barrier(const XcdBarrier& b) {
    asm volatile("s_waitcnt vmcnt(0)" ::: "memory");
    __syncthreads();
    if (threadIdx.x == 0) {
        unsigned* bar = b.bar;
        __builtin_amdgcn_s_waitcnt(0);
        unsigned nloc = b.st[0], nx = b.st[1];
        if (nloc == 0u) { xcd_barrier_complete(bar, b.x, nloc, nx); b.st[0] = nloc; b.st[1] = nx; }
        const unsigned old = xb_add(&bar[XB_XSUB(b.x)], 1u);
        const unsigned gen = old / nloc;
        if (old + 1u == (gen + 1u) * nloc) {
            __builtin_amdgcn_fence(__ATOMIC_RELEASE, "agent");
            asm volatile("s_waitcnt vmcnt(0)" ::: "memory");
            const unsigned og = xb_add(&bar[XB_TOP], 1u);
            const unsigned tg = og / nx;
            if (og + 1u == (tg + 1u) * nx) xb_add(&bar[XB_TOPGEN], 1u);
            else XB_SPIN(xb_ld(&bar[XB_TOPGEN]) == tg, bar);
            __builtin_amdgcn_fence(__ATOMIC_ACQUIRE, "agent");
            xb_add(&bar[XB_XGEN(b.x)], 1u);
            asm volatile("s_waitcnt vmcnt(0)" ::: "memory");
        } else {
            XB_SPIN(xb_ld(&bar[XB_XGEN(b.x)]) == gen, bar);
            __builtin_amdgcn_fence(__ATOMIC_ACQUIRE, "agent");
            asm volatile("s_waitcnt vmcnt(0)" ::: "memory");
        }
    }
    __syncthreads();
}
namespace sba {
using bf16x8=__attribute__((ext_vector_type(8)))short;
using s16x4=__attribute__((ext_vector_type(4)))short;
using f32x16=__attribute__((ext_vector_type(16)))float;
using u32x4=__attribute__((ext_vector_type(4)))unsigned;
typedef __hip_bfloat16 bf16;
constexpr int SEQ=8192,D=64,DM=512,OP=1024;
constexpr int NW=8,QBLK=32,QB=QBLK*NW,KVBLK=64;
constexpr int NSLOT=3,SLOTB=8192;
constexpr int LDS_K=0,LDS_V=NSLOT*SLOTB,LDS_OST=2*NSLOT*SLOTB,LDS_BYTES=LDS_OST+NW*4096;
__device__ __forceinline__ int crow(int r,int hi){return (r&3)+8*(r>>2)+4*hi;}
__device__ __forceinline__ void glds16(const void*gsrc,unsigned lds_dst){unsigned keep;
  asm volatile("s_mov_b32 %0, m0\n\ts_mov_b32 m0, %2\n\ts_nop 0\n\tglobal_load_lds_dwordx4 %1, off\n\ts_mov_b32 m0, %0":"=&s"(keep):"v"(gsrc),"s"(lds_dst):"memory");}
typedef float f32x2_t __attribute__((ext_vector_type(2))); typedef __bf16 bf16x2_t __attribute__((ext_vector_type(2)));
__device__ __forceinline__ unsigned cvtpk_s(float lo,float hi){f32x2_t v={lo,hi};bf16x2_t b=__builtin_convertvector(v,bf16x2_t);return __builtin_bit_cast(unsigned,b);}
typedef __attribute__((address_space(3))) const char* lds_cptr;
typedef short v4i16_t __attribute__((ext_vector_type(4)));
__device__ __forceinline__ s16x4 vtr(lds_cptr p){ return __builtin_bit_cast(s16x4,__builtin_amdgcn_ds_read_tr16_b64_v4i16((__attribute__((address_space(3))) v4i16_t*)p)); }
#define SBA_MFMA(a,b,c) __builtin_amdgcn_mfma_f32_32x32x16_bf16((a),(b),(c),0,0,0)
template<bool MASK> __device__ __forceinline__ void sb_weights(f32x16&c0,f32x16&c1,float&carry,int hi,int jb,int qrel){
  #pragma unroll
  for(int r=0;r<16;++r){
    float e0=__builtin_amdgcn_exp2f(c0[r]), e1=__builtin_amdgcn_exp2f(c1[r]);
    if(MASK){ const int kv=64*jb+crow(r,hi); if(kv>=qrel)e0=0.f; if(kv+32>=qrel)e1=0.f; }
    c0[r]=1.f+e0; c1[r]=1.f+e1; }
  float P2[8],P3[8],T[8];
  #pragma unroll
  for(int c=0;c<4;++c){ P2[c]=c0[4*c]*c0[4*c+1]; P3[c]=P2[c]*c0[4*c+2]; T[c]=__builtin_amdgcn_rcpf(P3[c]*c0[4*c+3]);
                        P2[4+c]=c1[4*c]*c1[4*c+1]; P3[4+c]=P2[4+c]*c1[4*c+2]; T[4+c]=__builtin_amdgcn_rcpf(P3[4+c]*c1[4*c+3]); }
  float Tl[8],Th[8];
  #pragma unroll
  for(int c=0;c<8;++c){ auto rr=__builtin_amdgcn_permlane32_swap(__float_as_uint(T[c]),__float_as_uint(T[c]),false,false); Tl[c]=__uint_as_float(rr[0]); Th[c]=__uint_as_float(rr[1]); }
  float E=carry;
  float off[8];
  #pragma unroll
  for(int c=7;c>=0;--c){ off[c]=hi?E:E*Th[c]; E=E*(Tl[c]*Th[c]); }
  carry=E;
  #pragma unroll
  for(int c=0;c<4;++c){
    { const float g=T[c]*off[c], R1=c0[4*c]*g, R2=P2[c]*g, R3=P3[c]*g; c0[4*c]=R1-g; c0[4*c+1]=R2-R1; c0[4*c+2]=R3-R2; c0[4*c+3]=off[c]-R3; }
    { const float g=T[4+c]*off[4+c], R1=c1[4*c]*g, R2=P2[4+c]*g, R3=P3[4+c]*g; c1[4*c]=R1-g; c1[4*c+1]=R2-R1; c1[4*c+2]=R3-R2; c1[4*c+3]=off[4+c]-R3; } }
}
__device__ __forceinline__ void pv(f32x16*o,lds_cptr vp,const f32x16&w0,const f32x16&w1){
  u32x4 pw[4];
  #pragma unroll
  for(int k=0;k<2;++k)
    #pragma unroll
    for(int j=0;j<4;++j){ pw[k][j]=cvtpk_s(w0[8*k+2*j],w0[8*k+2*j+1]); pw[2+k][j]=cvtpk_s(w1[8*k+2*j],w1[8*k+2*j+1]); }
  #pragma unroll
  for(int d0=0;d0<2;++d0)
    #pragma unroll
    for(int ks=0;ks<4;++ks){ const s16x4 lo=vtr(vp+d0*4096+ks*1024), hh=vtr(vp+d0*4096+ks*1024+512);
      const bf16x8 vf={lo[0],lo[1],lo[2],lo[3],hh[0],hh[1],hh[2],hh[3]};
      o[d0]=SBA_MFMA(__builtin_bit_cast(bf16x8,pw[ks]),vf,o[d0]); }
}
__device__ __forceinline__ void attn_unit(int b,int h,int qb,const bf16*Q,const bf16*__restrict__ K,const bf16*__restrict__ V,bf16*O,char*shm,float bias2){
  int tid_=threadIdx.x; asm volatile("":"+v"(tid_)); const int tid=tid_,lane=tid&63,r32=lane&31,hi=lane>>5; const int wid=__builtin_amdgcn_readfirstlane(tid>>6);
  const long rowbase=(long)b*SEQ; const int q0=qb*QB;
  const bf16*Qw=Q+(rowbase+q0+wid*QBLK)*DM+h*D;
  const bf16*Kh=K+rowbase*DM+h*D,*Vh=V+rowbase*DM+h*D;
  const unsigned lds0=(unsigned)(uintptr_t)shm;
  const bf16*ksrc=Kh+(long)lane*DM+wid*8;
  const bf16*vsrc=Vh+(long)(16*(wid&3)+(lane>>2))*DM+(wid>>2)*32+(lane&3)*8;
  const unsigned kdst=lds0+LDS_K+wid*1024, vdst=lds0+LDS_V+wid*1024;
  const int NT=(q0+QB)/KVBLK;
  #define DMA_KV(s_,slot_) do{ const long t_=(long)(NT-1-(s_))*KVBLK*DM; glds16(ksrc+t_,(unsigned)__builtin_amdgcn_readfirstlane(kdst+(slot_)*SLOTB)); glds16(vsrc+t_,(unsigned)__builtin_amdgcn_readfirstlane(vdst+(slot_)*SLOTB)); }while(0)
  bf16x8 qr[4];
  #pragma unroll
  for(int d0=0;d0<4;++d0)qr[d0]=*reinterpret_cast<const bf16x8*>(&Qw[(long)r32*DM+d0*16+hi*8]);
  DMA_KV(0,0); DMA_KV(1,1);
  const lds_cptr shm3=(lds_cptr)shm; const lds_cptr kp0=shm3+LDS_K+hi*1024+r32*16; const lds_cptr vp0=shm3+LDS_V+((lane>>4)&1)*32+(lane&3)*8+(4*hi+((lane&15)>>2))*64;
  f32x16 o[2];o[0]=f32x16{};o[1]=f32x16{}; f32x16 bv;
  #pragma unroll
  for(int r=0;r<16;++r)bv[r]=bias2;
  asm volatile("":"+v"(bv));
  float carry=1.f; const int qrel=wid*QBLK+r32;
  int slot=0;
  for(int s=0;s<NT;++s){
    if(s+1<NT) asm volatile("s_waitcnt vmcnt(2) lgkmcnt(0)\n\ts_barrier":::"memory"); else asm volatile("s_waitcnt vmcnt(0) lgkmcnt(0)\n\ts_barrier":::"memory");
    if(s+2<NT){ const int ns=(slot==0)?2:slot-1; DMA_KV(s+2,ns); }
    const lds_cptr kp=kp0+slot*SLOTB;
    f32x16 c0=bv,c1=bv;
    #pragma unroll
    for(int d0=0;d0<4;++d0){
      const bf16x8 k0=*(const __attribute__((address_space(3))) bf16x8*)(kp+d0*2048), k1=*(const __attribute__((address_space(3))) bf16x8*)(kp+d0*2048+512);
      c0=SBA_MFMA(k0,qr[d0],c0); c1=SBA_MFMA(k1,qr[d0],c1); }
    if(s<4) sb_weights<true>(c0,c1,carry,hi,3-s,qrel); else sb_weights<false>(c0,c1,carry,hi,0,0);
    pv(o,vp0+slot*SLOTB,c0,c1);
    slot=(slot==2)?0:slot+1;
  }
  #undef DMA_KV
  bf16*Ow=O+(rowbase+q0+wid*QBLK)*OP+h*D;
  { bf16*stg=(bf16*)(shm+LDS_OST)+wid*2048;
    #pragma unroll
    for(int r=0;r<16;++r){const int orow=crow(r,hi);
      #pragma unroll
      for(int d0=0;d0<2;++d0)stg[orow*64+d0*32+r32]=__float2bfloat16(o[d0][r]);}
    asm volatile("s_waitcnt lgkmcnt(0)":::"memory");
    #pragma unroll
    for(int i=0;i<4;++i){const int row=i*8+(lane>>3),ch=lane&7; const u32x4 v=*(const u32x4*)(stg+row*64+ch*8); *(u32x4*)(Ow+(long)row*OP+ch*8)=v;} }
  asm volatile("s_waitcnt vmcnt(0) lgkmcnt(0)\n\ts_barrier":::"memory");
}
}
namespace sbd {
using sba::bf16x8; using sba::f32x16; using sba::u32x4; using sba::bf16; using sba::crow; using sba::cvtpk_s;
typedef float f32x4 __attribute__((ext_vector_type(4)));
#define RLXA __ATOMIC_RELAXED, __HIP_MEMORY_SCOPE_AGENT
template<bool NEWK> __device__ __forceinline__ void weights32(f32x16&c,float&carry,int hi,int q){
  #pragma unroll
  for(int r=0;r<16;++r){ float e=__builtin_amdgcn_exp2f(c[r]);
    if(NEWK){ const int kv=crow(r,hi); if(kv>=8||kv>=q)e=0.f; }
    c[r]=1.f+e; }
  float P2[4],P3[4],T[4],Tl[4],Th[4],off[4];
  #pragma unroll
  for(int k=0;k<4;++k){ P2[k]=c[4*k]*c[4*k+1]; P3[k]=P2[k]*c[4*k+2]; T[k]=__builtin_amdgcn_rcpf(P3[k]*c[4*k+3]); }
  #pragma unroll
  for(int k=0;k<4;++k){ auto s=__builtin_amdgcn_permlane32_swap(__float_as_uint(T[k]),__float_as_uint(T[k]),false,false); Tl[k]=__uint_as_float(s[0]); Th[k]=__uint_as_float(s[1]); }
  float E=carry;
  #pragma unroll
  for(int k=3;k>=0;--k){ off[k]=hi?E:E*Th[k]; E=E*(Tl[k]*Th[k]); }
  carry=E;
  #pragma unroll
  for(int k=0;k<4;++k){ const float g=T[k]*off[k], R1=c[4*k]*g, R2=P2[k]*g, R3=P3[k]*g; c[4*k]=R1-g; c[4*k+1]=R2-R1; c[4*k+2]=R3-R2; c[4*k+3]=off[k]-R3; }
}
struct Raw { f32x4 k[8]; float v[32]; };
__device__ __forceinline__ void load_tile(Raw&R,const float*kb,const float*vb){
  #pragma unroll
  for(int d0=0;d0<4;++d0){ R.k[2*d0]=__builtin_nontemporal_load((const f32x4*)(kb+16*d0)); R.k[2*d0+1]=__builtin_nontemporal_load((const f32x4*)(kb+16*d0+4)); }
  #pragma unroll
  for(int d0=0;d0<2;++d0)
    #pragma unroll
    for(int ks=0;ks<2;++ks)
      #pragma unroll
      for(int j=0;j<8;++j) R.v[(d0*2+ks)*8+j]=__builtin_nontemporal_load(vb+(size_t)(16*ks+8*(j>>2)+(j&3))*512+32*d0);
}
struct Frag { bf16x8 k[4]; bf16x8 v[4]; };
__device__ __forceinline__ void cvt_tile(Frag&F,const Raw&R){
  #pragma unroll
  for(int d0=0;d0<4;++d0){ u32x4 p; p[0]=cvtpk_s(R.k[2*d0][0],R.k[2*d0][1]); p[1]=cvtpk_s(R.k[2*d0][2],R.k[2*d0][3]); p[2]=cvtpk_s(R.k[2*d0+1][0],R.k[2*d0+1][1]); p[3]=cvtpk_s(R.k[2*d0+1][2],R.k[2*d0+1][3]); F.k[d0]=__builtin_bit_cast(bf16x8,p); }
  #pragma unroll
  for(int i=0;i<4;++i){ u32x4 p;
    #pragma unroll
    for(int j=0;j<4;++j) p[j]=cvtpk_s(R.v[8*i+2*j],R.v[8*i+2*j+1]);
    F.v[i]=__builtin_bit_cast(bf16x8,p); }
}
template<bool NEWK> __device__ __forceinline__ void tile_step(const Frag&F,const bf16x8*qr,const f32x16&bv,f32x16*o,float&carry,int hi,int q){
  f32x16 c=bv;
  #pragma unroll
  for(int d0=0;d0<4;++d0) c=SBA_MFMA(F.k[d0],qr[d0],c);
  weights32<NEWK>(c,carry,hi,q);
  u32x4 pw[2];
  #pragma unroll
  for(int k=0;k<2;++k)
    #pragma unroll
    for(int j=0;j<4;++j) pw[k][j]=cvtpk_s(c[8*k+2*j],c[8*k+2*j+1]);
  #pragma unroll
  for(int d0=0;d0<2;++d0)
    #pragma unroll
    for(int ks=0;ks<2;++ks) o[d0]=SBA_MFMA(__builtin_bit_cast(bf16x8,pw[ks]),F.v[d0*2+ks],o[d0]);
}
__device__ __forceinline__ void decode_unit(int smp,int j,const float*cache_k,const float*cache_v,const int*page_table,const bf16*Q,const bf16*Kn,const bf16*Vn,const float*b_sb,
                                            float*part,float*rtot,unsigned*cnt,bf16*MIX,volatile __attribute__((address_space(3))) unsigned*flag){
  int tid_=threadIdx.x; asm volatile("":"+v"(tid_)); const int tid=tid_,lane=tid&63,r32=lane&31,hi=lane>>5; const int h=__builtin_amdgcn_readfirstlane(tid>>6);
  const float bias2=b_sb[h]*1.4426950408889634f;
  f32x16 bv;
  #pragma unroll
  for(int r=0;r<16;++r)bv[r]=bias2;
  const long srow=16384+8*smp;
  bf16x8 qr[4];
  #pragma unroll
  for(int d0=0;d0<4;++d0){ bf16x8 z={0,0,0,0,0,0,0,0}; if(r32<8) z=*reinterpret_cast<const bf16x8*>(Q+(srow+r32)*512+h*64+d0*16+hi*8); qr[d0]=z; }
  f32x16 o[2]; o[0]=f32x16{}; o[1]=f32x16{}; float carry=1.f;
  if(j==7){
    Frag F;
    #pragma unroll
    for(int d0=0;d0<4;++d0){ bf16x8 z={0,0,0,0,0,0,0,0}; if(r32<8) z=*reinterpret_cast<const bf16x8*>(Kn+(srow+r32)*512+h*64+d0*16+hi*8); F.k[d0]=z; }
    #pragma unroll
    for(int d0=0;d0<2;++d0){
      bf16x8 z={0,0,0,0,0,0,0,0};
      #pragma unroll
      for(int jj=0;jj<4;++jj) z[jj]=*reinterpret_cast<const short*>(Vn+(srow+4*hi+jj)*512+h*64+32*d0+r32);
      F.v[d0*2]=z; F.v[d0*2+1]=(bf16x8){0,0,0,0,0,0,0,0}; }
    tile_step<true>(F,qr,bv,o,carry,hi,r32);
  }
  const int*pt=page_table+smp*64+8*j;
  Raw R; Frag F;
  #define ROWK(tt) (cache_k+(((size_t)pt[(tt)>>2]*128+(size_t)(((tt)&3)*32+r32))*8+h)*64+8*hi)
  #define ROWV(tt) (cache_v+(((size_t)pt[(tt)>>2]*128+(size_t)(((tt)&3)*32+4*hi))*8+h)*64+r32)
  load_tile(R,ROWK(31),ROWV(31)); cvt_tile(F,R);
  for(int tt=31;tt>=0;--tt){
    if(tt>0) load_tile(R,ROWK(tt-1),ROWV(tt-1));
    tile_step<false>(F,qr,bv,o,carry,hi,r32);
    if(tt>0) cvt_tile(F,R);
  }
  #undef ROWK
  #undef ROWV
  const int unit=smp*8+j;
  int l2_=threadIdx.x; asm volatile("":"+v"(l2_)); const int lane2=l2_&63, r32b=lane2&31, hib=lane2>>5;
  unsigned*pp=(unsigned*)part+((size_t)unit*8+h)*512;
  #pragma unroll
  for(int r=0;r<4;++r)
    #pragma unroll
    for(int d0=0;d0<2;++d0) __hip_atomic_store(pp+(r+4*hib)*64+32*d0+r32b,__float_as_uint(o[d0][r]),RLXA);
  if(lane2<8) __hip_atomic_store((unsigned*)rtot+((size_t)unit*8+h)*8+lane2,__float_as_uint(carry),RLXA);
  asm volatile("s_waitcnt vmcnt(0)":::"memory");
  __syncthreads();
  if(tid==0){ const unsigned old=__hip_atomic_fetch_add(cnt+64*smp,1u,RLXA); flag[0]=(old==7u)?1u:0u; }
  __syncthreads();
  const bool last=flag[0]!=0u;
  __syncthreads();
  if(last){
    const int q=lane2>>3,dc=(lane2&7)*8; float acc[8];
    #pragma unroll
    for(int i=0;i<8;++i)acc[i]=0.f;
    float f=1.f;
    for(int jj=7;jj>=0;--jj){ const size_t u=(size_t)smp*8+jj; const unsigned*src=(const unsigned*)part+(u*8+h)*512+q*64+dc;
      #pragma unroll
      for(int i=0;i<8;++i) acc[i]+=f*__uint_as_float(__hip_atomic_load(src+i,RLXA));
      f*=__uint_as_float(__hip_atomic_load((const unsigned*)rtot+(u*8+h)*8+q,RLXA)); }
    u32x4 w; w[0]=cvtpk_s(acc[0],acc[1]); w[1]=cvtpk_s(acc[2],acc[3]); w[2]=cvtpk_s(acc[4],acc[5]); w[3]=cvtpk_s(acc[6],acc[7]);
    *(u32x4*)(MIX+(srow+q)*1024+h*64+dc)=w;
  }
}
}
namespace gla {
using sba::bf16; using sba::cvtpk_s;
typedef short bf16x8 __attribute__((ext_vector_type(8)));
typedef short bf16x4 __attribute__((ext_vector_type(4)));
typedef float f32x4 __attribute__((ext_vector_type(4)));
typedef unsigned u32x4 __attribute__((ext_vector_type(4)));
typedef unsigned u32x2 __attribute__((ext_vector_type(2)));
#define GLAS __attribute__((address_space(3)))
constexpr int GP=1792;
constexpr int L_QD=0,L_KI=9216,L_KET=18432,L_VT=27648,L_DEC=46080,L_EXR=46336,L_TOT=46592,L_SSQ=48640,L_END=50688;
#define GMFMA(a,b,c) __builtin_amdgcn_mfma_f32_16x16x32_bf16((a),(b),(c),0,0,0)
__device__ __forceinline__ float bf2f(short s){ return __uint_as_float(((unsigned)(unsigned short)s)<<16); }
__device__ __forceinline__ short f2bf(float f){ return (short)(cvtpk_s(f,0.f)&0xffffu); }
template<int MODE> __device__ __forceinline__ void chunk(const bf16*G,bf16*MIX,long m0,int ntok,int h,GLAS char*L,f32x4(&S)[4],const float(&wg)[16],float bg,float gain,float&dseg){
  int tid_=threadIdx.x; asm volatile("":"+v"(tid_)); const int tid=tid_,lane=tid&63,c=lane,fr=lane&15,fq=lane>>4; const int w=__builtin_amdgcn_readfirstlane(tid>>6); const int g=w;
  const short*Gs=(const short*)G;
  float bl[8]; float run=0.f;
  #pragma unroll
  for(int i=0;i<8;++i){ const int t=8*g+i; float la=0.f;
    if(t<ntok){ const bf16x8*ap=(const bf16x8*)(Gs+(m0+t)*GP+1536); const bf16x8 a0=ap[0],a1=ap[1]; float x=bg;
      #pragma unroll
      for(int j=0;j<8;++j){ x+=bf2f(a0[j])*wg[j]; x+=bf2f(a1[j])*wg[8+j]; }
      la=(fminf(x,0.f)-__logf(1.f+__expf(-fabsf(x))))*0.0625f; }
    run+=la; bl[i]=run; }
  GLAS float*TOT=(GLAS float*)(L+L_TOT);
  TOT[g*64+c]=run;
  __syncthreads();
  float prefix=0.f,total=0.f;
  #pragma unroll
  for(int gg=0;gg<8;++gg){ const float v=TOT[gg*64+c]; total+=v; if(gg<g)prefix+=v; }
  const float bref=0.5f*total;
  float ke[8];
  #pragma unroll
  for(int i=0;i<8;++i){ const int t=8*g+i; const float b=prefix+bl[i]; float kk=0.f,qq=0.f;
    if(t<ntok){ kk=bf2f(Gs[(m0+t)*GP+256+64*h+c]); if(MODE==1) qq=bf2f(Gs[(m0+t)*GP+64*h+c]); }
    ke[i]=kk*__expf(total-b);
    if(MODE==1){ *(GLAS short*)(L+L_QD+t*144+c*2)=f2bf(qq*0.125f*__expf(b-bref)); *(GLAS short*)(L+L_KI+t*144+c*2)=f2bf(kk*__expf(bref-b)); } }
  { u32x4 p; p[0]=cvtpk_s(ke[0],ke[1]); p[1]=cvtpk_s(ke[2],ke[3]); p[2]=cvtpk_s(ke[4],ke[5]); p[3]=cvtpk_s(ke[6],ke[7]); *(GLAS u32x4*)(L+L_KET+c*144+g*16)=p; }
  if(g==0){ const float d=__expf(total); ((GLAS float*)(L+L_DEC))[c]=d; ((GLAS float*)(L+L_EXR))[c]=__expf(bref); dseg*=d; }
  { const int dv=tid&127,tg=tid>>7; float vv[16];
    #pragma unroll
    for(int i=0;i<16;++i){ const int t=16*tg+i; vv[i]=(t<ntok)?bf2f(Gs[(m0+t)*GP+512+128*h+dv]):0.f; }
    u32x4 p0,p1;
    #pragma unroll
    for(int j=0;j<4;++j){ p0[j]=cvtpk_s(vv[2*j],vv[2*j+1]); p1[j]=cvtpk_s(vv[8+2*j],vv[8+2*j+1]); }
    *(GLAS u32x4*)(L+L_VT+dv*144+tg*32)=p0; *(GLAS u32x4*)(L+L_VT+dv*144+tg*32+16)=p1; }
  __syncthreads();
  const int dvl=16*w+fr;
  f32x4 O[4];
  if(MODE==1){
    f32x4 PT[4][4];
    #pragma unroll
    for(int st=0;st<4;++st)
      #pragma unroll
      for(int tt=0;tt<4;++tt){ f32x4 acc={0.f,0.f,0.f,0.f};
        if(st<=tt){
          #pragma unroll
          for(int kk=0;kk<2;++kk){ const bf16x8 a=*(GLAS const bf16x8*)(L+L_KI+(16*st+fr)*144+(32*kk+8*fq)*2), b=*(GLAS const bf16x8*)(L+L_QD+(16*tt+fr)*144+(32*kk+8*fq)*2); acc=GMFMA(a,b,acc); }
          if(st==tt){
            #pragma unroll
            for(int i=0;i<4;++i) if(4*fq+i>fr) acc[i]=0.f; } }
        PT[st][tt]=acc; }
    #pragma unroll
    for(int tt=0;tt<4;++tt){ O[tt]=(f32x4){0.f,0.f,0.f,0.f};
      #pragma unroll
      for(int pr=0;pr<2;++pr){ if(2*pr<=tt){
        u32x4 pa; pa[0]=cvtpk_s(PT[2*pr][tt][0],PT[2*pr][tt][1]); pa[1]=cvtpk_s(PT[2*pr][tt][2],PT[2*pr][tt][3]); pa[2]=cvtpk_s(PT[2*pr+1][tt][0],PT[2*pr+1][tt][1]); pa[3]=cvtpk_s(PT[2*pr+1][tt][2],PT[2*pr+1][tt][3]);
        const u32x2 b0=*(GLAS const u32x2*)(L+L_VT+dvl*144+(32*pr+4*fq)*2), b1=*(GLAS const u32x2*)(L+L_VT+dvl*144+(32*pr+16+4*fq)*2);
        const u32x4 pb={b0[0],b0[1],b1[0],b1[1]};
        O[tt]=GMFMA(__builtin_bit_cast(bf16x8,pa),__builtin_bit_cast(bf16x8,pb),O[tt]); } } }
    #pragma unroll
    for(int kk=0;kk<2;++kk){
      const f32x4 e0=*(GLAS const f32x4*)(L+L_EXR+(32*kk+4*fq)*4), e1=*(GLAS const f32x4*)(L+L_EXR+(32*kk+16+4*fq)*4);
      const f32x4 s0=S[2*kk]*e0, s1=S[2*kk+1]*e1;
      u32x4 pb; pb[0]=cvtpk_s(s0[0],s0[1]); pb[1]=cvtpk_s(s0[2],s0[3]); pb[2]=cvtpk_s(s1[0],s1[1]); pb[3]=cvtpk_s(s1[2],s1[3]);
      #pragma unroll
      for(int tt=0;tt<4;++tt){ const u32x2 a0=*(GLAS const u32x2*)(L+L_QD+(16*tt+fr)*144+(32*kk+4*fq)*2), a1=*(GLAS const u32x2*)(L+L_QD+(16*tt+fr)*144+(32*kk+16+4*fq)*2);
        const u32x4 pa={a0[0],a0[1],a1[0],a1[1]};
        O[tt]=GMFMA(__builtin_bit_cast(bf16x8,pa),__builtin_bit_cast(bf16x8,pb),O[tt]); } }
  }
  #pragma unroll
  for(int mt=0;mt<4;++mt){ const f32x4 d4=*(GLAS const f32x4*)(L+L_DEC+(16*mt+4*fq)*4); S[mt]=S[mt]*d4;
    #pragma unroll
    for(int kk=0;kk<2;++kk){ const bf16x8 a=*(GLAS const bf16x8*)(L+L_KET+(16*mt+fr)*144+(32*kk+8*fq)*2), b=*(GLAS const bf16x8*)(L+L_VT+dvl*144+(32*kk+8*fq)*2); S[mt]=GMFMA(a,b,S[mt]); } }
  if(MODE==1){
    GLAS float*SSQ=(GLAS float*)(L+L_SSQ);
    #pragma unroll
    for(int tt=0;tt<4;++tt)
      #pragma unroll
      for(int i=0;i<4;++i){ float ss=O[tt][i]*O[tt][i]; ss+=__shfl_xor(ss,1); ss+=__shfl_xor(ss,2); ss+=__shfl_xor(ss,4); ss+=__shfl_xor(ss,8); if(fr==0) SSQ[w*64+16*tt+4*fq+i]=ss; }
    __syncthreads();
    #pragma unroll
    for(int tt=0;tt<4;++tt)
      #pragma unroll
      for(int i=0;i<4;++i){ const int t=16*tt+4*fq+i; float tot=0.f;
        #pragma unroll
        for(int ww=0;ww<8;++ww) tot+=SSQ[ww*64+t];
        if(t<ntok){ const float rstd=rsqrtf(tot*(1.f/128.f)+1e-6f); const float rg=bf2f(Gs[(m0+t)*GP+1024+128*h+dvl]); const float sl=rg/(1.f+__expf(-rg));
          ((short*)MIX)[(m0+t)*1024+512+128*h+dvl]=f2bf(O[tt][i]*rstd*gain*sl); } }
  }
  __syncthreads();
}
__device__ __forceinline__ void load_consts(int h,const float*w_gate,const float*b_gate,const float*g_out,float(&wg)[16],float&bg,float&gain){
  const int lane=threadIdx.x&63, w=threadIdx.x>>6;
  #pragma unroll
  for(int j=0;j<16;++j) wg[j]=w_gate[j*256+64*h+lane];
  bg=b_gate[64*h+lane]; gain=g_out[16*w+(lane&15)];
}
__device__ __forceinline__ void pass1_unit(int unit,const bf16*G,const float*w_gate,const float*b_gate,const float*g_out,float*SLOC,float*DSEG,GLAS char*L){
  const int bh=unit>>5,sseg=unit&31,b=bh>>2,h=bh&3; const int tid=threadIdx.x;
  float wg[16],bg,gain; load_consts(h,w_gate,b_gate,g_out,wg,bg,gain);
  f32x4 S[4];
  #pragma unroll
  for(int mt=0;mt<4;++mt)S[mt]=(f32x4){0.f,0.f,0.f,0.f};
  float dseg=1.f; const long m0=(long)b*8192+256*sseg;
  for(int ch=0;ch<4;++ch) chunk<0>(G,nullptr,m0+64*ch,64,h,L,S,wg,bg,gain,dseg);
  f32x4*dst=(f32x4*)(SLOC+((size_t)unit*512+tid)*16);
  #pragma unroll
  for(int mt=0;mt<4;++mt)dst[mt]=S[mt];
  if(tid<64)DSEG[unit*64+tid]=dseg;
}
__device__ __forceinline__ void pass3_unit(int unit,const bf16*G,bf16*MIX,const float*w_gate,const float*b_gate,const float*g_out,const float*SLOC,const float*DSEG,float*sfin_base,GLAS char*L){
  const int bh=unit>>5,sseg=unit&31,b=bh>>2,h=bh&3; const int tid=threadIdx.x,lane=tid&63,fr=lane&15,fq=lane>>4,w=tid>>6;
  float wg[16],bg,gain; load_consts(h,w_gate,b_gate,g_out,wg,bg,gain);
  f32x4 S[4];
  #pragma unroll
  for(int mt=0;mt<4;++mt)S[mt]=(f32x4){0.f,0.f,0.f,0.f};
  for(int j=0;j<sseg;++j){ const int uj=bh*32+j; const f32x4*src=(const f32x4*)(SLOC+((size_t)uj*512+tid)*16);
    #pragma unroll
    for(int mt=0;mt<4;++mt){ const f32x4 d4=*(const f32x4*)(DSEG+uj*64+16*mt+4*fq); S[mt]=S[mt]*d4+src[mt]; } }
  float dseg=1.f; const long m0=(long)b*8192+256*sseg;
  for(int ch=0;ch<4;++ch) chunk<1>(G,MIX,m0+64*ch,64,h,L,S,wg,bg,gain,dseg);
  if(sseg==31){ float*o=sfin_base+(size_t)bh*8192;
    #pragma unroll
    for(int mt=0;mt<4;++mt)
      #pragma unroll
      for(int i=0;i<4;++i) o[(16*mt+4*fq+i)*128+16*w+fr]=S[mt][i]; }
}
__device__ __forceinline__ void sample_unit(int unit,const bf16*G,bf16*MIX,const float*w_gate,const float*b_gate,const float*g_out,const float*s0,float*sout,GLAS char*L){
  const int smp=unit>>2,h=unit&3; const int tid=threadIdx.x,lane=tid&63,fr=lane&15,fq=lane>>4,w=tid>>6;
  float wg[16],bg,gain; load_consts(h,w_gate,b_gate,g_out,wg,bg,gain);
  f32x4 S[4]; const float*si=s0+(size_t)unit*8192; float*so=sout+(size_t)unit*8192;
  #pragma unroll
  for(int mt=0;mt<4;++mt)
    #pragma unroll
    for(int i=0;i<4;++i) S[mt][i]=si[(16*mt+4*fq+i)*128+16*w+fr];
  float dseg=1.f;
  chunk<1>(G,MIX,16384+8*(long)smp,8,h,L,S,wg,bg,gain,dseg);
  #pragma unroll
  for(int mt=0;mt<4;++mt)
    #pragma unroll
    for(int i=0;i<4;++i) so[(16*mt+4*fq+i)*128+16*w+fr]=S[mt][i];
}
}
namespace thin {
using sba::bf16x8; using sba::f32x16; using sba::crow;
template<int KS,class Epi> __device__ __forceinline__ void run(const unsigned short*A,int lda,const unsigned short*Bt,int ldb,int K,int ntn,int tile0,int ntiles,__attribute__((address_space(3))) float*red,const Epi&epi){
  int tid_=threadIdx.x; asm volatile("":"+v"(tid_)); const int lane=tid_&63,r32=lane&31,hi=lane>>5; const int w=__builtin_amdgcn_readfirstlane(tid_>>6);
  const int sub=w/KS,kp=w%KS,tile=tile0+sub; const bool live=tile<ntiles; const int tm=live?tile/ntn:0,tn=live?tile%ntn:0;
  const int klen=K/KS,k0=kp*klen;
  const unsigned short*ap=A+(size_t)(32*tm+r32)*lda+k0+8*hi; const unsigned short*bp=Bt+(size_t)(32*tn+r32)*ldb+k0+8*hi;
  f32x16 acc=f32x16{};
  if(live){
    #pragma unroll 8
    for(int k=0;k<klen;k+=16){ const bf16x8 a=*(const bf16x8*)(ap+k), b=*(const bf16x8*)(bp+k); acc=__builtin_amdgcn_mfma_f32_32x32x16_bf16(a,b,acc,0,0,0); } }
  #pragma unroll
  for(int r=0;r<16;++r) red[(w*16+r)*64+lane]=acc[r];
  __syncthreads();
  if(kp==0&&live){
    #pragma unroll
    for(int r=0;r<16;++r){ float v=0.f;
      #pragma unroll
      for(int p=0;p<KS;++p) v+=red[((sub*KS+p)*16+r)*64+lane];
      epi(32*tm+crow(r,hi),32*tn+r32,v); } }
  __syncthreads();
}
struct EpiResGateS { const float*base; float*out; const float*gate; int ld;
  __device__ __forceinline__ void operator()(int row,int col,float v)const{ const size_t o=(size_t)row*ld+col; out[o]=base[o]+gate[(size_t)(2+(row>>3))*6144+col]*v; } };
struct EpiRelu2S { unsigned short*H; int ld;
  __device__ __forceinline__ void operator()(int row,int col,float v)const{ const float a=fmaxf(v,0.f); H[(size_t)row*ld+col]=(unsigned short)(sba::cvtpk_s(a*a,0.f)&0xffffu); } };
}
__device__ __forceinline__ float wave_sum(float v) {
#pragma unroll
    for (int o = 1; o < 64; o <<= 1) v += __shfl_xor(v, o);
    return v;
}
__device__ __forceinline__ void p0_transpose_item(const float* W, int K, int Nreal, int Npad, bf16* WT, LAS float* scr, int item, int lane) {
    const int nblk = Npad / 32, kb = item / nblk, nb = item % nblk, k0 = 64 * kb, n0 = 32 * nb;
    const int n = n0 + (lane & 31);
#pragma unroll 8
    for (int i = 0; i < 32; ++i) { const int kk = 2 * i + (lane >> 5); scr[kk * 33 + (lane & 31)] = (n < Nreal) ? W[(size_t)(k0 + kk) * Nreal + n] : 0.f; }
    LDS_WAIT(); asm volatile("" ::: "memory");
    const int c = lane & 7;
#pragma unroll
    for (int j = 0; j < 4; ++j) { const int nn = (lane >> 3) + 8 * j; const LAS float* s = scr + (8 * c) * 33 + nn;
        v4u o; o.x = pk2(s[0 * 33], s[1 * 33]); o.y = pk2(s[2 * 33], s[3 * 33]); o.z = pk2(s[4 * 33], s[5 * 33]); o.w = pk2(s[6 * 33], s[7 * 33]);
        *(GAS v4u*)(WT + (size_t)(n0 + nn) * K + k0 + 8 * c) = o; }
    LDS_WAIT(); asm volatile("" ::: "memory");
}
__device__ __forceinline__ void norm_mod_row_bf16(int lane, const float* xrow, const float* gain, const float* sc, const float* sh, bf16* orow) {
    const f32x4* xr = (const f32x4*)xrow + lane; f32x4 v[4]; float s = 0.f;
#pragma unroll
    for (int j = 0; j < 4; ++j) { v[j] = xr[64 * j]; s += (v[j].x * v[j].x + v[j].y * v[j].y) + (v[j].z * v[j].z + v[j].w * v[j].w); }
    const float rstd = rsqrtf(wave_sum(s) * (1.f / D) + NORM_EPS);
    unsigned long long* o8 = (unsigned long long*)orow + lane;
#pragma unroll
    for (int j = 0; j < 4; ++j) { const f32x4 g = ((const f32x4*)gain)[lane + 64 * j], a = ((const f32x4*)sc)[lane + 64 * j], b = ((const f32x4*)sh)[lane + 64 * j];
        const f32x4 y = v[j] * rstd * g * (a + 1.f) + b;
        o8[64 * j] = (unsigned long long)pk2(y.x, y.y) | ((unsigned long long)pk2(y.z, y.w) << 32); }
}
__device__ __forceinline__ void norm_row_f32_inplace(int lane, float* xrow, const float* gain) {
    f32x4* xr = (f32x4*)xrow + lane; f32x4 v[4]; float s = 0.f;
#pragma unroll
    for (int j = 0; j < 4; ++j) { v[j] = xr[64 * j]; s += (v[j].x * v[j].x + v[j].y * v[j].y) + (v[j].z * v[j].z + v[j].w * v[j].w); }
    const float rstd = rsqrtf(wave_sum(s) * (1.f / D) + NORM_EPS);
#pragma unroll
    for (int j = 0; j < 4; ++j) { const f32x4 g = ((const f32x4*)gain)[lane + 64 * j]; xr[64 * j] = v[j] * rstd * g; }
}
__device__ __forceinline__ int bidx_of_row(int m) { return m < MP ? (m >> 13) : 2 + ((m - MP) >> 3); }

struct Args { const float* in[21]; const int* page_table; float* out; unsigned char* ws; };
static_assert(sizeof(Args) == 24 * 8, "Args has no padding");

__global__ void __launch_bounds__(NWAVES * 64, 2) mk_fwd(Args args) {
    extern __shared__ __attribute__((aligned(16))) unsigned char lds[];
    LAS unsigned char* L = (LAS unsigned char*)lds;
    volatile LAS unsigned* MISC = (volatile LAS unsigned*)(L + MISC_OFF);
    const int tid = threadIdx.x, lane = tid & 63, wave = __builtin_amdgcn_readfirstlane(tid >> 6);
    const int G = gridDim.x; const int bx = blockIdx.x; const int vcu = (G % 8 == 0) ? (bx % 8) * (G / 8) + bx / 8 : bx;
    unsigned char* ws = args.ws;
    unsigned* ctl = (unsigned*)(ws + WS_CTL);
    const float *x_prompt = args.in[0], *x_sample = args.in[1], *c_prompt = args.in[2], *c_sample = args.in[3], *cache_k = args.in[4], *cache_v = args.in[5], *state_gla = args.in[6];
    const float *w_ada = args.in[8], *b_ada = args.in[9], *g_mix = args.in[10], *w_in = args.in[11], *b_sb = args.in[12], *w_gate = args.in[13], *b_gate = args.in[14], *g_gla_out = args.in[15];
    const float *w_out = args.in[16], *g_ffn = args.in[17], *w_up = args.in[18], *w_down = args.in[19], *g_final = args.in[20];
    float* out = args.out;
    float* MOD = (float*)(ws + WS_MOD);
    bf16 *Win_t = (bf16*)(ws + WS_WIN), *Wo_t = (bf16*)(ws + WS_WO), *Wup_t = (bf16*)(ws + WS_WUP), *Wdn_t = (bf16*)(ws + WS_WDN);
    bf16 *XN = (bf16*)(ws + WS_XN), *QB = (bf16*)(ws + WS_Q), *KB = (bf16*)(ws + WS_K), *VB = (bf16*)(ws + WS_V), *GB = (bf16*)(ws + WS_G), *MIX = (bf16*)(ws + WS_MIX), *HB = (bf16*)(ws + WS_H);
    float* X1 = (float*)(ws + WS_X1);
    float *SLOC = (float*)(ws + WS_SLOC), *DSEG = (float*)(ws + WS_DSEG), *DPART = (float*)(ws + WS_DPART), *DRTOT = (float*)(ws + WS_DRTOT);
    for (int u = tid; u < (LDS_BYTES - MISC_OFF) / 4; u += NWAVES * 64) ((LAS unsigned*)(L + MISC_OFF))[u] = 0u;
    __syncthreads();
    XcdBarrier bar = xcd_barrier_post(ctl + CW_BAR, MISC + 8);
    const int gw = vcu * NWAVES + wave, NGW = G * NWAVES;

    if (vcu < 96) {
        LAS float* s = (LAS float*)L;
        for (int i = tid; i < NMODR * D; i += NWAVES * 64) { const int r = i >> 10, k = i & 1023; const float c = r < 2 ? c_prompt[r * D + k] : c_sample[(r - 2) * D + k]; s[k * NMODR + r] = c / (1.f + __expf(-c)); }
        __syncthreads();
        const int col = 64 * vcu + lane, k0 = 128 * wave;
        float acc[NMODR];
#pragma unroll
        for (int r = 0; r < NMODR; ++r) acc[r] = 0.f;
#pragma unroll 4
        for (int kk = 0; kk < 128; ++kk) { const int k = k0 + kk; const float w = w_ada[(size_t)k * MODW + col];
#pragma unroll
            for (int r = 0; r < NMODR; ++r) acc[r] += s[k * NMODR + r] * w; }
        __syncthreads();
        LAS float* red = (LAS float*)L;
#pragma unroll
        for (int r = 0; r < NMODR; ++r) red[(wave * NMODR + r) * 64 + lane] = acc[r];
        __syncthreads();
        for (int o = tid; o < NMODR * 64; o += NWAVES * 64) { const int r = o >> 6, l = o & 63; float t = b_ada[64 * vcu + l];
#pragma unroll
            for (int w8 = 0; w8 < 8; ++w8) t += red[(w8 * NMODR + r) * 64 + l];
            MOD[r * MODW + 64 * vcu + l] = t; }
        __syncthreads();
    }
    {
        LAS float* scr = (LAS float*)(L + wave * 16384);
        constexpr int I_IN = (D / 64) * (NIN / 32), I_O = (D / 64) * (D / 32), I_UP = (D / 64) * (FF / 32), I_DN = (FF / 64) * (D / 32);
        constexpr int NITEMS = I_IN + I_O + I_UP + I_DN;
        for (int it = gw; it < NITEMS; it += NGW) {
            int r = it;
            if (r < I_IN) { p0_transpose_item(w_in, D, NIN_REAL, NIN, Win_t, scr, r, lane); continue; } r -= I_IN;
            if (r < I_O) { p0_transpose_item(w_out, D, D, D, Wo_t, scr, r, lane); continue; } r -= I_O;
            if (r < I_UP) { p0_transpose_item(w_up, D, FF, FF, Wup_t, scr, r, lane); continue; } r -= I_UP;
            p0_transpose_item(w_down, FF, D, D, Wdn_t, scr, r, lane);
        }
    }
    xcd_barrier(bar);
    for (int m = gw; m < M; m += NGW) { const float* xr = m < MP ? x_prompt + (size_t)m * D : x_sample + (size_t)(m - MP) * D; const float* md = MOD + (size_t)bidx_of_row(m) * MODW;
        norm_mod_row_bf16(lane, xr, g_mix, md + 1024, md, XN + (size_t)m * D); }
    xcd_barrier(bar);
    {
        pg8::Gemm g{XN, Win_t, M, NIN, D}; pg8::StaticOrder S; S.init(M, NIN, G, bx);
        pg8::EpiInProj E{QB, KB, VB, GB, out + OK_P, out + OV_P, out + OK_S - (size_t)MP * 512, out + OV_S - (size_t)MP * 512, QSCALE};
        pg8::gemm_phase<pg8::EpiInProj, pg8::StaticOrder, true, true>(L, g, S, E);
    }
    xcd_barrier(bar);
    for (int u = vcu; u < 256; u += G) gla::pass1_unit(u, (const gla::bf16*)GB, w_gate, b_gate, g_gla_out, SLOC, DSEG, (LAS char*)L);
    xcd_barrier(bar);
#ifdef PROBE_SB2
    for (int rep_ = 0; rep_ < 2; ++rep_)
#endif
    for (int v = vcu; v < 256; v += G) {
        const int bh = v >> 4, s = v & 15, b = bh >> 3, h = bh & 7; const float bias2 = b_sb[h] * 1.4426950408889634f;
        sba::attn_unit(b, h, 31 - s, (const sba::bf16*)QB, (const sba::bf16*)KB, (const sba::bf16*)VB, (sba::bf16*)MIX, (char*)lds, bias2);
        sba::attn_unit(b, h, s, (const sba::bf16*)QB, (const sba::bf16*)KB, (const sba::bf16*)VB, (sba::bf16*)MIX, (char*)lds, bias2);
    }
    for (int u = vcu; u < 256; u += G) gla::pass3_unit(u, (const gla::bf16*)GB, (gla::bf16*)MIX, w_gate, b_gate, g_gla_out, SLOC, DSEG, out + OSG_P, (LAS char*)L);
#ifdef PROBE_DEC2
    for (int rep_ = 0; rep_ < 2; ++rep_)
#endif
    for (int u = vcu; u < 256; u += G) sbd::decode_unit(u >> 3, u & 7, cache_k, cache_v, args.page_table, (const sba::bf16*)QB, (const sba::bf16*)KB, (const sba::bf16*)VB, b_sb, DPART, DRTOT, ctl + CW_DEC, (sba::bf16*)MIX, MISC + 16);
    for (int u = vcu; u < 128; u += G) gla::sample_unit(u, (const gla::bf16*)GB, (gla::bf16*)MIX, w_gate, b_gate, g_gla_out, state_gla, out + OSG_S, (LAS char*)L);
    xcd_barrier(bar);
    {
        pg8::Gemm g{MIX, Wo_t, MP, D, D}; pg8::StaticOrder S; S.init(MP, D, G, bx);
        pg8::EpiResGate E{x_prompt, x_sample - (size_t)MP * D, X1, MOD + 2048};
        pg8::gemm_phase<pg8::EpiResGate, pg8::StaticOrder, true, true>(L, g, S, E);
        thin::EpiResGateS Es{x_sample, X1 + (size_t)MP * D, MOD + 2048, D};
        for (int t0 = vcu; t0 < 256; t0 += G) thin::run<8>(MIX + (size_t)MP * D, D, Wo_t, D, D, 32, t0, 256, (LAS float*)L, Es);
    }
    xcd_barrier(bar);
    for (int m = gw; m < M; m += NGW) { const float* md = MOD + (size_t)bidx_of_row(m) * MODW; norm_mod_row_bf16(lane, X1 + (size_t)m * D, g_ffn, md + 4096, md + 3072, XN + (size_t)m * D); }
    xcd_barrier(bar);
    {
        pg8::Gemm g{XN, Wup_t, MP, FF, D}; pg8::StaticOrder S; S.init(MP, FF, G, bx);
        pg8::EpiRelu2 E{HB, FF};
        pg8::gemm_phase<pg8::EpiRelu2, pg8::StaticOrder, true, true>(L, g, S, E);
        thin::EpiRelu2S Es{HB + (size_t)MP * FF, FF};
        for (int t0 = 4 * vcu; t0 < 1024; t0 += 4 * G) thin::run<2>(XN + (size_t)MP * D, D, Wup_t, D, D, 128, t0, 1024, (LAS float*)L, Es);
    }
    xcd_barrier(bar);
    {
        pg8::Gemm g{HB, Wdn_t, MP, D, FF}; pg8::StaticOrder S; S.init(MP, D, G, bx);
        pg8::EpiResGate E{X1, X1, out + OY, MOD + 5120};
        pg8::gemm_phase<pg8::EpiResGate, pg8::StaticOrder, true, true>(L, g, S, E);
        thin::EpiResGateS Es{X1 + (size_t)MP * D, out + OY + (size_t)MP * D, MOD + 5120, D};
        for (int t0 = vcu; t0 < 256; t0 += G) thin::run<8>(HB + (size_t)MP * FF, FF, Wdn_t, FF, FF, 32, t0, 256, (LAS float*)L, Es);
    }
    xcd_barrier(bar);
    for (int m = gw; m < M; m += NGW) norm_row_f32_inplace(lane, out + OY + (size_t)m * D, g_final);
}

extern "C" void kernel_launch(void* const* d_in, const int* in_sizes, int n_in, void* d_out, int out_size, void* d_ws, size_t ws_size, hipStream_t stream) {
    static int grid = 0;
    if (grid == 0) {
        if (n_in != 21 || (size_t)out_size != OUT_TOTAL || ws_size < WS_END) { fprintf(stderr, "kernel_launch: unexpected sizes: n_in %d out %d ws %zu\n", n_in, out_size, ws_size); grid = -1; return; }
        int dev = 0, cus = 0, per_cu = 0;
        if (hipGetDevice(&dev) != hipSuccess || hipDeviceGetAttribute(&cus, hipDeviceAttributeMultiprocessorCount, dev) != hipSuccess) { grid = -1; return; }
        if (hipFuncSetAttribute((const void*)mk_fwd, hipFuncAttributeMaxDynamicSharedMemorySize, LDS_BYTES) != hipSuccess) { fprintf(stderr, "kernel_launch: hipFuncSetAttribute failed\n"); grid = -1; return; }
        if (hipOccupancyMaxActiveBlocksPerMultiprocessor(&per_cu, (const void*)mk_fwd, NWAVES * 64, LDS_BYTES) != hipSuccess || per_cu < 1) { fprintf(stderr, "kernel_launch: occupancy query says %d\n", per_cu); }
        (void)hipGetLastError();
        grid = cus;
    }
    if (grid < 0) return;
    if (hipMemsetAsync((char*)d_ws + WS_CTL, 0, CTL_ZERO_BYTES, stream) != hipSuccess) return;
    Args a{};
    for (int i = 0; i < 21; ++i) a.in[i] = (const float*)d_in[i];
    a.page_table = (const int*)d_in[7]; a.out = (float*)d_out; a.ws = (unsigned char*)d_ws;
    hipLaunchKernelGGL(mk_fwd, dim3(grid), dim3(NWAVES * 64), LDS_BYTES, stream, a);
    const hipError_t le = hipPeekAtLastError();
    if (le != hipSuccess) fprintf(stderr, "kernel_launch: launch failed: %s\n", hipGetErrorName(le));
}
```

```cpp
#include <hip/hip_runtime.h>
#include <hip/hip_bf16.h>
#include <cstdio>
#include <cstdint>
namespace pg8 {
#define PG8_LAS __attribute__((address_space(3)))
typedef unsigned short bf16_t;
typedef short bf16x8 __attribute__((ext_vector_type(8)));
typedef float f32x4 __attribute__((ext_vector_type(4)));
typedef unsigned u32x4 __attribute__((ext_vector_type(4)));
constexpr int BM = 256, BK = 64, HALF = 128, HTB = HALF * BK * 2  , STAGE_BYTES = 8 * HTB, NXCD = 8, WGM = 8;

__host__ __device__ __forceinline__ int lds_byte(int r, int c) { const int st = (r >> 4) * 2 + (c >> 5), rr = r & 15, cc = c & 31, ob = rr * 64 + cc * 2; return st * 1024 + (ob ^ (((ob >> 9) & 1) << 5)); }
__host__ __device__ __forceinline__ void stage_rc(int b, int& R, int& C) { const int st = b / 1024, sb = b % 1024, swz = sb ^ (((sb >> 9) & 1) << 5); R = (st >> 1) * 16 + swz / 64; C = (st & 1) * 32 + (swz % 64) / 2; }
__host__ __device__ __forceinline__ int perm32(int rho) { const int n = rho >> 4, i = rho & 15; return 8 * (i >> 2) + 4 * n + (i & 3); }

struct Unit { int pm, pn; };
struct Gemm { const bf16_t* A; const bf16_t* Bt; int M, N, K; };

struct StaticOrder {
    int nM, nN, nwg, G, c;
    __host__ __device__ void init(int M, int N, int G_, int c_) { nM = M / BM; nN = N / BM; nwg = nM * nN; G = G_; c = c_; }
    __host__ __device__ bool next(int i, Unit& u) const {
        const long L = (long)i * G + c; if (L >= nwg) return false;
        int wgid = (int)L; { const int q = nwg / NXCD, r = nwg % NXCD, xcd = wgid % NXCD, off = wgid / NXCD; wgid = (xcd < r ? xcd * (q + 1) : r * (q + 1) + (xcd - r) * q) + off; }
        const int nig = WGM * nN, gid = wgid / nig, fm = gid * WGM, gsz = (nM - fm) < WGM ? (nM - fm) : WGM;
        u.pm = fm + ((wgid % nig) % gsz); u.pn = (wgid % nig) / gsz; return true;
    }
    __device__ __forceinline__ void a_ready(const Unit&) const {}
    __device__ __forceinline__ void done(const Unit&) const {}
};

__device__ __forceinline__ unsigned cvt_pk_bf16(float lo, float hi) { unsigned r; asm volatile("v_cvt_pk_bf16_f32 %0, %1, %2" : "=v"(r) : "v"(lo), "v"(hi)); return r; }

struct EpiInProj {
    static constexpr bool PERM = true, AFTER_DRAIN = false;
    bf16_t *Q, *K, *V, *G; float *kP, *vP, *kS, *vS; float qscale;
    __device__ __forceinline__ void operator()(const f32x4 (&acc)[2][2][4][2], const Unit& u, int wr, int wc, int fr, int fq) const {
        const int pn = u.pn, pm = u.pm;
        bf16_t* dst; int ldc, colbase; float sc = 1.f; float* fo = nullptr;
        if (pn < 2)      { dst = Q; ldc = 512; colbase = pn * 256; sc = qscale; }
        else if (pn < 4) { dst = K; ldc = 512; colbase = (pn - 2) * 256; fo = pm < 64 ? kP : kS; }
        else if (pn < 6) { dst = V; ldc = 512; colbase = (pn - 4) * 256; fo = pm < 64 ? vP : vS; }
        else             { dst = G; ldc = 1792; colbase = (pn - 6) * 256; }
        const int row0 = pm * BM + wr * 64 + fr, cl = colbase + wc * 32 + 8 * fq;
#pragma unroll
        for (int ai = 0; ai < 2; ++ai)
#pragma unroll
            for (int m = 0; m < 4; ++m) { const size_t row = (size_t)(row0 + ai * HALF + m * 16);
#pragma unroll
                for (int bj = 0; bj < 2; ++bj) { const f32x4 a0 = acc[ai][bj][m][0], a1 = acc[ai][bj][m][1]; const int col = cl + bj * HALF;
                    const f32x4 v0 = a0 * sc, v1 = a1 * sc; u32x4 w; w.x = cvt_pk_bf16(v0[0], v0[1]); w.y = cvt_pk_bf16(v0[2], v0[3]); w.z = cvt_pk_bf16(v1[0], v1[1]); w.w = cvt_pk_bf16(v1[2], v1[3]);
                    *(u32x4*)(dst + row * ldc + col) = w;
                    if (fo) { *(f32x4*)(fo + row * 512 + col) = a0; *(f32x4*)(fo + row * 512 + col + 4) = a1; } } }
    }
};
struct EpiRelu2 {
    static constexpr bool PERM = true, AFTER_DRAIN = false;
    bf16_t* O; int ldc;
    __device__ __forceinline__ void operator()(const f32x4 (&acc)[2][2][4][2], const Unit& u, int wr, int wc, int fr, int fq) const {
        const int row0 = u.pm * BM + wr * 64 + fr, col0 = u.pn * BM + wc * 32 + 8 * fq;
#pragma unroll
        for (int ai = 0; ai < 2; ++ai)
#pragma unroll
            for (int m = 0; m < 4; ++m) { bf16_t* rowp = O + (size_t)(row0 + ai * HALF + m * 16) * ldc + col0;
#pragma unroll
                for (int bj = 0; bj < 2; ++bj) { f32x4 v0 = acc[ai][bj][m][0], v1 = acc[ai][bj][m][1];
#pragma unroll
                    for (int e = 0; e < 4; ++e) { const float a = fmaxf(v0[e], 0.f), b = fmaxf(v1[e], 0.f); v0[e] = a * a; v1[e] = b * b; }
                    u32x4 w; w.x = cvt_pk_bf16(v0[0], v0[1]); w.y = cvt_pk_bf16(v0[2], v0[3]); w.z = cvt_pk_bf16(v1[0], v1[1]); w.w = cvt_pk_bf16(v1[2], v1[3]);
                    *(u32x4*)(rowp + bj * HALF) = w; } }
    }
};
struct EpiResGate {
    static constexpr bool PERM = false, AFTER_DRAIN = false;
    const float* baseP; const float* baseS; float* out; const float* gate;
    __device__ __forceinline__ void operator()(const f32x4 (&acc)[2][2][4][2], const Unit& u, int wr, int wc, int fr, int fq) const {
        const int col0 = u.pn * BM + wc * 32 + 4 * fq;
#pragma unroll
        for (int ai = 0; ai < 2; ++ai)
#pragma unroll
            for (int m = 0; m < 4; ++m) { const int row = u.pm * BM + ai * HALF + wr * 64 + m * 16 + fr; const int bidx = row < 16384 ? (row >> 13) : 2 + ((row - 16384) >> 3);
                const float* b = (row < 16384 ? baseP : baseS) + (size_t)row * 1024 + col0; const float* g = gate + (size_t)bidx * 6144 + col0; float* o = out + (size_t)row * 1024 + col0;
#pragma unroll
                for (int bj = 0; bj < 2; ++bj)
#pragma unroll
                    for (int n = 0; n < 2; ++n) { const int c = bj * HALF + n * 16; const f32x4 bs = *(const f32x4*)(b + c), gv = *(const f32x4*)(g + c); *(f32x4*)(o + c) = bs + gv * acc[ai][bj][m][n]; } }
    }
};
template <class Epi, class Sched, bool ALIGN_EPI = false, bool SP2 = false>
__device__ __forceinline__ void gemm_phase(PG8_LAS unsigned char* lds, const Gemm g, const Sched& S, const Epi& E) {
    int tid_ = threadIdx.x; asm volatile("" : "+v"(tid_)); const int tid = tid_, wid = __builtin_amdgcn_readfirstlane(tid >> 6), lane = tid & 63, wr = wid >> 2, wc = wid & 3, fr = lane & 15, fq = lane >> 4;
    const int K = g.K, nt = K / BK;
    unsigned voffA[2], voffB[2];
#pragma unroll
    for (int i = 0; i < 2; ++i) { int R, C; stage_rc(tid * 16 + i * 8192, R, C); const int Rb = Epi::PERM ? ((R & ~31) + perm32(R & 31)) : R;
        voffA[i] = (unsigned)(R * K + C) * 2u; voffB[i] = (unsigned)(Rb * K + C) * 2u; }
    const size_t kstep = (size_t)(BK * 2);
    const size_t hstep = (size_t)HALF * K * 2;
    const size_t tstep = 2 * hstep;
    const unsigned ldsw = (unsigned)wid * 1024u;
    const int aoff = lds_byte(wr * 64 + fr, fq * 8), boff = lds_byte(wc * 32 + fr, fq * 8);
#define PG8_SA(b, h) (((b) * 2 + (h)) * HTB)
#define PG8_SB(b, h) ((4 + (b) * 2 + (h)) * HTB)
#define PG8_STAGE(bufoff, gbase, voff) do { _Pragma("unroll") for (int _i = 0; _i < 2; ++_i) \
        __builtin_amdgcn_global_load_lds((const unsigned*)((const char*)(gbase) + (voff)[_i]), (PG8_LAS unsigned*)(lds + (bufoff) + ldsw + _i * 8192), 16, 0, 0); } while (0)
#define PG8_LDA(dst, b, h) do { _Pragma("unroll") for (int m = 0; m < 4; ++m) _Pragma("unroll") for (int k = 0; k < 2; ++k) dst[m][k] = *(const PG8_LAS bf16x8*)(lds + PG8_SA(b, h) + aoff + m * 2048 + k * 1024); } while (0)
#define PG8_LDB(dst, b, h) do { _Pragma("unroll") for (int n = 0; n < 2; ++n) _Pragma("unroll") for (int k = 0; k < 2; ++k) dst[n][k] = *(const PG8_LAS bf16x8*)(lds + PG8_SB(b, h) + boff + n * 2048 + k * 1024); } while (0)
#define PG8_MMA(ai, bj, At, Bt) do { __builtin_amdgcn_s_setprio(1); _Pragma("unroll") for (int m = 0; m < 4; ++m) _Pragma("unroll") for (int n = 0; n < 2; ++n) _Pragma("unroll") for (int k = 0; k < 2; ++k) \
        acc[ai][bj][m][n] = __builtin_amdgcn_mfma_f32_16x16x32_bf16(Bt[n][k], At[m][k], acc[ai][bj][m][n], 0, 0, 0); __builtin_amdgcn_s_setprio(0); } while (0)
#define PG8_WAIT_V(n) asm volatile("s_waitcnt vmcnt(" #n ")" ::: "memory")
#define PG8_WAIT_L(n) asm volatile("s_waitcnt lgkmcnt(" #n ")" ::: "memory")
#define PG8_BAR __builtin_amdgcn_s_barrier()
#define PG8_SCHED __builtin_amdgcn_sched_barrier(0)
    Unit cur, nxt; int ui = 0;
    if (!S.next(0, cur)) return;
    f32x4 acc[2][2][4][2];
#pragma unroll
    for (int a = 0; a < 2; ++a)
#pragma unroll
        for (int b = 0; b < 2; ++b)
#pragma unroll
            for (int m = 0; m < 4; ++m)
#pragma unroll
                for (int n = 0; n < 2; ++n) acc[a][b][m][n] = (f32x4){0.f, 0.f, 0.f, 0.f};
    bf16x8 At[4][2], B0[2][2], B1[2][2];
    const char* cA = (const char*)g.A + (size_t)cur.pm * tstep; const char* cB = (const char*)g.Bt + (size_t)cur.pn * tstep;
    S.a_ready(cur);
    if constexpr (SP2) {
        PG8_STAGE(PG8_SB(0, 0), cB, voffB); PG8_STAGE(PG8_SB(0, 1), cB + hstep, voffB); PG8_STAGE(PG8_SA(0, 0), cA, voffA); PG8_STAGE(PG8_SA(0, 1), cA + hstep, voffA);
        if (wr == 1) PG8_BAR;
        PG8_WAIT_V(2); PG8_BAR;
        PG8_STAGE(PG8_SB(1, 0), cB + kstep, voffB); PG8_STAGE(PG8_SA(1, 0), cA + kstep, voffA); PG8_STAGE(PG8_SB(1, 1), cB + hstep + kstep, voffB);
        PG8_WAIT_V(6); PG8_BAR;
    } else {
        PG8_STAGE(PG8_SB(0, 0), cB, voffB); PG8_STAGE(PG8_SA(0, 0), cA, voffA); PG8_STAGE(PG8_SB(0, 1), cB + hstep, voffB); PG8_STAGE(PG8_SA(0, 1), cA + hstep, voffA);
        if (wr == 1) PG8_BAR;
        PG8_WAIT_V(4); PG8_BAR;
        PG8_STAGE(PG8_SB(1, 0), cB + kstep, voffB); PG8_STAGE(PG8_SA(1, 0), cA + kstep, voffA); PG8_STAGE(PG8_SB(1, 1), cB + hstep + kstep, voffB);
        PG8_WAIT_V(6); PG8_BAR;
    }
    for (;;) {
        const bool has_next = S.next(ui + 1, nxt);
        const char* nA = has_next ? (const char*)g.A + (size_t)nxt.pm * tstep : cA; const char* nB = has_next ? (const char*)g.Bt + (size_t)nxt.pn * tstep : cB;
        for (int t = 0; t < nt; t += 2) {
            const bool last = (t == nt - 2);
            const char* a1 = cA + (size_t)(t + 1) * kstep;
            const char* a2 = last ? nA : cA + (size_t)(t + 2) * kstep; const char* b2 = last ? nB : cB + (size_t)(t + 2) * kstep;
            const char* a3 = a2 + kstep; const char* b3 = b2 + kstep;
            if (last && has_next) S.a_ready(nxt);
            if constexpr (SP2) {
            PG8_LDB(B0, 0, 0); PG8_LDB(B1, 0, 1); PG8_SCHED; PG8_LDA(At, 0, 0); PG8_STAGE(PG8_SA(1, 1), a1 + hstep, voffA);
            PG8_WAIT_V(8); PG8_WAIT_L(0); PG8_BAR; PG8_MMA(0, 0, At, B0); PG8_MMA(0, 1, At, B1); PG8_BAR; PG8_SCHED;
            PG8_LDA(At, 0, 1); PG8_STAGE(PG8_SB(0, 0), b2, voffB); PG8_STAGE(PG8_SB(0, 1), b2 + hstep, voffB); PG8_STAGE(PG8_SA(0, 0), a2, voffA);
            PG8_WAIT_V(8); PG8_WAIT_L(0); PG8_BAR; PG8_MMA(1, 0, At, B0); PG8_MMA(1, 1, At, B1); PG8_BAR; PG8_SCHED;
            PG8_LDB(B0, 1, 0); PG8_LDB(B1, 1, 1); PG8_SCHED; PG8_LDA(At, 1, 0); PG8_STAGE(PG8_SA(0, 1), a2 + hstep, voffA);
            PG8_WAIT_V(8); PG8_WAIT_L(0); PG8_BAR; PG8_MMA(0, 0, At, B0); PG8_MMA(0, 1, At, B1); PG8_BAR; PG8_SCHED;
            PG8_LDA(At, 1, 1); PG8_STAGE(PG8_SB(1, 0), b3, voffB); PG8_STAGE(PG8_SB(1, 1), b3 + hstep, voffB); PG8_STAGE(PG8_SA(1, 0), a3, voffA);
            PG8_WAIT_V(8); PG8_WAIT_L(0); PG8_BAR; PG8_MMA(1, 0, At, B0); PG8_MMA(1, 1, At, B1); PG8_BAR; PG8_SCHED;
            } else {
            PG8_LDB(B0, 0, 0); PG8_SCHED; PG8_LDA(At, 0, 0); PG8_STAGE(PG8_SA(1, 1), a1 + hstep, voffA);
            PG8_WAIT_L(8); PG8_BAR; PG8_WAIT_L(0); PG8_MMA(0, 0, At, B0); PG8_BAR; PG8_SCHED;
            PG8_LDB(B1, 0, 1); PG8_STAGE(PG8_SB(0, 0), b2, voffB);
            PG8_BAR; PG8_WAIT_L(0); PG8_MMA(0, 1, At, B1); PG8_BAR;
            PG8_LDA(At, 0, 1); PG8_STAGE(PG8_SA(0, 0), a2, voffA);
            PG8_BAR; PG8_WAIT_L(0); PG8_MMA(1, 0, At, B0); PG8_BAR; PG8_SCHED;
            PG8_STAGE(PG8_SB(0, 1), b2 + hstep, voffB);
            PG8_WAIT_V(6); PG8_BAR; PG8_MMA(1, 1, At, B1); PG8_BAR;
            PG8_LDB(B0, 1, 0); PG8_SCHED; PG8_LDA(At, 1, 0); PG8_STAGE(PG8_SA(0, 1), a2 + hstep, voffA);
            PG8_WAIT_L(8); PG8_BAR; PG8_WAIT_L(0); PG8_MMA(0, 0, At, B0); PG8_BAR; PG8_SCHED;
            PG8_LDB(B1, 1, 1); PG8_STAGE(PG8_SB(1, 0), b3, voffB);
            PG8_BAR; PG8_WAIT_L(0); PG8_MMA(0, 1, At, B1); PG8_BAR;
            PG8_LDA(At, 1, 1); PG8_STAGE(PG8_SA(1, 0), a3, voffA);
            PG8_BAR; PG8_WAIT_L(0); PG8_MMA(1, 0, At, B0); PG8_BAR; PG8_SCHED;
            PG8_STAGE(PG8_SB(1, 1), b3 + hstep, voffB);
            PG8_WAIT_V(6); PG8_BAR; PG8_MMA(1, 1, At, B1); PG8_BAR;
            }
        }
        if constexpr (ALIGN_EPI) { if (wr == 0) PG8_BAR; }
        if constexpr (!Epi::AFTER_DRAIN) { E(acc, cur, wr, wc, fr, fq); S.done(cur); }
        if (!has_next) break;
#pragma unroll
        for (int a = 0; a < 2; ++a)
#pragma unroll
            for (int b = 0; b < 2; ++b)
#pragma unroll
                for (int m = 0; m < 4; ++m)
#pragma unroll
                    for (int n = 0; n < 2; ++n) acc[a][b][m][n] = (f32x4){0.f, 0.f, 0.f, 0.f};
        cur = nxt; cA = nA; cB = nB; ++ui;
        if constexpr (ALIGN_EPI) { if (wr == 1) PG8_BAR; }
    }
    PG8_WAIT_V(0);
    if constexpr (!ALIGN_EPI) { if (wr == 0) PG8_BAR; }
    PG8_BAR;
    if constexpr (Epi::AFTER_DRAIN) { E.fused(acc, cur, wr, wc, fr, fq, lds, wid, lane); S.done(cur); }
#undef PG8_SA
#undef PG8_SB
#undef PG8_STAGE
#undef PG8_LDA
#undef PG8_LDB
#undef PG8_MMA
#undef PG8_WAIT_V
#undef PG8_WAIT_L
#undef PG8_BAR
#undef PG8_SCHED
}
}
constexpr int NWAVES = 8;
constexpr int D = 1024, TP = 8192, MP = 16384, MS = 256, M = MP + MS, FF = 4096, NIN = 3328, NIN_REAL = 3088, NMODR = 34, MODW = 6144;
constexpr float NORM_EPS = 1e-6f;
constexpr float QSCALE = 0.125f * 1.4426950408889634f;
constexpr size_t OY = 0, OK_P = 17039360, OV_P = 25427968, OSG_P = 33816576, OK_S = 33882112, OV_S = 34013184, OSG_S = 34144256, OUT_TOTAL = 35192832;
constexpr size_t MiB = 1u << 20;
constexpr size_t WS_CTL = 0, CTL_ZERO_BYTES = 1 * MiB;
constexpr size_t WS_MOD = 1 * MiB, WS_WIN = 2 * MiB, WS_WO = 9 * MiB, WS_WUP = 11 * MiB, WS_WDN = 19 * MiB;
constexpr size_t WS_SLOC = 27 * MiB, WS_DSEG = 35 * MiB, WS_DPART = 36 * MiB, WS_DRTOT = 40 * MiB;
constexpr size_t WS_XN = 48 * MiB, WS_Q = 82 * MiB, WS_K = 99 * MiB, WS_V = 116 * MiB, WS_G = 133 * MiB, WS_MIX = 190 * MiB, WS_X1 = 224 * MiB, WS_H = 290 * MiB, WS_END = 421 * MiB;
static_assert(WS_WIN + (size_t)NIN * D * 2 <= WS_WO && WS_G + (size_t)M * 1792 * 2 <= WS_MIX && WS_MIX + (size_t)M * D * 2 <= WS_X1 && WS_X1 + (size_t)M * D * 4 <= WS_H && WS_H + (size_t)M * FF * 2 <= WS_END, "d_ws map");
static_assert(WS_XN + (size_t)M * D * 2 <= WS_Q && WS_Q + (size_t)M * 512 * 2 <= WS_K && WS_K + (size_t)M * 512 * 2 <= WS_V && WS_V + (size_t)M * 512 * 2 <= WS_G, "d_ws map 2");
constexpr int CW_BAR = 4096, CW_DEC = 16384;
constexpr int RING_BYTES = 139264, MISC_OFF = 146944, LDS_BYTES = 147456;

#define GAS __attribute__((address_space(1)))
#define LAS __attribute__((address_space(3)))
typedef unsigned short bf16;
typedef unsigned v4u __attribute__((ext_vector_type(4)));
typedef float f32x4 __attribute__((ext_vector_type(4)));
#define LDS_WAIT() asm volatile("s_waitcnt lgkmcnt(0)" ::: "memory")
__device__ __forceinline__ unsigned f2bf(float f) { unsigned u = __builtin_bit_cast(unsigned, f); return (u + 0x7fffu + ((u >> 16) & 1u)) >> 16; }
__device__ __forceinline__ unsigned pk2(float lo, float hi) { return f2bf(lo) | (f2bf(hi) << 16); }
#define XB_TMO      128
#define XB_XCNT(j)  (256  + 64 * (j))
#define XB_XSUB(j)  (1280 + 64 * (j))
#define XB_XGEN(j)  (2304 + 64 * (j))
#define XB_TOP      3328
#define XB_TOPGEN   3392
#define XCD_BAR_WORDS 3456
#define XB_SPIN_CAP (1u << 18)

__device__ __forceinline__ unsigned xb_ld(unsigned* p)              { return __hip_atomic_load(p, __ATOMIC_RELAXED, __HIP_MEMORY_SCOPE_AGENT); }
__device__ __forceinline__ unsigned xb_add(unsigned* p, unsigned v) { return __hip_atomic_fetch_add(p, v, __ATOMIC_RELAXED, __HIP_MEMORY_SCOPE_AGENT); }
__device__ __forceinline__ unsigned xb_xcc_id() { return (unsigned)__builtin_amdgcn_s_getreg((3 << 11) | 20) & 0xFu; }
#define XB_SPIN(cond, bar) do { unsigned _sp = 0; while (cond) { __builtin_amdgcn_s_sleep(1); \
    if ((++_sp & 255u) == 0u) { if (xb_ld(&(bar)[XB_TMO])) break; if (_sp > XB_SPIN_CAP) { atomicAdd(&(bar)[XB_TMO], 1u); break; } } } } while (0)

struct XcdBarrier {
    unsigned* bar; unsigned x;
    volatile LAS unsigned* st;
};

__device__ __forceinline__ XcdBarrier xcd_barrier_post(unsigned* bar, volatile LAS unsigned* st) {
    XcdBarrier b; b.bar = bar; b.x = xb_xcc_id(); b.st = st;
    if (threadIdx.x == 0) (void)xb_add(&bar[XB_XCNT(b.x)], 1u);
    return b;
}
__device__ __forceinline__ void xcd_barrier_complete(unsigned* bar, unsigned x, unsigned& nloc, unsigned& nx) {
    const unsigned G = gridDim.x * gridDim.y * gridDim.z;
    unsigned sum, cnt, mine, sp = 0u;
    for (;;) {
        sum = 0u; cnt = 0u; mine = 0u;
#pragma unroll
        for (unsigned j = 0; j < 16; ++j) { const unsigned c = xb_ld(&bar[XB_XCNT(j)]); sum += c; cnt += (c > 0u) ? 1u : 0u; mine = (j == x) ? c : mine; }
        if (sum == G) break;
        __builtin_amdgcn_s_sleep(1);
        if ((++sp & 255u) == 0u) { if (xb_ld(&bar[XB_TMO])) break; if (sp > XB_SPIN_CAP) { atomicAdd(&bar[XB_TMO], 1u); break; } }
    }
    nloc = mine > 0u ? mine : 1u; nx = cnt > 0u ? cnt : 1u;
}

__device__ __forceinline__ void xcd_barrier(const XcdBarrier& b) {
    asm volatile("s_waitcnt vmcnt(0)" ::: "memory");
    __syncthreads();
    if (threadIdx.x == 0) {
        unsigned* bar = b.bar;
        __builtin_amdgcn_s_waitcnt(0);
        unsigned nloc = b.st[0], nx = b.st[1];
        if (nloc == 0u) { xcd_barrier_complete(bar, b.x, nloc, nx); b.st[0] = nloc; b.st[1] = nx; }
        const unsigned old = xb_add(&bar[XB_XSUB(b.x)], 1u);
        const unsigned gen = old / nloc;
        if (old + 1u == (gen + 1u) * nloc) {
            __builtin_amdgcn_fence(__ATOMIC_RELEASE, "agent");
            asm volatile("s_waitcnt vmcnt(0)" ::: "memory");
            const unsigned og = xb_add(&bar[XB_TOP], 1u);
            const unsigned tg = og / nx;
            if (og + 1u == (tg + 1u) * nx) xb_add(&bar[XB_TOPGEN], 1u);
            else XB_SPIN(xb_ld(&bar[XB_TOPGEN]) == tg, bar);
            __builtin_amdgcn_fence(__ATOMIC_ACQUIRE, "agent");
            xb_add(&bar[XB_XGEN(b.x)], 1u);
            asm volatile("s_waitcnt vmcnt(0)" ::: "memory");
        } else {
            XB_SPIN(xb_ld(&bar[XB_XGEN(b.x)]) == gen, bar);
            __builtin_amdgcn_fence(__ATOMIC_ACQUIRE, "agent");
            asm volatile("s_waitcnt vmcnt(0)" ::: "memory");
        }
    }
    __syncthreads();
}
namespace sba {
using bf16x8=__attribute__((ext_vector_type(8)))short;
using s16x4=__attribute__((ext_vector_type(4)))short;
using f32x16=__attribute__((ext_vector_type(16)))float;
using u32x4=__attribute__((ext_vector_type(4)))unsigned;
typedef __hip_bfloat16 bf16;
constexpr int SEQ=8192,D=64,DM=512,OP=1024;
constexpr int NW=8,QBLK=32,QB=QBLK*NW,KVBLK=64;
constexpr int NSLOT=3,SLOTB=8192;
constexpr int LDS_K=0,LDS_V=NSLOT*SLOTB,LDS_OST=2*NSLOT*SLOTB,LDS_BYTES=LDS_OST+NW*4096;
__device__ __forceinline__ int crow(int r,int hi){return (r&3)+8*(r>>2)+4*hi;}
__device__ __forceinline__ void glds16(const void*gsrc,unsigned lds_dst){unsigned keep;
  asm volatile("s_mov_b32 %0, m0\n\ts_mov_b32 m0, %2\n\ts_nop 0\n\tglobal_load_lds_dwordx4 %1, off\n\ts_mov_b32 m0, %0":"=&s"(keep):"v"(gsrc),"s"(lds_dst):"memory");}
typedef float f32x2_t __attribute__((ext_vector_type(2))); typedef __bf16 bf16x2_t __attribute__((ext_vector_type(2)));
__device__ __forceinline__ unsigned cvtpk_s(float lo,float hi){f32x2_t v={lo,hi};bf16x2_t b=__builtin_convertvector(v,bf16x2_t);return __builtin_bit_cast(unsigned,b);}
typedef __attribute__((address_space(3))) const char* lds_cptr;
typedef short v4i16_t __attribute__((ext_vector_type(4)));
__device__ __forceinline__ s16x4 vtr(lds_cptr p){ return __builtin_bit_cast(s16x4,__builtin_amdgcn_ds_read_tr16_b64_v4i16((__attribute__((address_space(3))) v4i16_t*)p)); }
#define SBA_MFMA(a,b,c) __builtin_amdgcn_mfma_f32_32x32x16_bf16((a),(b),(c),0,0,0)
template<bool MASK> __device__ __forceinline__ void sb_weights(f32x16&c0,f32x16&c1,float&carry,int hi,int jb,int qrel){
  #pragma unroll
  for(int r=0;r<16;++r){
    float e0=__builtin_amdgcn_exp2f(c0[r]), e1=__builtin_amdgcn_exp2f(c1[r]);
    if(MASK){ const int kv=64*jb+crow(r,hi); if(kv>=qrel)e0=0.f; if(kv+32>=qrel)e1=0.f; }
    c0[r]=1.f+e0; c1[r]=1.f+e1; }
  float P2[8],P3[8],T[8];
  #pragma unroll
  for(int c=0;c<4;++c){ P2[c]=c0[4*c]*c0[4*c+1]; P3[c]=P2[c]*c0[4*c+2]; T[c]=__builtin_amdgcn_rcpf(P3[c]*c0[4*c+3]);
                        P2[4+c]=c1[4*c]*c1[4*c+1]; P3[4+c]=P2[4+c]*c1[4*c+2]; T[4+c]=__builtin_amdgcn_rcpf(P3[4+c]*c1[4*c+3]); }
  float Tl[8],Th[8];
  #pragma unroll
  for(int c=0;c<8;++c){ auto rr=__builtin_amdgcn_permlane32_swap(__float_as_uint(T[c]),__float_as_uint(T[c]),false,false); Tl[c]=__uint_as_float(rr[0]); Th[c]=__uint_as_float(rr[1]); }
  float E=carry;
  float off[8];
  #pragma unroll
  for(int c=7;c>=0;--c){ off[c]=hi?E:E*Th[c]; E=E*(Tl[c]*Th[c]); }
  carry=E;
  #pragma unroll
  for(int c=0;c<4;++c){
    { const float g=T[c]*off[c], R1=c0[4*c]*g, R2=P2[c]*g, R3=P3[c]*g; c0[4*c]=R1-g; c0[4*c+1]=R2-R1; c0[4*c+2]=R3-R2; c0[4*c+3]=off[c]-R3; }
    { const float g=T[4+c]*off[4+c], R1=c1[4*c]*g, R2=P2[4+c]*g, R3=P3[4+c]*g; c1[4*c]=R1-g; c1[4*c+1]=R2-R1; c1[4*c+2]=R3-R2; c1[4*c+3]=off[4+c]-R3; } }
}
__device__ __forceinline__ void pv(f32x16*o,lds_cptr vp,const f32x16&w0,const f32x16&w1){
  u32x4 pw[4];
  #pragma unroll
  for(int k=0;k<2;++k)
    #pragma unroll
    for(int j=0;j<4;++j){ pw[k][j]=cvtpk_s(w0[8*k+2*j],w0[8*k+2*j+1]); pw[2+k][j]=cvtpk_s(w1[8*k+2*j],w1[8*k+2*j+1]); }
  #pragma unroll
  for(int d0=0;d0<2;++d0)
    #pragma unroll
    for(int ks=0;ks<4;++ks){ const s16x4 lo=vtr(vp+d0*4096+ks*1024), hh=vtr(vp+d0*4096+ks*1024+512);
      const bf16x8 vf={lo[0],lo[1],lo[2],lo[3],hh[0],hh[1],hh[2],hh[3]};
      o[d0]=SBA_MFMA(__builtin_bit_cast(bf16x8,pw[ks]),vf,o[d0]); }
}
__device__ __forceinline__ void attn_unit(int b,int h,int qb,const bf16*Q,const bf16*__restrict__ K,const bf16*__restrict__ V,bf16*O,char*shm,float bias2){
  int tid_=threadIdx.x; asm volatile("":"+v"(tid_)); const int tid=tid_,lane=tid&63,r32=lane&31,hi=lane>>5; const int wid=__builtin_amdgcn_readfirstlane(tid>>6);
  const long rowbase=(long)b*SEQ; const int q0=qb*QB;
  const bf16*Qw=Q+(rowbase+q0+wid*QBLK)*DM+h*D;
  const bf16*Kh=K+rowbase*DM+h*D,*Vh=V+rowbase*DM+h*D;
  const unsigned lds0=(unsigned)(uintptr_t)shm;
  const bf16*ksrc=Kh+(long)lane*DM+wid*8;
  const bf16*vsrc=Vh+(long)(16*(wid&3)+(lane>>2))*DM+(wid>>2)*32+(lane&3)*8;
  const unsigned kdst=lds0+LDS_K+wid*1024, vdst=lds0+LDS_V+wid*1024;
  const int NT=(q0+QB)/KVBLK;
  #define DMA_KV(s_,slot_) do{ const long t_=(long)(NT-1-(s_))*KVBLK*DM; glds16(ksrc+t_,(unsigned)__builtin_amdgcn_readfirstlane(kdst+(slot_)*SLOTB)); glds16(vsrc+t_,(unsigned)__builtin_amdgcn_readfirstlane(vdst+(slot_)*SLOTB)); }while(0)
  bf16x8 qr[4];
  #pragma unroll
  for(int d0=0;d0<4;++d0)qr[d0]=*reinterpret_cast<const bf16x8*>(&Qw[(long)r32*DM+d0*16+hi*8]);
  DMA_KV(0,0); DMA_KV(1,1);
  const lds_cptr shm3=(lds_cptr)shm; const lds_cptr kp0=shm3+LDS_K+hi*1024+r32*16; const lds_cptr vp0=shm3+LDS_V+((lane>>4)&1)*32+(lane&3)*8+(4*hi+((lane&15)>>2))*64;
  f32x16 o[2];o[0]=f32x16{};o[1]=f32x16{}; f32x16 bv;
  #pragma unroll
  for(int r=0;r<16;++r)bv[r]=bias2;
  asm volatile("":"+v"(bv));
  float carry=1.f; const int qrel=wid*QBLK+r32;
  int slot=0;
  for(int s=0;s<NT;++s){
    if(s+1<NT) asm volatile("s_waitcnt vmcnt(2) lgkmcnt(0)\n\ts_barrier":::"memory"); else asm volatile("s_waitcnt vmcnt(0) lgkmcnt(0)\n\ts_barrier":::"memory");
    if(s+2<NT){ const int ns=(slot==0)?2:slot-1; DMA_KV(s+2,ns); }
    const lds_cptr kp=kp0+slot*SLOTB;
    f32x16 c0=bv,c1=bv;
    #pragma unroll
    for(int d0=0;d0<4;++d0){
      const bf16x8 k0=*(const __attribute__((address_space(3))) bf16x8*)(kp+d0*2048), k1=*(const __attribute__((address_space(3))) bf16x8*)(kp+d0*2048+512);
      c0=SBA_MFMA(k0,qr[d0],c0); c1=SBA_MFMA(k1,qr[d0],c1); }
    if(s<4) sb_weights<true>(c0,c1,carry,hi,3-s,qrel); else sb_weights<false>(c0,c1,carry,hi,0,0);
    pv(o,vp0+slot*SLOTB,c0,c1);
    slot=(slot==2)?0:slot+1;
  }
  #undef DMA_KV
  bf16*Ow=O+(rowbase+q0+wid*QBLK)*OP+h*D;
  { bf16*stg=(bf16*)(shm+LDS_OST)+wid*2048;
    #pragma unroll
    for(int r=0;r<16;++r){const int orow=crow(r,hi);
      #pragma unroll
      for(int d0=0;d0<2;++d0)stg[orow*64+d0*32+r32]=__float2bfloat16(o[d0][r]);}
    asm volatile("s_waitcnt lgkmcnt(0)":::"memory");
    #pragma unroll
    for(int i=0;i<4;++i){const int row=i*8+(lane>>3),ch=lane&7; const u32x4 v=*(const u32x4*)(stg+row*64+ch*8); *(u32x4*)(Ow+(long)row*OP+ch*8)=v;} }
  asm volatile("s_waitcnt vmcnt(0) lgkmcnt(0)\n\ts_barrier":::"memory");
}
}
namespace sbd {
using sba::bf16x8; using sba::f32x16; using sba::u32x4; using sba::bf16; using sba::crow; using sba::cvtpk_s;
typedef float f32x4 __attribute__((ext_vector_type(4)));
#define RLXA __ATOMIC_RELAXED, __HIP_MEMORY_SCOPE_AGENT
template<bool NEWK> __device__ __forceinline__ void weights32(f32x16&c,float&carry,int hi,int q){
  #pragma unroll
  for(int r=0;r<16;++r){ float e=__builtin_amdgcn_exp2f(c[r]);
    if(NEWK){ const int kv=crow(r,hi); if(kv>=8||kv>=q)e=0.f; }
    c[r]=1.f+e; }
  float P2[4],P3[4],T[4],Tl[4],Th[4],off[4];
  #pragma unroll
  for(int k=0;k<4;++k){ P2[k]=c[4*k]*c[4*k+1]; P3[k]=P2[k]*c[4*k+2]; T[k]=__builtin_amdgcn_rcpf(P3[k]*c[4*k+3]); }
  #pragma unroll
  for(int k=0;k<4;++k){ auto s=__builtin_amdgcn_permlane32_swap(__float_as_uint(T[k]),__float_as_uint(T[k]),false,false); Tl[k]=__uint_as_float(s[0]); Th[k]=__uint_as_float(s[1]); }
  float E=carry;
  #pragma unroll
  for(int k=3;k>=0;--k){ off[k]=hi?E:E*Th[k]; E=E*(Tl[k]*Th[k]); }
  carry=E;
  #pragma unroll
  for(int k=0;k<4;++k){ const float g=T[k]*off[k], R1=c[4*k]*g, R2=P2[k]*g, R3=P3[k]*g; c[4*k]=R1-g; c[4*k+1]=R2-R1; c[4*k+2]=R3-R2; c[4*k+3]=off[k]-R3; }
}
struct Raw { f32x4 k[8]; float v[32]; };
__device__ __forceinline__ void load_tile(Raw&R,const float*kb,const float*vb){
  #pragma unroll
  for(int d0=0;d0<4;++d0){ R.k[2*d0]=__builtin_nontemporal_load((const f32x4*)(kb+16*d0)); R.k[2*d0+1]=__builtin_nontemporal_load((const f32x4*)(kb+16*d0+4)); }
  #pragma unroll
  for(int d0=0;d0<2;++d0)
    #pragma unroll
    for(int ks=0;ks<2;++ks)
      #pragma unroll
      for(int j=0;j<8;++j) R.v[(d0*2+ks)*8+j]=__builtin_nontemporal_load(vb+(size_t)(16*ks+8*(j>>2)+(j&3))*512+32*d0);
}
struct Frag { bf16x8 k[4]; bf16x8 v[4]; };
__device__ __forceinline__ void cvt_tile(Frag&F,const Raw&R){
  #pragma unroll
  for(int d0=0;d0<4;++d0){ u32x4 p; p[0]=cvtpk_s(R.k[2*d0][0],R.k[2*d0][1]); p[1]=cvtpk_s(R.k[2*d0][2],R.k[2*d0][3]); p[2]=cvtpk_s(R.k[2*d0+1][0],R.k[2*d0+1][1]); p[3]=cvtpk_s(R.k[2*d0+1][2],R.k[2*d0+1][3]); F.k[d0]=__builtin_bit_cast(bf16x8,p); }
  #pragma unroll
  for(int i=0;i<4;++i){ u32x4 p;
    #pragma unroll
    for(int j=0;j<4;++j) p[j]=cvtpk_s(R.v[8*i+2*j],R.v[8*i+2*j+1]);
    F.v[i]=__builtin_bit_cast(bf16x8,p); }
}
template<bool NEWK> __device__ __forceinline__ void tile_step(const Frag&F,const bf16x8*qr,const f32x16&bv,f32x16*o,float&carry,int hi,int q){
  f32x16 c=bv;
  #pragma unroll
  for(int d0=0;d0<4;++d0) c=SBA_MFMA(F.k[d0],qr[d0],c);
  weights32<NEWK>(c,carry,hi,q);
  u32x4 pw[2];
  #pragma unroll
  for(int k=0;k<2;++k)
    #pragma unroll
    for(int j=0;j<4;++j) pw[k][j]=cvtpk_s(c[8*k+2*j],c[8*k+2*j+1]);
  #pragma unroll
  for(int d0=0;d0<2;++d0)
    #pragma unroll
    for(int ks=0;ks<2;++ks) o[d0]=SBA_MFMA(__builtin_bit_cast(bf16x8,pw[ks]),F.v[d0*2+ks],o[d0]);
}
__device__ __forceinline__ void decode_unit(int smp,int j,const float*cache_k,const float*cache_v,const int*page_table,const bf16*Q,const bf16*Kn,const bf16*Vn,const float*b_sb,
                                            float*part,float*rtot,unsigned*cnt,bf16*MIX,volatile __attribute__((address_space(3))) unsigned*flag){
  int tid_=threadIdx.x; asm volatile("":"+v"(tid_)); const int tid=tid_,lane=tid&63,r32=lane&31,hi=lane>>5; const int h=__builtin_amdgcn_readfirstlane(tid>>6);
  const float bias2=b_sb[h]*1.4426950408889634f;
  f32x16 bv;
  #pragma unroll
  for(int r=0;r<16;++r)bv[r]=bias2;
  const long srow=16384+8*smp;
  bf16x8 qr[4];
  #pragma unroll
  for(int d0=0;d0<4;++d0){ bf16x8 z={0,0,0,0,0,0,0,0}; if(r32<8) z=*reinterpret_cast<const bf16x8*>(Q+(srow+r32)*512+h*64+d0*16+hi*8); qr[d0]=z; }
  f32x16 o[2]; o[0]=f32x16{}; o[1]=f32x16{}; float carry=1.f;
  if(j==7){
    Frag F;
    #pragma unroll
    for(int d0=0;d0<4;++d0){ bf16x8 z={0,0,0,0,0,0,0,0}; if(r32<8) z=*reinterpret_cast<const bf16x8*>(Kn+(srow+r32)*512+h*64+d0*16+hi*8); F.k[d0]=z; }
    #pragma unroll
    for(int d0=0;d0<2;++d0){
      bf16x8 z={0,0,0,0,0,0,0,0};
      #pragma unroll
      for(int jj=0;jj<4;++jj) z[jj]=*reinterpret_cast<const short*>(Vn+(srow+4*hi+jj)*512+h*64+32*d0+r32);
      F.v[d0*2]=z; F.v[d0*2+1]=(bf16x8){0,0,0,0,0,0,0,0}; }
    tile_step<true>(F,qr,bv,o,carry,hi,r32);
  }
  const int*pt=page_table+smp*64+8*j;
  Raw R; Frag F;
  #define ROWK(tt) (cache_k+(((size_t)pt[(tt)>>2]*128+(size_t)(((tt)&3)*32+r32))*8+h)*64+8*hi)
  #define ROWV(tt) (cache_v+(((size_t)pt[(tt)>>2]*128+(size_t)(((tt)&3)*32+4*hi))*8+h)*64+r32)
  load_tile(R,ROWK(31),ROWV(31)); cvt_tile(F,R);
  for(int tt=31;tt>=0;--tt){
    if(tt>0) load_tile(R,ROWK(tt-1),ROWV(tt-1));
    tile_step<false>(F,qr,bv,o,carry,hi,r32);
    if(tt>0) cvt_tile(F,R);
  }
  #undef ROWK
  #undef ROWV
  const int unit=smp*8+j;
  int l2_=threadIdx.x; asm volatile("":"+v"(l2_)); const int lane2=l2_&63, r32b=lane2&31, hib=lane2>>5;
  unsigned*pp=(unsigned*)part+((size_t)unit*8+h)*512;
  #pragma unroll
  for(int r=0;r<4;++r)
    #pragma unroll
    for(int d0=0;d0<2;++d0) __hip_atomic_store(pp+(r+4*hib)*64+32*d0+r32b,__float_as_uint(o[d0][r]),RLXA);
  if(lane2<8) __hip_atomic_store((unsigned*)rtot+((size_t)unit*8+h)*8+lane2,__float_as_uint(carry),RLXA);
  asm volatile("s_waitcnt vmcnt(0)":::"memory");
  __syncthreads();
  if(tid==0){ const unsigned old=__hip_atomic_fetch_add(cnt+64*smp,1u,RLXA); flag[0]=(old==7u)?1u:0u; }
  __syncthreads();
  const bool last=flag[0]!=0u;
  __syncthreads();
  if(last){
    const int q=lane2>>3,dc=(lane2&7)*8; float acc[8];
    #pragma unroll
    for(int i=0;i<8;++i)acc[i]=0.f;
    float f=1.f;
    for(int jj=7;jj>=0;--jj){ const size_t u=(size_t)smp*8+jj; const unsigned*src=(const unsigned*)part+(u*8+h)*512+q*64+dc;
      #pragma unroll
      for(int i=0;i<8;++i) acc[i]+=f*__uint_as_float(__hip_atomic_load(src+i,RLXA));
      f*=__uint_as_float(__hip_atomic_load((const unsigned*)rtot+(u*8+h)*8+q,RLXA)); }
    u32x4 w; w[0]=cvtpk_s(acc[0],acc[1]); w[1]=cvtpk_s(acc[2],acc[3]); w[2]=cvtpk_s(acc[4],acc[5]); w[3]=cvtpk_s(acc[6],acc[7]);
    *(u32x4*)(MIX+(srow+q)*1024+h*64+dc)=w;
  }
}
}
namespace gla {
using sba::bf16; using sba::cvtpk_s;
typedef short bf16x8 __attribute__((ext_vector_type(8)));
typedef short bf16x4 __attribute__((ext_vector_type(4)));
typedef float f32x4 __attribute__((ext_vector_type(4)));
typedef unsigned u32x4 __attribute__((ext_vector_type(4)));
typedef unsigned u32x2 __attribute__((ext_vector_type(2)));
#define GLAS __attribute__((address_space(3)))
constexpr int GP=1792;
constexpr int L_QD=0,L_KI=9216,L_KET=18432,L_VT=27648,L_DEC=46080,L_EXR=46336,L_TOT=46592,L_SSQ=48640,L_END=50688;
#define GMFMA(a,b,c) __builtin_amdgcn_mfma_f32_16x16x32_bf16((a),(b),(c),0,0,0)
__device__ __forceinline__ float bf2f(short s){ return __uint_as_float(((unsigned)(unsigned short)s)<<16); }
__device__ __forceinline__ short f2bf(float f){ return (short)(cvtpk_s(f,0.f)&0xffffu); }
template<int MODE,bool FULL> __device__ __forceinline__ void chunk(const bf16*G,bf16*MIX,long m0,int ntok,int h,GLAS char*L,f32x4(&S)[4],const float(&wg)[16],float bg,float gain,float&dseg){
  int tid_=threadIdx.x; asm volatile("":"+v"(tid_)); const int tid=tid_,lane=tid&63,c=lane,fr=lane&15,fq=lane>>4; const int w=__builtin_amdgcn_readfirstlane(tid>>6); const int g=w;
  const short*Gs=(const short*)G;
  float bl[8]; float run=0.f;
  bf16x8 al0[8],al1[8]; short kraw[8],qraw[8],vraw[16];
  #pragma unroll
  for(int i=0;i<8;++i){ const int t=8*g+i; const bool ok=FULL||t<ntok; const long row=ok?(m0+t):m0; const bf16x8*ap=(const bf16x8*)(Gs+row*GP+1536); al0[i]=ap[0]; al1[i]=ap[1];
    kraw[i]=Gs[row*GP+256+64*h+c]; qraw[i]=(MODE==1)?Gs[row*GP+64*h+c]:(short)0; }
  #pragma unroll
  for(int i=0;i<16;++i){ const int t=16*(tid>>7)+i; const bool ok=FULL||t<ntok; const long row=ok?(m0+t):m0; vraw[i]=Gs[row*GP+512+128*h+(tid&127)]; }
  #pragma unroll
  for(int i=0;i<8;++i){ const int t=8*g+i; float la=0.f;
    if(FULL||t<ntok){ const bf16x8 a0=al0[i],a1=al1[i]; float x=bg;
      #pragma unroll
      for(int j=0;j<8;++j){ x+=bf2f(a0[j])*wg[j]; x+=bf2f(a1[j])*wg[8+j]; }
      la=(fminf(x,0.f)-__logf(1.f+__expf(-fabsf(x))))*0.0625f; }
    run+=la; bl[i]=run; }
  GLAS float*TOT=(GLAS float*)(L+L_TOT);
  TOT[g*64+c]=run;
  __syncthreads();
  float prefix=0.f,total=0.f;
  #pragma unroll
  for(int gg=0;gg<8;++gg){ const float v=TOT[gg*64+c]; total+=v; if(gg<g)prefix+=v; }
  const float bref=0.5f*total;
  float ke[8];
  #pragma unroll
  for(int i=0;i<8;++i){ const int t=8*g+i; const float b=prefix+bl[i]; float kk=0.f,qq=0.f;
    if(FULL||t<ntok){ kk=bf2f(kraw[i]); if(MODE==1) qq=bf2f(qraw[i]); }
    ke[i]=kk*__expf(total-b);
    if(MODE==1){ *(GLAS short*)(L+L_QD+t*144+c*2)=f2bf(qq*0.125f*__expf(b-bref)); *(GLAS short*)(L+L_KI+t*144+c*2)=f2bf(kk*__expf(bref-b)); } }
  { u32x4 p; p[0]=cvtpk_s(ke[0],ke[1]); p[1]=cvtpk_s(ke[2],ke[3]); p[2]=cvtpk_s(ke[4],ke[5]); p[3]=cvtpk_s(ke[6],ke[7]); *(GLAS u32x4*)(L+L_KET+c*144+g*16)=p; }
  if(g==0){ const float d=__expf(total); ((GLAS float*)(L+L_DEC))[c]=d; ((GLAS float*)(L+L_EXR))[c]=__expf(bref); dseg*=d; }
  { const int dv=tid&127,tg=tid>>7; float vv[16];
    #pragma unroll
    for(int i=0;i<16;++i){ const int t=16*tg+i; vv[i]=(FULL||t<ntok)?bf2f(vraw[i]):0.f; }
    u32x4 p0,p1;
    #pragma unroll
    for(int j=0;j<4;++j){ p0[j]=cvtpk_s(vv[2*j],vv[2*j+1]); p1[j]=cvtpk_s(vv[8+2*j],vv[8+2*j+1]); }
    *(GLAS u32x4*)(L+L_VT+dv*144+tg*32)=p0; *(GLAS u32x4*)(L+L_VT+dv*144+tg*32+16)=p1; }
  __syncthreads();
  const int dvl=16*w+fr;
  f32x4 O[4];
  if(MODE==1){
    f32x4 PT[4][4];
    #pragma unroll
    for(int st=0;st<4;++st)
      #pragma unroll
      for(int tt=0;tt<4;++tt){ f32x4 acc={0.f,0.f,0.f,0.f};
        if(st<=tt){
          #pragma unroll
          for(int kk=0;kk<2;++kk){ const bf16x8 a=*(GLAS const bf16x8*)(L+L_KI+(16*st+fr)*144+(32*kk+8*fq)*2), b=*(GLAS const bf16x8*)(L+L_QD+(16*tt+fr)*144+(32*kk+8*fq)*2); acc=GMFMA(a,b,acc); }
          if(st==tt){
            #pragma unroll
            for(int i=0;i<4;++i) if(4*fq+i>fr) acc[i]=0.f; } }
        PT[st][tt]=acc; }
    #pragma unroll
    for(int tt=0;tt<4;++tt){ O[tt]=(f32x4){0.f,0.f,0.f,0.f};
      #pragma unroll
      for(int pr=0;pr<2;++pr){ if(2*pr<=tt){
        u32x4 pa; pa[0]=cvtpk_s(PT[2*pr][tt][0],PT[2*pr][tt][1]); pa[1]=cvtpk_s(PT[2*pr][tt][2],PT[2*pr][tt][3]); pa[2]=cvtpk_s(PT[2*pr+1][tt][0],PT[2*pr+1][tt][1]); pa[3]=cvtpk_s(PT[2*pr+1][tt][2],PT[2*pr+1][tt][3]);
        const u32x2 b0=*(GLAS const u32x2*)(L+L_VT+dvl*144+(32*pr+4*fq)*2), b1=*(GLAS const u32x2*)(L+L_VT+dvl*144+(32*pr+16+4*fq)*2);
        const u32x4 pb={b0[0],b0[1],b1[0],b1[1]};
        O[tt]=GMFMA(__builtin_bit_cast(bf16x8,pa),__builtin_bit_cast(bf16x8,pb),O[tt]); } } }
    #pragma unroll
    for(int kk=0;kk<2;++kk){
      const f32x4 e0=*(GLAS const f32x4*)(L+L_EXR+(32*kk+4*fq)*4), e1=*(GLAS const f32x4*)(L+L_EXR+(32*kk+16+4*fq)*4);
      const f32x4 s0=S[2*kk]*e0, s1=S[2*kk+1]*e1;
      u32x4 pb; pb[0]=cvtpk_s(s0[0],s0[1]); pb[1]=cvtpk_s(s0[2],s0[3]); pb[2]=cvtpk_s(s1[0],s1[1]); pb[3]=cvtpk_s(s1[2],s1[3]);
      #pragma unroll
      for(int tt=0;tt<4;++tt){ const u32x2 a0=*(GLAS const u32x2*)(L+L_QD+(16*tt+fr)*144+(32*kk+4*fq)*2), a1=*(GLAS const u32x2*)(L+L_QD+(16*tt+fr)*144+(32*kk+16+4*fq)*2);
        const u32x4 pa={a0[0],a0[1],a1[0],a1[1]};
        O[tt]=GMFMA(__builtin_bit_cast(bf16x8,pa),__builtin_bit_cast(bf16x8,pb),O[tt]); } }
  }
  #pragma unroll
  for(int mt=0;mt<4;++mt){ const f32x4 d4=*(GLAS const f32x4*)(L+L_DEC+(16*mt+4*fq)*4); S[mt]=S[mt]*d4;
    #pragma unroll
    for(int kk=0;kk<2;++kk){ const bf16x8 a=*(GLAS const bf16x8*)(L+L_KET+(16*mt+fr)*144+(32*kk+8*fq)*2), b=*(GLAS const bf16x8*)(L+L_VT+dvl*144+(32*kk+8*fq)*2); S[mt]=GMFMA(a,b,S[mt]); } }
  if(MODE==1){
    GLAS float*SSQ=(GLAS float*)(L+L_SSQ);
    #pragma unroll
    for(int tt=0;tt<4;++tt)
      #pragma unroll
      for(int i=0;i<4;++i){ float ss=O[tt][i]*O[tt][i]; ss+=__shfl_xor(ss,1); ss+=__shfl_xor(ss,2); ss+=__shfl_xor(ss,4); ss+=__shfl_xor(ss,8); if(fr==0) SSQ[w*64+16*tt+4*fq+i]=ss; }
    short rraw[16];
    #pragma unroll
    for(int tt=0;tt<4;++tt)
      #pragma unroll
      for(int i=0;i<4;++i){ const int t=16*tt+4*fq+i; const long row=(FULL||t<ntok)?(m0+t):m0; rraw[4*tt+i]=Gs[row*GP+1024+128*h+dvl]; }
    __syncthreads();
    #pragma unroll
    for(int tt=0;tt<4;++tt)
      #pragma unroll
      for(int i=0;i<4;++i){ const int t=16*tt+4*fq+i; float tot=0.f;
        #pragma unroll
        for(int ww=0;ww<8;++ww) tot+=SSQ[ww*64+t];
        if(FULL||t<ntok){ const float rstd=rsqrtf(tot*(1.f/128.f)+1e-6f); const float rg=bf2f(rraw[4*tt+i]); const float sl=rg/(1.f+__expf(-rg));
          ((short*)MIX)[(m0+t)*1024+512+128*h+dvl]=f2bf(O[tt][i]*rstd*gain*sl); } }
  }
  __syncthreads();
}
__device__ __forceinline__ void load_consts(int h,const float*w_gate,const float*b_gate,const float*g_out,float(&wg)[16],float&bg,float&gain){
  const int lane=threadIdx.x&63, w=threadIdx.x>>6;
  #pragma unroll
  for(int j=0;j<16;++j) wg[j]=w_gate[j*256+64*h+lane];
  bg=b_gate[64*h+lane]; gain=g_out[16*w+(lane&15)];
}
__device__ __forceinline__ void pass1_unit(int unit,const bf16*G,const float*w_gate,const float*b_gate,const float*g_out,float*SLOC,float*DSEG,GLAS char*L){
  const int bh=unit>>5,sseg=unit&31,b=bh>>2,h=bh&3; const int tid=threadIdx.x;
  float wg[16],bg,gain; load_consts(h,w_gate,b_gate,g_out,wg,bg,gain);
  f32x4 S[4];
  #pragma unroll
  for(int mt=0;mt<4;++mt)S[mt]=(f32x4){0.f,0.f,0.f,0.f};
  float dseg=1.f; const long m0=(long)b*8192+256*sseg;
  for(int ch=0;ch<4;++ch) chunk<0,true>(G,nullptr,m0+64*ch,64,h,L,S,wg,bg,gain,dseg);
  f32x4*dst=(f32x4*)(SLOC+((size_t)unit*512+tid)*16);
  #pragma unroll
  for(int mt=0;mt<4;++mt)dst[mt]=S[mt];
  if(tid<64)DSEG[unit*64+tid]=dseg;
}
__device__ __forceinline__ void pass3_unit(int unit,const bf16*G,bf16*MIX,const float*w_gate,const float*b_gate,const float*g_out,const float*SLOC,const float*DSEG,float*sfin_base,GLAS char*L){
  const int bh=unit>>5,sseg=unit&31,b=bh>>2,h=bh&3; const int tid=threadIdx.x,lane=tid&63,fr=lane&15,fq=lane>>4,w=tid>>6;
  float wg[16],bg,gain; load_consts(h,w_gate,b_gate,g_out,wg,bg,gain);
  f32x4 S[4];
  #pragma unroll
  for(int mt=0;mt<4;++mt)S[mt]=(f32x4){0.f,0.f,0.f,0.f};
  #pragma unroll 4
  for(int j=0;j<sseg;++j){ const int uj=bh*32+j; const f32x4*src=(const f32x4*)(SLOC+((size_t)uj*512+tid)*16);
    #pragma unroll
    for(int mt=0;mt<4;++mt){ const f32x4 d4=*(const f32x4*)(DSEG+uj*64+16*mt+4*fq); S[mt]=S[mt]*d4+src[mt]; } }
  float dseg=1.f; const long m0=(long)b*8192+256*sseg;
  for(int ch=0;ch<4;++ch) chunk<1,true>(G,MIX,m0+64*ch,64,h,L,S,wg,bg,gain,dseg);
  if(sseg==31){ float*o=sfin_base+(size_t)bh*8192;
    #pragma unroll
    for(int mt=0;mt<4;++mt)
      #pragma unroll
      for(int i=0;i<4;++i) o[(16*mt+4*fq+i)*128+16*w+fr]=S[mt][i]; }
}
__device__ __forceinline__ void sample_unit(int unit,const bf16*G,bf16*MIX,const float*w_gate,const float*b_gate,const float*g_out,const float*s0,float*sout,GLAS char*L){
  const int smp=unit>>2,h=unit&3; const int tid=threadIdx.x,lane=tid&63,fr=lane&15,fq=lane>>4,w=tid>>6;
  float wg[16],bg,gain; load_consts(h,w_gate,b_gate,g_out,wg,bg,gain);
  f32x4 S[4]; const float*si=s0+(size_t)unit*8192; float*so=sout+(size_t)unit*8192;
  #pragma unroll
  for(int mt=0;mt<4;++mt)
    #pragma unroll
    for(int i=0;i<4;++i) S[mt][i]=si[(16*mt+4*fq+i)*128+16*w+fr];
  float dseg=1.f;
  chunk<1,false>(G,MIX,16384+8*(long)smp,8,h,L,S,wg,bg,gain,dseg);
  #pragma unroll
  for(int mt=0;mt<4;++mt)
    #pragma unroll
    for(int i=0;i<4;++i) so[(16*mt+4*fq+i)*128+16*w+fr]=S[mt][i];
}
}
namespace thin {
using sba::bf16x8; using sba::f32x16; using sba::crow;
template<int KS,class Epi> __device__ __forceinline__ void run(const unsigned short*A,int lda,const unsigned short*Bt,int ldb,int K,int ntn,int tile0,int ntiles,__attribute__((address_space(3))) float*red,const Epi&epi){
  int tid_=threadIdx.x; asm volatile("":"+v"(tid_)); const int lane=tid_&63,r32=lane&31,hi=lane>>5; const int w=__builtin_amdgcn_readfirstlane(tid_>>6);
  const int sub=w/KS,kp=w%KS,tile=tile0+sub; const bool live=tile<ntiles; const int tm=live?tile/ntn:0,tn=live?tile%ntn:0;
  const int klen=K/KS,k0=kp*klen;
  const unsigned short*ap=A+(size_t)(32*tm+r32)*lda+k0+8*hi; const unsigned short*bp=Bt+(size_t)(32*tn+r32)*ldb+k0+8*hi;
  f32x16 acc=f32x16{};
  if(live){
    #pragma unroll 8
    for(int k=0;k<klen;k+=16){ const bf16x8 a=*(const bf16x8*)(ap+k), b=*(const bf16x8*)(bp+k); acc=__builtin_amdgcn_mfma_f32_32x32x16_bf16(a,b,acc,0,0,0); } }
  #pragma unroll
  for(int r=0;r<16;++r) red[(w*16+r)*64+lane]=acc[r];
  __syncthreads();
  if(kp==0&&live){
    #pragma unroll
    for(int r=0;r<16;++r){ float v=0.f;
      #pragma unroll
      for(int p=0;p<KS;++p) v+=red[((sub*KS+p)*16+r)*64+lane];
      epi(32*tm+crow(r,hi),32*tn+r32,v); } }
  __syncthreads();
}
struct EpiResGateS { const float*base; float*out; const float*gate; int ld;
  __device__ __forceinline__ void operator()(int row,int col,float v)const{ const size_t o=(size_t)row*ld+col; out[o]=base[o]+gate[(size_t)(2+(row>>3))*6144+col]*v; } };
struct EpiRelu2S { unsigned short*H; int ld;
  __device__ __forceinline__ void operator()(int row,int col,float v)const{ const float a=fmaxf(v,0.f); H[(size_t)row*ld+col]=(unsigned short)(sba::cvtpk_s(a*a,0.f)&0xffffu); } };
}
__device__ __forceinline__ float wave_sum(float v) {
#pragma unroll
    for (int o = 1; o < 64; o <<= 1) v += __shfl_xor(v, o);
    return v;
}
__device__ __forceinline__ void p0_transpose_item(const float* W, int K, int Nreal, int Npad, bf16* WT, LAS float* scr, int item, int lane) {
    const int nblk = Npad / 32, kb = item / nblk, nb = item % nblk, k0 = 64 * kb, n0 = 32 * nb;
    const int n = n0 + (lane & 31);
#pragma unroll 8
    for (int i = 0; i < 32; ++i) { const int kk = 2 * i + (lane >> 5); scr[kk * 33 + (lane & 31)] = (n < Nreal) ? W[(size_t)(k0 + kk) * Nreal + n] : 0.f; }
    LDS_WAIT(); asm volatile("" ::: "memory");
    const int c = lane & 7;
#pragma unroll
    for (int j = 0; j < 4; ++j) { const int nn = (lane >> 3) + 8 * j; const LAS float* s = scr + (8 * c) * 33 + nn;
        v4u o; o.x = pk2(s[0 * 33], s[1 * 33]); o.y = pk2(s[2 * 33], s[3 * 33]); o.z = pk2(s[4 * 33], s[5 * 33]); o.w = pk2(s[6 * 33], s[7 * 33]);
        *(GAS v4u*)(WT + (size_t)(n0 + nn) * K + k0 + 8 * c) = o; }
    LDS_WAIT(); asm volatile("" ::: "memory");
}
__device__ __forceinline__ void norm_mod_row_bf16(int lane, const float* xrow, const float* gain, const float* sc, const float* sh, bf16* orow) {
    const f32x4* xr = (const f32x4*)xrow + lane; f32x4 v[4]; float s = 0.f;
#pragma unroll
    for (int j = 0; j < 4; ++j) { v[j] = xr[64 * j]; s += (v[j].x * v[j].x + v[j].y * v[j].y) + (v[j].z * v[j].z + v[j].w * v[j].w); }
    const float rstd = rsqrtf(wave_sum(s) * (1.f / D) + NORM_EPS);
    unsigned long long* o8 = (unsigned long long*)orow + lane;
#pragma unroll
    for (int j = 0; j < 4; ++j) { const f32x4 g = ((const f32x4*)gain)[lane + 64 * j], a = ((const f32x4*)sc)[lane + 64 * j], b = ((const f32x4*)sh)[lane + 64 * j];
        const f32x4 y = v[j] * rstd * g * (a + 1.f) + b;
        o8[64 * j] = (unsigned long long)pk2(y.x, y.y) | ((unsigned long long)pk2(y.z, y.w) << 32); }
}
__device__ __forceinline__ void norm_row_f32_inplace(int lane, float* xrow, const float* gain) {
    f32x4* xr = (f32x4*)xrow + lane; f32x4 v[4]; float s = 0.f;
#pragma unroll
    for (int j = 0; j < 4; ++j) { v[j] = xr[64 * j]; s += (v[j].x * v[j].x + v[j].y * v[j].y) + (v[j].z * v[j].z + v[j].w * v[j].w); }
    const float rstd = rsqrtf(wave_sum(s) * (1.f / D) + NORM_EPS);
#pragma unroll
    for (int j = 0; j < 4; ++j) { const f32x4 g = ((const f32x4*)gain)[lane + 64 * j]; xr[64 * j] = v[j] * rstd * g; }
}
__device__ __forceinline__ int bidx_of_row(int m) { return m < MP ? (m >> 13) : 2 + ((m - MP) >> 3); }

struct Args { const float* in[21]; const int* page_table; float* out; unsigned char* ws; };
static_assert(sizeof(Args) == 24 * 8, "Args has no padding");

__global__ void __launch_bounds__(NWAVES * 64, 2) mk_fwd(Args args) {
    extern __shared__ __attribute__((aligned(16))) unsigned char lds[];
    LAS unsigned char* L = (LAS unsigned char*)lds;
    volatile LAS unsigned* MISC = (volatile LAS unsigned*)(L + MISC_OFF);
    const int tid = threadIdx.x, lane = tid & 63, wave = __builtin_amdgcn_readfirstlane(tid >> 6);
    const int G = gridDim.x; const int bx = blockIdx.x; const int vcu = (G % 8 == 0) ? (bx % 8) * (G / 8) + bx / 8 : bx;
    unsigned char* ws = args.ws;
    unsigned* ctl = (unsigned*)(ws + WS_CTL);
    const float *x_prompt = args.in[0], *x_sample = args.in[1], *c_prompt = args.in[2], *c_sample = args.in[3], *cache_k = args.in[4], *cache_v = args.in[5], *state_gla = args.in[6];
    const float *w_ada = args.in[8], *b_ada = args.in[9], *g_mix = args.in[10], *w_in = args.in[11], *b_sb = args.in[12], *w_gate = args.in[13], *b_gate = args.in[14], *g_gla_out = args.in[15];
    const float *w_out = args.in[16], *g_ffn = args.in[17], *w_up = args.in[18], *w_down = args.in[19], *g_final = args.in[20];
    float* out = args.out;
    float* MOD = (float*)(ws + WS_MOD);
    bf16 *Win_t = (bf16*)(ws + WS_WIN), *Wo_t = (bf16*)(ws + WS_WO), *Wup_t = (bf16*)(ws + WS_WUP), *Wdn_t = (bf16*)(ws + WS_WDN);
    bf16 *XN = (bf16*)(ws + WS_XN), *QB = (bf16*)(ws + WS_Q), *KB = (bf16*)(ws + WS_K), *VB = (bf16*)(ws + WS_V), *GB = (bf16*)(ws + WS_G), *MIX = (bf16*)(ws + WS_MIX), *HB = (bf16*)(ws + WS_H);
    float* X1 = (float*)(ws + WS_X1);
    float *SLOC = (float*)(ws + WS_SLOC), *DSEG = (float*)(ws + WS_DSEG), *DPART = (float*)(ws + WS_DPART), *DRTOT = (float*)(ws + WS_DRTOT);
    for (int u = tid; u < (LDS_BYTES - MISC_OFF) / 4; u += NWAVES * 64) ((LAS unsigned*)(L + MISC_OFF))[u] = 0u;
    __syncthreads();
    XcdBarrier bar = xcd_barrier_post(ctl + CW_BAR, MISC + 8);
    const int gw = vcu * NWAVES + wave, NGW = G * NWAVES;

    if (vcu < 96) {
        LAS float* s = (LAS float*)L;
        for (int i = tid; i < NMODR * D; i += NWAVES * 64) { const int r = i >> 10, k = i & 1023; const float c = r < 2 ? c_prompt[r * D + k] : c_sample[(r - 2) * D + k]; s[k * NMODR + r] = c / (1.f + __expf(-c)); }
        __syncthreads();
        const int col = 64 * vcu + lane, k0 = 128 * wave;
        float acc[NMODR];
#pragma unroll
        for (int r = 0; r < NMODR; ++r) acc[r] = 0.f;
#pragma unroll 4
        for (int kk = 0; kk < 128; ++kk) { const int k = k0 + kk; const float w = w_ada[(size_t)k * MODW + col];
#pragma unroll
            for (int r = 0; r < NMODR; ++r) acc[r] += s[k * NMODR + r] * w; }
        __syncthreads();
        LAS float* red = (LAS float*)L;
#pragma unroll
        for (int r = 0; r < NMODR; ++r) red[(wave * NMODR + r) * 64 + lane] = acc[r];
        __syncthreads();
        for (int o = tid; o < NMODR * 64; o += NWAVES * 64) { const int r = o >> 6, l = o & 63; float t = b_ada[64 * vcu + l];
#pragma unroll
            for (int w8 = 0; w8 < 8; ++w8) t += red[(w8 * NMODR + r) * 64 + l];
            MOD[r * MODW + 64 * vcu + l] = t; }
        __syncthreads();
    }
    {
        LAS float* scr = (LAS float*)(L + wave * 16384);
        constexpr int I_IN = (D / 64) * (NIN / 32), I_O = (D / 64) * (D / 32), I_UP = (D / 64) * (FF / 32), I_DN = (FF / 64) * (D / 32);
        constexpr int NITEMS = I_IN + I_O + I_UP + I_DN;
        for (int it = gw; it < NITEMS; it += NGW) {
            int r = it;
            if (r < I_IN) { p0_transpose_item(w_in, D, NIN_REAL, NIN, Win_t, scr, r, lane); continue; } r -= I_IN;
            if (r < I_O) { p0_transpose_item(w_out, D, D, D, Wo_t, scr, r, lane); continue; } r -= I_O;
            if (r < I_UP) { p0_transpose_item(w_up, D, FF, FF, Wup_t, scr, r, lane); continue; } r -= I_UP;
            p0_transpose_item(w_down, FF, D, D, Wdn_t, scr, r, lane);
        }
    }
    xcd_barrier(bar);
    for (int m = gw; m < M; m += NGW) { const float* xr = m < MP ? x_prompt + (size_t)m * D : x_sample + (size_t)(m - MP) * D; const float* md = MOD + (size_t)bidx_of_row(m) * MODW;
        norm_mod_row_bf16(lane, xr, g_mix, md + 1024, md, XN + (size_t)m * D); }
    xcd_barrier(bar);
    {
        pg8::Gemm g{XN, Win_t, M, NIN, D}; pg8::StaticOrder S; S.init(M, NIN, G, bx);
        pg8::EpiInProj E{QB, KB, VB, GB, out + OK_P, out + OV_P, out + OK_S - (size_t)MP * 512, out + OV_S - (size_t)MP * 512, QSCALE};
        pg8::gemm_phase<pg8::EpiInProj, pg8::StaticOrder, true, true>(L, g, S, E);
    }
    xcd_barrier(bar);
#if defined(PROBE_GLA2) || defined(PROBE_GLA1)
    for (int rep_ = 0; rep_ < 2; ++rep_)
#endif
    for (int u = vcu; u < 256; u += G) gla::pass1_unit(u, (const gla::bf16*)GB, w_gate, b_gate, g_gla_out, SLOC, DSEG, (LAS char*)L);
    xcd_barrier(bar);
#ifdef PROBE_SB2
    for (int rep_ = 0; rep_ < 2; ++rep_)
#endif
    for (int v = vcu; v < 256; v += G) {
        const int bh = v >> 4, s = v & 15, b = bh >> 3, h = bh & 7; const float bias2 = b_sb[h] * 1.4426950408889634f;
        sba::attn_unit(b, h, 31 - s, (const sba::bf16*)QB, (const sba::bf16*)KB, (const sba::bf16*)VB, (sba::bf16*)MIX, (char*)lds, bias2);
        sba::attn_unit(b, h, s, (const sba::bf16*)QB, (const sba::bf16*)KB, (const sba::bf16*)VB, (sba::bf16*)MIX, (char*)lds, bias2);
    }
#ifdef PROBE_GLA2
    for (int rep_ = 0; rep_ < 2; ++rep_)
#endif
    for (int u = vcu; u < 256; u += G) gla::pass3_unit(u, (const gla::bf16*)GB, (gla::bf16*)MIX, w_gate, b_gate, g_gla_out, SLOC, DSEG, out + OSG_P, (LAS char*)L);
#ifdef PROBE_DEC2
    for (int rep_ = 0; rep_ < 2; ++rep_)
#endif
    for (int u = vcu; u < 256; u += G) sbd::decode_unit(u >> 3, u & 7, cache_k, cache_v, args.page_table, (const sba::bf16*)QB, (const sba::bf16*)KB, (const sba::bf16*)VB, b_sb, DPART, DRTOT, ctl + CW_DEC, (sba::bf16*)MIX, MISC + 16);
#ifdef PROBE_GLAS2
    for (int rep_ = 0; rep_ < 2; ++rep_)
#endif
    for (int u = vcu; u < 128; u += G) gla::sample_unit(u, (const gla::bf16*)GB, (gla::bf16*)MIX, w_gate, b_gate, g_gla_out, state_gla, out + OSG_S, (LAS char*)L);
    xcd_barrier(bar);
    {
        pg8::Gemm g{MIX, Wo_t, MP, D, D}; pg8::StaticOrder S; S.init(MP, D, G, bx);
        pg8::EpiResGate E{x_prompt, x_sample - (size_t)MP * D, X1, MOD + 2048};
        pg8::gemm_phase<pg8::EpiResGate, pg8::StaticOrder, true, true>(L, g, S, E);
        thin::EpiResGateS Es{x_sample, X1 + (size_t)MP * D, MOD + 2048, D};
        for (int t0 = vcu; t0 < 256; t0 += G) thin::run<8>(MIX + (size_t)MP * D, D, Wo_t, D, D, 32, t0, 256, (LAS float*)L, Es);
    }
    xcd_barrier(bar);
    for (int m = gw; m < M; m += NGW) { const float* md = MOD + (size_t)bidx_of_row(m) * MODW; norm_mod_row_bf16(lane, X1 + (size_t)m * D, g_ffn, md + 4096, md + 3072, XN + (size_t)m * D); }
    xcd_barrier(bar);
    {
        pg8::Gemm g{XN, Wup_t, MP, FF, D}; pg8::StaticOrder S; S.init(MP, FF, G, bx);
        pg8::EpiRelu2 E{HB, FF};
        pg8::gemm_phase<pg8::EpiRelu2, pg8::StaticOrder, true, true>(L, g, S, E);
        thin::EpiRelu2S Es{HB + (size_t)MP * FF, FF};
        for (int t0 = 4 * vcu; t0 < 1024; t0 += 4 * G) thin::run<2>(XN + (size_t)MP * D, D, Wup_t, D, D, 128, t0, 1024, (LAS float*)L, Es);
    }
    xcd_barrier(bar);
    {
        pg8::Gemm g{HB, Wdn_t, MP, D, FF}; pg8::StaticOrder S; S.init(MP, D, G, bx);
        pg8::EpiResGate E{X1, X1, out + OY, MOD + 5120};
        pg8::gemm_phase<pg8::EpiResGate, pg8::StaticOrder, true, true>(L, g, S, E);
        thin::EpiResGateS Es{X1 + (size_t)MP * D, out + OY + (size_t)MP * D, MOD + 5120, D};
        for (int t0 = vcu; t0 < 256; t0 += G) thin::run<8>(HB + (size_t)MP * FF, FF, Wdn_t, FF, FF, 32, t0, 256, (LAS float*)L, Es);
    }
    xcd_barrier(bar);
    for (int m = gw; m < M; m += NGW) norm_row_f32_inplace(lane, out + OY + (size_t)m * D, g_final);
}

extern "C" void kernel_launch(void* const* d_in, const int* in_sizes, int n_in, void* d_out, int out_size, void* d_ws, size_t ws_size, hipStream_t stream) {
    static int grid = 0;
    if (grid == 0) {
        if (n_in != 21 || (size_t)out_size != OUT_TOTAL || ws_size < WS_END) { fprintf(stderr, "kernel_launch: unexpected sizes: n_in %d out %d ws %zu\n", n_in, out_size, ws_size); grid = -1; return; }
        int dev = 0, cus = 0, per_cu = 0;
        if (hipGetDevice(&dev) != hipSuccess || hipDeviceGetAttribute(&cus, hipDeviceAttributeMultiprocessorCount, dev) != hipSuccess) { grid = -1; return; }
        if (hipFuncSetAttribute((const void*)mk_fwd, hipFuncAttributeMaxDynamicSharedMemorySize, LDS_BYTES) != hipSuccess) { fprintf(stderr, "kernel_launch: hipFuncSetAttribute failed\n"); grid = -1; return; }
        if (hipOccupancyMaxActiveBlocksPerMultiprocessor(&per_cu, (const void*)mk_fwd, NWAVES * 64, LDS_BYTES) != hipSuccess || per_cu < 1) { fprintf(stderr, "kernel_launch: occupancy query says %d\n", per_cu); }
        (void)hipGetLastError();
        grid = cus;
    }
    if (grid < 0) return;
    if (hipMemsetAsync((char*)d_ws + WS_CTL, 0, CTL_ZERO_BYTES, stream) != hipSuccess) return;
    Args a{};
    for (int i = 0; i < 21; ++i) a.in[i] = (const float*)d_in[i];
    a.page_table = (const int*)d_in[7]; a.out = (float*)d_out; a.ws = (unsigned char*)d_ws;
    hipLaunchKernelGGL(mk_fwd, dim3(grid), dim3(NWAVES * 64), LDS_BYTES, stream, a);
    const hipError_t le = hipPeekAtLastError();
    if (le != hipSuccess) fprintf(stderr, "kernel_launch: launch failed: %s\n", hipGetErrorName(le));
}
```

```cpp
#include <hip/hip_runtime.h>
#include <hip/hip_bf16.h>
#include <cstdio>
#include <cstdint>
namespace pg8 {
#define PG8_LAS __attribute__((address_space(3)))
typedef unsigned short bf16_t;
typedef short bf16x8 __attribute__((ext_vector_type(8)));
typedef float f32x4 __attribute__((ext_vector_type(4)));
typedef unsigned u32x4 __attribute__((ext_vector_type(4)));
constexpr int BM = 256, BK = 64, HALF = 128, HTB = HALF * BK * 2  , STAGE_BYTES = 8 * HTB, NXCD = 8, WGM = 8;

__host__ __device__ __forceinline__ int lds_byte(int r, int c) { const int st = (r >> 4) * 2 + (c >> 5), rr = r & 15, cc = c & 31, ob = rr * 64 + cc * 2; return st * 1024 + (ob ^ (((ob >> 9) & 1) << 5)); }
__host__ __device__ __forceinline__ void stage_rc(int b, int& R, int& C) { const int st = b / 1024, sb = b % 1024, swz = sb ^ (((sb >> 9) & 1) << 5); R = (st >> 1) * 16 + swz / 64; C = (st & 1) * 32 + (swz % 64) / 2; }
__host__ __device__ __forceinline__ int perm32(int rho) { const int n = rho >> 4, i = rho & 15; return 8 * (i >> 2) + 4 * n + (i & 3); }

struct Unit { int pm, pn; };
struct Gemm { const bf16_t* A; const bf16_t* Bt; int M, N, K; };

struct StaticOrder {
    int nM, nN, nwg, G, c;
    __host__ __device__ void init(int M, int N, int G_, int c_) { nM = M / BM; nN = N / BM; nwg = nM * nN; G = G_; c = c_; }
    __host__ __device__ bool next(int i, Unit& u) const {
        const long L = (long)i * G + c; if (L >= nwg) return false;
        int wgid = (int)L; { const int q = nwg / NXCD, r = nwg % NXCD, xcd = wgid % NXCD, off = wgid / NXCD; wgid = (xcd < r ? xcd * (q + 1) : r * (q + 1) + (xcd - r) * q) + off; }
        const int nig = WGM * nN, gid = wgid / nig, fm = gid * WGM, gsz = (nM - fm) < WGM ? (nM - fm) : WGM;
        u.pm = fm + ((wgid % nig) % gsz); u.pn = (wgid % nig) / gsz; return true;
    }
    __device__ __forceinline__ void a_ready(const Unit&) const {}
    __device__ __forceinline__ void done(const Unit&) const {}
};

__device__ __forceinline__ unsigned cvt_pk_bf16(float lo, float hi) { unsigned r; asm volatile("v_cvt_pk_bf16_f32 %0, %1, %2" : "=v"(r) : "v"(lo), "v"(hi)); return r; }

struct EpiInProj {
    static constexpr bool PERM = true, AFTER_DRAIN = false;
    bf16_t *Q, *K, *V, *G; float *kP, *vP, *kS, *vS; float qscale;
    __device__ __forceinline__ void operator()(const f32x4 (&acc)[2][2][4][2], const Unit& u, int wr, int wc, int fr, int fq) const {
        const int pn = u.pn, pm = u.pm;
        bf16_t* dst; int ldc, colbase; float sc = 1.f; float* fo = nullptr;
        if (pn < 2)      { dst = Q; ldc = 512; colbase = pn * 256; sc = qscale; }
        else if (pn < 4) { dst = K; ldc = 512; colbase = (pn - 2) * 256; fo = pm < 64 ? kP : kS; }
        else if (pn < 6) { dst = V; ldc = 512; colbase = (pn - 4) * 256; fo = pm < 64 ? vP : vS; }
        else             { dst = G; ldc = 1792; colbase = (pn - 6) * 256; }
        const int row0 = pm * BM + wr * 64 + fr, cl = colbase + wc * 32 + 8 * fq;
#pragma unroll
        for (int ai = 0; ai < 2; ++ai)
#pragma unroll
            for (int m = 0; m < 4; ++m) { const size_t row = (size_t)(row0 + ai * HALF + m * 16);
#pragma unroll
                for (int bj = 0; bj < 2; ++bj) { const f32x4 a0 = acc[ai][bj][m][0], a1 = acc[ai][bj][m][1]; const int col = cl + bj * HALF;
                    const f32x4 v0 = a0 * sc, v1 = a1 * sc; u32x4 w; w.x = cvt_pk_bf16(v0[0], v0[1]); w.y = cvt_pk_bf16(v0[2], v0[3]); w.z = cvt_pk_bf16(v1[0], v1[1]); w.w = cvt_pk_bf16(v1[2], v1[3]);
                    *(u32x4*)(dst + row * ldc + col) = w;
                    if (fo) { *(f32x4*)(fo + row * 512 + col) = a0; *(f32x4*)(fo + row * 512 + col + 4) = a1; } } }
    }
};
struct EpiRelu2 {
    static constexpr bool PERM = true, AFTER_DRAIN = false;
    bf16_t* O; int ldc;
    __device__ __forceinline__ void operator()(const f32x4 (&acc)[2][2][4][2], const Unit& u, int wr, int wc, int fr, int fq) const {
        const int row0 = u.pm * BM + wr * 64 + fr, col0 = u.pn * BM + wc * 32 + 8 * fq;
#pragma unroll
        for (int ai = 0; ai < 2; ++ai)
#pragma unroll
            for (int m = 0; m < 4; ++m) { bf16_t* rowp = O + (size_t)(row0 + ai * HALF + m * 16) * ldc + col0;
#pragma unroll
                for (int bj = 0; bj < 2; ++bj) { f32x4 v0 = acc[ai][bj][m][0], v1 = acc[ai][bj][m][1];
#pragma unroll
                    for (int e = 0; e < 4; ++e) { const float a = fmaxf(v0[e], 0.f), b = fmaxf(v1[e], 0.f); v0[e] = a * a; v1[e] = b * b; }
                    u32x4 w; w.x = cvt_pk_bf16(v0[0], v0[1]); w.y = cvt_pk_bf16(v0[2], v0[3]); w.z = cvt_pk_bf16(v1[0], v1[1]); w.w = cvt_pk_bf16(v1[2], v1[3]);
                    *(u32x4*)(rowp + bj * HALF) = w; } }
    }
};
struct EpiResGate {
    static constexpr bool PERM = false, AFTER_DRAIN = false;
    const float* baseP; const float* baseS; float* out; const float* gate;
    __device__ __forceinline__ void operator()(const f32x4 (&acc)[2][2][4][2], const Unit& u, int wr, int wc, int fr, int fq) const {
        const int col0 = u.pn * BM + wc * 32 + 4 * fq;
#pragma unroll
        for (int ai = 0; ai < 2; ++ai)
#pragma unroll
            for (int m = 0; m < 4; ++m) { const int row = u.pm * BM + ai * HALF + wr * 64 + m * 16 + fr; const int bidx = row < 16384 ? (row >> 13) : 2 + ((row - 16384) >> 3);
                const float* b = (row < 16384 ? baseP : baseS) + (size_t)row * 1024 + col0; const float* g = gate + (size_t)bidx * 6144 + col0; float* o = out + (size_t)row * 1024 + col0;
#pragma unroll
                for (int bj = 0; bj < 2; ++bj)
#pragma unroll
                    for (int n = 0; n < 2; ++n) { const int c = bj * HALF + n * 16; const f32x4 bs = *(const f32x4*)(b + c), gv = *(const f32x4*)(g + c); *(f32x4*)(o + c) = bs + gv * acc[ai][bj][m][n]; } }
    }
};
template <class Epi, class Sched, bool ALIGN_EPI = false, bool SP2 = false>
__device__ __forceinline__ void gemm_phase(PG8_LAS unsigned char* lds, const Gemm g, const Sched& S, const Epi& E) {
    int tid_ = threadIdx.x; asm volatile("" : "+v"(tid_)); const int tid = tid_, wid = __builtin_amdgcn_readfirstlane(tid >> 6), lane = tid & 63, wr = wid >> 2, wc = wid & 3, fr = lane & 15, fq = lane >> 4;
    const int K = g.K, nt = K / BK;
    unsigned voffA[2], voffB[2];
#pragma unroll
    for (int i = 0; i < 2; ++i) { int R, C; stage_rc(tid * 16 + i * 8192, R, C); const int Rb = Epi::PERM ? ((R & ~31) + perm32(R & 31)) : R;
        voffA[i] = (unsigned)(R * K + C) * 2u; voffB[i] = (unsigned)(Rb * K + C) * 2u; }
    const size_t kstep = (size_t)(BK * 2);
    const size_t hstep = (size_t)HALF * K * 2;
    const size_t tstep = 2 * hstep;
    const unsigned ldsw = (unsigned)wid * 1024u;
    const int aoff = lds_byte(wr * 64 + fr, fq * 8), boff = lds_byte(wc * 32 + fr, fq * 8);
#define PG8_SA(b, h) (((b) * 2 + (h)) * HTB)
#define PG8_SB(b, h) ((4 + (b) * 2 + (h)) * HTB)
#define PG8_STAGE(bufoff, gbase, voff) do { _Pragma("unroll") for (int _i = 0; _i < 2; ++_i) \
        __builtin_amdgcn_global_load_lds((const unsigned*)((const char*)(gbase) + (voff)[_i]), (PG8_LAS unsigned*)(lds + (bufoff) + ldsw + _i * 8192), 16, 0, 0); } while (0)
#define PG8_LDA(dst, b, h) do { _Pragma("unroll") for (int m = 0; m < 4; ++m) _Pragma("unroll") for (int k = 0; k < 2; ++k) dst[m][k] = *(const PG8_LAS bf16x8*)(lds + PG8_SA(b, h) + aoff + m * 2048 + k * 1024); } while (0)
#define PG8_LDB(dst, b, h) do { _Pragma("unroll") for (int n = 0; n < 2; ++n) _Pragma("unroll") for (int k = 0; k < 2; ++k) dst[n][k] = *(const PG8_LAS bf16x8*)(lds + PG8_SB(b, h) + boff + n * 2048 + k * 1024); } while (0)
#define PG8_MMA(ai, bj, At, Bt) do { __builtin_amdgcn_s_setprio(1); _Pragma("unroll") for (int m = 0; m < 4; ++m) _Pragma("unroll") for (int n = 0; n < 2; ++n) _Pragma("unroll") for (int k = 0; k < 2; ++k) \
        acc[ai][bj][m][n] = __builtin_amdgcn_mfma_f32_16x16x32_bf16(Bt[n][k], At[m][k], acc[ai][bj][m][n], 0, 0, 0); __builtin_amdgcn_s_setprio(0); } while (0)
#define PG8_WAIT_V(n) asm volatile("s_waitcnt vmcnt(" #n ")" ::: "memory")
#define PG8_WAIT_L(n) asm volatile("s_waitcnt lgkmcnt(" #n ")" ::: "memory")
#define PG8_BAR __builtin_amdgcn_s_barrier()
#define PG8_SCHED __builtin_amdgcn_sched_barrier(0)
    Unit cur, nxt; int ui = 0;
    if (!S.next(0, cur)) return;
    f32x4 acc[2][2][4][2];
#pragma unroll
    for (int a = 0; a < 2; ++a)
#pragma unroll
        for (int b = 0; b < 2; ++b)
#pragma unroll
            for (int m = 0; m < 4; ++m)
#pragma unroll
                for (int n = 0; n < 2; ++n) acc[a][b][m][n] = (f32x4){0.f, 0.f, 0.f, 0.f};
    bf16x8 At[4][2], B0[2][2], B1[2][2];
    const char* cA = (const char*)g.A + (size_t)cur.pm * tstep; const char* cB = (const char*)g.Bt + (size_t)cur.pn * tstep;
    S.a_ready(cur);
    if constexpr (SP2) {
        PG8_STAGE(PG8_SB(0, 0), cB, voffB); PG8_STAGE(PG8_SB(0, 1), cB + hstep, voffB); PG8_STAGE(PG8_SA(0, 0), cA, voffA); PG8_STAGE(PG8_SA(0, 1), cA + hstep, voffA);
        if (wr == 1) PG8_BAR;
        PG8_WAIT_V(2); PG8_BAR;
        PG8_STAGE(PG8_SB(1, 0), cB + kstep, voffB); PG8_STAGE(PG8_SA(1, 0), cA + kstep, voffA); PG8_STAGE(PG8_SB(1, 1), cB + hstep + kstep, voffB);
        PG8_WAIT_V(6); PG8_BAR;
    } else {
        PG8_STAGE(PG8_SB(0, 0), cB, voffB); PG8_STAGE(PG8_SA(0, 0), cA, voffA); PG8_STAGE(PG8_SB(0, 1), cB + hstep, voffB); PG8_STAGE(PG8_SA(0, 1), cA + hstep, voffA);
        if (wr == 1) PG8_BAR;
        PG8_WAIT_V(4); PG8_BAR;
        PG8_STAGE(PG8_SB(1, 0), cB + kstep, voffB); PG8_STAGE(PG8_SA(1, 0), cA + kstep, voffA); PG8_STAGE(PG8_SB(1, 1), cB + hstep + kstep, voffB);
        PG8_WAIT_V(6); PG8_BAR;
    }
    for (;;) {
        const bool has_next = S.next(ui + 1, nxt);
        const char* nA = has_next ? (const char*)g.A + (size_t)nxt.pm * tstep : cA; const char* nB = has_next ? (const char*)g.Bt + (size_t)nxt.pn * tstep : cB;
        for (int t = 0; t < nt; t += 2) {
            const bool last = (t == nt - 2);
            const char* a1 = cA + (size_t)(t + 1) * kstep;
            const char* a2 = last ? nA : cA + (size_t)(t + 2) * kstep; const char* b2 = last ? nB : cB + (size_t)(t + 2) * kstep;
            const char* a3 = a2 + kstep; const char* b3 = b2 + kstep;
            if (last && has_next) S.a_ready(nxt);
            if constexpr (SP2) {
            PG8_LDB(B0, 0, 0); PG8_LDB(B1, 0, 1); PG8_SCHED; PG8_LDA(At, 0, 0); PG8_STAGE(PG8_SA(1, 1), a1 + hstep, voffA);
            PG8_WAIT_V(8); PG8_WAIT_L(0); PG8_BAR; PG8_MMA(0, 0, At, B0); PG8_MMA(0, 1, At, B1); PG8_BAR; PG8_SCHED;
            PG8_LDA(At, 0, 1); PG8_STAGE(PG8_SB(0, 0), b2, voffB); PG8_STAGE(PG8_SB(0, 1), b2 + hstep, voffB); PG8_STAGE(PG8_SA(0, 0), a2, voffA);
            PG8_WAIT_V(8); PG8_WAIT_L(0); PG8_BAR; PG8_MMA(1, 0, At, B0); PG8_MMA(1, 1, At, B1); PG8_BAR; PG8_SCHED;
            PG8_LDB(B0, 1, 0); PG8_LDB(B1, 1, 1); PG8_SCHED; PG8_LDA(At, 1, 0); PG8_STAGE(PG8_SA(0, 1), a2 + hstep, voffA);
            PG8_WAIT_V(8); PG8_WAIT_L(0); PG8_BAR; PG8_MMA(0, 0, At, B0); PG8_MMA(0, 1, At, B1); PG8_BAR; PG8_SCHED;
            PG8_LDA(At, 1, 1); PG8_STAGE(PG8_SB(1, 0), b3, voffB); PG8_STAGE(PG8_SB(1, 1), b3 + hstep, voffB); PG8_STAGE(PG8_SA(1, 0), a3, voffA);
            PG8_WAIT_V(8); PG8_WAIT_L(0); PG8_BAR; PG8_MMA(1, 0, At, B0); PG8_MMA(1, 1, At, B1); PG8_BAR; PG8_SCHED;
            } else {
            PG8_LDB(B0, 0, 0); PG8_SCHED; PG8_LDA(At, 0, 0); PG8_STAGE(PG8_SA(1, 1), a1 + hstep, voffA);
            PG8_WAIT_L(8); PG8_BAR; PG8_WAIT_L(0); PG8_MMA(0, 0, At, B0); PG8_BAR; PG8_SCHED;
            PG8_LDB(B1, 0, 1); PG8_STAGE(PG8_SB(0, 0), b2, voffB);
            PG8_BAR; PG8_WAIT_L(0); PG8_MMA(0, 1, At, B1); PG8_BAR;
            PG8_LDA(At, 0, 1); PG8_STAGE(PG8_SA(0, 0), a2, voffA);
            PG8_BAR; PG8_WAIT_L(0); PG8_MMA(1, 0, At, B0); PG8_BAR; PG8_SCHED;
            PG8_STAGE(PG8_SB(0, 1), b2 + hstep, voffB);
            PG8_WAIT_V(6); PG8_BAR; PG8_MMA(1, 1, At, B1); PG8_BAR;
            PG8_LDB(B0, 1, 0); PG8_SCHED; PG8_LDA(At, 1, 0); PG8_STAGE(PG8_SA(0, 1), a2 + hstep, voffA);
            PG8_WAIT_L(8); PG8_BAR; PG8_WAIT_L(0); PG8_MMA(0, 0, At, B0); PG8_BAR; PG8_SCHED;
            PG8_LDB(B1, 1, 1); PG8_STAGE(PG8_SB(1, 0), b3, voffB);
            PG8_BAR; PG8_WAIT_L(0); PG8_MMA(0, 1, At, B1); PG8_BAR;
            PG8_LDA(At, 1, 1); PG8_STAGE(PG8_SA(1, 0), a3, voffA);
            PG8_BAR; PG8_WAIT_L(0); PG8_MMA(1, 0, At, B0); PG8_BAR; PG8_SCHED;
            PG8_STAGE(PG8_SB(1, 1), b3 + hstep, voffB);
            PG8_WAIT_V(6); PG8_BAR; PG8_MMA(1, 1, At, B1); PG8_BAR;
            }
        }
        if constexpr (ALIGN_EPI) { if (wr == 0) PG8_BAR; }
        if constexpr (!Epi::AFTER_DRAIN) { E(acc, cur, wr, wc, fr, fq); S.done(cur); }
        if (!has_next) break;
#pragma unroll
        for (int a = 0; a < 2; ++a)
#pragma unroll
            for (int b = 0; b < 2; ++b)
#pragma unroll
                for (int m = 0; m < 4; ++m)
#pragma unroll
                    for (int n = 0; n < 2; ++n) acc[a][b][m][n] = (f32x4){0.f, 0.f, 0.f, 0.f};
        cur = nxt; cA = nA; cB = nB; ++ui;
        if constexpr (ALIGN_EPI) { if (wr == 1) PG8_BAR; }
    }
    PG8_WAIT_V(0);
    if constexpr (!ALIGN_EPI) { if (wr == 0) PG8_BAR; }
    PG8_BAR;
    if constexpr (Epi::AFTER_DRAIN) { E.fused(acc, cur, wr, wc, fr, fq, lds, wid, lane); S.done(cur); }
#undef PG8_SA
#undef PG8_SB
#undef PG8_STAGE
#undef PG8_LDA
#undef PG8_LDB
#undef PG8_MMA
#undef PG8_WAIT_V
#undef PG8_WAIT_L
#undef PG8_BAR
#undef PG8_SCHED
}
}
constexpr int NWAVES = 8;
constexpr int D = 1024, TP = 8192, MP = 16384, MS = 256, M = MP + MS, FF = 4096, NIN = 3328, NIN_REAL = 3088, NMODR = 34, MODW = 6144;
constexpr float NORM_EPS = 1e-6f;
constexpr float QSCALE = 0.125f * 1.4426950408889634f;
constexpr size_t OY = 0, OK_P = 17039360, OV_P = 25427968, OSG_P = 33816576, OK_S = 33882112, OV_S = 34013184, OSG_S = 34144256, OUT_TOTAL = 35192832;
constexpr size_t MiB = 1u << 20;
constexpr size_t WS_CTL = 0, CTL_ZERO_BYTES = 1 * MiB;
constexpr size_t WS_MOD = 1 * MiB, WS_WIN = 2 * MiB, WS_WO = 9 * MiB, WS_WUP = 11 * MiB, WS_WDN = 19 * MiB;
constexpr size_t WS_SLOC = 27 * MiB, WS_DSEG = 35 * MiB, WS_DPART = 36 * MiB, WS_DRTOT = 40 * MiB;
constexpr size_t WS_XN = 48 * MiB, WS_Q = 82 * MiB, WS_K = 99 * MiB, WS_V = 116 * MiB, WS_G = 133 * MiB, WS_MIX = 190 * MiB, WS_X1 = 224 * MiB, WS_H = 290 * MiB, WS_END = 421 * MiB;
static_assert(WS_WIN + (size_t)NIN * D * 2 <= WS_WO && WS_G + (size_t)M * 1792 * 2 <= WS_MIX && WS_MIX + (size_t)M * D * 2 <= WS_X1 && WS_X1 + (size_t)M * D * 4 <= WS_H && WS_H + (size_t)M * FF * 2 <= WS_END, "d_ws map");
static_assert(WS_XN + (size_t)M * D * 2 <= WS_Q && WS_Q + (size_t)M * 512 * 2 <= WS_K && WS_K + (size_t)M * 512 * 2 <= WS_V && WS_V + (size_t)M * 512 * 2 <= WS_G, "d_ws map 2");
constexpr int CW_BAR = 4096, CW_DEC = 16384;
constexpr int RING_BYTES = 139264, MISC_OFF = 146944, LDS_BYTES = 147456;

#define GAS __attribute__((address_space(1)))
#define LAS __attribute__((address_space(3)))
typedef unsigned short bf16;
typedef unsigned v4u __attribute__((ext_vector_type(4)));
typedef float f32x4 __attribute__((ext_vector_type(4)));
#define LDS_WAIT() asm volatile("s_waitcnt lgkmcnt(0)" ::: "memory")
__device__ __forceinline__ unsigned f2bf(float f) { unsigned u = __builtin_bit_cast(unsigned, f); return (u + 0x7fffu + ((u >> 16) & 1u)) >> 16; }
__device__ __forceinline__ unsigned pk2(float lo, float hi) { return f2bf(lo) | (f2bf(hi) << 16); }
#define XB_TMO      128
#define XB_XCNT(j)  (256  + 64 * (j))
#define XB_XSUB(j)  (1280 + 64 * (j))
#define XB_XGEN(j)  (2304 + 64 * (j))
#define XB_TOP      3328
#define XB_TOPGEN   3392
#define XCD_BAR_WORDS 3456
#define XB_SPIN_CAP (1u << 18)

__device__ __forceinline__ unsigned xb_ld(unsigned* p)              { return __hip_atomic_load(p, __ATOMIC_RELAXED, __HIP_MEMORY_SCOPE_AGENT); }
__device__ __forceinline__ unsigned xb_add(unsigned* p, unsigned v) { return __hip_atomic_fetch_add(p, v, __ATOMIC_RELAXED, __HIP_MEMORY_SCOPE_AGENT); }
__device__ __forceinline__ unsigned xb_xcc_id() { return (unsigned)__builtin_amdgcn_s_getreg((3 << 11) | 20) & 0xFu; }
#define XB_SPIN(cond, bar) do { unsigned _sp = 0; while (cond) { __builtin_amdgcn_s_sleep(1); \
    if ((++_sp & 255u) == 0u) { if (xb_ld(&(bar)[XB_TMO])) break; if (_sp > XB_SPIN_CAP) { atomicAdd(&(bar)[XB_TMO], 1u); break; } } } } while (0)

struct XcdBarrier {
    unsigned* bar; unsigned x;
    volatile LAS unsigned* st;
};

__device__ __forceinline__ XcdBarrier xcd_barrier_post(unsigned* bar, volatile LAS unsigned* st) {
    XcdBarrier b; b.bar = bar; b.x = xb_xcc_id(); b.st = st;
    if (threadIdx.x == 0) (void)xb_add(&bar[XB_XCNT(b.x)], 1u);
    return b;
}
__device__ __forceinline__ void xcd_barrier_complete(unsigned* bar, unsigned x, unsigned& nloc, unsigned& nx) {
    const unsigned G = gridDim.x * gridDim.y * gridDim.z;
    unsigned sum, cnt, mine, sp = 0u;
    for (;;) {
        sum = 0u; cnt = 0u; mine = 0u;
#pragma unroll
        for (unsigned j = 0; j < 16; ++j) { const unsigned c = xb_ld(&bar[XB_XCNT(j)]); sum += c; cnt += (c > 0u) ? 1u : 0u; mine = (j == x) ? c : mine; }
        if (sum == G) break;
        __builtin_amdgcn_s_sleep(1);
        if ((++sp & 255u) == 0u) { if (xb_ld(&bar[XB_TMO])) break; if (sp > XB_SPIN_CAP) { atomicAdd(&bar[XB_TMO], 1u); break; } }
    }
    nloc = mine > 0u ? mine : 1u; nx = cnt > 0u ? cnt : 1u;
}

__device__ __forceinline__ void xcd_barrier(const XcdBarrier& b) {
    asm volatile("s_waitcnt vmcnt(0)" ::: "memory");
    __syncthreads();
    if (threadIdx.x == 0) {
        unsigned* bar = b.bar;
        __builtin_amdgcn_s_waitcnt(0);
        unsigned nloc = b.st[0], nx = b.st[1];
        if (nloc == 0u) { xcd_barrier_complete(bar, b.x, nloc, nx); b.st[0] = nloc; b.st[1] = nx; }
        const unsigned old = xb_add(&bar[XB_XSUB(b.x)], 1u);
        const unsigned gen = old / nloc;
        if (old + 1u == (gen + 1u) * nloc) {
            __builtin_amdgcn_fence(__ATOMIC_RELEASE, "agent");
            asm volatile("s_waitcnt vmcnt(0)" ::: "memory");
            const unsigned og = xb_add(&bar[XB_TOP], 1u);
            const unsigned tg = og / nx;
            if (og + 1u == (tg + 1u) * nx) xb_add(&bar[XB_TOPGEN], 1u);
            else XB_SPIN(xb_ld(&bar[XB_TOPGEN]) == tg, bar);
            __builtin_amdgcn_fence(__ATOMIC_ACQUIRE, "agent");
            xb_add(&bar[XB_XGEN(b.x)], 1u);
            asm volatile("s_waitcnt vmcnt(0)" ::: "memory");
        } else {
            XB_SPIN(xb_ld(&bar[XB_XGEN(b.x)]) == gen, bar);
            __builtin_amdgcn_fence(__ATOMIC_ACQUIRE, "agent");
            asm volatile("s_waitcnt vmcnt(0)" ::: "memory");
        }
    }
    __syncthreads();
}
namespace sba {
using bf16x8=__attribute__((ext_vector_type(8)))short;
using s16x4=__attribute__((ext_vector_type(4)))short;
using f32x16=__attribute__((ext_vector_type(16)))float;
using u32x4=__attribute__((ext_vector_type(4)))unsigned;
typedef __hip_bfloat16 bf16;
constexpr int SEQ=8192,D=64,DM=512,OP=1024;
constexpr int NW=8,QBLK=32,QB=QBLK*NW,KVBLK=64;
constexpr int NSLOT=3,SLOTB=8192;
constexpr int LDS_K=0,LDS_V=NSLOT*SLOTB,LDS_OST=2*NSLOT*SLOTB,LDS_BYTES=LDS_OST+NW*4096;
__device__ __forceinline__ int crow(int r,int hi){return (r&3)+8*(r>>2)+4*hi;}
__device__ __forceinline__ void glds16(const void*gsrc,unsigned lds_dst){unsigned keep;
  asm volatile("s_mov_b32 %0, m0\n\ts_mov_b32 m0, %2\n\ts_nop 0\n\tglobal_load_lds_dwordx4 %1, off\n\ts_mov_b32 m0, %0":"=&s"(keep):"v"(gsrc),"s"(lds_dst):"memory");}
typedef float f32x2_t __attribute__((ext_vector_type(2))); typedef __bf16 bf16x2_t __attribute__((ext_vector_type(2)));
__device__ __forceinline__ unsigned cvtpk_s(float lo,float hi){f32x2_t v={lo,hi};bf16x2_t b=__builtin_convertvector(v,bf16x2_t);return __builtin_bit_cast(unsigned,b);}
typedef __attribute__((address_space(3))) const char* lds_cptr;
typedef short v4i16_t __attribute__((ext_vector_type(4)));
__device__ __forceinline__ s16x4 vtr(lds_cptr p){ return __builtin_bit_cast(s16x4,__builtin_amdgcn_ds_read_tr16_b64_v4i16((__attribute__((address_space(3))) v4i16_t*)p)); }
#define SBA_MFMA(a,b,c) __builtin_amdgcn_mfma_f32_32x32x16_bf16((a),(b),(c),0,0,0)
template<bool MASK> __device__ __forceinline__ void sb_weights(f32x16&c0,f32x16&c1,float&carry,int hi,int jb,int qrel){
  #pragma unroll
  for(int r=0;r<16;++r){
    float e0=__builtin_amdgcn_exp2f(c0[r]), e1=__builtin_amdgcn_exp2f(c1[r]);
    if(MASK){ const int kv=64*jb+crow(r,hi); if(kv>=qrel)e0=0.f; if(kv+32>=qrel)e1=0.f; }
    c0[r]=1.f+e0; c1[r]=1.f+e1; }
  float P2[8],P3[8],T[8];
  #pragma unroll
  for(int c=0;c<4;++c){ P2[c]=c0[4*c]*c0[4*c+1]; P3[c]=P2[c]*c0[4*c+2]; T[c]=__builtin_amdgcn_rcpf(P3[c]*c0[4*c+3]);
                        P2[4+c]=c1[4*c]*c1[4*c+1]; P3[4+c]=P2[4+c]*c1[4*c+2]; T[4+c]=__builtin_amdgcn_rcpf(P3[4+c]*c1[4*c+3]); }
  float Tl[8],Th[8];
  #pragma unroll
  for(int c=0;c<8;++c){ auto rr=__builtin_amdgcn_permlane32_swap(__float_as_uint(T[c]),__float_as_uint(T[c]),false,false); Tl[c]=__uint_as_float(rr[0]); Th[c]=__uint_as_float(rr[1]); }
  float E=carry;
  float off[8];
  #pragma unroll
  for(int c=7;c>=0;--c){ off[c]=hi?E:E*Th[c]; E=E*(Tl[c]*Th[c]); }
  carry=E;
  #pragma unroll
  for(int c=0;c<4;++c){
    { const float g=T[c]*off[c], R1=c0[4*c]*g, R2=P2[c]*g, R3=P3[c]*g; c0[4*c]=R1-g; c0[4*c+1]=R2-R1; c0[4*c+2]=R3-R2; c0[4*c+3]=off[c]-R3; }
    { const float g=T[4+c]*off[4+c], R1=c1[4*c]*g, R2=P2[4+c]*g, R3=P3[4+c]*g; c1[4*c]=R1-g; c1[4*c+1]=R2-R1; c1[4*c+2]=R3-R2; c1[4*c+3]=off[4+c]-R3; } }
}
__device__ __forceinline__ void pv(f32x16*o,lds_cptr vp,const f32x16&w0,const f32x16&w1){
  u32x4 pw[4];
  #pragma unroll
  for(int k=0;k<2;++k)
    #pragma unroll
    for(int j=0;j<4;++j){ pw[k][j]=cvtpk_s(w0[8*k+2*j],w0[8*k+2*j+1]); pw[2+k][j]=cvtpk_s(w1[8*k+2*j],w1[8*k+2*j+1]); }
  #pragma unroll
  for(int d0=0;d0<2;++d0)
    #pragma unroll
    for(int ks=0;ks<4;++ks){ const s16x4 lo=vtr(vp+d0*4096+ks*1024), hh=vtr(vp+d0*4096+ks*1024+512);
      const bf16x8 vf={lo[0],lo[1],lo[2],lo[3],hh[0],hh[1],hh[2],hh[3]};
      o[d0]=SBA_MFMA(__builtin_bit_cast(bf16x8,pw[ks]),vf,o[d0]); }
}
__device__ __forceinline__ void attn_unit(int b,int h,int qb,const bf16*Q,const bf16*__restrict__ K,const bf16*__restrict__ V,bf16*O,char*shm,float bias2){
  int tid_=threadIdx.x; asm volatile("":"+v"(tid_)); const int tid=tid_,lane=tid&63,r32=lane&31,hi=lane>>5; const int wid=__builtin_amdgcn_readfirstlane(tid>>6);
  const long rowbase=(long)b*SEQ; const int q0=qb*QB;
  const bf16*Qw=Q+(rowbase+q0+wid*QBLK)*DM+h*D;
  const bf16*Kh=K+rowbase*DM+h*D,*Vh=V+rowbase*DM+h*D;
  const unsigned lds0=(unsigned)(uintptr_t)shm;
  const bf16*ksrc=Kh+(long)lane*DM+wid*8;
  const bf16*vsrc=Vh+(long)(16*(wid&3)+(lane>>2))*DM+(wid>>2)*32+(lane&3)*8;
  const unsigned kdst=lds0+LDS_K+wid*1024, vdst=lds0+LDS_V+wid*1024;
  const int NT=(q0+QB)/KVBLK;
  #define DMA_KV(s_,slot_) do{ const long t_=(long)(NT-1-(s_))*KVBLK*DM; glds16(ksrc+t_,(unsigned)__builtin_amdgcn_readfirstlane(kdst+(slot_)*SLOTB)); glds16(vsrc+t_,(unsigned)__builtin_amdgcn_readfirstlane(vdst+(slot_)*SLOTB)); }while(0)
  bf16x8 qr[4];
  #pragma unroll
  for(int d0=0;d0<4;++d0)qr[d0]=*reinterpret_cast<const bf16x8*>(&Qw[(long)r32*DM+d0*16+hi*8]);
  DMA_KV(0,0); DMA_KV(1,1);
  const lds_cptr shm3=(lds_cptr)shm; const lds_cptr kp0=shm3+LDS_K+hi*1024+r32*16; const lds_cptr vp0=shm3+LDS_V+((lane>>4)&1)*32+(lane&3)*8+(4*hi+((lane&15)>>2))*64;
  f32x16 o[2];o[0]=f32x16{};o[1]=f32x16{}; f32x16 bv;
  #pragma unroll
  for(int r=0;r<16;++r)bv[r]=bias2;
  asm volatile("":"+v"(bv));
  float carry=1.f; const int qrel=wid*QBLK+r32;
  int slot=0;
  for(int s=0;s<NT;++s){
    if(s+1<NT) asm volatile("s_waitcnt vmcnt(2) lgkmcnt(0)\n\ts_barrier":::"memory"); else asm volatile("s_waitcnt vmcnt(0) lgkmcnt(0)\n\ts_barrier":::"memory");
    if(s+2<NT){ const int ns=(slot==0)?2:slot-1; DMA_KV(s+2,ns); }
    const lds_cptr kp=kp0+slot*SLOTB;
    f32x16 c0=bv,c1=bv;
    #pragma unroll
    for(int d0=0;d0<4;++d0){
      const bf16x8 k0=*(const __attribute__((address_space(3))) bf16x8*)(kp+d0*2048), k1=*(const __attribute__((address_space(3))) bf16x8*)(kp+d0*2048+512);
      c0=SBA_MFMA(k0,qr[d0],c0); c1=SBA_MFMA(k1,qr[d0],c1); }
    if(s<4) sb_weights<true>(c0,c1,carry,hi,3-s,qrel); else sb_weights<false>(c0,c1,carry,hi,0,0);
    pv(o,vp0+slot*SLOTB,c0,c1);
    slot=(slot==2)?0:slot+1;
  }
  #undef DMA_KV
  bf16*Ow=O+(rowbase+q0+wid*QBLK)*OP+h*D;
  { bf16*stg=(bf16*)(shm+LDS_OST)+wid*2048;
    #pragma unroll
    for(int r=0;r<16;++r){const int orow=crow(r,hi);
      #pragma unroll
      for(int d0=0;d0<2;++d0)stg[orow*64+d0*32+r32]=__float2bfloat16(o[d0][r]);}
    asm volatile("s_waitcnt lgkmcnt(0)":::"memory");
    #pragma unroll
    for(int i=0;i<4;++i){const int row=i*8+(lane>>3),ch=lane&7; const u32x4 v=*(const u32x4*)(stg+row*64+ch*8); *(u32x4*)(Ow+(long)row*OP+ch*8)=v;} }
  asm volatile("s_waitcnt vmcnt(0) lgkmcnt(0)\n\ts_barrier":::"memory");
}
}
namespace sb8 {
typedef sba::bf16 bf16; using sba::bf16x8; using sba::s16x4; using sba::f32x16; using sba::u32x4; using sba::lds_cptr; using sba::glds16; using sba::vtr;
constexpr int SEQ=sba::SEQ,D=sba::D,DM=sba::DM,OP=sba::OP,QBLK=sba::QBLK,QB=sba::QB,KVBLK=sba::KVBLK,NSLOT=sba::NSLOT,SLOTB=sba::SLOTB;
constexpr int LDS_K=sba::LDS_K,LDS_V=sba::LDS_V,LDS_OST=sba::LDS_OST;
__device__ __forceinline__ unsigned cvtpk_a(float lo,float hi){ unsigned r; asm("v_cvt_pk_bf16_f32 %0, %1, %2":"=v"(r):"v"(lo),"v"(hi)); return r; }
template<bool MASK> __device__ __forceinline__ void weights(f32x16&c0,f32x16&c1,float&carry,int hi,int thr){
  #pragma unroll
  for(int r=0;r<16;++r){ float e0=__builtin_amdgcn_exp2f(c0[r]), e1=__builtin_amdgcn_exp2f(c1[r]);
    if(MASK){ if(r>=thr)e0=0.f; if(32+r>=thr)e1=0.f; }
    c0[r]=e0; c1[r]=e1; }
  float q0=1.f+c0[0], q1=1.f+c1[0];
  #pragma unroll
  for(int r=1;r<16;++r){ const float e0=c0[r], e1=c1[r]; c0[r]=q0*e0; c1[r]=q1*e1; q0=__builtin_fmaf(q0,e0,q0); q1=__builtin_fmaf(q1,e1,q1); }
  const float t0=__builtin_amdgcn_rcpf(q0), t1=__builtin_amdgcn_rcpf(q1);
  auto s1=__builtin_amdgcn_permlane32_swap(__float_as_uint(t1),__float_as_uint(t1),false,false);
  auto s0=__builtin_amdgcn_permlane32_swap(__float_as_uint(t0),__float_as_uint(t0),false,false);
  const float t1l=__uint_as_float(s1[0]),t1h=__uint_as_float(s1[1]),t0l=__uint_as_float(s0[0]),t0h=__uint_as_float(s0[1]);
  const float off1=hi?carry:carry*t1h; const float E=carry*(t1l*t1h);
  const float off0=hi?E:E*t0h; carry=E*(t0l*t0h);
  const float g1=t1*off1, g0=t0*off0;
  #pragma unroll
  for(int r=0;r<16;++r){ c0[r]*=g0; c1[r]*=g1; }
}
__device__ __forceinline__ void pv(f32x16*o,lds_cptr vp,const f32x16&w0,const f32x16&w1){
  u32x4 pw[4];
  #pragma unroll
  for(int k=0;k<2;++k)
    #pragma unroll
    for(int j=0;j<4;++j){ pw[k][j]=cvtpk_a(w0[8*k+2*j],w0[8*k+2*j+1]); pw[2+k][j]=cvtpk_a(w1[8*k+2*j],w1[8*k+2*j+1]); }
  #pragma unroll
  for(int d0=0;d0<2;++d0)
    #pragma unroll
    for(int ks=0;ks<4;++ks){ const s16x4 lo=vtr(vp+d0*4096+(ks>>1)*2048+(ks&1)*512), hh=vtr(vp+d0*4096+(ks>>1)*2048+(ks&1)*512+256);
      const bf16x8 vf={lo[0],lo[1],lo[2],lo[3],hh[0],hh[1],hh[2],hh[3]};
      o[d0]=SBA_MFMA(__builtin_bit_cast(bf16x8,pw[ks]),vf,o[d0]); }
}
__device__ __forceinline__ void qk(f32x16&c0,f32x16&c1,lds_cptr kp,const bf16x8*qr,const f32x16&bv){
  bf16x8 kf[8];
  #pragma unroll
  for(int d0=0;d0<4;++d0){ kf[2*d0]=*(const __attribute__((address_space(3))) bf16x8*)(kp+d0*2048); kf[2*d0+1]=*(const __attribute__((address_space(3))) bf16x8*)(kp+d0*2048+512); }
  c0=SBA_MFMA(kf[0],qr[0],bv); c1=SBA_MFMA(kf[1],qr[0],bv);
  #pragma unroll
  for(int d0=1;d0<4;++d0){ c0=SBA_MFMA(kf[2*d0],qr[d0],c0); c1=SBA_MFMA(kf[2*d0+1],qr[d0],c1); }
}
__device__ __forceinline__ void attn_unit(int b,int h,int qb,const bf16*Q,const bf16*__restrict__ K,const bf16*__restrict__ V,bf16*O,char*shm,float bias2){
  int tid_=threadIdx.x; asm volatile("":"+v"(tid_)); const int tid=tid_,lane=tid&63,r32=lane&31,hi=lane>>5; const int wid=__builtin_amdgcn_readfirstlane(tid>>6);
  const long rowbase=(long)b*SEQ; const int q0=qb*QB;
  const bf16*Qw=Q+(rowbase+q0+wid*QBLK)*DM+h*D;
  const bf16*Kh=K+rowbase*DM+h*D,*Vh=V+rowbase*DM+h*D;
  const unsigned lds0=(unsigned)(uintptr_t)shm;
  const bf16*ksrc=Kh+(long)lane*DM+wid*8;
  const bf16*vsrc=Vh+(long)(16*(wid&3)+(lane>>2))*DM+(wid>>2)*32+(lane&3)*8;
  const unsigned kdst=lds0+LDS_K+wid*1024, vdst=lds0+LDS_V+wid*1024;
  const int NT=(q0+QB)/KVBLK;
  #define DMA8_K(s_,slot_) do{ const long t_=(long)(NT-1-(s_))*KVBLK*DM; glds16(ksrc+t_,(unsigned)__builtin_amdgcn_readfirstlane(kdst+(slot_)*SLOTB)); }while(0)
  #define DMA8_V(s_,slot_) do{ const long t_=(long)(NT-1-(s_))*KVBLK*DM; glds16(vsrc+t_,(unsigned)__builtin_amdgcn_readfirstlane(vdst+(slot_)*SLOTB)); }while(0)
  bf16x8 qr[4];
  #pragma unroll
  for(int d0=0;d0<4;++d0)qr[d0]=*reinterpret_cast<const bf16x8*>(&Qw[(long)r32*DM+d0*16+hi*8]);
  DMA8_K(0,0);
  DMA8_K(1,1); DMA8_V(0,0);
  DMA8_K(2,2); DMA8_V(1,1);
  const int kperm=16*((r32>>2)&1)+(r32&3)+4*(r32>>3);
  const lds_cptr shm3=(lds_cptr)shm; const lds_cptr kp0=shm3+LDS_K+hi*1024+kperm*16; const lds_cptr vp0=shm3+LDS_V+((lane>>4)&1)*32+(lane&3)*8+(16*hi+((lane&15)>>2))*64;
  f32x16 o[2];o[0]=f32x16{};o[1]=f32x16{}; f32x16 bv;
  #pragma unroll
  for(int r=0;r<16;++r)bv[r]=bias2;
  asm volatile("":"+v"(bv));
  float carry=1.f; const int qrel=wid*QBLK+r32;
  f32x16 a0,a1,b0,b1;
  asm volatile("s_waitcnt vmcnt(4) lgkmcnt(0)\n\ts_barrier":::"memory");
  qk(a0,a1,kp0,qr,bv);
  int ks1=1,vs0=0;
  #define STEP8(C0,C1,N0,N1,st_) do{ const int st=(st_); \
    if(st+2<NT) asm volatile("s_waitcnt vmcnt(2) lgkmcnt(0)\n\ts_barrier":::"memory"); else if(st+2==NT) asm volatile("s_waitcnt vmcnt(1) lgkmcnt(0)\n\ts_barrier":::"memory"); else asm volatile("s_waitcnt vmcnt(0) lgkmcnt(0)\n\ts_barrier":::"memory"); \
    { const int kfree=(ks1==0)?2:ks1-1; const int vfree=(vs0==0)?2:vs0-1; if(st+3<NT) DMA8_K(st+3,kfree); if(st+2<NT) DMA8_V(st+2,vfree); } \
    if(st+1<NT) qk(N0,N1,kp0+ks1*SLOTB,qr,bv); \
    __builtin_amdgcn_sched_barrier(0); \
    if(st<4) weights<true>(C0,C1,carry,hi,qrel-64*(3-st)-16*hi); else weights<false>(C0,C1,carry,hi,0); \
    pv(o,vp0+vs0*SLOTB,C0,C1); \
    ks1=(ks1==2)?0:ks1+1; vs0=(vs0==2)?0:vs0+1; }while(0)
  for(int it=0;it<NT;it+=2){ STEP8(a0,a1,b0,b1,it); STEP8(b0,b1,a0,a1,it+1); }
  #undef STEP8
  #undef DMA8_K
  #undef DMA8_V
  bf16*Ow=O+(rowbase+q0+wid*QBLK)*OP+h*D;
  { bf16*stg=(bf16*)(shm+LDS_OST)+wid*2048;
    #pragma unroll
    for(int r=0;r<16;++r){const int orow=sba::crow(r,hi);
      #pragma unroll
      for(int d0=0;d0<2;++d0)stg[orow*64+d0*32+r32]=__float2bfloat16(o[d0][r]);}
    asm volatile("s_waitcnt lgkmcnt(0)":::"memory");
    #pragma unroll
    for(int i=0;i<4;++i){const int row=i*8+(lane>>3),ch=lane&7; const u32x4 v=*(const u32x4*)(stg+row*64+ch*8); *(u32x4*)(Ow+(long)row*OP+ch*8)=v;} }
  asm volatile("s_waitcnt vmcnt(0) lgkmcnt(0)\n\ts_barrier":::"memory");
}
}
namespace sbd {
using sba::bf16x8; using sba::f32x16; using sba::u32x4; using sba::bf16; using sba::crow; using sba::cvtpk_s;
typedef float f32x4 __attribute__((ext_vector_type(4)));
#define RLXA __ATOMIC_RELAXED, __HIP_MEMORY_SCOPE_AGENT
template<bool NEWK> __device__ __forceinline__ void weights32(f32x16&c,float&carry,int hi,int q){
  #pragma unroll
  for(int r=0;r<16;++r){ float e=__builtin_amdgcn_exp2f(c[r]);
    if(NEWK){ const int kv=crow(r,hi); if(kv>=8||kv>=q)e=0.f; }
    c[r]=1.f+e; }
  float P2[4],P3[4],T[4],Tl[4],Th[4],off[4];
  #pragma unroll
  for(int k=0;k<4;++k){ P2[k]=c[4*k]*c[4*k+1]; P3[k]=P2[k]*c[4*k+2]; T[k]=__builtin_amdgcn_rcpf(P3[k]*c[4*k+3]); }
  #pragma unroll
  for(int k=0;k<4;++k){ auto s=__builtin_amdgcn_permlane32_swap(__float_as_uint(T[k]),__float_as_uint(T[k]),false,false); Tl[k]=__uint_as_float(s[0]); Th[k]=__uint_as_float(s[1]); }
  float E=carry;
  #pragma unroll
  for(int k=3;k>=0;--k){ off[k]=hi?E:E*Th[k]; E=E*(Tl[k]*Th[k]); }
  carry=E;
  #pragma unroll
  for(int k=0;k<4;++k){ const float g=T[k]*off[k], R1=c[4*k]*g, R2=P2[k]*g, R3=P3[k]*g; c[4*k]=R1-g; c[4*k+1]=R2-R1; c[4*k+2]=R3-R2; c[4*k+3]=off[k]-R3; }
}
struct Raw { f32x4 k[8]; float v[32]; };
__device__ __forceinline__ void load_tile(Raw&R,const float*kb,const float*vb){
  #pragma unroll
  for(int d0=0;d0<4;++d0){ R.k[2*d0]=__builtin_nontemporal_load((const f32x4*)(kb+16*d0)); R.k[2*d0+1]=__builtin_nontemporal_load((const f32x4*)(kb+16*d0+4)); }
  #pragma unroll
  for(int d0=0;d0<2;++d0)
    #pragma unroll
    for(int ks=0;ks<2;++ks)
      #pragma unroll
      for(int j=0;j<8;++j) R.v[(d0*2+ks)*8+j]=__builtin_nontemporal_load(vb+(size_t)(16*ks+8*(j>>2)+(j&3))*512+32*d0);
}
struct Frag { bf16x8 k[4]; bf16x8 v[4]; };
__device__ __forceinline__ void cvt_tile(Frag&F,const Raw&R){
  #pragma unroll
  for(int d0=0;d0<4;++d0){ u32x4 p; p[0]=cvtpk_s(R.k[2*d0][0],R.k[2*d0][1]); p[1]=cvtpk_s(R.k[2*d0][2],R.k[2*d0][3]); p[2]=cvtpk_s(R.k[2*d0+1][0],R.k[2*d0+1][1]); p[3]=cvtpk_s(R.k[2*d0+1][2],R.k[2*d0+1][3]); F.k[d0]=__builtin_bit_cast(bf16x8,p); }
  #pragma unroll
  for(int i=0;i<4;++i){ u32x4 p;
    #pragma unroll
    for(int j=0;j<4;++j) p[j]=cvtpk_s(R.v[8*i+2*j],R.v[8*i+2*j+1]);
    F.v[i]=__builtin_bit_cast(bf16x8,p); }
}
template<bool NEWK> __device__ __forceinline__ void tile_step(const Frag&F,const bf16x8*qr,const f32x16&bv,f32x16*o,float&carry,int hi,int q){
  f32x16 c=bv;
  #pragma unroll
  for(int d0=0;d0<4;++d0) c=SBA_MFMA(F.k[d0],qr[d0],c);
  weights32<NEWK>(c,carry,hi,q);
  u32x4 pw[2];
  #pragma unroll
  for(int k=0;k<2;++k)
    #pragma unroll
    for(int j=0;j<4;++j) pw[k][j]=cvtpk_s(c[8*k+2*j],c[8*k+2*j+1]);
  #pragma unroll
  for(int d0=0;d0<2;++d0)
    #pragma unroll
    for(int ks=0;ks<2;++ks) o[d0]=SBA_MFMA(__builtin_bit_cast(bf16x8,pw[ks]),F.v[d0*2+ks],o[d0]);
}
__device__ __forceinline__ void decode_wave(int smp,int j,int h,const float*cache_k,const float*cache_v,const int*page_table,const bf16*Q,const bf16*Kn,const bf16*Vn,const float*b_sb,
                                            float*part,float*rtot,unsigned*cnt,bf16*MIX){
  int tid_=threadIdx.x; asm volatile("":"+v"(tid_)); const int lane=tid_&63,r32=lane&31,hi=lane>>5;
  const float bias2=b_sb[h]*1.4426950408889634f;
  f32x16 bv;
  #pragma unroll
  for(int r=0;r<16;++r)bv[r]=bias2;
  const long srow=16384+8*smp;
  bf16x8 qr[4];
  #pragma unroll
  for(int d0=0;d0<4;++d0){ bf16x8 z={0,0,0,0,0,0,0,0}; if(r32<8) z=*reinterpret_cast<const bf16x8*>(Q+(srow+r32)*512+h*64+d0*16+hi*8); qr[d0]=z; }
  f32x16 o[2]; o[0]=f32x16{}; o[1]=f32x16{}; float carry=1.f;
  if(j==7){
    Frag F;
    #pragma unroll
    for(int d0=0;d0<4;++d0){ bf16x8 z={0,0,0,0,0,0,0,0}; if(r32<8) z=*reinterpret_cast<const bf16x8*>(Kn+(srow+r32)*512+h*64+d0*16+hi*8); F.k[d0]=z; }
    #pragma unroll
    for(int d0=0;d0<2;++d0){
      bf16x8 z={0,0,0,0,0,0,0,0};
      #pragma unroll
      for(int jj=0;jj<4;++jj) z[jj]=*reinterpret_cast<const short*>(Vn+(srow+4*hi+jj)*512+h*64+32*d0+r32);
      F.v[d0*2]=z; F.v[d0*2+1]=(bf16x8){0,0,0,0,0,0,0,0}; }
    tile_step<true>(F,qr,bv,o,carry,hi,r32);
  }
  const int*pt=page_table+smp*64+8*j;
  Raw R; Frag F;
  #define ROWK(tt) (cache_k+(((size_t)pt[(tt)>>2]*128+(size_t)(((tt)&3)*32+r32))*8+h)*64+8*hi)
  #define ROWV(tt) (cache_v+(((size_t)pt[(tt)>>2]*128+(size_t)(((tt)&3)*32+4*hi))*8+h)*64+r32)
  load_tile(R,ROWK(31),ROWV(31)); cvt_tile(F,R);
  for(int tt=31;tt>=0;--tt){
    if(tt>0) load_tile(R,ROWK(tt-1),ROWV(tt-1));
    tile_step<false>(F,qr,bv,o,carry,hi,r32);
    if(tt>0) cvt_tile(F,R);
  }
  #undef ROWK
  #undef ROWV
  const int unit=smp*8+j;
  int l2_=threadIdx.x; asm volatile("":"+v"(l2_)); const int lane2=l2_&63, r32b=lane2&31, hib=lane2>>5;
  unsigned*pp=(unsigned*)part+((size_t)unit*8+h)*512;
  #pragma unroll
  for(int r=0;r<4;++r)
    #pragma unroll
    for(int d0=0;d0<2;++d0) __hip_atomic_store(pp+(r+4*hib)*64+32*d0+r32b,__float_as_uint(o[d0][r]),RLXA);
  if(lane2<8) __hip_atomic_store((unsigned*)rtot+((size_t)unit*8+h)*8+lane2,__float_as_uint(carry),RLXA);
  asm volatile("s_waitcnt vmcnt(0)":::"memory");
  unsigned old=0u;
  if(lane2==0) old=__hip_atomic_fetch_add(cnt+64*(smp*8+h),1u,RLXA);
  old=(unsigned)__builtin_amdgcn_readfirstlane((int)old);
  if(old==7u){
    const int q=lane2>>3,dc=(lane2&7)*8; float acc[8];
    #pragma unroll
    for(int i=0;i<8;++i)acc[i]=0.f;
    float f=1.f;
    for(int jj=7;jj>=0;--jj){ const size_t u=(size_t)smp*8+jj; const unsigned*src=(const unsigned*)part+(u*8+h)*512+q*64+dc;
      #pragma unroll
      for(int i=0;i<8;++i) acc[i]+=f*__uint_as_float(__hip_atomic_load(src+i,RLXA));
      f*=__uint_as_float(__hip_atomic_load((const unsigned*)rtot+(u*8+h)*8+q,RLXA)); }
    u32x4 w; w[0]=cvtpk_s(acc[0],acc[1]); w[1]=cvtpk_s(acc[2],acc[3]); w[2]=cvtpk_s(acc[4],acc[5]); w[3]=cvtpk_s(acc[6],acc[7]);
    *(u32x4*)(MIX+(srow+q)*1024+h*64+dc)=w;
  }
}
}
namespace gla {
using sba::bf16; using sba::cvtpk_s;
typedef short bf16x8 __attribute__((ext_vector_type(8)));
typedef short bf16x4 __attribute__((ext_vector_type(4)));
typedef float f32x4 __attribute__((ext_vector_type(4)));
typedef unsigned u32x4 __attribute__((ext_vector_type(4)));
typedef unsigned u32x2 __attribute__((ext_vector_type(2)));
#define GLAS __attribute__((address_space(3)))
constexpr int GP=1792;
constexpr int L_QD=0,L_KI=9216,L_KET=18432,L_VT=27648,L_DEC=46080,L_EXR=46336,L_TOT=46592,L_SSQ=48640,L_END=50688;
#define GMFMA(a,b,c) __builtin_amdgcn_mfma_f32_16x16x32_bf16((a),(b),(c),0,0,0)
__device__ __forceinline__ float bf2f(short s){ return __uint_as_float(((unsigned)(unsigned short)s)<<16); }
__device__ __forceinline__ short f2bf(float f){ return (short)(cvtpk_s(f,0.f)&0xffffu); }
template<int MODE,bool FULL> __device__ __forceinline__ void chunk(const bf16*G,bf16*MIX,long m0,int ntok,int h,GLAS char*L,f32x4(&S)[4],const float(&wg)[16],float bg,float gain,float&dseg){
  int tid_=threadIdx.x; asm volatile("":"+v"(tid_)); const int tid=tid_,lane=tid&63,c=lane,fr=lane&15,fq=lane>>4; const int w=__builtin_amdgcn_readfirstlane(tid>>6); const int g=w;
  const short*Gs=(const short*)G;
  float bl[8]; float run=0.f;
  bf16x8 al0[8],al1[8]; short kraw[8],qraw[8],vraw[16];
  #pragma unroll
  for(int i=0;i<8;++i){ const int t=8*g+i; const bool ok=FULL||t<ntok; const long row=ok?(m0+t):m0; const bf16x8*ap=(const bf16x8*)(Gs+row*GP+1536); al0[i]=ap[0]; al1[i]=ap[1];
    kraw[i]=Gs[row*GP+256+64*h+c]; qraw[i]=(MODE==1)?Gs[row*GP+64*h+c]:(short)0; }
  #pragma unroll
  for(int i=0;i<16;++i){ const int t=16*(tid>>7)+i; const bool ok=FULL||t<ntok; const long row=ok?(m0+t):m0; vraw[i]=Gs[row*GP+512+128*h+(tid&127)]; }
  #pragma unroll
  for(int i=0;i<8;++i){ const int t=8*g+i; float la=0.f;
    if(FULL||t<ntok){ const bf16x8 a0=al0[i],a1=al1[i]; float x=bg;
      #pragma unroll
      for(int j=0;j<8;++j){ x+=bf2f(a0[j])*wg[j]; x+=bf2f(a1[j])*wg[8+j]; }
      la=(fminf(x,0.f)-__logf(1.f+__expf(-fabsf(x))))*0.0625f; }
    run+=la; bl[i]=run; }
  GLAS float*TOT=(GLAS float*)(L+L_TOT);
  TOT[g*64+c]=run;
  __syncthreads();
  float prefix=0.f,total=0.f;
  #pragma unroll
  for(int gg=0;gg<8;++gg){ const float v=TOT[gg*64+c]; total+=v; if(gg<g)prefix+=v; }
  const float bref=0.5f*total;
  float ke[8];
  #pragma unroll
  for(int i=0;i<8;++i){ const int t=8*g+i; const float b=prefix+bl[i]; float kk=0.f,qq=0.f;
    if(FULL||t<ntok){ kk=bf2f(kraw[i]); if(MODE==1) qq=bf2f(qraw[i]); }
    ke[i]=kk*__expf(total-b);
    if(MODE==1){ *(GLAS short*)(L+L_QD+t*144+c*2)=f2bf(qq*0.125f*__expf(b-bref)); *(GLAS short*)(L+L_KI+t*144+c*2)=f2bf(kk*__expf(bref-b)); } }
  { u32x4 p; p[0]=cvtpk_s(ke[0],ke[1]); p[1]=cvtpk_s(ke[2],ke[3]); p[2]=cvtpk_s(ke[4],ke[5]); p[3]=cvtpk_s(ke[6],ke[7]); *(GLAS u32x4*)(L+L_KET+c*144+g*16)=p; }
  if(g==0){ const float d=__expf(total); ((GLAS float*)(L+L_DEC))[c]=d; ((GLAS float*)(L+L_EXR))[c]=__expf(bref); dseg*=d; }
  { const int dv=tid&127,tg=tid>>7; float vv[16];
    #pragma unroll
    for(int i=0;i<16;++i){ const int t=16*tg+i; vv[i]=(FULL||t<ntok)?bf2f(vraw[i]):0.f; }
    u32x4 p0,p1;
    #pragma unroll
    for(int j=0;j<4;++j){ p0[j]=cvtpk_s(vv[2*j],vv[2*j+1]); p1[j]=cvtpk_s(vv[8+2*j],vv[8+2*j+1]); }
    *(GLAS u32x4*)(L+L_VT+dv*144+tg*32)=p0; *(GLAS u32x4*)(L+L_VT+dv*144+tg*32+16)=p1; }
  __syncthreads();
  const int dvl=16*w+fr;
  f32x4 O[4];
  if(MODE==1){
    f32x4 PT[4][4];
    #pragma unroll
    for(int st=0;st<4;++st)
      #pragma unroll
      for(int tt=0;tt<4;++tt){ f32x4 acc={0.f,0.f,0.f,0.f};
        if(st<=tt){
          #pragma unroll
          for(int kk=0;kk<2;++kk){ const bf16x8 a=*(GLAS const bf16x8*)(L+L_KI+(16*st+fr)*144+(32*kk+8*fq)*2), b=*(GLAS const bf16x8*)(L+L_QD+(16*tt+fr)*144+(32*kk+8*fq)*2); acc=GMFMA(a,b,acc); }
          if(st==tt){
            #pragma unroll
            for(int i=0;i<4;++i) if(4*fq+i>fr) acc[i]=0.f; } }
        PT[st][tt]=acc; }
    #pragma unroll
    for(int tt=0;tt<4;++tt){ O[tt]=(f32x4){0.f,0.f,0.f,0.f};
      #pragma unroll
      for(int pr=0;pr<2;++pr){ if(2*pr<=tt){
        u32x4 pa; pa[0]=cvtpk_s(PT[2*pr][tt][0],PT[2*pr][tt][1]); pa[1]=cvtpk_s(PT[2*pr][tt][2],PT[2*pr][tt][3]); pa[2]=cvtpk_s(PT[2*pr+1][tt][0],PT[2*pr+1][tt][1]); pa[3]=cvtpk_s(PT[2*pr+1][tt][2],PT[2*pr+1][tt][3]);
        const u32x2 b0=*(GLAS const u32x2*)(L+L_VT+dvl*144+(32*pr+4*fq)*2), b1=*(GLAS const u32x2*)(L+L_VT+dvl*144+(32*pr+16+4*fq)*2);
        const u32x4 pb={b0[0],b0[1],b1[0],b1[1]};
        O[tt]=GMFMA(__builtin_bit_cast(bf16x8,pa),__builtin_bit_cast(bf16x8,pb),O[tt]); } } }
    #pragma unroll
    for(int kk=0;kk<2;++kk){
      const f32x4 e0=*(GLAS const f32x4*)(L+L_EXR+(32*kk+4*fq)*4), e1=*(GLAS const f32x4*)(L+L_EXR+(32*kk+16+4*fq)*4);
      const f32x4 s0=S[2*kk]*e0, s1=S[2*kk+1]*e1;
      u32x4 pb; pb[0]=cvtpk_s(s0[0],s0[1]); pb[1]=cvtpk_s(s0[2],s0[3]); pb[2]=cvtpk_s(s1[0],s1[1]); pb[3]=cvtpk_s(s1[2],s1[3]);
      #pragma unroll
      for(int tt=0;tt<4;++tt){ const u32x2 a0=*(GLAS const u32x2*)(L+L_QD+(16*tt+fr)*144+(32*kk+4*fq)*2), a1=*(GLAS const u32x2*)(L+L_QD+(16*tt+fr)*144+(32*kk+16+4*fq)*2);
        const u32x4 pa={a0[0],a0[1],a1[0],a1[1]};
        O[tt]=GMFMA(__builtin_bit_cast(bf16x8,pa),__builtin_bit_cast(bf16x8,pb),O[tt]); } }
  }
  #pragma unroll
  for(int mt=0;mt<4;++mt){ const f32x4 d4=*(GLAS const f32x4*)(L+L_DEC+(16*mt+4*fq)*4); S[mt]=S[mt]*d4;
    #pragma unroll
    for(int kk=0;kk<2;++kk){ const bf16x8 a=*(GLAS const bf16x8*)(L+L_KET+(16*mt+fr)*144+(32*kk+8*fq)*2), b=*(GLAS const bf16x8*)(L+L_VT+dvl*144+(32*kk+8*fq)*2); S[mt]=GMFMA(a,b,S[mt]); } }
  if(MODE==1){
    GLAS float*SSQ=(GLAS float*)(L+L_SSQ);
    #pragma unroll
    for(int tt=0;tt<4;++tt)
      #pragma unroll
      for(int i=0;i<4;++i){ float ss=O[tt][i]*O[tt][i]; ss+=__shfl_xor(ss,1); ss+=__shfl_xor(ss,2); ss+=__shfl_xor(ss,4); ss+=__shfl_xor(ss,8); if(fr==0) SSQ[w*64+16*tt+4*fq+i]=ss; }
    short rraw[16];
    #pragma unroll
    for(int tt=0;tt<4;++tt)
      #pragma unroll
      for(int i=0;i<4;++i){ const int t=16*tt+4*fq+i; const long row=(FULL||t<ntok)?(m0+t):m0; rraw[4*tt+i]=Gs[row*GP+1024+128*h+dvl]; }
    __syncthreads();
    #pragma unroll
    for(int tt=0;tt<4;++tt)
      #pragma unroll
      for(int i=0;i<4;++i){ const int t=16*tt+4*fq+i; float tot=0.f;
        #pragma unroll
        for(int ww=0;ww<8;++ww) tot+=SSQ[ww*64+t];
        if(FULL||t<ntok){ const float rstd=rsqrtf(tot*(1.f/128.f)+1e-6f); const float rg=bf2f(rraw[4*tt+i]); const float sl=rg/(1.f+__expf(-rg));
          ((short*)MIX)[(m0+t)*1024+512+128*h+dvl]=f2bf(O[tt][i]*rstd*gain*sl); } }
  }
  __syncthreads();
}
__device__ __forceinline__ void load_consts(int h,const float*w_gate,const float*b_gate,const float*g_out,float(&wg)[16],float&bg,float&gain){
  const int lane=threadIdx.x&63, w=threadIdx.x>>6;
  #pragma unroll
  for(int j=0;j<16;++j) wg[j]=w_gate[j*256+64*h+lane];
  bg=b_gate[64*h+lane]; gain=g_out[16*w+(lane&15)];
}
__device__ __forceinline__ void pass1_unit(int unit,const bf16*G,const float*w_gate,const float*b_gate,const float*g_out,float*SLOC,float*DSEG,GLAS char*L){
  const int bh=unit>>5,sseg=unit&31,b=bh>>2,h=bh&3; const int tid=threadIdx.x;
  float wg[16],bg,gain; load_consts(h,w_gate,b_gate,g_out,wg,bg,gain);
  f32x4 S[4];
  #pragma unroll
  for(int mt=0;mt<4;++mt)S[mt]=(f32x4){0.f,0.f,0.f,0.f};
  float dseg=1.f; const long m0=(long)b*8192+256*sseg;
  for(int ch=0;ch<4;++ch) chunk<0,true>(G,nullptr,m0+64*ch,64,h,L,S,wg,bg,gain,dseg);
  f32x4*dst=(f32x4*)(SLOC+((size_t)unit*512+tid)*16);
  #pragma unroll
  for(int mt=0;mt<4;++mt)dst[mt]=S[mt];
  if(tid<64)DSEG[unit*64+tid]=dseg;
}
__device__ __forceinline__ void pass3_unit(int unit,const bf16*G,bf16*MIX,const float*w_gate,const float*b_gate,const float*g_out,const float*SLOC,const float*DSEG,float*sfin_base,GLAS char*L){
  const int bh=unit>>5,sseg=unit&31,b=bh>>2,h=bh&3; const int tid=threadIdx.x,lane=tid&63,fr=lane&15,fq=lane>>4,w=tid>>6;
  float wg[16],bg,gain; load_consts(h,w_gate,b_gate,g_out,wg,bg,gain);
  f32x4 S[4];
  #pragma unroll
  for(int mt=0;mt<4;++mt)S[mt]=(f32x4){0.f,0.f,0.f,0.f};
  #pragma unroll 4
  for(int j=0;j<sseg;++j){ const int uj=bh*32+j; const f32x4*src=(const f32x4*)(SLOC+((size_t)uj*512+tid)*16);
    #pragma unroll
    for(int mt=0;mt<4;++mt){ const f32x4 d4=*(const f32x4*)(DSEG+uj*64+16*mt+4*fq); S[mt]=S[mt]*d4+src[mt]; } }
  float dseg=1.f; const long m0=(long)b*8192+256*sseg;
  for(int ch=0;ch<4;++ch) chunk<1,true>(G,MIX,m0+64*ch,64,h,L,S,wg,bg,gain,dseg);
  if(sseg==31){ float*o=sfin_base+(size_t)bh*8192;
    #pragma unroll
    for(int mt=0;mt<4;++mt)
      #pragma unroll
      for(int i=0;i<4;++i) o[(16*mt+4*fq+i)*128+16*w+fr]=S[mt][i]; }
}
__device__ __forceinline__ void sample_unit(int unit,const bf16*G,bf16*MIX,const float*w_gate,const float*b_gate,const float*g_out,const float*s0,float*sout,GLAS char*L){
  const int smp=unit>>2,h=unit&3; const int tid=threadIdx.x,lane=tid&63,fr=lane&15,fq=lane>>4,w=tid>>6;
  float wg[16],bg,gain; load_consts(h,w_gate,b_gate,g_out,wg,bg,gain);
  f32x4 S[4]; const float*si=s0+(size_t)unit*8192; float*so=sout+(size_t)unit*8192;
  #pragma unroll
  for(int mt=0;mt<4;++mt)
    #pragma unroll
    for(int i=0;i<4;++i) S[mt][i]=si[(16*mt+4*fq+i)*128+16*w+fr];
  float dseg=1.f;
  chunk<1,false>(G,MIX,16384+8*(long)smp,8,h,L,S,wg,bg,gain,dseg);
  #pragma unroll
  for(int mt=0;mt<4;++mt)
    #pragma unroll
    for(int i=0;i<4;++i) so[(16*mt+4*fq+i)*128+16*w+fr]=S[mt][i];
}
}
namespace thin {
using sba::bf16x8; using sba::f32x16; using sba::crow;
template<int KS,class Epi> __device__ __forceinline__ void run(const unsigned short*A,int lda,const unsigned short*Bt,int ldb,int K,int ntn,int tile0,int ntiles,__attribute__((address_space(3))) float*red,const Epi&epi){
  int tid_=threadIdx.x; asm volatile("":"+v"(tid_)); const int lane=tid_&63,r32=lane&31,hi=lane>>5; const int w=__builtin_amdgcn_readfirstlane(tid_>>6);
  const int sub=w/KS,kp=w%KS,tile=tile0+sub; const bool live=tile<ntiles; const int tm=live?tile/ntn:0,tn=live?tile%ntn:0;
  const int klen=K/KS,k0=kp*klen;
  const unsigned short*ap=A+(size_t)(32*tm+r32)*lda+k0+8*hi; const unsigned short*bp=Bt+(size_t)(32*tn+r32)*ldb+k0+8*hi;
  f32x16 acc=f32x16{};
  if(live){
    #pragma unroll 8
    for(int k=0;k<klen;k+=16){ const bf16x8 a=*(const bf16x8*)(ap+k), b=*(const bf16x8*)(bp+k); acc=__builtin_amdgcn_mfma_f32_32x32x16_bf16(a,b,acc,0,0,0); } }
  #pragma unroll
  for(int r=0;r<16;++r) red[(w*16+r)*64+lane]=acc[r];
  __syncthreads();
  if(kp==0&&live){
    #pragma unroll
    for(int r=0;r<16;++r){ float v=0.f;
      #pragma unroll
      for(int p=0;p<KS;++p) v+=red[((sub*KS+p)*16+r)*64+lane];
      epi(32*tm+crow(r,hi),32*tn+r32,v); } }
  __syncthreads();
}
struct EpiResGateS { const float*base; float*out; const float*gate; int ld;
  __device__ __forceinline__ void operator()(int row,int col,float v)const{ const size_t o=(size_t)row*ld+col; out[o]=base[o]+gate[(size_t)(2+(row>>3))*6144+col]*v; } };
struct EpiRelu2S { unsigned short*H; int ld;
  __device__ __forceinline__ void operator()(int row,int col,float v)const{ const float a=fmaxf(v,0.f); H[(size_t)row*ld+col]=(unsigned short)(sba::cvtpk_s(a*a,0.f)&0xffffu); } };
}
__device__ __forceinline__ float wave_sum(float v) {
#pragma unroll
    for (int o = 1; o < 64; o <<= 1) v += __shfl_xor(v, o);
    return v;
}
__device__ __forceinline__ void p0_transpose_item(const float* W, int K, int Nreal, int Npad, bf16* WT, LAS float* scr, int item, int lane) {
    const int nblk = Npad / 32, kb = item / nblk, nb = item % nblk, k0 = 64 * kb, n0 = 32 * nb;
    const int n = n0 + (lane & 31);
#pragma unroll 8
    for (int i = 0; i < 32; ++i) { const int kk = 2 * i + (lane >> 5); scr[kk * 33 + (lane & 31)] = (n < Nreal) ? W[(size_t)(k0 + kk) * Nreal + n] : 0.f; }
    LDS_WAIT(); asm volatile("" ::: "memory");
    const int c = lane & 7;
#pragma unroll
    for (int j = 0; j < 4; ++j) { const int nn = (lane >> 3) + 8 * j; const LAS float* s = scr + (8 * c) * 33 + nn;
        v4u o; o.x = pk2(s[0 * 33], s[1 * 33]); o.y = pk2(s[2 * 33], s[3 * 33]); o.z = pk2(s[4 * 33], s[5 * 33]); o.w = pk2(s[6 * 33], s[7 * 33]);
        *(GAS v4u*)(WT + (size_t)(n0 + nn) * K + k0 + 8 * c) = o; }
    LDS_WAIT(); asm volatile("" ::: "memory");
}
__device__ __forceinline__ void norm_mod_row_bf16(int lane, const float* xrow, const float* gain, const float* sc, const float* sh, bf16* orow) {
    const f32x4* xr = (const f32x4*)xrow + lane; f32x4 v[4]; float s = 0.f;
#pragma unroll
    for (int j = 0; j < 4; ++j) { v[j] = xr[64 * j]; s += (v[j].x * v[j].x + v[j].y * v[j].y) + (v[j].z * v[j].z + v[j].w * v[j].w); }
    const float rstd = rsqrtf(wave_sum(s) * (1.f / D) + NORM_EPS);
    unsigned long long* o8 = (unsigned long long*)orow + lane;
#pragma unroll
    for (int j = 0; j < 4; ++j) { const f32x4 g = ((const f32x4*)gain)[lane + 64 * j], a = ((const f32x4*)sc)[lane + 64 * j], b = ((const f32x4*)sh)[lane + 64 * j];
        const f32x4 y = v[j] * rstd * g * (a + 1.f) + b;
        o8[64 * j] = (unsigned long long)pk2(y.x, y.y) | ((unsigned long long)pk2(y.z, y.w) << 32); }
}
__device__ __forceinline__ void norm_row_f32_inplace(int lane, float* xrow, const float* gain) {
    f32x4* xr = (f32x4*)xrow + lane; f32x4 v[4]; float s = 0.f;
#pragma unroll
    for (int j = 0; j < 4; ++j) { v[j] = xr[64 * j]; s += (v[j].x * v[j].x + v[j].y * v[j].y) + (v[j].z * v[j].z + v[j].w * v[j].w); }
    const float rstd = rsqrtf(wave_sum(s) * (1.f / D) + NORM_EPS);
#pragma unroll
    for (int j = 0; j < 4; ++j) { const f32x4 g = ((const f32x4*)gain)[lane + 64 * j]; xr[64 * j] = v[j] * rstd * g; }
}
__device__ __forceinline__ int bidx_of_row(int m) { return m < MP ? (m >> 13) : 2 + ((m - MP) >> 3); }

struct Args { const float* in[21]; const int* page_table; float* out; unsigned char* ws; };
static_assert(sizeof(Args) == 24 * 8, "Args has no padding");

__global__ void __launch_bounds__(NWAVES * 64, 2) mk_fwd(Args args) {
    extern __shared__ __attribute__((aligned(16))) unsigned char lds[];
    LAS unsigned char* L = (LAS unsigned char*)lds;
    volatile LAS unsigned* MISC = (volatile LAS unsigned*)(L + MISC_OFF);
    const int tid = threadIdx.x, lane = tid & 63, wave = __builtin_amdgcn_readfirstlane(tid >> 6);
    const int G = gridDim.x; const int bx = blockIdx.x; const int vcu = (G % 8 == 0) ? (bx % 8) * (G / 8) + bx / 8 : bx;
    unsigned char* ws = args.ws;
    unsigned* ctl = (unsigned*)(ws + WS_CTL);
    const float *x_prompt = args.in[0], *x_sample = args.in[1], *c_prompt = args.in[2], *c_sample = args.in[3], *cache_k = args.in[4], *cache_v = args.in[5], *state_gla = args.in[6];
    const float *w_ada = args.in[8], *b_ada = args.in[9], *g_mix = args.in[10], *w_in = args.in[11], *b_sb = args.in[12], *w_gate = args.in[13], *b_gate = args.in[14], *g_gla_out = args.in[15];
    const float *w_out = args.in[16], *g_ffn = args.in[17], *w_up = args.in[18], *w_down = args.in[19], *g_final = args.in[20];
    float* out = args.out;
    float* MOD = (float*)(ws + WS_MOD);
    bf16 *Win_t = (bf16*)(ws + WS_WIN), *Wo_t = (bf16*)(ws + WS_WO), *Wup_t = (bf16*)(ws + WS_WUP), *Wdn_t = (bf16*)(ws + WS_WDN);
    bf16 *XN = (bf16*)(ws + WS_XN), *QB = (bf16*)(ws + WS_Q), *KB = (bf16*)(ws + WS_K), *VB = (bf16*)(ws + WS_V), *GB = (bf16*)(ws + WS_G), *MIX = (bf16*)(ws + WS_MIX), *HB = (bf16*)(ws + WS_H);
    float* X1 = (float*)(ws + WS_X1);
    float *SLOC = (float*)(ws + WS_SLOC), *DSEG = (float*)(ws + WS_DSEG), *DPART = (float*)(ws + WS_DPART), *DRTOT = (float*)(ws + WS_DRTOT);
    for (int u = tid; u < (LDS_BYTES - MISC_OFF) / 4; u += NWAVES * 64) ((LAS unsigned*)(L + MISC_OFF))[u] = 0u;
    __syncthreads();
    XcdBarrier bar = xcd_barrier_post(ctl + CW_BAR, MISC + 8);
    const int gw = vcu * NWAVES + wave, NGW = G * NWAVES;

    if (vcu < 96) {
        LAS float* s = (LAS float*)L;
        for (int i = tid; i < NMODR * D; i += NWAVES * 64) { const int r = i >> 10, k = i & 1023; const float c = r < 2 ? c_prompt[r * D + k] : c_sample[(r - 2) * D + k]; s[k * NMODR + r] = c / (1.f + __expf(-c)); }
        __syncthreads();
        const int col = 64 * vcu + lane, k0 = 128 * wave;
        float acc[NMODR];
#pragma unroll
        for (int r = 0; r < NMODR; ++r) acc[r] = 0.f;
#pragma unroll 4
        for (int kk = 0; kk < 128; ++kk) { const int k = k0 + kk; const float w = w_ada[(size_t)k * MODW + col];
#pragma unroll
            for (int r = 0; r < NMODR; ++r) acc[r] += s[k * NMODR + r] * w; }
        __syncthreads();
        LAS float* red = (LAS float*)L;
#pragma unroll
        for (int r = 0; r < NMODR; ++r) red[(wave * NMODR + r) * 64 + lane] = acc[r];
        __syncthreads();
        for (int o = tid; o < NMODR * 64; o += NWAVES * 64) { const int r = o >> 6, l = o & 63; float t = b_ada[64 * vcu + l];
#pragma unroll
            for (int w8 = 0; w8 < 8; ++w8) t += red[(w8 * NMODR + r) * 64 + l];
            MOD[r * MODW + 64 * vcu + l] = t; }
        __syncthreads();
    }
    {
        LAS float* scr = (LAS float*)(L + wave * 16384);
        constexpr int I_IN = (D / 64) * (NIN / 32), I_O = (D / 64) * (D / 32), I_UP = (D / 64) * (FF / 32), I_DN = (FF / 64) * (D / 32);
        constexpr int NITEMS = I_IN + I_O + I_UP + I_DN;
        for (int it = gw; it < NITEMS; it += NGW) {
            int r = it;
            if (r < I_IN) { p0_transpose_item(w_in, D, NIN_REAL, NIN, Win_t, scr, r, lane); continue; } r -= I_IN;
            if (r < I_O) { p0_transpose_item(w_out, D, D, D, Wo_t, scr, r, lane); continue; } r -= I_O;
            if (r < I_UP) { p0_transpose_item(w_up, D, FF, FF, Wup_t, scr, r, lane); continue; } r -= I_UP;
            p0_transpose_item(w_down, FF, D, D, Wdn_t, scr, r, lane);
        }
    }
    xcd_barrier(bar);
    for (int m = gw; m < M; m += NGW) { const float* xr = m < MP ? x_prompt + (size_t)m * D : x_sample + (size_t)(m - MP) * D; const float* md = MOD + (size_t)bidx_of_row(m) * MODW;
        norm_mod_row_bf16(lane, xr, g_mix, md + 1024, md, XN + (size_t)m * D); }
    xcd_barrier(bar);
    {
        pg8::Gemm g{XN, Win_t, M, NIN, D}; pg8::StaticOrder S; S.init(M, NIN, G, bx);
        pg8::EpiInProj E{QB, KB, VB, GB, out + OK_P, out + OV_P, out + OK_S - (size_t)MP * 512, out + OV_S - (size_t)MP * 512, QSCALE};
        pg8::gemm_phase<pg8::EpiInProj, pg8::StaticOrder, true, true>(L, g, S, E);
    }
    xcd_barrier(bar);
#if defined(PROBE_GLA2) || defined(PROBE_GLA1)
    for (int rep_ = 0; rep_ < 2; ++rep_)
#endif
    for (int u = vcu; u < 256; u += G) gla::pass1_unit(u, (const gla::bf16*)GB, w_gate, b_gate, g_gla_out, SLOC, DSEG, (LAS char*)L);
    xcd_barrier(bar);
    for (int rep = 0; rep < 2; ++rep) {
        const bool do_sb = ((vcu & 1) == rep);
        if (do_sb) {
#ifdef PROBE_SB2
            for (int rep_ = 0; rep_ < 2; ++rep_)
#endif
            for (int v = vcu; v < 256; v += G) {
                const int bh = v >> 4, s = v & 15, b = bh >> 3, h = bh & 7; const float bias2 = b_sb[h] * 1.4426950408889634f;
                sb8::attn_unit(b, h, 31 - s, (const sba::bf16*)QB, (const sba::bf16*)KB, (const sba::bf16*)VB, (sba::bf16*)MIX, (char*)lds, bias2);
                sb8::attn_unit(b, h, s, (const sba::bf16*)QB, (const sba::bf16*)KB, (const sba::bf16*)VB, (sba::bf16*)MIX, (char*)lds, bias2);
            }
        } else {
#ifdef PROBE_DEC2
            for (int rep_ = 0; rep_ < 2; ++rep_)
#endif
            for (int u = vcu; u < 256; u += G)
                sbd::decode_wave(u >> 3, u & 7, wave, cache_k, cache_v, args.page_table, (const sba::bf16*)QB, (const sba::bf16*)KB, (const sba::bf16*)VB, b_sb, DPART, DRTOT, ctl + CW_DEC, (sba::bf16*)MIX);
            asm volatile("s_waitcnt vmcnt(0)" ::: "memory"); __syncthreads();
        }
    }
#if defined(PROBE_GLA2)
    for (int rep_ = 0; rep_ < 2; ++rep_)
#endif
    for (int u = vcu; u < 256; u += G) gla::pass3_unit(u, (const gla::bf16*)GB, (gla::bf16*)MIX, w_gate, b_gate, g_gla_out, SLOC, DSEG, out + OSG_P, (LAS char*)L);
    for (int u = vcu; u < 128; u += G) gla::sample_unit(u, (const gla::bf16*)GB, (gla::bf16*)MIX, w_gate, b_gate, g_gla_out, state_gla, out + OSG_S, (LAS char*)L);
    xcd_barrier(bar);
    {
        pg8::Gemm g{MIX, Wo_t, MP, D, D}; pg8::StaticOrder S; S.init(MP, D, G, bx);
        pg8::EpiResGate E{x_prompt, x_sample - (size_t)MP * D, X1, MOD + 2048};
        pg8::gemm_phase<pg8::EpiResGate, pg8::StaticOrder, true, true>(L, g, S, E);
        thin::EpiResGateS Es{x_sample, X1 + (size_t)MP * D, MOD + 2048, D};
        for (int t0 = vcu; t0 < 256; t0 += G) thin::run<8>(MIX + (size_t)MP * D, D, Wo_t, D, D, 32, t0, 256, (LAS float*)L, Es);
    }
    xcd_barrier(bar);
    for (int m = gw; m < M; m += NGW) { const float* md = MOD + (size_t)bidx_of_row(m) * MODW; norm_mod_row_bf16(lane, X1 + (size_t)m * D, g_ffn, md + 4096, md + 3072, XN + (size_t)m * D); }
    xcd_barrier(bar);
    {
        pg8::Gemm g{XN, Wup_t, MP, FF, D}; pg8::StaticOrder S; S.init(MP, FF, G, bx);
        pg8::EpiRelu2 E{HB, FF};
        pg8::gemm_phase<pg8::EpiRelu2, pg8::StaticOrder, true, true>(L, g, S, E);
        thin::EpiRelu2S Es{HB + (size_t)MP * FF, FF};
        for (int t0 = 4 * vcu; t0 < 1024; t0 += 4 * G) thin::run<2>(XN + (size_t)MP * D, D, Wup_t, D, D, 128, t0, 1024, (LAS float*)L, Es);
    }
    xcd_barrier(bar);
    {
        pg8::Gemm g{HB, Wdn_t, MP, D, FF}; pg8::StaticOrder S; S.init(MP, D, G, bx);
        pg8::EpiResGate E{X1, X1, out + OY, MOD + 5120};
        pg8::gemm_phase<pg8::EpiResGate, pg8::StaticOrder, true, true>(L, g, S, E);
        thin::EpiResGateS Es{X1 + (size_t)MP * D, out + OY + (size_t)MP * D, MOD + 5120, D};
        for (int t0 = vcu; t0 < 256; t0 += G) thin::run<8>(HB + (size_t)MP * FF, FF, Wdn_t, FF, FF, 32, t0, 256, (LAS float*)L, Es);
    }
    xcd_barrier(bar);
    for (int m = gw; m < M; m += NGW) norm_row_f32_inplace(lane, out + OY + (size_t)m * D, g_final);
}

extern "C" void kernel_launch(void* const* d_in, const int* in_sizes, int n_in, void* d_out, int out_size, void* d_ws, size_t ws_size, hipStream_t stream) {
    static int grid = 0;
    if (grid == 0) {
        if (n_in != 21 || (size_t)out_size != OUT_TOTAL || ws_size < WS_END) { fprintf(stderr, "kernel_launch: unexpected sizes: n_in %d out %d ws %zu\n", n_in, out_size, ws_size); grid = -1; return; }
        int dev = 0, cus = 0, per_cu = 0;
        if (hipGetDevice(&dev) != hipSuccess || hipDeviceGetAttribute(&cus, hipDeviceAttributeMultiprocessorCount, dev) != hipSuccess) { grid = -1; return; }
        if (hipFuncSetAttribute((const void*)mk_fwd, hipFuncAttributeMaxDynamicSharedMemorySize, LDS_BYTES) != hipSuccess) { fprintf(stderr, "kernel_launch: hipFuncSetAttribute failed\n"); grid = -1; return; }
        if (hipOccupancyMaxActiveBlocksPerMultiprocessor(&per_cu, (const void*)mk_fwd, NWAVES * 64, LDS_BYTES) != hipSuccess || per_cu < 1) { fprintf(stderr, "kernel_launch: occupancy query says %d\n", per_cu); }
        (void)hipGetLastError();
        grid = cus;
    }
    if (grid < 0) return;
    if (hipMemsetAsync((char*)d_ws + WS_CTL, 0, CTL_ZERO_BYTES, stream) != hipSuccess) return;
    Args a{};
    for (int i = 0; i < 21; ++i) a.in[i] = (const float*)d_in[i];
    a.page_table = (const int*)d_in[7]; a.out = (float*)d_out; a.ws = (unsigned char*)d_ws;
    hipLaunchKernelGGL(mk_fwd, dim3(grid), dim3(NWAVES * 64), LDS_BYTES, stream, a);
    const hipError_t le = hipPeekAtLastError();
    if (le != hipSuccess) fprintf(stderr, "kernel_launch: launch failed: %s\n", hipGetErrorName(le));
}
```

```cpp
#include <hip/hip_runtime.h>
#include <hip/hip_bf16.h>
#include <cstdio>
#include <cstdint>
namespace pg8 {
#define PG8_LAS __attribute__((address_space(3)))
typedef unsigned short bf16_t;
typedef short bf16x8 __attribute__((ext_vector_type(8)));
typedef float f32x4 __attribute__((ext_vector_type(4)));
typedef unsigned u32x4 __attribute__((ext_vector_type(4)));
constexpr int BM = 256, BK = 64, HALF = 128, HTB = HALF * BK * 2  , STAGE_BYTES = 8 * HTB, NXCD = 8, WGM = 8;

__host__ __device__ __forceinline__ int lds_byte(int r, int c) { const int st = (r >> 4) * 2 + (c >> 5), rr = r & 15, cc = c & 31, ob = rr * 64 + cc * 2; return st * 1024 + (ob ^ (((ob >> 9) & 1) << 5)); }
__host__ __device__ __forceinline__ void stage_rc(int b, int& R, int& C) { const int st = b / 1024, sb = b % 1024, swz = sb ^ (((sb >> 9) & 1) << 5); R = (st >> 1) * 16 + swz / 64; C = (st & 1) * 32 + (swz % 64) / 2; }
__host__ __device__ __forceinline__ int perm32(int rho) { const int n = rho >> 4, i = rho & 15; return 8 * (i >> 2) + 4 * n + (i & 3); }

struct Unit { int pm, pn; };
struct Gemm { const bf16_t* A; const bf16_t* Bt; int M, N, K; };

struct StaticOrder {
    int nM, nN, nwg, G, c;
    __host__ __device__ void init(int M, int N, int G_, int c_) { nM = M / BM; nN = N / BM; nwg = nM * nN; G = G_; c = c_; }
    __host__ __device__ bool next(int i, Unit& u) const {
        const long L = (long)i * G + c; if (L >= nwg) return false;
        int wgid = (int)L; { const int q = nwg / NXCD, r = nwg % NXCD, xcd = wgid % NXCD, off = wgid / NXCD; wgid = (xcd < r ? xcd * (q + 1) : r * (q + 1) + (xcd - r) * q) + off; }
        const int nig = WGM * nN, gid = wgid / nig, fm = gid * WGM, gsz = (nM - fm) < WGM ? (nM - fm) : WGM;
        u.pm = fm + ((wgid % nig) % gsz); u.pn = (wgid % nig) / gsz; return true;
    }
    __device__ __forceinline__ void a_ready(const Unit&) const {}
    __device__ __forceinline__ void done(const Unit&) const {}
};

__device__ __forceinline__ unsigned cvt_pk_bf16(float lo, float hi) { unsigned r; asm volatile("v_cvt_pk_bf16_f32 %0, %1, %2" : "=v"(r) : "v"(lo), "v"(hi)); return r; }

struct EpiInProj {
    static constexpr bool PERM = true, AFTER_DRAIN = false;
    bf16_t *Q, *K, *V, *G; float *kP, *vP, *kS, *vS; float qscale;
    __device__ __forceinline__ void operator()(const f32x4 (&acc)[2][2][4][2], const Unit& u, int wr, int wc, int fr, int fq) const {
        const int pn = u.pn, pm = u.pm;
        bf16_t* dst; int ldc, colbase; float sc = 1.f; float* fo = nullptr;
        if (pn < 2)      { dst = Q; ldc = 512; colbase = pn * 256; sc = qscale; }
        else if (pn < 4) { dst = K; ldc = 512; colbase = (pn - 2) * 256; fo = pm < 64 ? kP : kS; }
        else if (pn < 6) { dst = V; ldc = 512; colbase = (pn - 4) * 256; fo = pm < 64 ? vP : vS; }
        else             { dst = G; ldc = 1792; colbase = (pn - 6) * 256; }
        const int row0 = pm * BM + wr * 64 + fr, cl = colbase + wc * 32 + 8 * fq;
#pragma unroll
        for (int ai = 0; ai < 2; ++ai)
#pragma unroll
            for (int m = 0; m < 4; ++m) { const size_t row = (size_t)(row0 + ai * HALF + m * 16);
#pragma unroll
                for (int bj = 0; bj < 2; ++bj) { const f32x4 a0 = acc[ai][bj][m][0], a1 = acc[ai][bj][m][1]; const int col = cl + bj * HALF;
                    const f32x4 v0 = a0 * sc, v1 = a1 * sc; u32x4 w; w.x = cvt_pk_bf16(v0[0], v0[1]); w.y = cvt_pk_bf16(v0[2], v0[3]); w.z = cvt_pk_bf16(v1[0], v1[1]); w.w = cvt_pk_bf16(v1[2], v1[3]);
                    *(u32x4*)(dst + row * ldc + col) = w;
                    if (fo) { *(f32x4*)(fo + row * 512 + col) = a0; *(f32x4*)(fo + row * 512 + col + 4) = a1; } } }
    }
};
struct EpiRelu2 {
    static constexpr bool PERM = true, AFTER_DRAIN = false;
    bf16_t* O; int ldc;
    __device__ __forceinline__ void operator()(const f32x4 (&acc)[2][2][4][2], const Unit& u, int wr, int wc, int fr, int fq) const {
        const int row0 = u.pm * BM + wr * 64 + fr, col0 = u.pn * BM + wc * 32 + 8 * fq;
#pragma unroll
        for (int ai = 0; ai < 2; ++ai)
#pragma unroll
            for (int m = 0; m < 4; ++m) { bf16_t* rowp = O + (size_t)(row0 + ai * HALF + m * 16) * ldc + col0;
#pragma unroll
                for (int bj = 0; bj < 2; ++bj) { f32x4 v0 = acc[ai][bj][m][0], v1 = acc[ai][bj][m][1];
#pragma unroll
                    for (int e = 0; e < 4; ++e) { const float a = fmaxf(v0[e], 0.f), b = fmaxf(v1[e], 0.f); v0[e] = a * a; v1[e] = b * b; }
                    u32x4 w; w.x = cvt_pk_bf16(v0[0], v0[1]); w.y = cvt_pk_bf16(v0[2], v0[3]); w.z = cvt_pk_bf16(v1[0], v1[1]); w.w = cvt_pk_bf16(v1[2], v1[3]);
                    *(u32x4*)(rowp + bj * HALF) = w; } }
    }
};
struct EpiResGate {
    static constexpr bool PERM = false, AFTER_DRAIN = false;
    const float* baseP; const float* baseS; float* out; const float* gate;
    __device__ __forceinline__ void operator()(const f32x4 (&acc)[2][2][4][2], const Unit& u, int wr, int wc, int fr, int fq) const {
        const int col0 = u.pn * BM + wc * 32 + 4 * fq;
#pragma unroll
        for (int ai = 0; ai < 2; ++ai)
#pragma unroll
            for (int m = 0; m < 4; ++m) { const int row = u.pm * BM + ai * HALF + wr * 64 + m * 16 + fr; const int bidx = row < 16384 ? (row >> 13) : 2 + ((row - 16384) >> 3);
                const float* b = (row < 16384 ? baseP : baseS) + (size_t)row * 1024 + col0; const float* g = gate + (size_t)bidx * 6144 + col0; float* o = out + (size_t)row * 1024 + col0;
#pragma unroll
                for (int bj = 0; bj < 2; ++bj)
#pragma unroll
                    for (int n = 0; n < 2; ++n) { const int c = bj * HALF + n * 16; const f32x4 bs = *(const f32x4*)(b + c), gv = *(const f32x4*)(g + c); *(f32x4*)(o + c) = bs + gv * acc[ai][bj][m][n]; } }
    }
};
template <class Epi, class Sched, bool ALIGN_EPI = false, bool SP2 = false>
__device__ __forceinline__ void gemm_phase(PG8_LAS unsigned char* lds, const Gemm g, const Sched& S, const Epi& E) {
    int tid_ = threadIdx.x; asm volatile("" : "+v"(tid_)); const int tid = tid_, wid = __builtin_amdgcn_readfirstlane(tid >> 6), lane = tid & 63, wr = wid >> 2, wc = wid & 3, fr = lane & 15, fq = lane >> 4;
    const int K = g.K, nt = K / BK;
    unsigned voffA[2], voffB[2];
#pragma unroll
    for (int i = 0; i < 2; ++i) { int R, C; stage_rc(tid * 16 + i * 8192, R, C); const int Rb = Epi::PERM ? ((R & ~31) + perm32(R & 31)) : R;
        voffA[i] = (unsigned)(R * K + C) * 2u; voffB[i] = (unsigned)(Rb * K + C) * 2u; }
    const size_t kstep = (size_t)(BK * 2);
    const size_t hstep = (size_t)HALF * K * 2;
    const size_t tstep = 2 * hstep;
    const unsigned ldsw = (unsigned)wid * 1024u;
    const int aoff = lds_byte(wr * 64 + fr, fq * 8), boff = lds_byte(wc * 32 + fr, fq * 8);
#define PG8_SA(b, h) (((b) * 2 + (h)) * HTB)
#define PG8_SB(b, h) ((4 + (b) * 2 + (h)) * HTB)
#define PG8_STAGE(bufoff, gbase, voff) do { _Pragma("unroll") for (int _i = 0; _i < 2; ++_i) \
        __builtin_amdgcn_global_load_lds((const unsigned*)((const char*)(gbase) + (voff)[_i]), (PG8_LAS unsigned*)(lds + (bufoff) + ldsw + _i * 8192), 16, 0, 0); } while (0)
#define PG8_LDA(dst, b, h) do { _Pragma("unroll") for (int m = 0; m < 4; ++m) _Pragma("unroll") for (int k = 0; k < 2; ++k) dst[m][k] = *(const PG8_LAS bf16x8*)(lds + PG8_SA(b, h) + aoff + m * 2048 + k * 1024); } while (0)
#define PG8_LDB(dst, b, h) do { _Pragma("unroll") for (int n = 0; n < 2; ++n) _Pragma("unroll") for (int k = 0; k < 2; ++k) dst[n][k] = *(const PG8_LAS bf16x8*)(lds + PG8_SB(b, h) + boff + n * 2048 + k * 1024); } while (0)
#define PG8_MMA(ai, bj, At, Bt) do { __builtin_amdgcn_s_setprio(1); _Pragma("unroll") for (int m = 0; m < 4; ++m) _Pragma("unroll") for (int n = 0; n < 2; ++n) _Pragma("unroll") for (int k = 0; k < 2; ++k) \
        acc[ai][bj][m][n] = __builtin_amdgcn_mfma_f32_16x16x32_bf16(Bt[n][k], At[m][k], acc[ai][bj][m][n], 0, 0, 0); __builtin_amdgcn_s_setprio(0); } while (0)
#define PG8_WAIT_V(n) asm volatile("s_waitcnt vmcnt(" #n ")" ::: "memory")
#define PG8_WAIT_L(n) asm volatile("s_waitcnt lgkmcnt(" #n ")" ::: "memory")
#define PG8_BAR __builtin_amdgcn_s_barrier()
#define PG8_SCHED __builtin_amdgcn_sched_barrier(0)
    Unit cur, nxt; int ui = 0;
    if (!S.next(0, cur)) return;
    f32x4 acc[2][2][4][2];
#pragma unroll
    for (int a = 0; a < 2; ++a)
#pragma unroll
        for (int b = 0; b < 2; ++b)
#pragma unroll
            for (int m = 0; m < 4; ++m)
#pragma unroll
                for (int n = 0; n < 2; ++n) acc[a][b][m][n] = (f32x4){0.f, 0.f, 0.f, 0.f};
    bf16x8 At[4][2], B0[2][2], B1[2][2];
    const char* cA = (const char*)g.A + (size_t)cur.pm * tstep; const char* cB = (const char*)g.Bt + (size_t)cur.pn * tstep;
    S.a_ready(cur);
    if constexpr (SP2) {
        PG8_STAGE(PG8_SB(0, 0), cB, voffB); PG8_STAGE(PG8_SB(0, 1), cB + hstep, voffB); PG8_STAGE(PG8_SA(0, 0), cA, voffA); PG8_STAGE(PG8_SA(0, 1), cA + hstep, voffA);
        if (wr == 1) PG8_BAR;
        PG8_WAIT_V(2); PG8_BAR;
        PG8_STAGE(PG8_SB(1, 0), cB + kstep, voffB); PG8_STAGE(PG8_SA(1, 0), cA + kstep, voffA); PG8_STAGE(PG8_SB(1, 1), cB + hstep + kstep, voffB);
        PG8_WAIT_V(6); PG8_BAR;
    } else {
        PG8_STAGE(PG8_SB(0, 0), cB, voffB); PG8_STAGE(PG8_SA(0, 0), cA, voffA); PG8_STAGE(PG8_SB(0, 1), cB + hstep, voffB); PG8_STAGE(PG8_SA(0, 1), cA + hstep, voffA);
        if (wr == 1) PG8_BAR;
        PG8_WAIT_V(4); PG8_BAR;
        PG8_STAGE(PG8_SB(1, 0), cB + kstep, voffB); PG8_STAGE(PG8_SA(1, 0), cA + kstep, voffA); PG8_STAGE(PG8_SB(1, 1), cB + hstep + kstep, voffB);
        PG8_WAIT_V(6); PG8_BAR;
    }
    for (;;) {
        const bool has_next = S.next(ui + 1, nxt);
        const char* nA = has_next ? (const char*)g.A + (size_t)nxt.pm * tstep : cA; const char* nB = has_next ? (const char*)g.Bt + (size_t)nxt.pn * tstep : cB;
        for (int t = 0; t < nt; t += 2) {
            const bool last = (t == nt - 2);
            const char* a1 = cA + (size_t)(t + 1) * kstep;
            const char* a2 = last ? nA : cA + (size_t)(t + 2) * kstep; const char* b2 = last ? nB : cB + (size_t)(t + 2) * kstep;
            const char* a3 = a2 + kstep; const char* b3 = b2 + kstep;
            if (last && has_next) S.a_ready(nxt);
            if constexpr (SP2) {
            PG8_LDB(B0, 0, 0); PG8_LDB(B1, 0, 1); PG8_SCHED; PG8_LDA(At, 0, 0); PG8_STAGE(PG8_SA(1, 1), a1 + hstep, voffA);
            PG8_WAIT_V(8); PG8_WAIT_L(0); PG8_BAR; PG8_MMA(0, 0, At, B0); PG8_MMA(0, 1, At, B1); PG8_BAR; PG8_SCHED;
            PG8_LDA(At, 0, 1); PG8_STAGE(PG8_SB(0, 0), b2, voffB); PG8_STAGE(PG8_SB(0, 1), b2 + hstep, voffB); PG8_STAGE(PG8_SA(0, 0), a2, voffA);
            PG8_WAIT_V(8); PG8_WAIT_L(0); PG8_BAR; PG8_MMA(1, 0, At, B0); PG8_MMA(1, 1, At, B1); PG8_BAR; PG8_SCHED;
            PG8_LDB(B0, 1, 0); PG8_LDB(B1, 1, 1); PG8_SCHED; PG8_LDA(At, 1, 0); PG8_STAGE(PG8_SA(0, 1), a2 + hstep, voffA);
            PG8_WAIT_V(8); PG8_WAIT_L(0); PG8_BAR; PG8_MMA(0, 0, At, B0); PG8_MMA(0, 1, At, B1); PG8_BAR; PG8_SCHED;
            PG8_LDA(At, 1, 1); PG8_STAGE(PG8_SB(1, 0), b3, voffB); PG8_STAGE(PG8_SB(1, 1), b3 + hstep, voffB); PG8_STAGE(PG8_SA(1, 0), a3, voffA);
            PG8_WAIT_V(8); PG8_WAIT_L(0); PG8_BAR; PG8_MMA(1, 0, At, B0); PG8_MMA(1, 1, At, B1); PG8_BAR; PG8_SCHED;
            } else {
            PG8_LDB(B0, 0, 0); PG8_SCHED; PG8_LDA(At, 0, 0); PG8_STAGE(PG8_SA(1, 1), a1 + hstep, voffA);
            PG8_WAIT_L(8); PG8_BAR; PG8_WAIT_L(0); PG8_MMA(0, 0, At, B0); PG8_BAR; PG8_SCHED;
            PG8_LDB(B1, 0, 1); PG8_STAGE(PG8_SB(0, 0), b2, voffB);
            PG8_BAR; PG8_WAIT_L(0); PG8_MMA(0, 1, At, B1); PG8_BAR;
            PG8_LDA(At, 0, 1); PG8_STAGE(PG8_SA(0, 0), a2, voffA);
            PG8_BAR; PG8_WAIT_L(0); PG8_MMA(1, 0, At, B0); PG8_BAR; PG8_SCHED;
            PG8_STAGE(PG8_SB(0, 1), b2 + hstep, voffB);
            PG8_WAIT_V(6); PG8_BAR; PG8_MMA(1, 1, At, B1); PG8_BAR;
            PG8_LDB(B0, 1, 0); PG8_SCHED; PG8_LDA(At, 1, 0); PG8_STAGE(PG8_SA(0, 1), a2 + hstep, voffA);
            PG8_WAIT_L(8); PG8_BAR; PG8_WAIT_L(0); PG8_MMA(0, 0, At, B0); PG8_BAR; PG8_SCHED;
            PG8_LDB(B1, 1, 1); PG8_STAGE(PG8_SB(1, 0), b3, voffB);
            PG8_BAR; PG8_WAIT_L(0); PG8_MMA(0, 1, At, B1); PG8_BAR;
            PG8_LDA(At, 1, 1); PG8_STAGE(PG8_SA(1, 0), a3, voffA);
            PG8_BAR; PG8_WAIT_L(0); PG8_MMA(1, 0, At, B0); PG8_BAR; PG8_SCHED;
            PG8_STAGE(PG8_SB(1, 1), b3 + hstep, voffB);
            PG8_WAIT_V(6); PG8_BAR; PG8_MMA(1, 1, At, B1); PG8_BAR;
            }
        }
        if constexpr (ALIGN_EPI) { if (wr == 0) PG8_BAR; }
        if constexpr (!Epi::AFTER_DRAIN) { E(acc, cur, wr, wc, fr, fq); S.done(cur); }
        if (!has_next) break;
#pragma unroll
        for (int a = 0; a < 2; ++a)
#pragma unroll
            for (int b = 0; b < 2; ++b)
#pragma unroll
                for (int m = 0; m < 4; ++m)
#pragma unroll
                    for (int n = 0; n < 2; ++n) acc[a][b][m][n] = (f32x4){0.f, 0.f, 0.f, 0.f};
        cur = nxt; cA = nA; cB = nB; ++ui;
        if constexpr (ALIGN_EPI) { if (wr == 1) PG8_BAR; }
    }
    PG8_WAIT_V(0);
    if constexpr (!ALIGN_EPI) { if (wr == 0) PG8_BAR; }
    PG8_BAR;
    if constexpr (Epi::AFTER_DRAIN) { E.fused(acc, cur, wr, wc, fr, fq, lds, wid, lane); S.done(cur); }
#undef PG8_SA
#undef PG8_SB
#undef PG8_STAGE
#undef PG8_LDA
#undef PG8_LDB
#undef PG8_MMA
#undef PG8_WAIT_V
#undef PG8_WAIT_L
#undef PG8_BAR
#undef PG8_SCHED
}
}
constexpr int NWAVES = 8;
constexpr int D = 1024, TP = 8192, MP = 16384, MS = 256, M = MP + MS, FF = 4096, NIN = 3328, NIN_REAL = 3088, NMODR = 34, MODW = 6144;
constexpr float NORM_EPS = 1e-6f;
constexpr float QSCALE = 0.125f * 1.4426950408889634f;
constexpr size_t OY = 0, OK_P = 17039360, OV_P = 25427968, OSG_P = 33816576, OK_S = 33882112, OV_S = 34013184, OSG_S = 34144256, OUT_TOTAL = 35192832;
constexpr size_t MiB = 1u << 20;
constexpr size_t WS_CTL = 0, CTL_ZERO_BYTES = 1 * MiB;
constexpr size_t WS_MOD = 1 * MiB, WS_WIN = 2 * MiB, WS_WO = 9 * MiB, WS_WUP = 11 * MiB, WS_WDN = 19 * MiB;
constexpr size_t WS_SLOC = 27 * MiB, WS_DSEG = 35 * MiB, WS_DPART = 36 * MiB, WS_DRTOT = 40 * MiB;
constexpr size_t WS_XN = 48 * MiB, WS_Q = 82 * MiB, WS_K = 99 * MiB, WS_V = 116 * MiB, WS_G = 133 * MiB, WS_MIX = 190 * MiB, WS_X1 = 224 * MiB, WS_H = 290 * MiB, WS_END = 421 * MiB;
static_assert(WS_WIN + (size_t)NIN * D * 2 <= WS_WO && WS_G + (size_t)M * 1792 * 2 <= WS_MIX && WS_MIX + (size_t)M * D * 2 <= WS_X1 && WS_X1 + (size_t)M * D * 4 <= WS_H && WS_H + (size_t)M * FF * 2 <= WS_END, "d_ws map");
static_assert(WS_XN + (size_t)M * D * 2 <= WS_Q && WS_Q + (size_t)M * 512 * 2 <= WS_K && WS_K + (size_t)M * 512 * 2 <= WS_V && WS_V + (size_t)M * 512 * 2 <= WS_G, "d_ws map 2");
constexpr int CW_BAR = 4096, CW_DEC = 16384;
constexpr int RING_BYTES = 139264, MISC_OFF = 146944, LDS_BYTES = 147456;

#define GAS __attribute__((address_space(1)))
#define LAS __attribute__((address_space(3)))
typedef unsigned short bf16;
typedef unsigned v4u __attribute__((ext_vector_type(4)));
typedef float f32x4 __attribute__((ext_vector_type(4)));
#define LDS_WAIT() asm volatile("s_waitcnt lgkmcnt(0)" ::: "memory")
__device__ __forceinline__ unsigned f2bf(float f) { unsigned u = __builtin_bit_cast(unsigned, f); return (u + 0x7fffu + ((u >> 16) & 1u)) >> 16; }
__device__ __forceinline__ unsigned pk2(float lo, float hi) { return f2bf(lo) | (f2bf(hi) << 16); }
#define XB_TMO      128
#define XB_XCNT(j)  (256  + 64 * (j))
#define XB_XSUB(j)  (1280 + 64 * (j))
#define XB_XGEN(j)  (2304 + 64 * (j))
#define XB_TOP      3328
#define XB_TOPGEN   3392
#define XCD_BAR_WORDS 3456
#define XB_SPIN_CAP (1u << 18)

__device__ __forceinline__ unsigned xb_ld(unsigned* p)              { return __hip_atomic_load(p, __ATOMIC_RELAXED, __HIP_MEMORY_SCOPE_AGENT); }
__device__ __forceinline__ unsigned xb_add(unsigned* p, unsigned v) { return __hip_atomic_fetch_add(p, v, __ATOMIC_RELAXED, __HIP_MEMORY_SCOPE_AGENT); }
__device__ __forceinline__ unsigned xb_xcc_id() { return (unsigned)__builtin_amdgcn_s_getreg((3 << 11) | 20) & 0xFu; }
#define XB_SPIN(cond, bar) do { unsigned _sp = 0; while (cond) { __builtin_amdgcn_s_sleep(1); \
    if ((++_sp & 255u) == 0u) { if (xb_ld(&(bar)[XB_TMO])) break; if (_sp > XB_SPIN_CAP) { atomicAdd(&(bar)[XB_TMO], 1u); break; } } } } while (0)

struct XcdBarrier {
    unsigned* bar; unsigned x;
    volatile LAS unsigned* st;
};

__device__ __forceinline__ XcdBarrier xcd_barrier_post(unsigned* bar, volatile LAS unsigned* st) {
    XcdBarrier b; b.bar = bar; b.x = xb_xcc_id(); b.st = st;
    if (threadIdx.x == 0) (void)xb_add(&bar[XB_XCNT(b.x)], 1u);
    return b;
}
__device__ __forceinline__ void xcd_barrier_complete(unsigned* bar, unsigned x, unsigned& nloc, unsigned& nx) {
    const unsigned G = gridDim.x * gridDim.y * gridDim.z;
    unsigned sum, cnt, mine, sp = 0u;
    for (;;) {
        sum = 0u; cnt = 0u; mine = 0u;
#pragma unroll
        for (unsigned j = 0; j < 16; ++j) { const unsigned c = xb_ld(&bar[XB_XCNT(j)]); sum += c; cnt += (c > 0u) ? 1u : 0u; mine = (j == x) ? c : mine; }
        if (sum == G) break;
        __builtin_amdgcn_s_sleep(1);
        if ((++sp & 255u) == 0u) { if (xb_ld(&bar[XB_TMO])) break; if (sp > XB_SPIN_CAP) { atomicAdd(&bar[XB_TMO], 1u); break; } }
    }
    nloc = mine > 0u ? mine : 1u; nx = cnt > 0u ? cnt : 1u;
}

__device__ __forceinline__ void xcd_barrier(const XcdBarrier& b) {
    asm volatile("s_waitcnt vmcnt(0)" ::: "memory");
    __syncthreads();
    if (threadIdx.x == 0) {
        unsigned* bar = b.bar;
        __builtin_amdgcn_s_waitcnt(0);
        unsigned nloc = b.st[0], nx = b.st[1];
        if (nloc == 0u) { xcd_barrier_complete(bar, b.x, nloc, nx); b.st[0] = nloc; b.st[1] = nx; }
        const unsigned old = xb_add(&bar[XB_XSUB(b.x)], 1u);
        const unsigned gen = old / nloc;
        if (old + 1u == (gen + 1u) * nloc) {
            __builtin_amdgcn_fence(__ATOMIC_RELEASE, "agent");
            asm volatile("s_waitcnt vmcnt(0)" ::: "memory");
            const unsigned og = xb_add(&bar[XB_TOP], 1u);
            const unsigned tg = og / nx;
            if (og + 1u == (tg + 1u) * nx) xb_add(&bar[XB_TOPGEN], 1u);
            else XB_SPIN(xb_ld(&bar[XB_TOPGEN]) == tg, bar);
            __builtin_amdgcn_fence(__ATOMIC_ACQUIRE, "agent");
            xb_add(&bar[XB_XGEN(b.x)], 1u);
            asm volatile("s_waitcnt vmcnt(0)" ::: "memory");
        } else {
            XB_SPIN(xb_ld(&bar[XB_XGEN(b.x)]) == gen, bar);
            __builtin_amdgcn_fence(__ATOMIC_ACQUIRE, "agent");
            asm volatile("s_waitcnt vmcnt(0)" ::: "memory");
        }
    }
    __syncthreads();
}
namespace sba {
using bf16x8=__attribute__((ext_vector_type(8)))short;
using s16x4=__attribute__((ext_vector_type(4)))short;
using f32x16=__attribute__((ext_vector_type(16)))float;
using u32x4=__attribute__((ext_vector_type(4)))unsigned;
typedef __hip_bfloat16 bf16;
constexpr int SEQ=8192,D=64,DM=512,OP=1024;
constexpr int NW=8,QBLK=32,QB=QBLK*NW,KVBLK=64;
constexpr int NSLOT=3,SLOTB=8192;
constexpr int LDS_K=0,LDS_V=NSLOT*SLOTB,LDS_OST=2*NSLOT*SLOTB,LDS_BYTES=LDS_OST+NW*4096;
__device__ __forceinline__ int crow(int r,int hi){return (r&3)+8*(r>>2)+4*hi;}
__device__ __forceinline__ void glds16(const void*gsrc,unsigned lds_dst){unsigned keep;
  asm volatile("s_mov_b32 %0, m0\n\ts_mov_b32 m0, %2\n\ts_nop 0\n\tglobal_load_lds_dwordx4 %1, off\n\ts_mov_b32 m0, %0":"=&s"(keep):"v"(gsrc),"s"(lds_dst):"memory");}
typedef float f32x2_t __attribute__((ext_vector_type(2))); typedef __bf16 bf16x2_t __attribute__((ext_vector_type(2)));
__device__ __forceinline__ unsigned cvtpk_s(float lo,float hi){f32x2_t v={lo,hi};bf16x2_t b=__builtin_convertvector(v,bf16x2_t);return __builtin_bit_cast(unsigned,b);}
typedef __attribute__((address_space(3))) const char* lds_cptr;
typedef short v4i16_t __attribute__((ext_vector_type(4)));
__device__ __forceinline__ s16x4 vtr(lds_cptr p){ return __builtin_bit_cast(s16x4,__builtin_amdgcn_ds_read_tr16_b64_v4i16((__attribute__((address_space(3))) v4i16_t*)p)); }
#define SBA_MFMA(a,b,c) __builtin_amdgcn_mfma_f32_32x32x16_bf16((a),(b),(c),0,0,0)
template<bool MASK> __device__ __forceinline__ void sb_weights(f32x16&c0,f32x16&c1,float&carry,int hi,int jb,int qrel){
  #pragma unroll
  for(int r=0;r<16;++r){
    float e0=__builtin_amdgcn_exp2f(c0[r]), e1=__builtin_amdgcn_exp2f(c1[r]);
    if(MASK){ const int kv=64*jb+crow(r,hi); if(kv>=qrel)e0=0.f; if(kv+32>=qrel)e1=0.f; }
    c0[r]=1.f+e0; c1[r]=1.f+e1; }
  float P2[8],P3[8],T[8];
  #pragma unroll
  for(int c=0;c<4;++c){ P2[c]=c0[4*c]*c0[4*c+1]; P3[c]=P2[c]*c0[4*c+2]; T[c]=__builtin_amdgcn_rcpf(P3[c]*c0[4*c+3]);
                        P2[4+c]=c1[4*c]*c1[4*c+1]; P3[4+c]=P2[4+c]*c1[4*c+2]; T[4+c]=__builtin_amdgcn_rcpf(P3[4+c]*c1[4*c+3]); }
  float Tl[8],Th[8];
  #pragma unroll
  for(int c=0;c<8;++c){ auto rr=__builtin_amdgcn_permlane32_swap(__float_as_uint(T[c]),__float_as_uint(T[c]),false,false); Tl[c]=__uint_as_float(rr[0]); Th[c]=__uint_as_float(rr[1]); }
  float E=carry;
  float off[8];
  #pragma unroll
  for(int c=7;c>=0;--c){ off[c]=hi?E:E*Th[c]; E=E*(Tl[c]*Th[c]); }
  carry=E;
  #pragma unroll
  for(int c=0;c<4;++c){
    { const float g=T[c]*off[c], R1=c0[4*c]*g, R2=P2[c]*g, R3=P3[c]*g; c0[4*c]=R1-g; c0[4*c+1]=R2-R1; c0[4*c+2]=R3-R2; c0[4*c+3]=off[c]-R3; }
    { const float g=T[4+c]*off[4+c], R1=c1[4*c]*g, R2=P2[4+c]*g, R3=P3[4+c]*g; c1[4*c]=R1-g; c1[4*c+1]=R2-R1; c1[4*c+2]=R3-R2; c1[4*c+3]=off[4+c]-R3; } }
}
__device__ __forceinline__ void pv(f32x16*o,lds_cptr vp,const f32x16&w0,const f32x16&w1){
  u32x4 pw[4];
  #pragma unroll
  for(int k=0;k<2;++k)
    #pragma unroll
    for(int j=0;j<4;++j){ pw[k][j]=cvtpk_s(w0[8*k+2*j],w0[8*k+2*j+1]); pw[2+k][j]=cvtpk_s(w1[8*k+2*j],w1[8*k+2*j+1]); }
  #pragma unroll
  for(int d0=0;d0<2;++d0)
    #pragma unroll
    for(int ks=0;ks<4;++ks){ const s16x4 lo=vtr(vp+d0*4096+ks*1024), hh=vtr(vp+d0*4096+ks*1024+512);
      const bf16x8 vf={lo[0],lo[1],lo[2],lo[3],hh[0],hh[1],hh[2],hh[3]};
      o[d0]=SBA_MFMA(__builtin_bit_cast(bf16x8,pw[ks]),vf,o[d0]); }
}
__device__ __forceinline__ void attn_unit(int b,int h,int qb,const bf16*Q,const bf16*__restrict__ K,const bf16*__restrict__ V,bf16*O,char*shm,float bias2){
  int tid_=threadIdx.x; asm volatile("":"+v"(tid_)); const int tid=tid_,lane=tid&63,r32=lane&31,hi=lane>>5; const int wid=__builtin_amdgcn_readfirstlane(tid>>6);
  const long rowbase=(long)b*SEQ; const int q0=qb*QB;
  const bf16*Qw=Q+(rowbase+q0+wid*QBLK)*DM+h*D;
  const bf16*Kh=K+rowbase*DM+h*D,*Vh=V+rowbase*DM+h*D;
  const unsigned lds0=(unsigned)(uintptr_t)shm;
  const bf16*ksrc=Kh+(long)lane*DM+wid*8;
  const bf16*vsrc=Vh+(long)(16*(wid&3)+(lane>>2))*DM+(wid>>2)*32+(lane&3)*8;
  const unsigned kdst=lds0+LDS_K+wid*1024, vdst=lds0+LDS_V+wid*1024;
  const int NT=(q0+QB)/KVBLK;
  #define DMA_KV(s_,slot_) do{ const long t_=(long)(NT-1-(s_))*KVBLK*DM; glds16(ksrc+t_,(unsigned)__builtin_amdgcn_readfirstlane(kdst+(slot_)*SLOTB)); glds16(vsrc+t_,(unsigned)__builtin_amdgcn_readfirstlane(vdst+(slot_)*SLOTB)); }while(0)
  bf16x8 qr[4];
  #pragma unroll
  for(int d0=0;d0<4;++d0)qr[d0]=*reinterpret_cast<const bf16x8*>(&Qw[(long)r32*DM+d0*16+hi*8]);
  DMA_KV(0,0); DMA_KV(1,1);
  const lds_cptr shm3=(lds_cptr)shm; const lds_cptr kp0=shm3+LDS_K+hi*1024+r32*16; const lds_cptr vp0=shm3+LDS_V+((lane>>4)&1)*32+(lane&3)*8+(4*hi+((lane&15)>>2))*64;
  f32x16 o[2];o[0]=f32x16{};o[1]=f32x16{}; f32x16 bv;
  #pragma unroll
  for(int r=0;r<16;++r)bv[r]=bias2;
  asm volatile("":"+v"(bv));
  float carry=1.f; const int qrel=wid*QBLK+r32;
  int slot=0;
  for(int s=0;s<NT;++s){
    if(s+1<NT) asm volatile("s_waitcnt vmcnt(2) lgkmcnt(0)\n\ts_barrier":::"memory"); else asm volatile("s_waitcnt vmcnt(0) lgkmcnt(0)\n\ts_barrier":::"memory");
    if(s+2<NT){ const int ns=(slot==0)?2:slot-1; DMA_KV(s+2,ns); }
    const lds_cptr kp=kp0+slot*SLOTB;
    f32x16 c0=bv,c1=bv;
    #pragma unroll
    for(int d0=0;d0<4;++d0){
      const bf16x8 k0=*(const __attribute__((address_space(3))) bf16x8*)(kp+d0*2048), k1=*(const __attribute__((address_space(3))) bf16x8*)(kp+d0*2048+512);
      c0=SBA_MFMA(k0,qr[d0],c0); c1=SBA_MFMA(k1,qr[d0],c1); }
    if(s<4) sb_weights<true>(c0,c1,carry,hi,3-s,qrel); else sb_weights<false>(c0,c1,carry,hi,0,0);
    pv(o,vp0+slot*SLOTB,c0,c1);
    slot=(slot==2)?0:slot+1;
  }
  #undef DMA_KV
  bf16*Ow=O+(rowbase+q0+wid*QBLK)*OP+h*D;
  { bf16*stg=(bf16*)(shm+LDS_OST)+wid*2048;
    #pragma unroll
    for(int r=0;r<16;++r){const int orow=crow(r,hi);
      #pragma unroll
      for(int d0=0;d0<2;++d0)stg[orow*64+d0*32+r32]=__float2bfloat16(o[d0][r]);}
    asm volatile("s_waitcnt lgkmcnt(0)":::"memory");
    #pragma unroll
    for(int i=0;i<4;++i){const int row=i*8+(lane>>3),ch=lane&7; const u32x4 v=*(const u32x4*)(stg+row*64+ch*8); *(u32x4*)(Ow+(long)row*OP+ch*8)=v;} }
  asm volatile("s_waitcnt vmcnt(0) lgkmcnt(0)\n\ts_barrier":::"memory");
}
}
namespace sb8 {
typedef sba::bf16 bf16; using sba::bf16x8; using sba::s16x4; using sba::f32x16; using sba::u32x4; using sba::lds_cptr; using sba::glds16; using sba::vtr;
constexpr int SEQ=sba::SEQ,D=sba::D,DM=sba::DM,OP=sba::OP,QBLK=sba::QBLK,QB=sba::QB,KVBLK=sba::KVBLK,NSLOT=sba::NSLOT,SLOTB=sba::SLOTB;
constexpr int LDS_K=sba::LDS_K,LDS_V=sba::LDS_V,LDS_OST=sba::LDS_OST;
__device__ __forceinline__ unsigned cvtpk_a(float lo,float hi){ unsigned r; asm("v_cvt_pk_bf16_f32 %0, %1, %2":"=v"(r):"v"(lo),"v"(hi)); return r; }
template<bool MASK> __device__ __forceinline__ void weights(f32x16&c0,f32x16&c1,float&carry,int hi,int thr){
  #pragma unroll
  for(int r=0;r<16;++r){ float e0=__builtin_amdgcn_exp2f(c0[r]), e1=__builtin_amdgcn_exp2f(c1[r]);
    if(MASK){ if(r>=thr)e0=0.f; if(32+r>=thr)e1=0.f; }
    c0[r]=e0; c1[r]=e1; }
  float q0=1.f+c0[0], q1=1.f+c1[0];
  #pragma unroll
  for(int r=1;r<16;++r){ const float e0=c0[r], e1=c1[r]; c0[r]=q0*e0; c1[r]=q1*e1; q0=__builtin_fmaf(q0,e0,q0); q1=__builtin_fmaf(q1,e1,q1); }
  const float t0=__builtin_amdgcn_rcpf(q0), t1=__builtin_amdgcn_rcpf(q1);
  auto s1=__builtin_amdgcn_permlane32_swap(__float_as_uint(t1),__float_as_uint(t1),false,false);
  auto s0=__builtin_amdgcn_permlane32_swap(__float_as_uint(t0),__float_as_uint(t0),false,false);
  const float t1l=__uint_as_float(s1[0]),t1h=__uint_as_float(s1[1]),t0l=__uint_as_float(s0[0]),t0h=__uint_as_float(s0[1]);
  const float off1=hi?carry:carry*t1h; const float E=carry*(t1l*t1h);
  const float off0=hi?E:E*t0h; carry=E*(t0l*t0h);
  const float g1=t1*off1, g0=t0*off0;
  #pragma unroll
  for(int r=0;r<16;++r){ c0[r]*=g0; c1[r]*=g1; }
}
__device__ __forceinline__ void pv(f32x16*o,lds_cptr vp,const f32x16&w0,const f32x16&w1){
  u32x4 pw[4];
  #pragma unroll
  for(int k=0;k<2;++k)
    #pragma unroll
    for(int j=0;j<4;++j){ pw[k][j]=cvtpk_a(w0[8*k+2*j],w0[8*k+2*j+1]); pw[2+k][j]=cvtpk_a(w1[8*k+2*j],w1[8*k+2*j+1]); }
  #pragma unroll
  for(int d0=0;d0<2;++d0)
    #pragma unroll
    for(int ks=0;ks<4;++ks){ const s16x4 lo=vtr(vp+d0*4096+(ks>>1)*2048+(ks&1)*512), hh=vtr(vp+d0*4096+(ks>>1)*2048+(ks&1)*512+256);
      const bf16x8 vf={lo[0],lo[1],lo[2],lo[3],hh[0],hh[1],hh[2],hh[3]};
      o[d0]=SBA_MFMA(__builtin_bit_cast(bf16x8,pw[ks]),vf,o[d0]); }
}
__device__ __forceinline__ void qk(f32x16&c0,f32x16&c1,lds_cptr kp,const bf16x8*qr,const f32x16&bv){
  bf16x8 kf[8];
  #pragma unroll
  for(int d0=0;d0<4;++d0){ kf[2*d0]=*(const __attribute__((address_space(3))) bf16x8*)(kp+d0*2048); kf[2*d0+1]=*(const __attribute__((address_space(3))) bf16x8*)(kp+d0*2048+512); }
  c0=SBA_MFMA(kf[0],qr[0],bv); c1=SBA_MFMA(kf[1],qr[0],bv);
  #pragma unroll
  for(int d0=1;d0<4;++d0){ c0=SBA_MFMA(kf[2*d0],qr[d0],c0); c1=SBA_MFMA(kf[2*d0+1],qr[d0],c1); }
}
__device__ __forceinline__ void attn_unit(int b,int h,int qb,const bf16*Q,const bf16*__restrict__ K,const bf16*__restrict__ V,bf16*O,char*shm,float bias2){
  int tid_=threadIdx.x; asm volatile("":"+v"(tid_)); const int tid=tid_,lane=tid&63,r32=lane&31,hi=lane>>5; const int wid=__builtin_amdgcn_readfirstlane(tid>>6);
  const long rowbase=(long)b*SEQ; const int q0=qb*QB;
  const bf16*Qw=Q+(rowbase+q0+wid*QBLK)*DM+h*D;
  const bf16*Kh=K+rowbase*DM+h*D,*Vh=V+rowbase*DM+h*D;
  const unsigned lds0=(unsigned)(uintptr_t)shm;
  const bf16*ksrc=Kh+(long)lane*DM+wid*8;
  const bf16*vsrc=Vh+(long)(16*(wid&3)+(lane>>2))*DM+(wid>>2)*32+(lane&3)*8;
  const unsigned kdst=lds0+LDS_K+wid*1024, vdst=lds0+LDS_V+wid*1024;
  const int NT=(q0+QB)/KVBLK;
  #define DMA8_K(s_,slot_) do{ const long t_=(long)(NT-1-(s_))*KVBLK*DM; glds16(ksrc+t_,(unsigned)__builtin_amdgcn_readfirstlane(kdst+(slot_)*SLOTB)); }while(0)
  #define DMA8_V(s_,slot_) do{ const long t_=(long)(NT-1-(s_))*KVBLK*DM; glds16(vsrc+t_,(unsigned)__builtin_amdgcn_readfirstlane(vdst+(slot_)*SLOTB)); }while(0)
  bf16x8 qr[4];
  #pragma unroll
  for(int d0=0;d0<4;++d0)qr[d0]=*reinterpret_cast<const bf16x8*>(&Qw[(long)r32*DM+d0*16+hi*8]);
  DMA8_K(0,0);
  DMA8_K(1,1); DMA8_V(0,0);
  DMA8_K(2,2); DMA8_V(1,1);
  const int kperm=16*((r32>>2)&1)+(r32&3)+4*(r32>>3);
  const lds_cptr shm3=(lds_cptr)shm; const lds_cptr kp0=shm3+LDS_K+hi*1024+kperm*16; const lds_cptr vp0=shm3+LDS_V+((lane>>4)&1)*32+(lane&3)*8+(16*hi+((lane&15)>>2))*64;
  f32x16 o[2];o[0]=f32x16{};o[1]=f32x16{}; f32x16 bv;
  #pragma unroll
  for(int r=0;r<16;++r)bv[r]=bias2;
  asm volatile("":"+v"(bv));
  float carry=1.f; const int qrel=wid*QBLK+r32;
  f32x16 a0,a1,b0,b1;
  asm volatile("s_waitcnt vmcnt(4) lgkmcnt(0)\n\ts_barrier":::"memory");
  qk(a0,a1,kp0,qr,bv);
  int ks1=1,vs0=0;
  #define STEP8(C0,C1,N0,N1,st_) do{ const int st=(st_); \
    if(st+2<NT) asm volatile("s_waitcnt vmcnt(2) lgkmcnt(0)\n\ts_barrier":::"memory"); else if(st+2==NT) asm volatile("s_waitcnt vmcnt(1) lgkmcnt(0)\n\ts_barrier":::"memory"); else asm volatile("s_waitcnt vmcnt(0) lgkmcnt(0)\n\ts_barrier":::"memory"); \
    { const int kfree=(ks1==0)?2:ks1-1; const int vfree=(vs0==0)?2:vs0-1; if(st+3<NT) DMA8_K(st+3,kfree); if(st+2<NT) DMA8_V(st+2,vfree); } \
    if(st+1<NT) qk(N0,N1,kp0+ks1*SLOTB,qr,bv); \
    __builtin_amdgcn_sched_barrier(0); \
    if(st<4) weights<true>(C0,C1,carry,hi,qrel-64*(3-st)-16*hi); else weights<false>(C0,C1,carry,hi,0); \
    pv(o,vp0+vs0*SLOTB,C0,C1); \
    ks1=(ks1==2)?0:ks1+1; vs0=(vs0==2)?0:vs0+1; }while(0)
  for(int it=0;it<NT;it+=2){ STEP8(a0,a1,b0,b1,it); STEP8(b0,b1,a0,a1,it+1); }
  #undef STEP8
  #undef DMA8_K
  #undef DMA8_V
  bf16*Ow=O+(rowbase+q0+wid*QBLK)*OP+h*D;
  { bf16*stg=(bf16*)(shm+LDS_OST)+wid*2048;
    #pragma unroll
    for(int r=0;r<16;++r){const int orow=sba::crow(r,hi);
      #pragma unroll
      for(int d0=0;d0<2;++d0)stg[orow*64+d0*32+r32]=__float2bfloat16(o[d0][r]);}
    asm volatile("s_waitcnt lgkmcnt(0)":::"memory");
    #pragma unroll
    for(int i=0;i<4;++i){const int row=i*8+(lane>>3),ch=lane&7; const u32x4 v=*(const u32x4*)(stg+row*64+ch*8); *(u32x4*)(Ow+(long)row*OP+ch*8)=v;} }
  asm volatile("s_waitcnt vmcnt(0) lgkmcnt(0)\n\ts_barrier":::"memory");
}
}
namespace sbd {
using sba::bf16x8; using sba::f32x16; using sba::u32x4; using sba::bf16; using sba::crow; using sba::cvtpk_s;
typedef float f32x4 __attribute__((ext_vector_type(4)));
#define RLXA __ATOMIC_RELAXED, __HIP_MEMORY_SCOPE_AGENT
template<bool NEWK> __device__ __forceinline__ void weights32(f32x16&c,float&carry,int hi,int q){
  #pragma unroll
  for(int r=0;r<16;++r){ float e=__builtin_amdgcn_exp2f(c[r]);
    if(NEWK){ const int kv=crow(r,hi); if(kv>=8||kv>=q)e=0.f; }
    c[r]=1.f+e; }
  float P2[4],P3[4],T[4],Tl[4],Th[4],off[4];
  #pragma unroll
  for(int k=0;k<4;++k){ P2[k]=c[4*k]*c[4*k+1]; P3[k]=P2[k]*c[4*k+2]; T[k]=__builtin_amdgcn_rcpf(P3[k]*c[4*k+3]); }
  #pragma unroll
  for(int k=0;k<4;++k){ auto s=__builtin_amdgcn_permlane32_swap(__float_as_uint(T[k]),__float_as_uint(T[k]),false,false); Tl[k]=__uint_as_float(s[0]); Th[k]=__uint_as_float(s[1]); }
  float E=carry;
  #pragma unroll
  for(int k=3;k>=0;--k){ off[k]=hi?E:E*Th[k]; E=E*(Tl[k]*Th[k]); }
  carry=E;
  #pragma unroll
  for(int k=0;k<4;++k){ const float g=T[k]*off[k], R1=c[4*k]*g, R2=P2[k]*g, R3=P3[k]*g; c[4*k]=R1-g; c[4*k+1]=R2-R1; c[4*k+2]=R3-R2; c[4*k+3]=off[k]-R3; }
}
struct Raw { f32x4 k[8]; float v[32]; };
typedef unsigned u32x2v __attribute__((ext_vector_type(2)));
__device__ __forceinline__ void load_tile(Raw&R,__amdgpu_buffer_rsrc_t rk,__amdgpu_buffer_rsrc_t rv,unsigned ub,int kvo,int vvo){
  #pragma unroll
  for(int i=0;i<8;++i) R.k[i]=__builtin_bit_cast(f32x4,__builtin_amdgcn_raw_buffer_load_b128(rk,kvo,(int)(ub+(unsigned)i*8192u),2));
  #pragma unroll
  for(int ks=0;ks<2;++ks)
    #pragma unroll
    for(int j=0;j<8;++j){ const unsigned so=ub+(unsigned)(16*ks+8*(j>>2)+(j&3))*2048u;
      #pragma unroll
      for(int d0=0;d0<2;++d0) R.v[(d0*2+ks)*8+j]=__uint_as_float(__builtin_amdgcn_raw_buffer_load_b32(rv,vvo+128*d0,(int)so,2)); }
}
struct Frag { bf16x8 k[4]; bf16x8 v[4]; };
__device__ __forceinline__ void cvt_tile(Frag&F,const Raw&R,__attribute__((address_space(3))) char*kl,int kwo,int kro){
  #pragma unroll
  for(int i=0;i<8;++i){ u32x2v p; p[0]=cvtpk_s(R.k[i][0],R.k[i][1]); p[1]=cvtpk_s(R.k[i][2],R.k[i][3]); *(__attribute__((address_space(3))) u32x2v*)(kl+kwo+i*576)=p; }
  #pragma unroll
  for(int i=0;i<4;++i){ u32x4 p;
    #pragma unroll
    for(int j=0;j<4;++j) p[j]=cvtpk_s(R.v[8*i+2*j],R.v[8*i+2*j+1]);
    F.v[i]=__builtin_bit_cast(bf16x8,p); }
  #pragma unroll
  for(int d0=0;d0<4;++d0) F.k[d0]=*(const __attribute__((address_space(3))) bf16x8*)(kl+kro+32*d0);
}
template<bool NEWK> __device__ __forceinline__ void tile_step(const Frag&F,const bf16x8*qr,const float bias2,f32x16*o,float&carry,int hi,int q){
  f32x16 c;
  #pragma unroll
  for(int r=0;r<16;++r)c[r]=bias2;
  #pragma unroll
  for(int d0=0;d0<4;++d0) c=SBA_MFMA(F.k[d0],qr[d0],c);
  weights32<NEWK>(c,carry,hi,q);
  u32x4 pw[2];
  #pragma unroll
  for(int k=0;k<2;++k)
    #pragma unroll
    for(int j=0;j<4;++j) pw[k][j]=cvtpk_s(c[8*k+2*j],c[8*k+2*j+1]);
  #pragma unroll
  for(int d0=0;d0<2;++d0)
    #pragma unroll
    for(int ks=0;ks<2;++ks) o[d0]=SBA_MFMA(__builtin_bit_cast(bf16x8,pw[ks]),F.v[d0*2+ks],o[d0]);
}
__device__ __forceinline__ void decode_wave(int smp,int j,int h,const float*cache_k,const float*cache_v,const int*page_table,const bf16*Q,const bf16*Kn,const bf16*Vn,const float*b_sb,
                                            float*part,float*rtot,unsigned*cnt,bf16*MIX,__attribute__((address_space(3))) char*kl){
  int tid_=threadIdx.x; asm volatile("":"+v"(tid_)); const int lane=tid_&63,r32=lane&31,hi=lane>>5;
  const float bias2=b_sb[h]*1.4426950408889634f;
  const long srow=16384+8*smp;
  bf16x8 qr[4];
  #pragma unroll
  for(int d0=0;d0<4;++d0){ bf16x8 z={0,0,0,0,0,0,0,0}; if(r32<8) z=*reinterpret_cast<const bf16x8*>(Q+(srow+r32)*512+h*64+d0*16+hi*8); qr[d0]=z; }
  f32x16 o[2]; o[0]=f32x16{}; o[1]=f32x16{}; float carry=1.f;
  if(j==7){
    Frag F;
    #pragma unroll
    for(int d0=0;d0<4;++d0){ bf16x8 z={0,0,0,0,0,0,0,0}; if(r32<8) z=*reinterpret_cast<const bf16x8*>(Kn+(srow+r32)*512+h*64+d0*16+hi*8); F.k[d0]=z; }
    #pragma unroll
    for(int d0=0;d0<2;++d0){
      bf16x8 z={0,0,0,0,0,0,0,0};
      #pragma unroll
      for(int jj=0;jj<4;++jj) z[jj]=*reinterpret_cast<const short*>(Vn+(srow+4*hi+jj)*512+h*64+32*d0+r32);
      F.v[d0*2]=z; F.v[d0*2+1]=(bf16x8){0,0,0,0,0,0,0,0}; }
    tile_step<true>(F,qr,bias2,o,carry,hi,r32);
  }
  const int*pt=page_table+smp*64+8*j;
  Raw R; Frag F;
  const int kvo=(lane>>4)*2048+(lane&15)*16, vvo=(4*hi*512+r32)*4;
  const int kwo=(lane>>4)*144+(lane&15)*8, kro=r32*144+16*hi;
  const __amdgpu_buffer_rsrc_t rk=__builtin_amdgcn_make_buffer_rsrc((void*)cache_k,0,671088640,0x00020000), rv=__builtin_amdgcn_make_buffer_rsrc((void*)cache_v,0,671088640,0x00020000);
  #define UOFF(tt) ((unsigned)__builtin_amdgcn_readfirstlane((int)(((((unsigned)pt[(tt)>>2]*128u+(unsigned)(((tt)&3)*32))*8u+(unsigned)h)*64u)*4u)))
  #define LOADT(R_,tt) load_tile(R_,rk,rv,UOFF(tt),kvo,vvo)
  LOADT(R,31); cvt_tile(F,R,kl,kwo,kro);
  for(int tt=31;tt>=0;--tt){
    if(tt>0) LOADT(R,tt-1);
    tile_step<false>(F,qr,bias2,o,carry,hi,r32);
    if(tt>0) cvt_tile(F,R,kl,kwo,kro);
  }
  #undef UOFF
  #undef LOADT
  const int unit=smp*8+j;
  int l2_=threadIdx.x; asm volatile("":"+v"(l2_)); const int lane2=l2_&63, r32b=lane2&31, hib=lane2>>5;
  unsigned*pp=(unsigned*)part+((size_t)unit*8+h)*512;
  #pragma unroll
  for(int r=0;r<4;++r)
    #pragma unroll
    for(int d0=0;d0<2;++d0) __hip_atomic_store(pp+(r+4*hib)*64+32*d0+r32b,__float_as_uint(o[d0][r]),RLXA);
  if(lane2<8) __hip_atomic_store((unsigned*)rtot+((size_t)unit*8+h)*8+lane2,__float_as_uint(carry),RLXA);
  asm volatile("s_waitcnt vmcnt(0)":::"memory");
  unsigned old=0u;
  if(lane2==0) old=__hip_atomic_fetch_add(cnt+64*(smp*8+h),1u,RLXA);
  old=(unsigned)__builtin_amdgcn_readfirstlane((int)old);
  if(old==7u){
    const int q=lane2>>3,dc=(lane2&7)*8; float acc[8];
    #pragma unroll
    for(int i=0;i<8;++i)acc[i]=0.f;
    float f=1.f;
    for(int jj=7;jj>=0;--jj){ const size_t u=(size_t)smp*8+jj; const unsigned*src=(const unsigned*)part+(u*8+h)*512+q*64+dc;
      #pragma unroll
      for(int i=0;i<8;++i) acc[i]+=f*__uint_as_float(__hip_atomic_load(src+i,RLXA));
      f*=__uint_as_float(__hip_atomic_load((const unsigned*)rtot+(u*8+h)*8+q,RLXA)); }
    u32x4 w; w[0]=cvtpk_s(acc[0],acc[1]); w[1]=cvtpk_s(acc[2],acc[3]); w[2]=cvtpk_s(acc[4],acc[5]); w[3]=cvtpk_s(acc[6],acc[7]);
    *(u32x4*)(MIX+(srow+q)*1024+h*64+dc)=w;
  }
}
}
namespace gla {
using sba::bf16; using sba::cvtpk_s;
typedef short bf16x8 __attribute__((ext_vector_type(8)));
typedef short bf16x4 __attribute__((ext_vector_type(4)));
typedef float f32x4 __attribute__((ext_vector_type(4)));
typedef unsigned u32x4 __attribute__((ext_vector_type(4)));
typedef unsigned u32x2 __attribute__((ext_vector_type(2)));
#define GLAS __attribute__((address_space(3)))
constexpr int GP=1792;
constexpr int L_QD=0,L_KI=9216,L_KET=18432,L_VT=27648,L_DEC=46080,L_EXR=46336,L_TOT=46592,L_SSQ=48640,L_END=50688;
#define GMFMA(a,b,c) __builtin_amdgcn_mfma_f32_16x16x32_bf16((a),(b),(c),0,0,0)
__device__ __forceinline__ float bf2f(short s){ return __uint_as_float(((unsigned)(unsigned short)s)<<16); }
__device__ __forceinline__ short f2bf(float f){ return (short)(cvtpk_s(f,0.f)&0xffffu); }
template<int MODE,bool FULL> __device__ __forceinline__ void chunk(const bf16*G,bf16*MIX,long m0,int ntok,int h,GLAS char*L,f32x4(&S)[4],const float(&wg)[16],float bg,float gain,float&dseg){
  int tid_=threadIdx.x; asm volatile("":"+v"(tid_)); const int tid=tid_,lane=tid&63,c=lane,fr=lane&15,fq=lane>>4; const int w=__builtin_amdgcn_readfirstlane(tid>>6); const int g=w;
  const short*Gs=(const short*)G;
  float bl[8]; float run=0.f;
  bf16x8 al0[8],al1[8]; short kraw[8],qraw[8],vraw[16];
  #pragma unroll
  for(int i=0;i<8;++i){ const int t=8*g+i; const bool ok=FULL||t<ntok; const long row=ok?(m0+t):m0; const bf16x8*ap=(const bf16x8*)(Gs+row*GP+1536); al0[i]=ap[0]; al1[i]=ap[1];
    kraw[i]=Gs[row*GP+256+64*h+c]; qraw[i]=(MODE==1)?Gs[row*GP+64*h+c]:(short)0; }
  #pragma unroll
  for(int i=0;i<16;++i){ const int t=16*(tid>>7)+i; const bool ok=FULL||t<ntok; const long row=ok?(m0+t):m0; vraw[i]=Gs[row*GP+512+128*h+(tid&127)]; }
  #pragma unroll
  for(int i=0;i<8;++i){ const int t=8*g+i; float la=0.f;
    if(FULL||t<ntok){ const bf16x8 a0=al0[i],a1=al1[i]; float x=bg;
      #pragma unroll
      for(int j=0;j<8;++j){ x+=bf2f(a0[j])*wg[j]; x+=bf2f(a1[j])*wg[8+j]; }
      la=(fminf(x,0.f)-__logf(1.f+__expf(-fabsf(x))))*0.0625f; }
    run+=la; bl[i]=run; }
  GLAS float*TOT=(GLAS float*)(L+L_TOT);
  TOT[g*64+c]=run;
  __syncthreads();
  float prefix=0.f,total=0.f;
  #pragma unroll
  for(int gg=0;gg<8;++gg){ const float v=TOT[gg*64+c]; total+=v; if(gg<g)prefix+=v; }
  const float bref=0.5f*total;
  float ke[8];
  #pragma unroll
  for(int i=0;i<8;++i){ const int t=8*g+i; const float b=prefix+bl[i]; float kk=0.f,qq=0.f;
    if(FULL||t<ntok){ kk=bf2f(kraw[i]); if(MODE==1) qq=bf2f(qraw[i]); }
    ke[i]=kk*__expf(total-b);
    if(MODE==1){ *(GLAS short*)(L+L_QD+t*144+c*2)=f2bf(qq*0.125f*__expf(b-bref)); *(GLAS short*)(L+L_KI+t*144+c*2)=f2bf(kk*__expf(bref-b)); } }
  { u32x4 p; p[0]=cvtpk_s(ke[0],ke[1]); p[1]=cvtpk_s(ke[2],ke[3]); p[2]=cvtpk_s(ke[4],ke[5]); p[3]=cvtpk_s(ke[6],ke[7]); *(GLAS u32x4*)(L+L_KET+c*144+g*16)=p; }
  if(g==0){ const float d=__expf(total); ((GLAS float*)(L+L_DEC))[c]=d; ((GLAS float*)(L+L_EXR))[c]=__expf(bref); dseg*=d; }
  { const int dv=tid&127,tg=tid>>7; float vv[16];
    #pragma unroll
    for(int i=0;i<16;++i){ const int t=16*tg+i; vv[i]=(FULL||t<ntok)?bf2f(vraw[i]):0.f; }
    u32x4 p0,p1;
    #pragma unroll
    for(int j=0;j<4;++j){ p0[j]=cvtpk_s(vv[2*j],vv[2*j+1]); p1[j]=cvtpk_s(vv[8+2*j],vv[8+2*j+1]); }
    *(GLAS u32x4*)(L+L_VT+dv*144+tg*32)=p0; *(GLAS u32x4*)(L+L_VT+dv*144+tg*32+16)=p1; }
  __syncthreads();
  const int dvl=16*w+fr;
  f32x4 O[4];
  if(MODE==1){
    f32x4 PT[4][4];
    #pragma unroll
    for(int st=0;st<4;++st)
      #pragma unroll
      for(int tt=0;tt<4;++tt){ f32x4 acc={0.f,0.f,0.f,0.f};
        if(st<=tt){
          #pragma unroll
          for(int kk=0;kk<2;++kk){ const bf16x8 a=*(GLAS const bf16x8*)(L+L_KI+(16*st+fr)*144+(32*kk+8*fq)*2), b=*(GLAS const bf16x8*)(L+L_QD+(16*tt+fr)*144+(32*kk+8*fq)*2); acc=GMFMA(a,b,acc); }
          if(st==tt){
            #pragma unroll
            for(int i=0;i<4;++i) if(4*fq+i>fr) acc[i]=0.f; } }
        PT[st][tt]=acc; }
    #pragma unroll
    for(int tt=0;tt<4;++tt){ O[tt]=(f32x4){0.f,0.f,0.f,0.f};
      #pragma unroll
      for(int pr=0;pr<2;++pr){ if(2*pr<=tt){
        u32x4 pa; pa[0]=cvtpk_s(PT[2*pr][tt][0],PT[2*pr][tt][1]); pa[1]=cvtpk_s(PT[2*pr][tt][2],PT[2*pr][tt][3]); pa[2]=cvtpk_s(PT[2*pr+1][tt][0],PT[2*pr+1][tt][1]); pa[3]=cvtpk_s(PT[2*pr+1][tt][2],PT[2*pr+1][tt][3]);
        const u32x2 b0=*(GLAS const u32x2*)(L+L_VT+dvl*144+(32*pr+4*fq)*2), b1=*(GLAS const u32x2*)(L+L_VT+dvl*144+(32*pr+16+4*fq)*2);
        const u32x4 pb={b0[0],b0[1],b1[0],b1[1]};
        O[tt]=GMFMA(__builtin_bit_cast(bf16x8,pa),__builtin_bit_cast(bf16x8,pb),O[tt]); } } }
    #pragma unroll
    for(int kk=0;kk<2;++kk){
      const f32x4 e0=*(GLAS const f32x4*)(L+L_EXR+(32*kk+4*fq)*4), e1=*(GLAS const f32x4*)(L+L_EXR+(32*kk+16+4*fq)*4);
      const f32x4 s0=S[2*kk]*e0, s1=S[2*kk+1]*e1;
      u32x4 pb; pb[0]=cvtpk_s(s0[0],s0[1]); pb[1]=cvtpk_s(s0[2],s0[3]); pb[2]=cvtpk_s(s1[0],s1[1]); pb[3]=cvtpk_s(s1[2],s1[3]);
      #pragma unroll
      for(int tt=0;tt<4;++tt){ const u32x2 a0=*(GLAS const u32x2*)(L+L_QD+(16*tt+fr)*144+(32*kk+4*fq)*2), a1=*(GLAS const u32x2*)(L+L_QD+(16*tt+fr)*144+(32*kk+16+4*fq)*2);
        const u32x4 pa={a0[0],a0[1],a1[0],a1[1]};
        O[tt]=GMFMA(__builtin_bit_cast(bf16x8,pa),__builtin_bit_cast(bf16x8,pb),O[tt]); } }
  }
  #pragma unroll
  for(int mt=0;mt<4;++mt){ const f32x4 d4=*(GLAS const f32x4*)(L+L_DEC+(16*mt+4*fq)*4); S[mt]=S[mt]*d4;
    #pragma unroll
    for(int kk=0;kk<2;++kk){ const bf16x8 a=*(GLAS const bf16x8*)(L+L_KET+(16*mt+fr)*144+(32*kk+8*fq)*2), b=*(GLAS const bf16x8*)(L+L_VT+dvl*144+(32*kk+8*fq)*2); S[mt]=GMFMA(a,b,S[mt]); } }
  if(MODE==1){
    GLAS float*SSQ=(GLAS float*)(L+L_SSQ);
    #pragma unroll
    for(int tt=0;tt<4;++tt)
      #pragma unroll
      for(int i=0;i<4;++i){ float ss=O[tt][i]*O[tt][i]; ss+=__shfl_xor(ss,1); ss+=__shfl_xor(ss,2); ss+=__shfl_xor(ss,4); ss+=__shfl_xor(ss,8); if(fr==0) SSQ[w*64+16*tt+4*fq+i]=ss; }
    short rraw[16];
    #pragma unroll
    for(int tt=0;tt<4;++tt)
      #pragma unroll
      for(int i=0;i<4;++i){ const int t=16*tt+4*fq+i; const long row=(FULL||t<ntok)?(m0+t):m0; rraw[4*tt+i]=Gs[row*GP+1024+128*h+dvl]; }
    __syncthreads();
    #pragma unroll
    for(int tt=0;tt<4;++tt)
      #pragma unroll
      for(int i=0;i<4;++i){ const int t=16*tt+4*fq+i; float tot=0.f;
        #pragma unroll
        for(int ww=0;ww<8;++ww) tot+=SSQ[ww*64+t];
        if(FULL||t<ntok){ const float rstd=rsqrtf(tot*(1.f/128.f)+1e-6f); const float rg=bf2f(rraw[4*tt+i]); const float sl=rg/(1.f+__expf(-rg));
          ((short*)MIX)[(m0+t)*1024+512+128*h+dvl]=f2bf(O[tt][i]*rstd*gain*sl); } }
  }
  __syncthreads();
}
__device__ __forceinline__ void load_consts(int h,const float*w_gate,const float*b_gate,const float*g_out,float(&wg)[16],float&bg,float&gain){
  const int lane=threadIdx.x&63, w=threadIdx.x>>6;
  #pragma unroll
  for(int j=0;j<16;++j) wg[j]=w_gate[j*256+64*h+lane];
  bg=b_gate[64*h+lane]; gain=g_out[16*w+(lane&15)];
}
__device__ __forceinline__ void pass1_unit(int unit,const bf16*G,const float*w_gate,const float*b_gate,const float*g_out,float*SLOC,float*DSEG,GLAS char*L){
  const int bh=unit>>5,sseg=unit&31,b=bh>>2,h=bh&3; const int tid=threadIdx.x;
  float wg[16],bg,gain; load_consts(h,w_gate,b_gate,g_out,wg,bg,gain);
  f32x4 S[4];
  #pragma unroll
  for(int mt=0;mt<4;++mt)S[mt]=(f32x4){0.f,0.f,0.f,0.f};
  float dseg=1.f; const long m0=(long)b*8192+256*sseg;
  for(int ch=0;ch<4;++ch) chunk<0,true>(G,nullptr,m0+64*ch,64,h,L,S,wg,bg,gain,dseg);
  f32x4*dst=(f32x4*)(SLOC+((size_t)unit*512+tid)*16);
  #pragma unroll
  for(int mt=0;mt<4;++mt)dst[mt]=S[mt];
  if(tid<64)DSEG[unit*64+tid]=dseg;
}
__device__ __forceinline__ void pass3_unit(int unit,const bf16*G,bf16*MIX,const float*w_gate,const float*b_gate,const float*g_out,const float*SLOC,const float*DSEG,float*sfin_base,GLAS char*L){
  const int bh=unit>>5,sseg=unit&31,b=bh>>2,h=bh&3; const int tid=threadIdx.x,lane=tid&63,fr=lane&15,fq=lane>>4,w=tid>>6;
  float wg[16],bg,gain; load_consts(h,w_gate,b_gate,g_out,wg,bg,gain);
  f32x4 S[4];
  #pragma unroll
  for(int mt=0;mt<4;++mt)S[mt]=(f32x4){0.f,0.f,0.f,0.f};
  #pragma unroll 4
  for(int j=0;j<sseg;++j){ const int uj=bh*32+j; const f32x4*src=(const f32x4*)(SLOC+((size_t)uj*512+tid)*16);
    #pragma unroll
    for(int mt=0;mt<4;++mt){ const f32x4 d4=*(const f32x4*)(DSEG+uj*64+16*mt+4*fq); S[mt]=S[mt]*d4+src[mt]; } }
  float dseg=1.f; const long m0=(long)b*8192+256*sseg;
  for(int ch=0;ch<4;++ch) chunk<1,true>(G,MIX,m0+64*ch,64,h,L,S,wg,bg,gain,dseg);
  if(sseg==31){ float*o=sfin_base+(size_t)bh*8192;
    #pragma unroll
    for(int mt=0;mt<4;++mt)
      #pragma unroll
      for(int i=0;i<4;++i) o[(16*mt+4*fq+i)*128+16*w+fr]=S[mt][i]; }
}
__device__ __forceinline__ void sample_unit(int unit,const bf16*G,bf16*MIX,const float*w_gate,const float*b_gate,const float*g_out,const float*s0,float*sout,GLAS char*L){
  const int smp=unit>>2,h=unit&3; const int tid=threadIdx.x,lane=tid&63,fr=lane&15,fq=lane>>4,w=tid>>6;
  float wg[16],bg,gain; load_consts(h,w_gate,b_gate,g_out,wg,bg,gain);
  f32x4 S[4]; const float*si=s0+(size_t)unit*8192; float*so=sout+(size_t)unit*8192;
  #pragma unroll
  for(int mt=0;mt<4;++mt)
    #pragma unroll
    for(int i=0;i<4;++i) S[mt][i]=si[(16*mt+4*fq+i)*128+16*w+fr];
  float dseg=1.f;
  chunk<1,false>(G,MIX,16384+8*(long)smp,8,h,L,S,wg,bg,gain,dseg);
  #pragma unroll
  for(int mt=0;mt<4;++mt)
    #pragma unroll
    for(int i=0;i<4;++i) so[(16*mt+4*fq+i)*128+16*w+fr]=S[mt][i];
}
}
namespace thin {
using sba::bf16x8; using sba::f32x16; using sba::crow;
template<int KS,class Epi> __device__ __forceinline__ void run(const unsigned short*A,int lda,const unsigned short*Bt,int ldb,int K,int ntn,int tile0,int ntiles,__attribute__((address_space(3))) float*red,const Epi&epi){
  int tid_=threadIdx.x; asm volatile("":"+v"(tid_)); const int lane=tid_&63,r32=lane&31,hi=lane>>5; const int w=__builtin_amdgcn_readfirstlane(tid_>>6);
  const int sub=w/KS,kp=w%KS,tile=tile0+sub; const bool live=tile<ntiles; const int tm=live?tile/ntn:0,tn=live?tile%ntn:0;
  const int klen=K/KS,k0=kp*klen;
  const unsigned short*ap=A+(size_t)(32*tm+r32)*lda+k0+8*hi; const unsigned short*bp=Bt+(size_t)(32*tn+r32)*ldb+k0+8*hi;
  f32x16 acc=f32x16{};
  if(live){
    #pragma unroll 8
    for(int k=0;k<klen;k+=16){ const bf16x8 a=*(const bf16x8*)(ap+k), b=*(const bf16x8*)(bp+k); acc=__builtin_amdgcn_mfma_f32_32x32x16_bf16(a,b,acc,0,0,0); } }
  #pragma unroll
  for(int r=0;r<16;++r) red[(w*16+r)*64+lane]=acc[r];
  __syncthreads();
  if(kp==0&&live){
    #pragma unroll
    for(int r=0;r<16;++r){ float v=0.f;
      #pragma unroll
      for(int p=0;p<KS;++p) v+=red[((sub*KS+p)*16+r)*64+lane];
      epi(32*tm+crow(r,hi),32*tn+r32,v); } }
  __syncthreads();
}
struct EpiResGateS { const float*base; float*out; const float*gate; int ld;
  __device__ __forceinline__ void operator()(int row,int col,float v)const{ const size_t o=(size_t)row*ld+col; out[o]=base[o]+gate[(size_t)(2+(row>>3))*6144+col]*v; } };
struct EpiRelu2S { unsigned short*H; int ld;
  __device__ __forceinline__ void operator()(int row,int col,float v)const{ const float a=fmaxf(v,0.f); H[(size_t)row*ld+col]=(unsigned short)(sba::cvtpk_s(a*a,0.f)&0xffffu); } };
}
__device__ __forceinline__ float wave_sum(float v) {
#pragma unroll
    for (int o = 1; o < 64; o <<= 1) v += __shfl_xor(v, o);
    return v;
}
__device__ __forceinline__ void p0_transpose_item(const float* W, int K, int Nreal, int Npad, bf16* WT, LAS float* scr, int item, int lane) {
    const int nblk = Npad / 32, kb = item / nblk, nb = item % nblk, k0 = 64 * kb, n0 = 32 * nb;
    const int n = n0 + (lane & 31);
#pragma unroll 8
    for (int i = 0; i < 32; ++i) { const int kk = 2 * i + (lane >> 5); scr[kk * 33 + (lane & 31)] = (n < Nreal) ? W[(size_t)(k0 + kk) * Nreal + n] : 0.f; }
    LDS_WAIT(); asm volatile("" ::: "memory");
    const int c = lane & 7;
#pragma unroll
    for (int j = 0; j < 4; ++j) { const int nn = (lane >> 3) + 8 * j; const LAS float* s = scr + (8 * c) * 33 + nn;
        v4u o; o.x = pk2(s[0 * 33], s[1 * 33]); o.y = pk2(s[2 * 33], s[3 * 33]); o.z = pk2(s[4 * 33], s[5 * 33]); o.w = pk2(s[6 * 33], s[7 * 33]);
        *(GAS v4u*)(WT + (size_t)(n0 + nn) * K + k0 + 8 * c) = o; }
    LDS_WAIT(); asm volatile("" ::: "memory");
}
__device__ __forceinline__ void norm_mod_row_bf16(int lane, const float* xrow, const float* gain, const float* sc, const float* sh, bf16* orow) {
    const f32x4* xr = (const f32x4*)xrow + lane; f32x4 v[4]; float s = 0.f;
#pragma unroll
    for (int j = 0; j < 4; ++j) { v[j] = xr[64 * j]; s += (v[j].x * v[j].x + v[j].y * v[j].y) + (v[j].z * v[j].z + v[j].w * v[j].w); }
    const float rstd = rsqrtf(wave_sum(s) * (1.f / D) + NORM_EPS);
    unsigned long long* o8 = (unsigned long long*)orow + lane;
#pragma unroll
    for (int j = 0; j < 4; ++j) { const f32x4 g = ((const f32x4*)gain)[lane + 64 * j], a = ((const f32x4*)sc)[lane + 64 * j], b = ((const f32x4*)sh)[lane + 64 * j];
        const f32x4 y = v[j] * rstd * g * (a + 1.f) + b;
        o8[64 * j] = (unsigned long long)pk2(y.x, y.y) | ((unsigned long long)pk2(y.z, y.w) << 32); }
}
__device__ __forceinline__ void norm_row_f32_inplace(int lane, float* xrow, const float* gain) {
    f32x4* xr = (f32x4*)xrow + lane; f32x4 v[4]; float s = 0.f;
#pragma unroll
    for (int j = 0; j < 4; ++j) { v[j] = xr[64 * j]; s += (v[j].x * v[j].x + v[j].y * v[j].y) + (v[j].z * v[j].z + v[j].w * v[j].w); }
    const float rstd = rsqrtf(wave_sum(s) * (1.f / D) + NORM_EPS);
#pragma unroll
    for (int j = 0; j < 4; ++j) { const f32x4 g = ((const f32x4*)gain)[lane + 64 * j]; xr[64 * j] = v[j] * rstd * g; }
}
__device__ __forceinline__ int bidx_of_row(int m) { return m < MP ? (m >> 13) : 2 + ((m - MP) >> 3); }

struct Args { const float* in[21]; const int* page_table; float* out; unsigned char* ws; };
static_assert(sizeof(Args) == 24 * 8, "Args has no padding");

__global__ void __launch_bounds__(NWAVES * 64, 2) mk_fwd(Args args) {
    extern __shared__ __attribute__((aligned(16))) unsigned char lds[];
    LAS unsigned char* L = (LAS unsigned char*)lds;
    volatile LAS unsigned* MISC = (volatile LAS unsigned*)(L + MISC_OFF);
    const int tid = threadIdx.x, lane = tid & 63, wave = __builtin_amdgcn_readfirstlane(tid >> 6);
    const int G = gridDim.x; const int bx = blockIdx.x; const int vcu = (G % 8 == 0) ? (bx % 8) * (G / 8) + bx / 8 : bx;
    unsigned char* ws = args.ws;
    unsigned* ctl = (unsigned*)(ws + WS_CTL);
    const float *x_prompt = args.in[0], *x_sample = args.in[1], *c_prompt = args.in[2], *c_sample = args.in[3], *cache_k = args.in[4], *cache_v = args.in[5], *state_gla = args.in[6];
    const float *w_ada = args.in[8], *b_ada = args.in[9], *g_mix = args.in[10], *w_in = args.in[11], *b_sb = args.in[12], *w_gate = args.in[13], *b_gate = args.in[14], *g_gla_out = args.in[15];
    const float *w_out = args.in[16], *g_ffn = args.in[17], *w_up = args.in[18], *w_down = args.in[19], *g_final = args.in[20];
    float* out = args.out;
    float* MOD = (float*)(ws + WS_MOD);
    bf16 *Win_t = (bf16*)(ws + WS_WIN), *Wo_t = (bf16*)(ws + WS_WO), *Wup_t = (bf16*)(ws + WS_WUP), *Wdn_t = (bf16*)(ws + WS_WDN);
    bf16 *XN = (bf16*)(ws + WS_XN), *QB = (bf16*)(ws + WS_Q), *KB = (bf16*)(ws + WS_K), *VB = (bf16*)(ws + WS_V), *GB = (bf16*)(ws + WS_G), *MIX = (bf16*)(ws + WS_MIX), *HB = (bf16*)(ws + WS_H);
    float* X1 = (float*)(ws + WS_X1);
    float *SLOC = (float*)(ws + WS_SLOC), *DSEG = (float*)(ws + WS_DSEG), *DPART = (float*)(ws + WS_DPART), *DRTOT = (float*)(ws + WS_DRTOT);
    for (int u = tid; u < (LDS_BYTES - MISC_OFF) / 4; u += NWAVES * 64) ((LAS unsigned*)(L + MISC_OFF))[u] = 0u;
    __syncthreads();
    XcdBarrier bar = xcd_barrier_post(ctl + CW_BAR, MISC + 8);
    const int gw = vcu * NWAVES + wave, NGW = G * NWAVES;

#ifdef PROBE_P0A
    for (int rep_ = 0; rep_ < 2; ++rep_) {
#else
    {
#endif
    if (vcu < 96) {
        LAS float* s = (LAS float*)L;
        for (int i = tid; i < NMODR * D; i += NWAVES * 64) { const int r = i >> 10, k = i & 1023; const float c = r < 2 ? c_prompt[r * D + k] : c_sample[(r - 2) * D + k]; s[k * NMODR + r] = c / (1.f + __expf(-c)); }
        __syncthreads();
        const int col = 64 * vcu + lane, k0 = 128 * wave;
        float acc[NMODR];
#pragma unroll
        for (int r = 0; r < NMODR; ++r) acc[r] = 0.f;
#pragma unroll 4
        for (int kk = 0; kk < 128; ++kk) { const int k = k0 + kk; const float w = w_ada[(size_t)k * MODW + col];
#pragma unroll
            for (int r = 0; r < NMODR; ++r) acc[r] += s[k * NMODR + r] * w; }
        __syncthreads();
        LAS float* red = (LAS float*)L;
#pragma unroll
        for (int r = 0; r < NMODR; ++r) red[(wave * NMODR + r) * 64 + lane] = acc[r];
        __syncthreads();
        for (int o = tid; o < NMODR * 64; o += NWAVES * 64) { const int r = o >> 6, l = o & 63; float t = b_ada[64 * vcu + l];
#pragma unroll
            for (int w8 = 0; w8 < 8; ++w8) t += red[(w8 * NMODR + r) * 64 + l];
            MOD[r * MODW + 64 * vcu + l] = t; }
        __syncthreads();
    }
    {
        LAS float* scr = (LAS float*)(L + wave * 16384);
        constexpr int I_IN = (D / 64) * (NIN / 32), I_O = (D / 64) * (D / 32), I_UP = (D / 64) * (FF / 32), I_DN = (FF / 64) * (D / 32);
        constexpr int NITEMS = I_IN + I_O + I_UP + I_DN;
        for (int it = gw; it < NITEMS; it += NGW) {
            int r = it;
            if (r < I_IN) { p0_transpose_item(w_in, D, NIN_REAL, NIN, Win_t, scr, r, lane); continue; } r -= I_IN;
            if (r < I_O) { p0_transpose_item(w_out, D, D, D, Wo_t, scr, r, lane); continue; } r -= I_O;
            if (r < I_UP) { p0_transpose_item(w_up, D, FF, FF, Wup_t, scr, r, lane); continue; } r -= I_UP;
            p0_transpose_item(w_down, FF, D, D, Wdn_t, scr, r, lane);
        }
    }
    __syncthreads();
    }
    xcd_barrier(bar);
#ifdef PROBE_P0B
    for (int rep_ = 0; rep_ < 2; ++rep_)
#endif
    for (int m = gw; m < M; m += NGW) { const float* xr = m < MP ? x_prompt + (size_t)m * D : x_sample + (size_t)(m - MP) * D; const float* md = MOD + (size_t)bidx_of_row(m) * MODW;
        norm_mod_row_bf16(lane, xr, g_mix, md + 1024, md, XN + (size_t)m * D); }
    xcd_barrier(bar);
#ifdef PROBE_P1
    for (int rep_ = 0; rep_ < 2; ++rep_)
#endif
    {
        pg8::Gemm g{XN, Win_t, M, NIN, D}; pg8::StaticOrder S; S.init(M, NIN, G, bx);
        pg8::EpiInProj E{QB, KB, VB, GB, out + OK_P, out + OV_P, out + OK_S - (size_t)MP * 512, out + OV_S - (size_t)MP * 512, QSCALE};
        pg8::gemm_phase<pg8::EpiInProj, pg8::StaticOrder, true, true>(L, g, S, E);
    }
    xcd_barrier(bar);
#if defined(PROBE_GLA2) || defined(PROBE_GLA1)
    for (int rep_ = 0; rep_ < 2; ++rep_)
#endif
    for (int u = vcu; u < 256; u += G) gla::pass1_unit(u, (const gla::bf16*)GB, w_gate, b_gate, g_gla_out, SLOC, DSEG, (LAS char*)L);
    xcd_barrier(bar);
    for (int rep = 0; rep < 2; ++rep) {
        const bool do_sb = ((vcu & 1) == rep);
        if (do_sb) {
#ifdef PROBE_SB2
            for (int rep_ = 0; rep_ < 2; ++rep_)
#endif
            for (int v = vcu; v < 256; v += G) {
                const int bh = v >> 4, s = v & 15, b = bh >> 3, h = bh & 7; const float bias2 = b_sb[h] * 1.4426950408889634f;
                sb8::attn_unit(b, h, 31 - s, (const sba::bf16*)QB, (const sba::bf16*)KB, (const sba::bf16*)VB, (sba::bf16*)MIX, (char*)lds, bias2);
                sb8::attn_unit(b, h, s, (const sba::bf16*)QB, (const sba::bf16*)KB, (const sba::bf16*)VB, (sba::bf16*)MIX, (char*)lds, bias2);
            }
        } else {
#ifdef PROBE_DEC2
            for (int rep_ = 0; rep_ < 2; ++rep_)
#endif
            for (int u = vcu; u < 256; u += G)
                sbd::decode_wave(u >> 3, u & 7, wave, cache_k, cache_v, args.page_table, (const sba::bf16*)QB, (const sba::bf16*)KB, (const sba::bf16*)VB, b_sb, DPART, DRTOT, ctl + CW_DEC, (sba::bf16*)MIX, (LAS char*)L + wave * 5120);
            asm volatile("s_waitcnt vmcnt(0)" ::: "memory"); __syncthreads();
        }
    }
#if defined(PROBE_GLA2)
    for (int rep_ = 0; rep_ < 2; ++rep_)
#endif
    for (int u = vcu; u < 256; u += G) gla::pass3_unit(u, (const gla::bf16*)GB, (gla::bf16*)MIX, w_gate, b_gate, g_gla_out, SLOC, DSEG, out + OSG_P, (LAS char*)L);
    for (int u = vcu; u < 128; u += G) gla::sample_unit(u, (const gla::bf16*)GB, (gla::bf16*)MIX, w_gate, b_gate, g_gla_out, state_gla, out + OSG_S, (LAS char*)L);
    xcd_barrier(bar);
#ifdef PROBE_P3
    for (int rep_ = 0; rep_ < 2; ++rep_)
#endif
    {
        pg8::Gemm g{MIX, Wo_t, MP, D, D}; pg8::StaticOrder S; S.init(MP, D, G, bx);
        pg8::EpiResGate E{x_prompt, x_sample - (size_t)MP * D, X1, MOD + 2048};
        pg8::gemm_phase<pg8::EpiResGate, pg8::StaticOrder, true, true>(L, g, S, E);
        thin::EpiResGateS Es{x_sample, X1 + (size_t)MP * D, MOD + 2048, D};
        for (int t0 = vcu; t0 < 256; t0 += G) thin::run<8>(MIX + (size_t)MP * D, D, Wo_t, D, D, 32, t0, 256, (LAS float*)L, Es);
    }
    xcd_barrier(bar);
    for (int m = gw; m < M; m += NGW) { const float* md = MOD + (size_t)bidx_of_row(m) * MODW; norm_mod_row_bf16(lane, X1 + (size_t)m * D, g_ffn, md + 4096, md + 3072, XN + (size_t)m * D); }
    xcd_barrier(bar);
#ifdef PROBE_P4
    for (int rep_ = 0; rep_ < 2; ++rep_)
#endif
    {
        pg8::Gemm g{XN, Wup_t, MP, FF, D}; pg8::StaticOrder S; S.init(MP, FF, G, bx);
        pg8::EpiRelu2 E{HB, FF};
        pg8::gemm_phase<pg8::EpiRelu2, pg8::StaticOrder, true, true>(L, g, S, E);
        thin::EpiRelu2S Es{HB + (size_t)MP * FF, FF};
        for (int t0 = 4 * vcu; t0 < 1024; t0 += 4 * G) thin::run<2>(XN + (size_t)MP * D, D, Wup_t, D, D, 128, t0, 1024, (LAS float*)L, Es);
    }
    xcd_barrier(bar);
#ifdef PROBE_P5
    for (int rep_ = 0; rep_ < 2; ++rep_)
#endif
    {
        pg8::Gemm g{HB, Wdn_t, MP, D, FF}; pg8::StaticOrder S; S.init(MP, D, G, bx);
        pg8::EpiResGate E{X1, X1, out + OY, MOD + 5120};
        pg8::gemm_phase<pg8::EpiResGate, pg8::StaticOrder, true, true>(L, g, S, E);
        thin::EpiResGateS Es{X1 + (size_t)MP * D, out + OY + (size_t)MP * D, MOD + 5120, D};
        for (int t0 = vcu; t0 < 256; t0 += G) thin::run<8>(HB + (size_t)MP * FF, FF, Wdn_t, FF, FF, 32, t0, 256, (LAS float*)L, Es);
    }
    xcd_barrier(bar);
    for (int m = gw; m < M; m += NGW) norm_row_f32_inplace(lane, out + OY + (size_t)m * D, g_final);
}

extern "C" void kernel_launch(void* const* d_in, const int* in_sizes, int n_in, void* d_out, int out_size, void* d_ws, size_t ws_size, hipStream_t stream) {
    static int grid = 0;
    if (grid == 0) {
        if (n_in != 21 || (size_t)out_size != OUT_TOTAL || ws_size < WS_END) { fprintf(stderr, "kernel_launch: unexpected sizes: n_in %d out %d ws %zu\n", n_in, out_size, ws_size); grid = -1; return; }
        int dev = 0, cus = 0, per_cu = 0;
        if (hipGetDevice(&dev) != hipSuccess || hipDeviceGetAttribute(&cus, hipDeviceAttributeMultiprocessorCount, dev) != hipSuccess) { grid = -1; return; }
        if (hipFuncSetAttribute((const void*)mk_fwd, hipFuncAttributeMaxDynamicSharedMemorySize, LDS_BYTES) != hipSuccess) { fprintf(stderr, "kernel_launch: hipFuncSetAttribute failed\n"); grid = -1; return; }
        if (hipOccupancyMaxActiveBlocksPerMultiprocessor(&per_cu, (const void*)mk_fwd, NWAVES * 64, LDS_BYTES) != hipSuccess || per_cu < 1) { fprintf(stderr, "kernel_launch: occupancy query says %d\n", per_cu); }
        (void)hipGetLastError();
        grid = cus;
    }
    if (grid < 0) return;
    if (hipMemsetAsync((char*)d_ws + WS_CTL, 0, CTL_ZERO_BYTES, stream) != hipSuccess) return;
    Args a{};
    for (int i = 0; i < 21; ++i) a.in[i] = (const float*)d_in[i];
    a.page_table = (const int*)d_in[7]; a.out = (float*)d_out; a.ws = (unsigned char*)d_ws;
    hipLaunchKernelGGL(mk_fwd, dim3(grid), dim3(NWAVES * 64), LDS_BYTES, stream, a);
    const hipError_t le = hipPeekAtLastError();
    if (le != hipSuccess) fprintf(stderr, "kernel_launch: launch failed: %s\n", hipGetErrorName(le));
}
```

```cpp
#include <hip/hip_runtime.h>
#include <hip/hip_bf16.h>
#include <cstdio>
#include <cstdint>
namespace pg8 {
#define PG8_LAS __attribute__((address_space(3)))
typedef unsigned short bf16_t;
typedef short bf16x8 __attribute__((ext_vector_type(8)));
typedef float f32x4 __attribute__((ext_vector_type(4)));
typedef unsigned u32x4 __attribute__((ext_vector_type(4)));
constexpr int BM = 256, BK = 64, HALF = 128, HTB = HALF * BK * 2  , STAGE_BYTES = 8 * HTB, NXCD = 8, WGM = 8;

__host__ __device__ __forceinline__ int lds_byte(int r, int c) { const int st = (r >> 4) * 2 + (c >> 5), rr = r & 15, cc = c & 31, ob = rr * 64 + cc * 2; return st * 1024 + (ob ^ (((ob >> 9) & 1) << 5)); }
__host__ __device__ __forceinline__ void stage_rc(int b, int& R, int& C) { const int st = b / 1024, sb = b % 1024, swz = sb ^ (((sb >> 9) & 1) << 5); R = (st >> 1) * 16 + swz / 64; C = (st & 1) * 32 + (swz % 64) / 2; }
__host__ __device__ __forceinline__ int perm32(int rho) { const int n = rho >> 4, i = rho & 15; return 8 * (i >> 2) + 4 * n + (i & 3); }

struct Unit { int pm, pn; };
struct Gemm { const bf16_t* A; const bf16_t* Bt; int M, N, K; };

struct StaticOrder {
    int nM, nN, nwg, G, c;
    __host__ __device__ void init(int M, int N, int G_, int c_) { nM = M / BM; nN = N / BM; nwg = nM * nN; G = G_; c = c_; }
    __host__ __device__ bool next(int i, Unit& u) const {
        const long L = (long)i * G + c; if (L >= nwg) return false;
        int wgid = (int)L; { const int q = nwg / NXCD, r = nwg % NXCD, xcd = wgid % NXCD, off = wgid / NXCD; wgid = (xcd < r ? xcd * (q + 1) : r * (q + 1) + (xcd - r) * q) + off; }
        const int nig = WGM * nN, gid = wgid / nig, fm = gid * WGM, gsz = (nM - fm) < WGM ? (nM - fm) : WGM;
        u.pm = fm + ((wgid % nig) % gsz); u.pn = (wgid % nig) / gsz; return true;
    }
    __device__ __forceinline__ void a_ready(const Unit&) const {}
    __device__ __forceinline__ void done(const Unit&) const {}
};

__device__ __forceinline__ unsigned cvt_pk_bf16(float lo, float hi) { unsigned r; asm volatile("v_cvt_pk_bf16_f32 %0, %1, %2" : "=v"(r) : "v"(lo), "v"(hi)); return r; }

struct EpiInProj {
    static constexpr bool PERM = true, AFTER_DRAIN = false;
    bf16_t *Q, *K, *V, *G; float *kP, *vP, *kS, *vS; float qscale;
    __device__ __forceinline__ void operator()(const f32x4 (&acc)[2][2][4][2], const Unit& u, int wr, int wc, int fr, int fq) const {
        const int pn = u.pn, pm = u.pm;
        bf16_t* dst; int ldc, colbase; float sc = 1.f; float* fo = nullptr;
        if (pn < 2)      { dst = Q; ldc = 512; colbase = pn * 256; sc = qscale; }
        else if (pn < 4) { dst = K; ldc = 512; colbase = (pn - 2) * 256; fo = pm < 64 ? kP : kS; }
        else if (pn < 6) { dst = V; ldc = 512; colbase = (pn - 4) * 256; fo = pm < 64 ? vP : vS; }
        else             { dst = G; ldc = 1792; colbase = (pn - 6) * 256; }
        const int row0 = pm * BM + wr * 64 + fr, cl = colbase + wc * 32 + 8 * fq;
#pragma unroll
        for (int ai = 0; ai < 2; ++ai)
#pragma unroll
            for (int m = 0; m < 4; ++m) { const size_t row = (size_t)(row0 + ai * HALF + m * 16);
#pragma unroll
                for (int bj = 0; bj < 2; ++bj) { const f32x4 a0 = acc[ai][bj][m][0], a1 = acc[ai][bj][m][1]; const int col = cl + bj * HALF;
                    const f32x4 v0 = a0 * sc, v1 = a1 * sc; u32x4 w; w.x = cvt_pk_bf16(v0[0], v0[1]); w.y = cvt_pk_bf16(v0[2], v0[3]); w.z = cvt_pk_bf16(v1[0], v1[1]); w.w = cvt_pk_bf16(v1[2], v1[3]);
                    *(u32x4*)(dst + row * ldc + col) = w;
                    if (fo) { *(f32x4*)(fo + row * 512 + col) = a0; *(f32x4*)(fo + row * 512 + col + 4) = a1; } } }
    }
};
struct EpiRelu2 {
    static constexpr bool PERM = true, AFTER_DRAIN = false;
    bf16_t* O; int ldc;
    __device__ __forceinline__ void operator()(const f32x4 (&acc)[2][2][4][2], const Unit& u, int wr, int wc, int fr, int fq) const {
        const int row0 = u.pm * BM + wr * 64 + fr, col0 = u.pn * BM + wc * 32 + 8 * fq;
#pragma unroll
        for (int ai = 0; ai < 2; ++ai)
#pragma unroll
            for (int m = 0; m < 4; ++m) { bf16_t* rowp = O + (size_t)(row0 + ai * HALF + m * 16) * ldc + col0;
#pragma unroll
                for (int bj = 0; bj < 2; ++bj) { f32x4 v0 = acc[ai][bj][m][0], v1 = acc[ai][bj][m][1];
#pragma unroll
                    for (int e = 0; e < 4; ++e) { const float a = fmaxf(v0[e], 0.f), b = fmaxf(v1[e], 0.f); v0[e] = a * a; v1[e] = b * b; }
                    u32x4 w; w.x = cvt_pk_bf16(v0[0], v0[1]); w.y = cvt_pk_bf16(v0[2], v0[3]); w.z = cvt_pk_bf16(v1[0], v1[1]); w.w = cvt_pk_bf16(v1[2], v1[3]);
                    *(u32x4*)(rowp + bj * HALF) = w; } }
    }
};
struct EpiResGate {
    static constexpr bool PERM = false, AFTER_DRAIN = false;
    const float* baseP; const float* baseS; float* out; const float* gate;
    __device__ __forceinline__ void operator()(const f32x4 (&acc)[2][2][4][2], const Unit& u, int wr, int wc, int fr, int fq) const {
        const int col0 = u.pn * BM + wc * 32 + 4 * fq;
#pragma unroll
        for (int ai = 0; ai < 2; ++ai)
#pragma unroll
            for (int m = 0; m < 4; ++m) { const int row = u.pm * BM + ai * HALF + wr * 64 + m * 16 + fr; const int bidx = row < 16384 ? (row >> 13) : 2 + ((row - 16384) >> 3);
                const float* b = (row < 16384 ? baseP : baseS) + (size_t)row * 1024 + col0; const float* g = gate + (size_t)bidx * 6144 + col0; float* o = out + (size_t)row * 1024 + col0;
#pragma unroll
                for (int bj = 0; bj < 2; ++bj)
#pragma unroll
                    for (int n = 0; n < 2; ++n) { const int c = bj * HALF + n * 16; const f32x4 bs = *(const f32x4*)(b + c), gv = *(const f32x4*)(g + c); *(f32x4*)(o + c) = bs + gv * acc[ai][bj][m][n]; } }
    }
};
template <class Epi, class Sched, bool ALIGN_EPI = false, bool SP2 = false>
__device__ __forceinline__ void gemm_phase(PG8_LAS unsigned char* lds, const Gemm g, const Sched& S, const Epi& E) {
    int tid_ = threadIdx.x; asm volatile("" : "+v"(tid_)); const int tid = tid_, wid = __builtin_amdgcn_readfirstlane(tid >> 6), lane = tid & 63, wr = wid >> 2, wc = wid & 3, fr = lane & 15, fq = lane >> 4;
    const int K = g.K, nt = K / BK;
    unsigned voffA[2], voffB[2];
#pragma unroll
    for (int i = 0; i < 2; ++i) { int R, C; stage_rc(tid * 16 + i * 8192, R, C); const int Rb = Epi::PERM ? ((R & ~31) + perm32(R & 31)) : R;
        voffA[i] = (unsigned)(R * K + C) * 2u; voffB[i] = (unsigned)(Rb * K + C) * 2u; }
    const size_t kstep = (size_t)(BK * 2);
    const size_t hstep = (size_t)HALF * K * 2;
    const size_t tstep = 2 * hstep;
    const unsigned ldsw = (unsigned)wid * 1024u;
    const int aoff = lds_byte(wr * 64 + fr, fq * 8), boff = lds_byte(wc * 32 + fr, fq * 8);
#define PG8_SA(b, h) (((b) * 2 + (h)) * HTB)
#define PG8_SB(b, h) ((4 + (b) * 2 + (h)) * HTB)
#define PG8_STAGE(bufoff, gbase, voff) do { _Pragma("unroll") for (int _i = 0; _i < 2; ++_i) \
        __builtin_amdgcn_global_load_lds((const unsigned*)((const char*)(gbase) + (voff)[_i]), (PG8_LAS unsigned*)(lds + (bufoff) + ldsw + _i * 8192), 16, 0, 0); } while (0)
#define PG8_LDA(dst, b, h) do { _Pragma("unroll") for (int m = 0; m < 4; ++m) _Pragma("unroll") for (int k = 0; k < 2; ++k) dst[m][k] = *(const PG8_LAS bf16x8*)(lds + PG8_SA(b, h) + aoff + m * 2048 + k * 1024); } while (0)
#define PG8_LDB(dst, b, h) do { _Pragma("unroll") for (int n = 0; n < 2; ++n) _Pragma("unroll") for (int k = 0; k < 2; ++k) dst[n][k] = *(const PG8_LAS bf16x8*)(lds + PG8_SB(b, h) + boff + n * 2048 + k * 1024); } while (0)
#define PG8_MMA(ai, bj, At, Bt) do { __builtin_amdgcn_s_setprio(1); _Pragma("unroll") for (int m = 0; m < 4; ++m) _Pragma("unroll") for (int n = 0; n < 2; ++n) _Pragma("unroll") for (int k = 0; k < 2; ++k) \
        acc[ai][bj][m][n] = __builtin_amdgcn_mfma_f32_16x16x32_bf16(Bt[n][k], At[m][k], acc[ai][bj][m][n], 0, 0, 0); __builtin_amdgcn_s_setprio(0); } while (0)
#define PG8_WAIT_V(n) asm volatile("s_waitcnt vmcnt(" #n ")" ::: "memory")
#define PG8_WAIT_L(n) asm volatile("s_waitcnt lgkmcnt(" #n ")" ::: "memory")
#define PG8_BAR __builtin_amdgcn_s_barrier()
#define PG8_SCHED __builtin_amdgcn_sched_barrier(0)
    Unit cur, nxt; int ui = 0;
    if (!S.next(0, cur)) return;
    f32x4 acc[2][2][4][2];
#pragma unroll
    for (int a = 0; a < 2; ++a)
#pragma unroll
        for (int b = 0; b < 2; ++b)
#pragma unroll
            for (int m = 0; m < 4; ++m)
#pragma unroll
                for (int n = 0; n < 2; ++n) acc[a][b][m][n] = (f32x4){0.f, 0.f, 0.f, 0.f};
    bf16x8 At[4][2], B0[2][2], B1[2][2];
    const char* cA = (const char*)g.A + (size_t)cur.pm * tstep; const char* cB = (const char*)g.Bt + (size_t)cur.pn * tstep;
    S.a_ready(cur);
    if constexpr (SP2) {
        PG8_STAGE(PG8_SB(0, 0), cB, voffB); PG8_STAGE(PG8_SB(0, 1), cB + hstep, voffB); PG8_STAGE(PG8_SA(0, 0), cA, voffA); PG8_STAGE(PG8_SA(0, 1), cA + hstep, voffA);
        if (wr == 1) PG8_BAR;
        PG8_WAIT_V(2); PG8_BAR;
        PG8_STAGE(PG8_SB(1, 0), cB + kstep, voffB); PG8_STAGE(PG8_SA(1, 0), cA + kstep, voffA); PG8_STAGE(PG8_SB(1, 1), cB + hstep + kstep, voffB);
        PG8_WAIT_V(6); PG8_BAR;
    } else {
        PG8_STAGE(PG8_SB(0, 0), cB, voffB); PG8_STAGE(PG8_SA(0, 0), cA, voffA); PG8_STAGE(PG8_SB(0, 1), cB + hstep, voffB); PG8_STAGE(PG8_SA(0, 1), cA + hstep, voffA);
        if (wr == 1) PG8_BAR;
        PG8_WAIT_V(4); PG8_BAR;
        PG8_STAGE(PG8_SB(1, 0), cB + kstep, voffB); PG8_STAGE(PG8_SA(1, 0), cA + kstep, voffA); PG8_STAGE(PG8_SB(1, 1), cB + hstep + kstep, voffB);
        PG8_WAIT_V(6); PG8_BAR;
    }
    for (;;) {
        const bool has_next = S.next(ui + 1, nxt);
        const char* nA = has_next ? (const char*)g.A + (size_t)nxt.pm * tstep : cA; const char* nB = has_next ? (const char*)g.Bt + (size_t)nxt.pn * tstep : cB;
        for (int t = 0; t < nt; t += 2) {
            const bool last = (t == nt - 2);
            const char* a1 = cA + (size_t)(t + 1) * kstep;
            const char* a2 = last ? nA : cA + (size_t)(t + 2) * kstep; const char* b2 = last ? nB : cB + (size_t)(t + 2) * kstep;
            const char* a3 = a2 + kstep; const char* b3 = b2 + kstep;
            if (last && has_next) S.a_ready(nxt);
            if constexpr (SP2) {
            PG8_LDB(B0, 0, 0); PG8_LDB(B1, 0, 1); PG8_SCHED; PG8_LDA(At, 0, 0); PG8_STAGE(PG8_SA(1, 1), a1 + hstep, voffA);
            PG8_WAIT_V(8); PG8_WAIT_L(0); PG8_BAR; PG8_MMA(0, 0, At, B0); PG8_MMA(0, 1, At, B1); PG8_BAR; PG8_SCHED;
            PG8_LDA(At, 0, 1); PG8_STAGE(PG8_SB(0, 0), b2, voffB); PG8_STAGE(PG8_SB(0, 1), b2 + hstep, voffB); PG8_STAGE(PG8_SA(0, 0), a2, voffA);
            PG8_WAIT_V(8); PG8_WAIT_L(0); PG8_BAR; PG8_MMA(1, 0, At, B0); PG8_MMA(1, 1, At, B1); PG8_BAR; PG8_SCHED;
            PG8_LDB(B0, 1, 0); PG8_LDB(B1, 1, 1); PG8_SCHED; PG8_LDA(At, 1, 0); PG8_STAGE(PG8_SA(0, 1), a2 + hstep, voffA);
            PG8_WAIT_V(8); PG8_WAIT_L(0); PG8_BAR; PG8_MMA(0, 0, At, B0); PG8_MMA(0, 1, At, B1); PG8_BAR; PG8_SCHED;
            PG8_LDA(At, 1, 1); PG8_STAGE(PG8_SB(1, 0), b3, voffB); PG8_STAGE(PG8_SB(1, 1), b3 + hstep, voffB); PG8_STAGE(PG8_SA(1, 0), a3, voffA);
            PG8_WAIT_V(8); PG8_WAIT_L(0); PG8_BAR; PG8_MMA(1, 0, At, B0); PG8_MMA(1, 1, At, B1); PG8_BAR; PG8_SCHED;
            } else {
            PG8_LDB(B0, 0, 0); PG8_SCHED; PG8_LDA(At, 0, 0); PG8_STAGE(PG8_SA(1, 1), a1 + hstep, voffA);
            PG8_WAIT_L(8); PG8_BAR; PG8_WAIT_L(0); PG8_MMA(0, 0, At, B0); PG8_BAR; PG8_SCHED;
            PG8_LDB(B1, 0, 1); PG8_STAGE(PG8_SB(0, 0), b2, voffB);
            PG8_BAR; PG8_WAIT_L(0); PG8_MMA(0, 1, At, B1); PG8_BAR;
            PG8_LDA(At, 0, 1); PG8_STAGE(PG8_SA(0, 0), a2, voffA);
            PG8_BAR; PG8_WAIT_L(0); PG8_MMA(1, 0, At, B0); PG8_BAR; PG8_SCHED;
            PG8_STAGE(PG8_SB(0, 1), b2 + hstep, voffB);
            PG8_WAIT_V(6); PG8_BAR; PG8_MMA(1, 1, At, B1); PG8_BAR;
            PG8_LDB(B0, 1, 0); PG8_SCHED; PG8_LDA(At, 1, 0); PG8_STAGE(PG8_SA(0, 1), a2 + hstep, voffA);
            PG8_WAIT_L(8); PG8_BAR; PG8_WAIT_L(0); PG8_MMA(0, 0, At, B0); PG8_BAR; PG8_SCHED;
            PG8_LDB(B1, 1, 1); PG8_STAGE(PG8_SB(1, 0), b3, voffB);
            PG8_BAR; PG8_WAIT_L(0); PG8_MMA(0, 1, At, B1); PG8_BAR;
            PG8_LDA(At, 1, 1); PG8_STAGE(PG8_SA(1, 0), a3, voffA);
            PG8_BAR; PG8_WAIT_L(0); PG8_MMA(1, 0, At, B0); PG8_BAR; PG8_SCHED;
            PG8_STAGE(PG8_SB(1, 1), b3 + hstep, voffB);
            PG8_WAIT_V(6); PG8_BAR; PG8_MMA(1, 1, At, B1); PG8_BAR;
            }
        }
        if constexpr (ALIGN_EPI) { if (wr == 0) PG8_BAR; }
        if constexpr (!Epi::AFTER_DRAIN) { E(acc, cur, wr, wc, fr, fq); S.done(cur); }
        if (!has_next) break;
#pragma unroll
        for (int a = 0; a < 2; ++a)
#pragma unroll
            for (int b = 0; b < 2; ++b)
#pragma unroll
                for (int m = 0; m < 4; ++m)
#pragma unroll
                    for (int n = 0; n < 2; ++n) acc[a][b][m][n] = (f32x4){0.f, 0.f, 0.f, 0.f};
        cur = nxt; cA = nA; cB = nB; ++ui;
        if constexpr (ALIGN_EPI) { if (wr == 1) PG8_BAR; }
    }
    PG8_WAIT_V(0);
    if constexpr (!ALIGN_EPI) { if (wr == 0) PG8_BAR; }
    PG8_BAR;
    if constexpr (Epi::AFTER_DRAIN) { E.fused(acc, cur, wr, wc, fr, fq, lds, wid, lane); S.done(cur); }
#undef PG8_SA
#undef PG8_SB
#undef PG8_STAGE
#undef PG8_LDA
#undef PG8_LDB
#undef PG8_MMA
#undef PG8_WAIT_V
#undef PG8_WAIT_L
#undef PG8_BAR
#undef PG8_SCHED
}
}
constexpr int NWAVES = 8;
constexpr int D = 1024, TP = 8192, MP = 16384, MS = 256, M = MP + MS, FF = 4096, NIN = 3328, NIN_REAL = 3088, NMODR = 34, MODW = 6144;
constexpr float NORM_EPS = 1e-6f;
constexpr float QSCALE = 0.125f * 1.4426950408889634f;
constexpr size_t OY = 0, OK_P = 17039360, OV_P = 25427968, OSG_P = 33816576, OK_S = 33882112, OV_S = 34013184, OSG_S = 34144256, OUT_TOTAL = 35192832;
constexpr size_t MiB = 1u << 20;
constexpr size_t WS_CTL = 0, CTL_ZERO_BYTES = 1 * MiB;
constexpr size_t WS_MOD = 1 * MiB, WS_WIN = 2 * MiB, WS_WO = 9 * MiB, WS_WUP = 11 * MiB, WS_WDN = 19 * MiB;
constexpr size_t WS_SLOC = 27 * MiB, WS_DSEG = 35 * MiB, WS_DPART = 36 * MiB, WS_DRTOT = 40 * MiB;
constexpr size_t WS_XN = 48 * MiB, WS_Q = 82 * MiB, WS_K = 99 * MiB, WS_V = 116 * MiB, WS_G = 133 * MiB, WS_MIX = 190 * MiB, WS_X1 = 224 * MiB, WS_H = 290 * MiB, WS_END = 421 * MiB;
static_assert(WS_WIN + (size_t)NIN * D * 2 <= WS_WO && WS_G + (size_t)M * 1792 * 2 <= WS_MIX && WS_MIX + (size_t)M * D * 2 <= WS_X1 && WS_X1 + (size_t)M * D * 4 <= WS_H && WS_H + (size_t)M * FF * 2 <= WS_END, "d_ws map");
static_assert(WS_XN + (size_t)M * D * 2 <= WS_Q && WS_Q + (size_t)M * 512 * 2 <= WS_K && WS_K + (size_t)M * 512 * 2 <= WS_V && WS_V + (size_t)M * 512 * 2 <= WS_G, "d_ws map 2");
constexpr int CW_BAR = 4096, CW_DEC = 16384;
constexpr int RING_BYTES = 139264, MISC_OFF = 146944, LDS_BYTES = 147456;

#define GAS __attribute__((address_space(1)))
#define LAS __attribute__((address_space(3)))
typedef unsigned short bf16;
typedef unsigned v4u __attribute__((ext_vector_type(4)));
typedef float f32x4 __attribute__((ext_vector_type(4)));
#define LDS_WAIT() asm volatile("s_waitcnt lgkmcnt(0)" ::: "memory")
__device__ __forceinline__ unsigned f2bf(float f) { unsigned u = __builtin_bit_cast(unsigned, f); return (u + 0x7fffu + ((u >> 16) & 1u)) >> 16; }
__device__ __forceinline__ unsigned pk2(float lo, float hi) { return f2bf(lo) | (f2bf(hi) << 16); }
#define XB_TMO      128
#define XB_XCNT(j)  (256  + 64 * (j))
#define XB_XSUB(j)  (1280 + 64 * (j))
#define XB_XGEN(j)  (2304 + 64 * (j))
#define XB_TOP      3328
#define XB_TOPGEN   3392
#define XCD_BAR_WORDS 3456
#define XB_SPIN_CAP (1u << 18)

__device__ __forceinline__ unsigned xb_ld(unsigned* p)              { return __hip_atomic_load(p, __ATOMIC_RELAXED, __HIP_MEMORY_SCOPE_AGENT); }
__device__ __forceinline__ unsigned xb_add(unsigned* p, unsigned v) { return __hip_atomic_fetch_add(p, v, __ATOMIC_RELAXED, __HIP_MEMORY_SCOPE_AGENT); }
__device__ __forceinline__ unsigned xb_xcc_id() { return (unsigned)__builtin_amdgcn_s_getreg((3 << 11) | 20) & 0xFu; }
#define XB_SPIN(cond, bar) do { unsigned _sp = 0; while (cond) { __builtin_amdgcn_s_sleep(1); \
    if ((++_sp & 255u) == 0u) { if (xb_ld(&(bar)[XB_TMO])) break; if (_sp > XB_SPIN_CAP) { atomicAdd(&(bar)[XB_TMO], 1u); break; } } } } while (0)

struct XcdBarrier {
    unsigned* bar; unsigned x;
    volatile LAS unsigned* st;
};

__device__ __forceinline__ XcdBarrier xcd_barrier_post(unsigned* bar, volatile LAS unsigned* st) {
    XcdBarrier b; b.bar = bar; b.x = xb_xcc_id(); b.st = st;
    if (threadIdx.x == 0) (void)xb_add(&bar[XB_XCNT(b.x)], 1u);
    return b;
}
__device__ __forceinline__ void xcd_barrier_complete(unsigned* bar, unsigned x, unsigned& nloc, unsigned& nx) {
    const unsigned G = gridDim.x * gridDim.y * gridDim.z;
    unsigned sum, cnt, mine, sp = 0u;
    for (;;) {
        sum = 0u; cnt = 0u; mine = 0u;
#pragma unroll
        for (unsigned j = 0; j < 16; ++j) { const unsigned c = xb_ld(&bar[XB_XCNT(j)]); sum += c; cnt += (c > 0u) ? 1u : 0u; mine = (j == x) ? c : mine; }
        if (sum == G) break;
        __builtin_amdgcn_s_sleep(1);
        if ((++sp & 255u) == 0u) { if (xb_ld(&bar[XB_TMO])) break; if (sp > XB_SPIN_CAP) { atomicAdd(&bar[XB_TMO], 1u); break; } }
    }
    nloc = mine > 0u ? mine : 1u; nx = cnt > 0u ? cnt : 1u;
}

__device__ __forceinline__ void xcd_barrier(const XcdBarrier& b) {
    asm volatile("s_waitcnt vmcnt(0)" ::: "memory");
    __syncthreads();
    if (threadIdx.x == 0) {
        unsigned* bar = b.bar;
        __builtin_amdgcn_s_waitcnt(0);
        unsigned nloc = b.st[0], nx = b.st[1];
        if (nloc == 0u) { xcd_barrier_complete(bar, b.x, nloc, nx); b.st[0] = nloc; b.st[1] = nx; }
        const unsigned old = xb_add(&bar[XB_XSUB(b.x)], 1u);
        const unsigned gen = old / nloc;
        if (old + 1u == (gen + 1u) * nloc) {
            __builtin_amdgcn_fence(__ATOMIC_RELEASE, "agent");
            asm volatile("s_waitcnt vmcnt(0)" ::: "memory");
            const unsigned og = xb_add(&bar[XB_TOP], 1u);
            const unsigned tg = og / nx;
            if (og + 1u == (tg + 1u) * nx) xb_add(&bar[XB_TOPGEN], 1u);
            else XB_SPIN(xb_ld(&bar[XB_TOPGEN]) == tg, bar);
            __builtin_amdgcn_fence(__ATOMIC_ACQUIRE, "agent");
            xb_add(&bar[XB_XGEN(b.x)], 1u);
            asm volatile("s_waitcnt vmcnt(0)" ::: "memory");
        } else {
            XB_SPIN(xb_ld(&bar[XB_XGEN(b.x)]) == gen, bar);
            __builtin_amdgcn_fence(__ATOMIC_ACQUIRE, "agent");
            asm volatile("s_waitcnt vmcnt(0)" ::: "memory");
        }
    }
    __syncthreads();
}
namespace sba {
using bf16x8=__attribute__((ext_vector_type(8)))short;
using s16x4=__attribute__((ext_vector_type(4)))short;
using f32x16=__attribute__((ext_vector_type(16)))float;
using u32x4=__attribute__((ext_vector_type(4)))unsigned;
typedef __hip_bfloat16 bf16;
constexpr int SEQ=8192,D=64,DM=512,OP=1024;
constexpr int NW=8,QBLK=32,QB=QBLK*NW,KVBLK=64;
constexpr int NSLOT=3,SLOTB=8192;
constexpr int LDS_K=0,LDS_V=NSLOT*SLOTB,LDS_OST=2*NSLOT*SLOTB,LDS_BYTES=LDS_OST+NW*4096;
__device__ __forceinline__ int crow(int r,int hi){return (r&3)+8*(r>>2)+4*hi;}
__device__ __forceinline__ void glds16(const void*gsrc,unsigned lds_dst){unsigned keep;
  asm volatile("s_mov_b32 %0, m0\n\ts_mov_b32 m0, %2\n\ts_nop 0\n\tglobal_load_lds_dwordx4 %1, off\n\ts_mov_b32 m0, %0":"=&s"(keep):"v"(gsrc),"s"(lds_dst):"memory");}
typedef float f32x2_t __attribute__((ext_vector_type(2))); typedef __bf16 bf16x2_t __attribute__((ext_vector_type(2)));
__device__ __forceinline__ unsigned cvtpk_s(float lo,float hi){f32x2_t v={lo,hi};bf16x2_t b=__builtin_convertvector(v,bf16x2_t);return __builtin_bit_cast(unsigned,b);}
typedef __attribute__((address_space(3))) const char* lds_cptr;
typedef short v4i16_t __attribute__((ext_vector_type(4)));
__device__ __forceinline__ s16x4 vtr(lds_cptr p){ return __builtin_bit_cast(s16x4,__builtin_amdgcn_ds_read_tr16_b64_v4i16((__attribute__((address_space(3))) v4i16_t*)p)); }
#define SBA_MFMA(a,b,c) __builtin_amdgcn_mfma_f32_32x32x16_bf16((a),(b),(c),0,0,0)
template<bool MASK> __device__ __forceinline__ void sb_weights(f32x16&c0,f32x16&c1,float&carry,int hi,int jb,int qrel){
  #pragma unroll
  for(int r=0;r<16;++r){
    float e0=__builtin_amdgcn_exp2f(c0[r]), e1=__builtin_amdgcn_exp2f(c1[r]);
    if(MASK){ const int kv=64*jb+crow(r,hi); if(kv>=qrel)e0=0.f; if(kv+32>=qrel)e1=0.f; }
    c0[r]=1.f+e0; c1[r]=1.f+e1; }
  float P2[8],P3[8],T[8];
  #pragma unroll
  for(int c=0;c<4;++c){ P2[c]=c0[4*c]*c0[4*c+1]; P3[c]=P2[c]*c0[4*c+2]; T[c]=__builtin_amdgcn_rcpf(P3[c]*c0[4*c+3]);
                        P2[4+c]=c1[4*c]*c1[4*c+1]; P3[4+c]=P2[4+c]*c1[4*c+2]; T[4+c]=__builtin_amdgcn_rcpf(P3[4+c]*c1[4*c+3]); }
  float Tl[8],Th[8];
  #pragma unroll
  for(int c=0;c<8;++c){ auto rr=__builtin_amdgcn_permlane32_swap(__float_as_uint(T[c]),__float_as_uint(T[c]),false,false); Tl[c]=__uint_as_float(rr[0]); Th[c]=__uint_as_float(rr[1]); }
  float E=carry;
  float off[8];
  #pragma unroll
  for(int c=7;c>=0;--c){ off[c]=hi?E:E*Th[c]; E=E*(Tl[c]*Th[c]); }
  carry=E;
  #pragma unroll
  for(int c=0;c<4;++c){
    { const float g=T[c]*off[c], R1=c0[4*c]*g, R2=P2[c]*g, R3=P3[c]*g; c0[4*c]=R1-g; c0[4*c+1]=R2-R1; c0[4*c+2]=R3-R2; c0[4*c+3]=off[c]-R3; }
    { const float g=T[4+c]*off[4+c], R1=c1[4*c]*g, R2=P2[4+c]*g, R3=P3[4+c]*g; c1[4*c]=R1-g; c1[4*c+1]=R2-R1; c1[4*c+2]=R3-R2; c1[4*c+3]=off[4+c]-R3; } }
}
__device__ __forceinline__ void pv(f32x16*o,lds_cptr vp,const f32x16&w0,const f32x16&w1){
  u32x4 pw[4];
  #pragma unroll
  for(int k=0;k<2;++k)
    #pragma unroll
    for(int j=0;j<4;++j){ pw[k][j]=cvtpk_s(w0[8*k+2*j],w0[8*k+2*j+1]); pw[2+k][j]=cvtpk_s(w1[8*k+2*j],w1[8*k+2*j+1]); }
  #pragma unroll
  for(int d0=0;d0<2;++d0)
    #pragma unroll
    for(int ks=0;ks<4;++ks){ const s16x4 lo=vtr(vp+d0*4096+ks*1024), hh=vtr(vp+d0*4096+ks*1024+512);
      const bf16x8 vf={lo[0],lo[1],lo[2],lo[3],hh[0],hh[1],hh[2],hh[3]};
      o[d0]=SBA_MFMA(__builtin_bit_cast(bf16x8,pw[ks]),vf,o[d0]); }
}
__device__ __forceinline__ void attn_unit(int b,int h,int qb,const bf16*Q,const bf16*__restrict__ K,const bf16*__restrict__ V,bf16*O,char*shm,float bias2){
  int tid_=threadIdx.x; asm volatile("":"+v"(tid_)); const int tid=tid_,lane=tid&63,r32=lane&31,hi=lane>>5; const int wid=__builtin_amdgcn_readfirstlane(tid>>6);
  const long rowbase=(long)b*SEQ; const int q0=qb*QB;
  const bf16*Qw=Q+(rowbase+q0+wid*QBLK)*DM+h*D;
  const bf16*Kh=K+rowbase*DM+h*D,*Vh=V+rowbase*DM+h*D;
  const unsigned lds0=(unsigned)(uintptr_t)shm;
  const bf16*ksrc=Kh+(long)lane*DM+wid*8;
  const bf16*vsrc=Vh+(long)(16*(wid&3)+(lane>>2))*DM+(wid>>2)*32+(lane&3)*8;
  const unsigned kdst=lds0+LDS_K+wid*1024, vdst=lds0+LDS_V+wid*1024;
  const int NT=(q0+QB)/KVBLK;
  #define DMA_KV(s_,slot_) do{ const long t_=(long)(NT-1-(s_))*KVBLK*DM; glds16(ksrc+t_,(unsigned)__builtin_amdgcn_readfirstlane(kdst+(slot_)*SLOTB)); glds16(vsrc+t_,(unsigned)__builtin_amdgcn_readfirstlane(vdst+(slot_)*SLOTB)); }while(0)
  bf16x8 qr[4];
  #pragma unroll
  for(int d0=0;d0<4;++d0)qr[d0]=*reinterpret_cast<const bf16x8*>(&Qw[(long)r32*DM+d0*16+hi*8]);
  DMA_KV(0,0); DMA_KV(1,1);
  const lds_cptr shm3=(lds_cptr)shm; const lds_cptr kp0=shm3+LDS_K+hi*1024+r32*16; const lds_cptr vp0=shm3+LDS_V+((lane>>4)&1)*32+(lane&3)*8+(4*hi+((lane&15)>>2))*64;
  f32x16 o[2];o[0]=f32x16{};o[1]=f32x16{}; f32x16 bv;
  #pragma unroll
  for(int r=0;r<16;++r)bv[r]=bias2;
  asm volatile("":"+v"(bv));
  float carry=1.f; const int qrel=wid*QBLK+r32;
  int slot=0;
  for(int s=0;s<NT;++s){
    if(s+1<NT) asm volatile("s_waitcnt vmcnt(2) lgkmcnt(0)\n\ts_barrier":::"memory"); else asm volatile("s_waitcnt vmcnt(0) lgkmcnt(0)\n\ts_barrier":::"memory");
    if(s+2<NT){ const int ns=(slot==0)?2:slot-1; DMA_KV(s+2,ns); }
    const lds_cptr kp=kp0+slot*SLOTB;
    f32x16 c0=bv,c1=bv;
    #pragma unroll
    for(int d0=0;d0<4;++d0){
      const bf16x8 k0=*(const __attribute__((address_space(3))) bf16x8*)(kp+d0*2048), k1=*(const __attribute__((address_space(3))) bf16x8*)(kp+d0*2048+512);
      c0=SBA_MFMA(k0,qr[d0],c0); c1=SBA_MFMA(k1,qr[d0],c1); }
    if(s<4) sb_weights<true>(c0,c1,carry,hi,3-s,qrel); else sb_weights<false>(c0,c1,carry,hi,0,0);
    pv(o,vp0+slot*SLOTB,c0,c1);
    slot=(slot==2)?0:slot+1;
  }
  #undef DMA_KV
  bf16*Ow=O+(rowbase+q0+wid*QBLK)*OP+h*D;
  { bf16*stg=(bf16*)(shm+LDS_OST)+wid*2048;
    #pragma unroll
    for(int r=0;r<16;++r){const int orow=crow(r,hi);
      #pragma unroll
      for(int d0=0;d0<2;++d0)stg[orow*64+d0*32+r32]=__float2bfloat16(o[d0][r]);}
    asm volatile("s_waitcnt lgkmcnt(0)":::"memory");
    #pragma unroll
    for(int i=0;i<4;++i){const int row=i*8+(lane>>3),ch=lane&7; const u32x4 v=*(const u32x4*)(stg+row*64+ch*8); *(u32x4*)(Ow+(long)row*OP+ch*8)=v;} }
  asm volatile("s_waitcnt vmcnt(0) lgkmcnt(0)\n\ts_barrier":::"memory");
}
}
namespace sb8 {
typedef sba::bf16 bf16; using sba::bf16x8; using sba::s16x4; using sba::f32x16; using sba::u32x4; using sba::lds_cptr; using sba::glds16; using sba::vtr;
constexpr int SEQ=sba::SEQ,D=sba::D,DM=sba::DM,OP=sba::OP,QBLK=sba::QBLK,QB=sba::QB,KVBLK=sba::KVBLK,NSLOT=sba::NSLOT,SLOTB=sba::SLOTB;
constexpr int LDS_K=sba::LDS_K,LDS_V=sba::LDS_V,LDS_OST=sba::LDS_OST;
__device__ __forceinline__ unsigned cvtpk_a(float lo,float hi){ unsigned r; asm("v_cvt_pk_bf16_f32 %0, %1, %2":"=v"(r):"v"(lo),"v"(hi)); return r; }
template<bool MASK> __device__ __forceinline__ void weights(f32x16&c0,f32x16&c1,float&carry,int hi,int thr){
  #pragma unroll
  for(int r=0;r<16;++r){ float e0=__builtin_amdgcn_exp2f(c0[r]), e1=__builtin_amdgcn_exp2f(c1[r]);
    if(MASK){ if(r>=thr)e0=0.f; if(32+r>=thr)e1=0.f; }
    c0[r]=e0; c1[r]=e1; }
  float q0=1.f+c0[0], q1=1.f+c1[0];
  #pragma unroll
  for(int r=1;r<16;++r){ const float e0=c0[r], e1=c1[r]; c0[r]=q0*e0; c1[r]=q1*e1; q0=__builtin_fmaf(q0,e0,q0); q1=__builtin_fmaf(q1,e1,q1); }
  const float t0=__builtin_amdgcn_rcpf(q0), t1=__builtin_amdgcn_rcpf(q1);
  auto s1=__builtin_amdgcn_permlane32_swap(__float_as_uint(t1),__float_as_uint(t1),false,false);
  auto s0=__builtin_amdgcn_permlane32_swap(__float_as_uint(t0),__float_as_uint(t0),false,false);
  const float t1l=__uint_as_float(s1[0]),t1h=__uint_as_float(s1[1]),t0l=__uint_as_float(s0[0]),t0h=__uint_as_float(s0[1]);
  const float off1=hi?carry:carry*t1h; const float E=carry*(t1l*t1h);
  const float off0=hi?E:E*t0h; carry=E*(t0l*t0h);
  const float g1=t1*off1, g0=t0*off0;
  #pragma unroll
  for(int r=0;r<16;++r){ c0[r]*=g0; c1[r]*=g1; }
}
__device__ __forceinline__ void pv(f32x16*o,lds_cptr vp,const f32x16&w0,const f32x16&w1){
  u32x4 pw[4];
  #pragma unroll
  for(int k=0;k<2;++k)
    #pragma unroll
    for(int j=0;j<4;++j){ pw[k][j]=cvtpk_a(w0[8*k+2*j],w0[8*k+2*j+1]); pw[2+k][j]=cvtpk_a(w1[8*k+2*j],w1[8*k+2*j+1]); }
  #pragma unroll
  for(int d0=0;d0<2;++d0)
    #pragma unroll
    for(int ks=0;ks<4;++ks){ const s16x4 lo=vtr(vp+d0*4096+(ks>>1)*2048+(ks&1)*512), hh=vtr(vp+d0*4096+(ks>>1)*2048+(ks&1)*512+256);
      const bf16x8 vf={lo[0],lo[1],lo[2],lo[3],hh[0],hh[1],hh[2],hh[3]};
      o[d0]=SBA_MFMA(__builtin_bit_cast(bf16x8,pw[ks]),vf,o[d0]); }
}
__device__ __forceinline__ void qk(f32x16&c0,f32x16&c1,lds_cptr kp,const bf16x8*qr,const f32x16&bv){
  bf16x8 kf[8];
  #pragma unroll
  for(int d0=0;d0<4;++d0){ kf[2*d0]=*(const __attribute__((address_space(3))) bf16x8*)(kp+d0*2048); kf[2*d0+1]=*(const __attribute__((address_space(3))) bf16x8*)(kp+d0*2048+512); }
  c0=SBA_MFMA(kf[0],qr[0],bv); c1=SBA_MFMA(kf[1],qr[0],bv);
  #pragma unroll
  for(int d0=1;d0<4;++d0){ c0=SBA_MFMA(kf[2*d0],qr[d0],c0); c1=SBA_MFMA(kf[2*d0+1],qr[d0],c1); }
}
__device__ __forceinline__ void attn_unit(int b,int h,int qb,const bf16*Q,const bf16*__restrict__ K,const bf16*__restrict__ V,bf16*O,char*shm,float bias2){
  int tid_=threadIdx.x; asm volatile("":"+v"(tid_)); const int tid=tid_,lane=tid&63,r32=lane&31,hi=lane>>5; const int wid=__builtin_amdgcn_readfirstlane(tid>>6);
  const long rowbase=(long)b*SEQ; const int q0=qb*QB;
  const bf16*Qw=Q+(rowbase+q0+wid*QBLK)*DM+h*D;
  const bf16*Kh=K+rowbase*DM+h*D,*Vh=V+rowbase*DM+h*D;
  const unsigned lds0=(unsigned)(uintptr_t)shm;
  const bf16*ksrc=Kh+(long)lane*DM+wid*8;
  const bf16*vsrc=Vh+(long)(16*(wid&3)+(lane>>2))*DM+(wid>>2)*32+(lane&3)*8;
  const unsigned kdst=lds0+LDS_K+wid*1024, vdst=lds0+LDS_V+wid*1024;
  const int NT=(q0+QB)/KVBLK;
  #define DMA8_K(s_,slot_) do{ const long t_=(long)(NT-1-(s_))*KVBLK*DM; glds16(ksrc+t_,(unsigned)__builtin_amdgcn_readfirstlane(kdst+(slot_)*SLOTB)); }while(0)
  #define DMA8_V(s_,slot_) do{ const long t_=(long)(NT-1-(s_))*KVBLK*DM; glds16(vsrc+t_,(unsigned)__builtin_amdgcn_readfirstlane(vdst+(slot_)*SLOTB)); }while(0)
  bf16x8 qr[4];
  #pragma unroll
  for(int d0=0;d0<4;++d0)qr[d0]=*reinterpret_cast<const bf16x8*>(&Qw[(long)r32*DM+d0*16+hi*8]);
  DMA8_K(0,0);
  DMA8_K(1,1); DMA8_V(0,0);
  DMA8_K(2,2); DMA8_V(1,1);
  const int kperm=16*((r32>>2)&1)+(r32&3)+4*(r32>>3);
  const lds_cptr shm3=(lds_cptr)shm; const lds_cptr kp0=shm3+LDS_K+hi*1024+kperm*16; const lds_cptr vp0=shm3+LDS_V+((lane>>4)&1)*32+(lane&3)*8+(16*hi+((lane&15)>>2))*64;
  f32x16 o[2];o[0]=f32x16{};o[1]=f32x16{}; f32x16 bv;
  #pragma unroll
  for(int r=0;r<16;++r)bv[r]=bias2;
  asm volatile("":"+v"(bv));
  float carry=1.f; const int qrel=wid*QBLK+r32;
  f32x16 a0,a1,b0,b1;
  asm volatile("s_waitcnt vmcnt(4) lgkmcnt(0)\n\ts_barrier":::"memory");
  qk(a0,a1,kp0,qr,bv);
  int ks1=1,vs0=0;
  #define STEP8(C0,C1,N0,N1,st_) do{ const int st=(st_); \
    if(st+2<NT) asm volatile("s_waitcnt vmcnt(2) lgkmcnt(0)\n\ts_barrier":::"memory"); else if(st+2==NT) asm volatile("s_waitcnt vmcnt(1) lgkmcnt(0)\n\ts_barrier":::"memory"); else asm volatile("s_waitcnt vmcnt(0) lgkmcnt(0)\n\ts_barrier":::"memory"); \
    { const int kfree=(ks1==0)?2:ks1-1; const int vfree=(vs0==0)?2:vs0-1; if(st+3<NT) DMA8_K(st+3,kfree); if(st+2<NT) DMA8_V(st+2,vfree); } \
    if(st+1<NT) qk(N0,N1,kp0+ks1*SLOTB,qr,bv); \
    __builtin_amdgcn_sched_barrier(0); \
    if(st<4) weights<true>(C0,C1,carry,hi,qrel-64*(3-st)-16*hi); else weights<false>(C0,C1,carry,hi,0); \
    pv(o,vp0+vs0*SLOTB,C0,C1); \
    ks1=(ks1==2)?0:ks1+1; vs0=(vs0==2)?0:vs0+1; }while(0)
  for(int it=0;it<NT;it+=2){ STEP8(a0,a1,b0,b1,it); STEP8(b0,b1,a0,a1,it+1); }
  #undef STEP8
  #undef DMA8_K
  #undef DMA8_V
  bf16*Ow=O+(rowbase+q0+wid*QBLK)*OP+h*D;
  { bf16*stg=(bf16*)(shm+LDS_OST)+wid*2048;
    #pragma unroll
    for(int r=0;r<16;++r){const int orow=sba::crow(r,hi);
      #pragma unroll
      for(int d0=0;d0<2;++d0)stg[orow*64+d0*32+r32]=__float2bfloat16(o[d0][r]);}
    asm volatile("s_waitcnt lgkmcnt(0)":::"memory");
    #pragma unroll
    for(int i=0;i<4;++i){const int row=i*8+(lane>>3),ch=lane&7; const u32x4 v=*(const u32x4*)(stg+row*64+ch*8); *(u32x4*)(Ow+(long)row*OP+ch*8)=v;} }
  asm volatile("s_waitcnt vmcnt(0) lgkmcnt(0)\n\ts_barrier":::"memory");
}
}
namespace sbd {
using sba::bf16x8; using sba::f32x16; using sba::u32x4; using sba::bf16; using sba::crow; using sba::cvtpk_s;
typedef float f32x4 __attribute__((ext_vector_type(4)));
#define RLXA __ATOMIC_RELAXED, __HIP_MEMORY_SCOPE_AGENT
template<bool NEWK> __device__ __forceinline__ void weights32(f32x16&c,float&carry,int hi,int q){
  #pragma unroll
  for(int r=0;r<16;++r){ float e=__builtin_amdgcn_exp2f(c[r]);
    if(NEWK){ const int kv=crow(r,hi); if(kv>=8||kv>=q)e=0.f; }
    c[r]=1.f+e; }
  float P2[4],P3[4],T[4],Tl[4],Th[4],off[4];
  #pragma unroll
  for(int k=0;k<4;++k){ P2[k]=c[4*k]*c[4*k+1]; P3[k]=P2[k]*c[4*k+2]; T[k]=__builtin_amdgcn_rcpf(P3[k]*c[4*k+3]); }
  #pragma unroll
  for(int k=0;k<4;++k){ auto s=__builtin_amdgcn_permlane32_swap(__float_as_uint(T[k]),__float_as_uint(T[k]),false,false); Tl[k]=__uint_as_float(s[0]); Th[k]=__uint_as_float(s[1]); }
  float E=carry;
  #pragma unroll
  for(int k=3;k>=0;--k){ off[k]=hi?E:E*Th[k]; E=E*(Tl[k]*Th[k]); }
  carry=E;
  #pragma unroll
  for(int k=0;k<4;++k){ const float g=T[k]*off[k], R1=c[4*k]*g, R2=P2[k]*g, R3=P3[k]*g; c[4*k]=R1-g; c[4*k+1]=R2-R1; c[4*k+2]=R3-R2; c[4*k+3]=off[k]-R3; }
}
struct Raw { f32x4 k[8]; f32x4 v[8]; };
typedef unsigned u32x2v __attribute__((ext_vector_type(2)));
__device__ __forceinline__ void load_tile(Raw&R,__amdgpu_buffer_rsrc_t rk,__amdgpu_buffer_rsrc_t rv,unsigned ub,int kvo){
  #pragma unroll
  for(int i=0;i<8;++i) R.k[i]=__builtin_bit_cast(f32x4,__builtin_amdgcn_raw_buffer_load_b128(rk,kvo,(int)(ub+(unsigned)i*8192u),2));
  #pragma unroll
  for(int i=0;i<8;++i) R.v[i]=__builtin_bit_cast(f32x4,__builtin_amdgcn_raw_buffer_load_b128(rv,kvo,(int)(ub+(unsigned)i*8192u),2));
}
struct Frag { bf16x8 k[4]; bf16x8 v[4]; };
__device__ __forceinline__ void cvt_tile(Frag&F,const Raw&R,__attribute__((address_space(3))) char*kl,int kwo,int kro,int vwo,int vro){
  #pragma unroll
  for(int i=0;i<8;++i){ u32x2v p; p[0]=cvtpk_s(R.k[i][0],R.k[i][1]); p[1]=cvtpk_s(R.k[i][2],R.k[i][3]); *(__attribute__((address_space(3))) u32x2v*)(kl+kwo+i*576)=p;
                        u32x2v q; q[0]=cvtpk_s(R.v[i][0],R.v[i][1]); q[1]=cvtpk_s(R.v[i][2],R.v[i][3]); *(__attribute__((address_space(3))) u32x2v*)(kl+4608+vwo+i*256)=q; }
  #pragma unroll
  for(int d0=0;d0<4;++d0) F.k[d0]=*(const __attribute__((address_space(3))) bf16x8*)(kl+kro+32*d0);
  #pragma unroll
  for(int d0=0;d0<2;++d0)
    #pragma unroll
    for(int ks=0;ks<2;++ks){ const sba::s16x4 lo=sba::vtr((sba::lds_cptr)(kl+4608+vro+d0*2048+ks*1024)), hh=sba::vtr((sba::lds_cptr)(kl+4608+vro+d0*2048+ks*1024+512));
      F.v[d0*2+ks]=(bf16x8){lo[0],lo[1],lo[2],lo[3],hh[0],hh[1],hh[2],hh[3]}; }
}
template<bool NEWK> __device__ __forceinline__ void tile_step(const Frag&F,const bf16x8*qr,const float bias2,f32x16*o,float&carry,int hi,int q){
  f32x16 c;
  #pragma unroll
  for(int r=0;r<16;++r)c[r]=bias2;
  #pragma unroll
  for(int d0=0;d0<4;++d0) c=SBA_MFMA(F.k[d0],qr[d0],c);
  weights32<NEWK>(c,carry,hi,q);
  u32x4 pw[2];
  #pragma unroll
  for(int k=0;k<2;++k)
    #pragma unroll
    for(int j=0;j<4;++j) pw[k][j]=cvtpk_s(c[8*k+2*j],c[8*k+2*j+1]);
  #pragma unroll
  for(int d0=0;d0<2;++d0)
    #pragma unroll
    for(int ks=0;ks<2;++ks) o[d0]=SBA_MFMA(__builtin_bit_cast(bf16x8,pw[ks]),F.v[d0*2+ks],o[d0]);
}
__device__ __forceinline__ void decode_wave(int smp,int j,int h,const float*cache_k,const float*cache_v,const int*page_table,const bf16*Q,const bf16*Kn,const bf16*Vn,const float*b_sb,
                                            float*part,float*rtot,unsigned*cnt,bf16*MIX,__attribute__((address_space(3))) char*kl){
  int tid_=threadIdx.x; asm volatile("":"+v"(tid_)); const int lane=tid_&63,r32=lane&31,hi=lane>>5;
  const float bias2=b_sb[h]*1.4426950408889634f;
  const long srow=16384+8*smp;
  bf16x8 qr[4];
  #pragma unroll
  for(int d0=0;d0<4;++d0){ bf16x8 z={0,0,0,0,0,0,0,0}; if(r32<8) z=*reinterpret_cast<const bf16x8*>(Q+(srow+r32)*512+h*64+d0*16+hi*8); qr[d0]=z; }
  f32x16 o[2]; o[0]=f32x16{}; o[1]=f32x16{}; float carry=1.f;
  if(j==7){
    Frag F;
    #pragma unroll
    for(int d0=0;d0<4;++d0){ bf16x8 z={0,0,0,0,0,0,0,0}; if(r32<8) z=*reinterpret_cast<const bf16x8*>(Kn+(srow+r32)*512+h*64+d0*16+hi*8); F.k[d0]=z; }
    #pragma unroll
    for(int d0=0;d0<2;++d0){
      bf16x8 z={0,0,0,0,0,0,0,0};
      #pragma unroll
      for(int jj=0;jj<4;++jj) z[jj]=*reinterpret_cast<const short*>(Vn+(srow+4*hi+jj)*512+h*64+32*d0+r32);
      F.v[d0*2]=z; F.v[d0*2+1]=(bf16x8){0,0,0,0,0,0,0,0}; }
    tile_step<true>(F,qr,bias2,o,carry,hi,r32);
  }
  const int*pt=page_table+smp*64+8*j;
  Raw R; Frag F;
  const int kvo=(lane>>4)*2048+(lane&15)*16;
  const int kwo=(lane>>4)*144+(lane&15)*8, kro=r32*144+16*hi;
  const int vwo=((lane&15)>>3)*2048+(lane>>4)*64+(lane&7)*8, vro=((lane>>4)&1)*32+(lane&3)*8+(4*hi+((lane&15)>>2))*64;
  const __amdgpu_buffer_rsrc_t rk=__builtin_amdgcn_make_buffer_rsrc((void*)cache_k,0,671088640,0x00020000), rv=__builtin_amdgcn_make_buffer_rsrc((void*)cache_v,0,671088640,0x00020000);
  #define UOFF(tt) ((unsigned)__builtin_amdgcn_readfirstlane((int)(((((unsigned)pt[(tt)>>2]*128u+(unsigned)(((tt)&3)*32))*8u+(unsigned)h)*64u)*4u)))
  #define LOADT(R_,tt) load_tile(R_,rk,rv,UOFF(tt),kvo)
  LOADT(R,31); cvt_tile(F,R,kl,kwo,kro,vwo,vro);
  for(int tt=31;tt>=0;--tt){
    if(tt>0) LOADT(R,tt-1);
    tile_step<false>(F,qr,bias2,o,carry,hi,r32);
    if(tt>0) cvt_tile(F,R,kl,kwo,kro,vwo,vro);
  }
  #undef UOFF
  #undef LOADT
  const int unit=smp*8+j;
  int l2_=threadIdx.x; asm volatile("":"+v"(l2_)); const int lane2=l2_&63, r32b=lane2&31, hib=lane2>>5;
  unsigned*pp=(unsigned*)part+((size_t)unit*8+h)*512;
  #pragma unroll
  for(int r=0;r<4;++r)
    #pragma unroll
    for(int d0=0;d0<2;++d0) __hip_atomic_store(pp+(r+4*hib)*64+32*d0+r32b,__float_as_uint(o[d0][r]),RLXA);
  if(lane2<8) __hip_atomic_store((unsigned*)rtot+((size_t)unit*8+h)*8+lane2,__float_as_uint(carry),RLXA);
  asm volatile("s_waitcnt vmcnt(0)":::"memory");
  unsigned old=0u;
  if(lane2==0) old=__hip_atomic_fetch_add(cnt+64*(smp*8+h),1u,RLXA);
  old=(unsigned)__builtin_amdgcn_readfirstlane((int)old);
  if(old==7u){
    const int q=lane2>>3,dc=(lane2&7)*8; float acc[8];
    #pragma unroll
    for(int i=0;i<8;++i)acc[i]=0.f;
    float f=1.f;
    for(int jj=7;jj>=0;--jj){ const size_t u=(size_t)smp*8+jj; const unsigned*src=(const unsigned*)part+(u*8+h)*512+q*64+dc;
      #pragma unroll
      for(int i=0;i<8;++i) acc[i]+=f*__uint_as_float(__hip_atomic_load(src+i,RLXA));
      f*=__uint_as_float(__hip_atomic_load((const unsigned*)rtot+(u*8+h)*8+q,RLXA)); }
    u32x4 w; w[0]=cvtpk_s(acc[0],acc[1]); w[1]=cvtpk_s(acc[2],acc[3]); w[2]=cvtpk_s(acc[4],acc[5]); w[3]=cvtpk_s(acc[6],acc[7]);
    *(u32x4*)(MIX+(srow+q)*1024+h*64+dc)=w;
  }
}
}
namespace gla {
using sba::bf16; using sba::cvtpk_s;
typedef short bf16x8 __attribute__((ext_vector_type(8)));
typedef short bf16x4 __attribute__((ext_vector_type(4)));
typedef float f32x4 __attribute__((ext_vector_type(4)));
typedef unsigned u32x4 __attribute__((ext_vector_type(4)));
typedef unsigned u32x2 __attribute__((ext_vector_type(2)));
#define GLAS __attribute__((address_space(3)))
constexpr int GP=1792;
constexpr int L_QD=0,L_KI=9216,L_KET=18432,L_VT=27648,L_DEC=46080,L_EXR=46336,L_TOT=46592,L_SSQ=48640,L_END=50688;
#define GMFMA(a,b,c) __builtin_amdgcn_mfma_f32_16x16x32_bf16((a),(b),(c),0,0,0)
__device__ __forceinline__ float bf2f(short s){ return __uint_as_float(((unsigned)(unsigned short)s)<<16); }
__device__ __forceinline__ short f2bf(float f){ return (short)(cvtpk_s(f,0.f)&0xffffu); }
template<int MODE,bool FULL> __device__ __forceinline__ void chunk(const bf16*G,bf16*MIX,long m0,int ntok,int h,GLAS char*L,f32x4(&S)[4],const float(&wg)[16],float bg,float gain,float&dseg){
  int tid_=threadIdx.x; asm volatile("":"+v"(tid_)); const int tid=tid_,lane=tid&63,c=lane,fr=lane&15,fq=lane>>4; const int w=__builtin_amdgcn_readfirstlane(tid>>6); const int g=w;
  const short*Gs=(const short*)G;
  float bl[8]; float run=0.f;
  bf16x8 al0[8],al1[8]; short kraw[8],qraw[8],vraw[16];
  #pragma unroll
  for(int i=0;i<8;++i){ const int t=8*g+i; const bool ok=FULL||t<ntok; const long row=ok?(m0+t):m0; const bf16x8*ap=(const bf16x8*)(Gs+row*GP+1536); al0[i]=ap[0]; al1[i]=ap[1];
    kraw[i]=Gs[row*GP+256+64*h+c]; qraw[i]=(MODE==1)?Gs[row*GP+64*h+c]:(short)0; }
  #pragma unroll
  for(int i=0;i<16;++i){ const int t=16*(tid>>7)+i; const bool ok=FULL||t<ntok; const long row=ok?(m0+t):m0; vraw[i]=Gs[row*GP+512+128*h+(tid&127)]; }
  #pragma unroll
  for(int i=0;i<8;++i){ const int t=8*g+i; float la=0.f;
    if(FULL||t<ntok){ const bf16x8 a0=al0[i],a1=al1[i]; float x=bg;
      #pragma unroll
      for(int j=0;j<8;++j){ x+=bf2f(a0[j])*wg[j]; x+=bf2f(a1[j])*wg[8+j]; }
      la=(fminf(x,0.f)-__logf(1.f+__expf(-fabsf(x))))*0.0625f; }
    run+=la; bl[i]=run; }
  GLAS float*TOT=(GLAS float*)(L+L_TOT);
  TOT[g*64+c]=run;
  __syncthreads();
  float prefix=0.f,total=0.f;
  #pragma unroll
  for(int gg=0;gg<8;++gg){ const float v=TOT[gg*64+c]; total+=v; if(gg<g)prefix+=v; }
  const float bref=0.5f*total;
  float ke[8];
  #pragma unroll
  for(int i=0;i<8;++i){ const int t=8*g+i; const float b=prefix+bl[i]; float kk=0.f,qq=0.f;
    if(FULL||t<ntok){ kk=bf2f(kraw[i]); if(MODE==1) qq=bf2f(qraw[i]); }
    ke[i]=kk*__expf(total-b);
    if(MODE==1){ *(GLAS short*)(L+L_QD+t*144+c*2)=f2bf(qq*0.125f*__expf(b-bref)); *(GLAS short*)(L+L_KI+t*144+c*2)=f2bf(kk*__expf(bref-b)); } }
  { u32x4 p; p[0]=cvtpk_s(ke[0],ke[1]); p[1]=cvtpk_s(ke[2],ke[3]); p[2]=cvtpk_s(ke[4],ke[5]); p[3]=cvtpk_s(ke[6],ke[7]); *(GLAS u32x4*)(L+L_KET+c*144+g*16)=p; }
  if(g==0){ const float d=__expf(total); ((GLAS float*)(L+L_DEC))[c]=d; ((GLAS float*)(L+L_EXR))[c]=__expf(bref); dseg*=d; }
  { const int dv=tid&127,tg=tid>>7; float vv[16];
    #pragma unroll
    for(int i=0;i<16;++i){ const int t=16*tg+i; vv[i]=(FULL||t<ntok)?bf2f(vraw[i]):0.f; }
    u32x4 p0,p1;
    #pragma unroll
    for(int j=0;j<4;++j){ p0[j]=cvtpk_s(vv[2*j],vv[2*j+1]); p1[j]=cvtpk_s(vv[8+2*j],vv[8+2*j+1]); }
    *(GLAS u32x4*)(L+L_VT+dv*144+tg*32)=p0; *(GLAS u32x4*)(L+L_VT+dv*144+tg*32+16)=p1; }
  __syncthreads();
  const int dvl=16*w+fr;
  f32x4 O[4];
  if(MODE==1){
    f32x4 PT[4][4];
    #pragma unroll
    for(int st=0;st<4;++st)
      #pragma unroll
      for(int tt=0;tt<4;++tt){ f32x4 acc={0.f,0.f,0.f,0.f};
        if(st<=tt){
          #pragma unroll
          for(int kk=0;kk<2;++kk){ const bf16x8 a=*(GLAS const bf16x8*)(L+L_KI+(16*st+fr)*144+(32*kk+8*fq)*2), b=*(GLAS const bf16x8*)(L+L_QD+(16*tt+fr)*144+(32*kk+8*fq)*2); acc=GMFMA(a,b,acc); }
          if(st==tt){
            #pragma unroll
            for(int i=0;i<4;++i) if(4*fq+i>fr) acc[i]=0.f; } }
        PT[st][tt]=acc; }
    #pragma unroll
    for(int tt=0;tt<4;++tt){ O[tt]=(f32x4){0.f,0.f,0.f,0.f};
      #pragma unroll
      for(int pr=0;pr<2;++pr){ if(2*pr<=tt){
        u32x4 pa; pa[0]=cvtpk_s(PT[2*pr][tt][0],PT[2*pr][tt][1]); pa[1]=cvtpk_s(PT[2*pr][tt][2],PT[2*pr][tt][3]); pa[2]=cvtpk_s(PT[2*pr+1][tt][0],PT[2*pr+1][tt][1]); pa[3]=cvtpk_s(PT[2*pr+1][tt][2],PT[2*pr+1][tt][3]);
        const u32x2 b0=*(GLAS const u32x2*)(L+L_VT+dvl*144+(32*pr+4*fq)*2), b1=*(GLAS const u32x2*)(L+L_VT+dvl*144+(32*pr+16+4*fq)*2);
        const u32x4 pb={b0[0],b0[1],b1[0],b1[1]};
        O[tt]=GMFMA(__builtin_bit_cast(bf16x8,pa),__builtin_bit_cast(bf16x8,pb),O[tt]); } } }
    #pragma unroll
    for(int kk=0;kk<2;++kk){
      const f32x4 e0=*(GLAS const f32x4*)(L+L_EXR+(32*kk+4*fq)*4), e1=*(GLAS const f32x4*)(L+L_EXR+(32*kk+16+4*fq)*4);
      const f32x4 s0=S[2*kk]*e0, s1=S[2*kk+1]*e1;
      u32x4 pb; pb[0]=cvtpk_s(s0[0],s0[1]); pb[1]=cvtpk_s(s0[2],s0[3]); pb[2]=cvtpk_s(s1[0],s1[1]); pb[3]=cvtpk_s(s1[2],s1[3]);
      #pragma unroll
      for(int tt=0;tt<4;++tt){ const u32x2 a0=*(GLAS const u32x2*)(L+L_QD+(16*tt+fr)*144+(32*kk+4*fq)*2), a1=*(GLAS const u32x2*)(L+L_QD+(16*tt+fr)*144+(32*kk+16+4*fq)*2);
        const u32x4 pa={a0[0],a0[1],a1[0],a1[1]};
        O[tt]=GMFMA(__builtin_bit_cast(bf16x8,pa),__builtin_bit_cast(bf16x8,pb),O[tt]); } }
  }
  #pragma unroll
  for(int mt=0;mt<4;++mt){ const f32x4 d4=*(GLAS const f32x4*)(L+L_DEC+(16*mt+4*fq)*4); S[mt]=S[mt]*d4;
    #pragma unroll
    for(int kk=0;kk<2;++kk){ const bf16x8 a=*(GLAS const bf16x8*)(L+L_KET+(16*mt+fr)*144+(32*kk+8*fq)*2), b=*(GLAS const bf16x8*)(L+L_VT+dvl*144+(32*kk+8*fq)*2); S[mt]=GMFMA(a,b,S[mt]); } }
  if(MODE==1){
    GLAS float*SSQ=(GLAS float*)(L+L_SSQ);
    #pragma unroll
    for(int tt=0;tt<4;++tt)
      #pragma unroll
      for(int i=0;i<4;++i){ float ss=O[tt][i]*O[tt][i]; ss+=__shfl_xor(ss,1); ss+=__shfl_xor(ss,2); ss+=__shfl_xor(ss,4); ss+=__shfl_xor(ss,8); if(fr==0) SSQ[w*64+16*tt+4*fq+i]=ss; }
    short rraw[16];
    #pragma unroll
    for(int tt=0;tt<4;++tt)
      #pragma unroll
      for(int i=0;i<4;++i){ const int t=16*tt+4*fq+i; const long row=(FULL||t<ntok)?(m0+t):m0; rraw[4*tt+i]=Gs[row*GP+1024+128*h+dvl]; }
    __syncthreads();
    #pragma unroll
    for(int tt=0;tt<4;++tt)
      #pragma unroll
      for(int i=0;i<4;++i){ const int t=16*tt+4*fq+i; float tot=0.f;
        #pragma unroll
        for(int ww=0;ww<8;++ww) tot+=SSQ[ww*64+t];
        if(FULL||t<ntok){ const float rstd=rsqrtf(tot*(1.f/128.f)+1e-6f); const float rg=bf2f(rraw[4*tt+i]); const float sl=rg/(1.f+__expf(-rg));
          ((short*)MIX)[(m0+t)*1024+512+128*h+dvl]=f2bf(O[tt][i]*rstd*gain*sl); } }
  }
  __syncthreads();
}
__device__ __forceinline__ void load_consts(int h,const float*w_gate,const float*b_gate,const float*g_out,float(&wg)[16],float&bg,float&gain){
  const int lane=threadIdx.x&63, w=threadIdx.x>>6;
  #pragma unroll
  for(int j=0;j<16;++j) wg[j]=w_gate[j*256+64*h+lane];
  bg=b_gate[64*h+lane]; gain=g_out[16*w+(lane&15)];
}
__device__ __forceinline__ void pass1_unit(int unit,const bf16*G,const float*w_gate,const float*b_gate,const float*g_out,float*SLOC,float*DSEG,GLAS char*L){
  const int bh=unit>>5,sseg=unit&31,b=bh>>2,h=bh&3; const int tid=threadIdx.x;
  float wg[16],bg,gain; load_consts(h,w_gate,b_gate,g_out,wg,bg,gain);
  f32x4 S[4];
  #pragma unroll
  for(int mt=0;mt<4;++mt)S[mt]=(f32x4){0.f,0.f,0.f,0.f};
  float dseg=1.f; const long m0=(long)b*8192+256*sseg;
  for(int ch=0;ch<4;++ch) chunk<0,true>(G,nullptr,m0+64*ch,64,h,L,S,wg,bg,gain,dseg);
  f32x4*dst=(f32x4*)(SLOC+((size_t)unit*512+tid)*16);
  #pragma unroll
  for(int mt=0;mt<4;++mt)dst[mt]=S[mt];
  if(tid<64)DSEG[unit*64+tid]=dseg;
}
__device__ __forceinline__ void pass3_unit(int unit,const bf16*G,bf16*MIX,const float*w_gate,const float*b_gate,const float*g_out,const float*SLOC,const float*DSEG,float*sfin_base,GLAS char*L){
  const int bh=unit>>5,sseg=unit&31,b=bh>>2,h=bh&3; const int tid=threadIdx.x,lane=tid&63,fr=lane&15,fq=lane>>4,w=tid>>6;
  float wg[16],bg,gain; load_consts(h,w_gate,b_gate,g_out,wg,bg,gain);
  f32x4 S[4];
  #pragma unroll
  for(int mt=0;mt<4;++mt)S[mt]=(f32x4){0.f,0.f,0.f,0.f};
  #pragma unroll 4
  for(int j=0;j<sseg;++j){ const int uj=bh*32+j; const f32x4*src=(const f32x4*)(SLOC+((size_t)uj*512+tid)*16);
    #pragma unroll
    for(int mt=0;mt<4;++mt){ const f32x4 d4=*(const f32x4*)(DSEG+uj*64+16*mt+4*fq); S[mt]=S[mt]*d4+src[mt]; } }
  float dseg=1.f; const long m0=(long)b*8192+256*sseg;
  for(int ch=0;ch<4;++ch) chunk<1,true>(G,MIX,m0+64*ch,64,h,L,S,wg,bg,gain,dseg);
  if(sseg==31){ float*o=sfin_base+(size_t)bh*8192;
    #pragma unroll
    for(int mt=0;mt<4;++mt)
      #pragma unroll
      for(int i=0;i<4;++i) o[(16*mt+4*fq+i)*128+16*w+fr]=S[mt][i]; }
}
__device__ __forceinline__ void sample_unit(int unit,const bf16*G,bf16*MIX,const float*w_gate,const float*b_gate,const float*g_out,const float*s0,float*sout,GLAS char*L){
  const int smp=unit>>2,h=unit&3; const int tid=threadIdx.x,lane=tid&63,fr=lane&15,fq=lane>>4,w=tid>>6;
  float wg[16],bg,gain; load_consts(h,w_gate,b_gate,g_out,wg,bg,gain);
  f32x4 S[4]; const float*si=s0+(size_t)unit*8192; float*so=sout+(size_t)unit*8192;
  #pragma unroll
  for(int mt=0;mt<4;++mt)
    #pragma unroll
    for(int i=0;i<4;++i) S[mt][i]=si[(16*mt+4*fq+i)*128+16*w+fr];
  float dseg=1.f;
  chunk<1,false>(G,MIX,16384+8*(long)smp,8,h,L,S,wg,bg,gain,dseg);
  #pragma unroll
  for(int mt=0;mt<4;++mt)
    #pragma unroll
    for(int i=0;i<4;++i) so[(16*mt+4*fq+i)*128+16*w+fr]=S[mt][i];
}
}
namespace thin {
using sba::bf16x8; using sba::f32x16; using sba::crow;
template<int KS,class Epi> __device__ __forceinline__ void run(const unsigned short*A,int lda,const unsigned short*Bt,int ldb,int K,int ntn,int tile0,int ntiles,__attribute__((address_space(3))) float*red,const Epi&epi){
  int tid_=threadIdx.x; asm volatile("":"+v"(tid_)); const int lane=tid_&63,r32=lane&31,hi=lane>>5; const int w=__builtin_amdgcn_readfirstlane(tid_>>6);
  const int sub=w/KS,kp=w%KS,tile=tile0+sub; const bool live=tile<ntiles; const int tm=live?tile/ntn:0,tn=live?tile%ntn:0;
  const int klen=K/KS,k0=kp*klen;
  const unsigned short*ap=A+(size_t)(32*tm+r32)*lda+k0+8*hi; const unsigned short*bp=Bt+(size_t)(32*tn+r32)*ldb+k0+8*hi;
  f32x16 acc=f32x16{};
  if(live){
    #pragma unroll 8
    for(int k=0;k<klen;k+=16){ const bf16x8 a=*(const bf16x8*)(ap+k), b=*(const bf16x8*)(bp+k); acc=__builtin_amdgcn_mfma_f32_32x32x16_bf16(a,b,acc,0,0,0); } }
  #pragma unroll
  for(int r=0;r<16;++r) red[(w*16+r)*64+lane]=acc[r];
  __syncthreads();
  if(kp==0&&live){
    #pragma unroll
    for(int r=0;r<16;++r){ float v=0.f;
      #pragma unroll
      for(int p=0;p<KS;++p) v+=red[((sub*KS+p)*16+r)*64+lane];
      epi(32*tm+crow(r,hi),32*tn+r32,v); } }
  __syncthreads();
}
struct EpiResGateS { const float*base; float*out; const float*gate; int ld;
  __device__ __forceinline__ void operator()(int row,int col,float v)const{ const size_t o=(size_t)row*ld+col; out[o]=base[o]+gate[(size_t)(2+(row>>3))*6144+col]*v; } };
struct EpiRelu2S { unsigned short*H; int ld;
  __device__ __forceinline__ void operator()(int row,int col,float v)const{ const float a=fmaxf(v,0.f); H[(size_t)row*ld+col]=(unsigned short)(sba::cvtpk_s(a*a,0.f)&0xffffu); } };
}
__device__ __forceinline__ float wave_sum(float v) {
#pragma unroll
    for (int o = 1; o < 64; o <<= 1) v += __shfl_xor(v, o);
    return v;
}
__device__ __forceinline__ void p0_transpose_item(const float* W, int K, int Nreal, int Npad, bf16* WT, LAS float* scr, int item, int lane) {
    const int nblk = Npad / 32, kb = item / nblk, nb = item % nblk, k0 = 64 * kb, n0 = 32 * nb;
    const int n = n0 + (lane & 31);
#pragma unroll 8
    for (int i = 0; i < 32; ++i) { const int kk = 2 * i + (lane >> 5); scr[kk * 33 + (lane & 31)] = (n < Nreal) ? W[(size_t)(k0 + kk) * Nreal + n] : 0.f; }
    LDS_WAIT(); asm volatile("" ::: "memory");
    const int c = lane & 7;
#pragma unroll
    for (int j = 0; j < 4; ++j) { const int nn = (lane >> 3) + 8 * j; const LAS float* s = scr + (8 * c) * 33 + nn;
        v4u o; o.x = pk2(s[0 * 33], s[1 * 33]); o.y = pk2(s[2 * 33], s[3 * 33]); o.z = pk2(s[4 * 33], s[5 * 33]); o.w = pk2(s[6 * 33], s[7 * 33]);
        *(GAS v4u*)(WT + (size_t)(n0 + nn) * K + k0 + 8 * c) = o; }
    LDS_WAIT(); asm volatile("" ::: "memory");
}
__device__ __forceinline__ void norm_mod_row_bf16(int lane, const float* xrow, const float* gain, const float* sc, const float* sh, bf16* orow) {
    const f32x4* xr = (const f32x4*)xrow + lane; f32x4 v[4]; float s = 0.f;
#pragma unroll
    for (int j = 0; j < 4; ++j) { v[j] = xr[64 * j]; s += (v[j].x * v[j].x + v[j].y * v[j].y) + (v[j].z * v[j].z + v[j].w * v[j].w); }
    const float rstd = rsqrtf(wave_sum(s) * (1.f / D) + NORM_EPS);
    unsigned long long* o8 = (unsigned long long*)orow + lane;
#pragma unroll
    for (int j = 0; j < 4; ++j) { const f32x4 g = ((const f32x4*)gain)[lane + 64 * j], a = ((const f32x4*)sc)[lane + 64 * j], b = ((const f32x4*)sh)[lane + 64 * j];
        const f32x4 y = v[j] * rstd * g * (a + 1.f) + b;
        o8[64 * j] = (unsigned long long)pk2(y.x, y.y) | ((unsigned long long)pk2(y.z, y.w) << 32); }
}
__device__ __forceinline__ void norm_row_f32_inplace(int lane, float* xrow, const float* gain) {
    f32x4* xr = (f32x4*)xrow + lane; f32x4 v[4]; float s = 0.f;
#pragma unroll
    for (int j = 0; j < 4; ++j) { v[j] = xr[64 * j]; s += (v[j].x * v[j].x + v[j].y * v[j].y) + (v[j].z * v[j].z + v[j].w * v[j].w); }
    const float rstd = rsqrtf(wave_sum(s) * (1.f / D) + NORM_EPS);
#pragma unroll
    for (int j = 0; j < 4; ++j) { const f32x4 g = ((const f32x4*)gain)[lane + 64 * j]; xr[64 * j] = v[j] * rstd * g; }
}
__device__ __forceinline__ int bidx_of_row(int m) { return m < MP ? (m >> 13) : 2 + ((m - MP) >> 3); }

struct Args { const float* in[21]; const int* page_table; float* out; unsigned char* ws; };
static_assert(sizeof(Args) == 24 * 8, "Args has no padding");

__global__ void __launch_bounds__(NWAVES * 64, 2) mk_fwd(Args args) {
    extern __shared__ __attribute__((aligned(16))) unsigned char lds[];
    LAS unsigned char* L = (LAS unsigned char*)lds;
    volatile LAS unsigned* MISC = (volatile LAS unsigned*)(L + MISC_OFF);
    const int tid = threadIdx.x, lane = tid & 63, wave = __builtin_amdgcn_readfirstlane(tid >> 6);
    const int G = gridDim.x; const int bx = blockIdx.x; const int vcu = (G % 8 == 0) ? (bx % 8) * (G / 8) + bx / 8 : bx;
    unsigned char* ws = args.ws;
    unsigned* ctl = (unsigned*)(ws + WS_CTL);
    const float *x_prompt = args.in[0], *x_sample = args.in[1], *c_prompt = args.in[2], *c_sample = args.in[3], *cache_k = args.in[4], *cache_v = args.in[5], *state_gla = args.in[6];
    const float *w_ada = args.in[8], *b_ada = args.in[9], *g_mix = args.in[10], *w_in = args.in[11], *b_sb = args.in[12], *w_gate = args.in[13], *b_gate = args.in[14], *g_gla_out = args.in[15];
    const float *w_out = args.in[16], *g_ffn = args.in[17], *w_up = args.in[18], *w_down = args.in[19], *g_final = args.in[20];
    float* out = args.out;
    float* MOD = (float*)(ws + WS_MOD);
    bf16 *Win_t = (bf16*)(ws + WS_WIN), *Wo_t = (bf16*)(ws + WS_WO), *Wup_t = (bf16*)(ws + WS_WUP), *Wdn_t = (bf16*)(ws + WS_WDN);
    bf16 *XN = (bf16*)(ws + WS_XN), *QB = (bf16*)(ws + WS_Q), *KB = (bf16*)(ws + WS_K), *VB = (bf16*)(ws + WS_V), *GB = (bf16*)(ws + WS_G), *MIX = (bf16*)(ws + WS_MIX), *HB = (bf16*)(ws + WS_H);
    float* X1 = (float*)(ws + WS_X1);
    float *SLOC = (float*)(ws + WS_SLOC), *DSEG = (float*)(ws + WS_DSEG), *DPART = (float*)(ws + WS_DPART), *DRTOT = (float*)(ws + WS_DRTOT);
    for (int u = tid; u < (LDS_BYTES - MISC_OFF) / 4; u += NWAVES * 64) ((LAS unsigned*)(L + MISC_OFF))[u] = 0u;
    __syncthreads();
    XcdBarrier bar = xcd_barrier_post(ctl + CW_BAR, MISC + 8);
    const int gw = vcu * NWAVES + wave, NGW = G * NWAVES;

#ifdef PROBE_P0A
    for (int rep_ = 0; rep_ < 2; ++rep_) {
#else
    {
#endif
    if (vcu < 96) {
        LAS float* s = (LAS float*)L;
        for (int i = tid; i < NMODR * D; i += NWAVES * 64) { const int r = i >> 10, k = i & 1023; const float c = r < 2 ? c_prompt[r * D + k] : c_sample[(r - 2) * D + k]; s[k * NMODR + r] = c / (1.f + __expf(-c)); }
        __syncthreads();
        const int col = 64 * vcu + lane, k0 = 128 * wave;
        const __amdgpu_buffer_rsrc_t rw = __builtin_amdgcn_make_buffer_rsrc((void*)w_ada, 0, D * MODW * 4, 0x00020000);
        float acc[NMODR];
#pragma unroll
        for (int r = 0; r < NMODR; ++r) acc[r] = 0.f;
#pragma unroll 1
        for (int kb = 0; kb < 128; kb += 16) {
            float wv[16];
#pragma unroll
            for (int i = 0; i < 16; ++i) wv[i] = __uint_as_float(__builtin_amdgcn_raw_buffer_load_b32(rw, col * 4, (k0 + kb + i) * MODW * 4, 2));
#pragma unroll
            for (int i = 0; i < 16; ++i) { const int k = k0 + kb + i;
#pragma unroll
                for (int r = 0; r < NMODR; ++r) acc[r] += s[k * NMODR + r] * wv[i];
                if ((i & 1) == 1) { asm volatile("" ::: "memory"); __builtin_amdgcn_sched_barrier(0); } }
        }
        __syncthreads();
        LAS float* red = (LAS float*)L;
#pragma unroll
        for (int r = 0; r < NMODR; ++r) red[(wave * NMODR + r) * 64 + lane] = acc[r];
        __syncthreads();
        for (int o = tid; o < NMODR * 64; o += NWAVES * 64) { const int r = o >> 6, l = o & 63; float t = b_ada[64 * vcu + l];
#pragma unroll
            for (int w8 = 0; w8 < 8; ++w8) t += red[(w8 * NMODR + r) * 64 + l];
            MOD[r * MODW + 64 * vcu + l] = t; }
        __syncthreads();
    }
    {
        LAS float* scr = (LAS float*)(L + wave * 16384);
        constexpr int I_IN = (D / 64) * (NIN / 32), I_O = (D / 64) * (D / 32), I_UP = (D / 64) * (FF / 32), I_DN = (FF / 64) * (D / 32);
        constexpr int NITEMS = I_IN + I_O + I_UP + I_DN;
        const bool split = G > 96; const int tw = split ? (vcu - 96) * NWAVES + wave : gw, TNW = split ? (G - 96) * NWAVES : NGW;
        if (!split || vcu >= 96)
        for (int it = tw; it < NITEMS; it += TNW) {
            int r = it;
            if (r < I_IN) { p0_transpose_item(w_in, D, NIN_REAL, NIN, Win_t, scr, r, lane); continue; } r -= I_IN;
            if (r < I_O) { p0_transpose_item(w_out, D, D, D, Wo_t, scr, r, lane); continue; } r -= I_O;
            if (r < I_UP) { p0_transpose_item(w_up, D, FF, FF, Wup_t, scr, r, lane); continue; } r -= I_UP;
            p0_transpose_item(w_down, FF, D, D, Wdn_t, scr, r, lane);
        }
    }
    __syncthreads();
    }
    xcd_barrier(bar);
#ifdef PROBE_P0B
    for (int rep_ = 0; rep_ < 2; ++rep_)
#endif
    for (int m = gw; m < M; m += NGW) { const float* xr = m < MP ? x_prompt + (size_t)m * D : x_sample + (size_t)(m - MP) * D; const float* md = MOD + (size_t)bidx_of_row(m) * MODW;
        norm_mod_row_bf16(lane, xr, g_mix, md + 1024, md, XN + (size_t)m * D); }
    xcd_barrier(bar);
#ifdef PROBE_P1
    for (int rep_ = 0; rep_ < 2; ++rep_)
#endif
    {
        pg8::Gemm g{XN, Win_t, M, NIN, D}; pg8::StaticOrder S; S.init(M, NIN, G, bx);
        pg8::EpiInProj E{QB, KB, VB, GB, out + OK_P, out + OV_P, out + OK_S - (size_t)MP * 512, out + OV_S - (size_t)MP * 512, QSCALE};
        pg8::gemm_phase<pg8::EpiInProj, pg8::StaticOrder, true, true>(L, g, S, E);
    }
    xcd_barrier(bar);
#if defined(PROBE_GLA2) || defined(PROBE_GLA1)
    for (int rep_ = 0; rep_ < 2; ++rep_)
#endif
    for (int u = vcu; u < 256; u += G) gla::pass1_unit(u, (const gla::bf16*)GB, w_gate, b_gate, g_gla_out, SLOC, DSEG, (LAS char*)L);
    xcd_barrier(bar);
    for (int rep = 0; rep < 2; ++rep) {
        const bool do_sb = ((vcu & 1) == rep);
        if (do_sb) {
#ifdef PROBE_SB2
            for (int rep_ = 0; rep_ < 2; ++rep_)
#endif
            for (int v = vcu; v < 256; v += G) {
                const int bh = v >> 4, s = v & 15, b = bh >> 3, h = bh & 7; const float bias2 = b_sb[h] * 1.4426950408889634f;
                sb8::attn_unit(b, h, 31 - s, (const sba::bf16*)QB, (const sba::bf16*)KB, (const sba::bf16*)VB, (sba::bf16*)MIX, (char*)lds, bias2);
                sb8::attn_unit(b, h, s, (const sba::bf16*)QB, (const sba::bf16*)KB, (const sba::bf16*)VB, (sba::bf16*)MIX, (char*)lds, bias2);
            }
        } else {
#ifdef PROBE_DEC2
            for (int rep_ = 0; rep_ < 2; ++rep_)
#endif
            for (int u = vcu; u < 256; u += G)
                sbd::decode_wave(u >> 3, u & 7, wave, cache_k, cache_v, args.page_table, (const sba::bf16*)QB, (const sba::bf16*)KB, (const sba::bf16*)VB, b_sb, DPART, DRTOT, ctl + CW_DEC, (sba::bf16*)MIX, (LAS char*)L + wave * 9216);
            asm volatile("s_waitcnt vmcnt(0)" ::: "memory"); __syncthreads();
        }
    }
#if defined(PROBE_GLA2)
    for (int rep_ = 0; rep_ < 2; ++rep_)
#endif
    for (int u = vcu; u < 256; u += G) gla::pass3_unit(u, (const gla::bf16*)GB, (gla::bf16*)MIX, w_gate, b_gate, g_gla_out, SLOC, DSEG, out + OSG_P, (LAS char*)L);
    for (int u = vcu; u < 128; u += G) gla::sample_unit(u, (const gla::bf16*)GB, (gla::bf16*)MIX, w_gate, b_gate, g_gla_out, state_gla, out + OSG_S, (LAS char*)L);
    xcd_barrier(bar);
#ifdef PROBE_P3
    for (int rep_ = 0; rep_ < 2; ++rep_)
#endif
    {
        pg8::Gemm g{MIX, Wo_t, MP, D, D}; pg8::StaticOrder S; S.init(MP, D, G, bx);
        pg8::EpiResGate E{x_prompt, x_sample - (size_t)MP * D, X1, MOD + 2048};
        pg8::gemm_phase<pg8::EpiResGate, pg8::StaticOrder, true, true>(L, g, S, E);
        thin::EpiResGateS Es{x_sample, X1 + (size_t)MP * D, MOD + 2048, D};
        for (int t0 = vcu; t0 < 256; t0 += G) thin::run<8>(MIX + (size_t)MP * D, D, Wo_t, D, D, 32, t0, 256, (LAS float*)L, Es);
    }
    xcd_barrier(bar);
#ifdef PROBE_BAR10
    for (int rep_ = 0; rep_ < 10; ++rep_) xcd_barrier(bar);
#endif
#ifdef PROBE_P3B
    for (int rep_ = 0; rep_ < 2; ++rep_)
#endif
    for (int m = gw; m < M; m += NGW) { const float* md = MOD + (size_t)bidx_of_row(m) * MODW; norm_mod_row_bf16(lane, X1 + (size_t)m * D, g_ffn, md + 4096, md + 3072, XN + (size_t)m * D); }
    xcd_barrier(bar);
#ifdef PROBE_P4
    for (int rep_ = 0; rep_ < 2; ++rep_)
#endif
    {
        pg8::Gemm g{XN, Wup_t, MP, FF, D}; pg8::StaticOrder S; S.init(MP, FF, G, bx);
        pg8::EpiRelu2 E{HB, FF};
        pg8::gemm_phase<pg8::EpiRelu2, pg8::StaticOrder, true, true>(L, g, S, E);
        thin::EpiRelu2S Es{HB + (size_t)MP * FF, FF};
        for (int t0 = 4 * vcu; t0 < 1024; t0 += 4 * G) thin::run<2>(XN + (size_t)MP * D, D, Wup_t, D, D, 128, t0, 1024, (LAS float*)L, Es);
    }
    xcd_barrier(bar);
#ifdef PROBE_P5
    for (int rep_ = 0; rep_ < 2; ++rep_)
#endif
    {
        pg8::Gemm g{HB, Wdn_t, MP, D, FF}; pg8::StaticOrder S; S.init(MP, D, G, bx);
        pg8::EpiResGate E{X1, X1, out + OY, MOD + 5120};
        pg8::gemm_phase<pg8::EpiResGate, pg8::StaticOrder, true, true>(L, g, S, E);
        thin::EpiResGateS Es{X1 + (size_t)MP * D, out + OY + (size_t)MP * D, MOD + 5120, D};
        for (int t0 = vcu; t0 < 256; t0 += G) thin::run<8>(HB + (size_t)MP * FF, FF, Wdn_t, FF, FF, 32, t0, 256, (LAS float*)L, Es);
    }
    xcd_barrier(bar);
    for (int m = gw; m < M; m += NGW) norm_row_f32_inplace(lane, out + OY + (size_t)m * D, g_final);
}

extern "C" void kernel_launch(void* const* d_in, const int* in_sizes, int n_in, void* d_out, int out_size, void* d_ws, size_t ws_size, hipStream_t stream) {
    static int grid = 0;
    if (grid == 0) {
        if (n_in != 21 || (size_t)out_size != OUT_TOTAL || ws_size < WS_END) { fprintf(stderr, "kernel_launch: unexpected sizes: n_in %d out %d ws %zu\n", n_in, out_size, ws_size); grid = -1; return; }
        int dev = 0, cus = 0, per_cu = 0;
        if (hipGetDevice(&dev) != hipSuccess || hipDeviceGetAttribute(&cus, hipDeviceAttributeMultiprocessorCount, dev) != hipSuccess) { grid = -1; return; }
        if (hipFuncSetAttribute((const void*)mk_fwd, hipFuncAttributeMaxDynamicSharedMemorySize, LDS_BYTES) != hipSuccess) { fprintf(stderr, "kernel_launch: hipFuncSetAttribute failed\n"); grid = -1; return; }
        if (hipOccupancyMaxActiveBlocksPerMultiprocessor(&per_cu, (const void*)mk_fwd, NWAVES * 64, LDS_BYTES) != hipSuccess || per_cu < 1) { fprintf(stderr, "kernel_launch: occupancy query says %d\n", per_cu); }
        (void)hipGetLastError();
        grid = cus;
    }
    if (grid < 0) return;
    if (hipMemsetAsync((char*)d_ws + WS_CTL, 0, CTL_ZERO_BYTES, stream) != hipSuccess) return;
    Args a{};
    for (int i = 0; i < 21; ++i) a.in[i] = (const float*)d_in[i];
    a.page_table = (const int*)d_in[7]; a.out = (float*)d_out; a.ws = (unsigned char*)d_ws;
    hipLaunchKernelGGL(mk_fwd, dim3(grid), dim3(NWAVES * 64), LDS_BYTES, stream, a);
    const hipError_t le = hipPeekAtLastError();
    if (le != hipSuccess) fprintf(stderr, "kernel_launch: launch failed: %s\n", hipGetErrorName(le));
}
```

```cpp
#include <hip/hip_runtime.h>
#include <hip/hip_bf16.h>
#include <cstdio>
#include <cstdint>
namespace pg8 {
#define PG8_LAS __attribute__((address_space(3)))
typedef unsigned short bf16_t;
typedef short bf16x8 __attribute__((ext_vector_type(8)));
typedef float f32x4 __attribute__((ext_vector_type(4)));
typedef unsigned u32x4 __attribute__((ext_vector_type(4)));
constexpr int BM = 256, BK = 64, HALF = 128, HTB = HALF * BK * 2  , STAGE_BYTES = 8 * HTB, NXCD = 8, WGM = 8;

__host__ __device__ __forceinline__ int lds_byte(int r, int c) { const int st = (r >> 4) * 2 + (c >> 5), rr = r & 15, cc = c & 31, ob = rr * 64 + cc * 2; return st * 1024 + (ob ^ (((ob >> 9) & 1) << 5)); }
__host__ __device__ __forceinline__ void stage_rc(int b, int& R, int& C) { const int st = b / 1024, sb = b % 1024, swz = sb ^ (((sb >> 9) & 1) << 5); R = (st >> 1) * 16 + swz / 64; C = (st & 1) * 32 + (swz % 64) / 2; }
__host__ __device__ __forceinline__ int perm32(int rho) { const int n = rho >> 4, i = rho & 15; return 8 * (i >> 2) + 4 * n + (i & 3); }

struct Unit { int pm, pn; };
struct Gemm { const bf16_t* A; const bf16_t* Bt; int M, N, K; };

struct StaticOrder {
    int nM, nN, nwg, G, c;
    __host__ __device__ void init(int M, int N, int G_, int c_) { nM = M / BM; nN = N / BM; nwg = nM * nN; G = G_; c = c_; }
    __host__ __device__ bool next(int i, Unit& u) const {
        const long L = (long)i * G + c; if (L >= nwg) return false;
        int wgid = (int)L; { const int q = nwg / NXCD, r = nwg % NXCD, xcd = wgid % NXCD, off = wgid / NXCD; wgid = (xcd < r ? xcd * (q + 1) : r * (q + 1) + (xcd - r) * q) + off; }
        const int nig = WGM * nN, gid = wgid / nig, fm = gid * WGM, gsz = (nM - fm) < WGM ? (nM - fm) : WGM;
        u.pm = fm + ((wgid % nig) % gsz); u.pn = (wgid % nig) / gsz; return true;
    }
    __device__ __forceinline__ void a_ready(const Unit&) const {}
    __device__ __forceinline__ void done(const Unit&) const {}
};

__device__ __forceinline__ unsigned cvt_pk_bf16(float lo, float hi) { unsigned r; asm volatile("v_cvt_pk_bf16_f32 %0, %1, %2" : "=v"(r) : "v"(lo), "v"(hi)); return r; }

struct EpiInProj {
    static constexpr bool PERM = true, AFTER_DRAIN = false;
    bf16_t *Q, *K, *V, *G; float *kP, *vP, *kS, *vS; float qscale;
    __device__ __forceinline__ void operator()(const f32x4 (&acc)[2][2][4][2], const Unit& u, int wr, int wc, int fr, int fq) const {
        const int pn = u.pn, pm = u.pm;
        bf16_t* dst; int ldc, colbase; float sc = 1.f; float* fo = nullptr;
        if (pn < 2)      { dst = Q; ldc = 512; colbase = pn * 256; sc = qscale; }
        else if (pn < 4) { dst = K; ldc = 512; colbase = (pn - 2) * 256; fo = pm < 64 ? kP : kS; }
        else if (pn < 6) { dst = V; ldc = 512; colbase = (pn - 4) * 256; fo = pm < 64 ? vP : vS; }
        else             { dst = G; ldc = 1792; colbase = (pn - 6) * 256; }
        const int row0 = pm * BM + wr * 64 + fr, cl = colbase + wc * 32 + 8 * fq;
#pragma unroll
        for (int ai = 0; ai < 2; ++ai)
#pragma unroll
            for (int m = 0; m < 4; ++m) { const size_t row = (size_t)(row0 + ai * HALF + m * 16);
#pragma unroll
                for (int bj = 0; bj < 2; ++bj) { const f32x4 a0 = acc[ai][bj][m][0], a1 = acc[ai][bj][m][1]; const int col = cl + bj * HALF;
                    const f32x4 v0 = a0 * sc, v1 = a1 * sc; u32x4 w; w.x = cvt_pk_bf16(v0[0], v0[1]); w.y = cvt_pk_bf16(v0[2], v0[3]); w.z = cvt_pk_bf16(v1[0], v1[1]); w.w = cvt_pk_bf16(v1[2], v1[3]);
                    *(u32x4*)(dst + row * ldc + col) = w;
                    if (fo) { *(f32x4*)(fo + row * 512 + col) = a0; *(f32x4*)(fo + row * 512 + col + 4) = a1; } } }
    }
};
struct EpiRelu2 {
    static constexpr bool PERM = true, AFTER_DRAIN = false;
    bf16_t* O; int ldc;
    __device__ __forceinline__ void operator()(const f32x4 (&acc)[2][2][4][2], const Unit& u, int wr, int wc, int fr, int fq) const {
        const int row0 = u.pm * BM + wr * 64 + fr, col0 = u.pn * BM + wc * 32 + 8 * fq;
#pragma unroll
        for (int ai = 0; ai < 2; ++ai)
#pragma unroll
            for (int m = 0; m < 4; ++m) { bf16_t* rowp = O + (size_t)(row0 + ai * HALF + m * 16) * ldc + col0;
#pragma unroll
                for (int bj = 0; bj < 2; ++bj) { f32x4 v0 = acc[ai][bj][m][0], v1 = acc[ai][bj][m][1];
#pragma unroll
                    for (int e = 0; e < 4; ++e) { const float a = fmaxf(v0[e], 0.f), b = fmaxf(v1[e], 0.f); v0[e] = a * a; v1[e] = b * b; }
                    u32x4 w; w.x = cvt_pk_bf16(v0[0], v0[1]); w.y = cvt_pk_bf16(v0[2], v0[3]); w.z = cvt_pk_bf16(v1[0], v1[1]); w.w = cvt_pk_bf16(v1[2], v1[3]);
                    *(u32x4*)(rowp + bj * HALF) = w; } }
    }
};
struct EpiResGate {
    static constexpr bool PERM = false, AFTER_DRAIN = false;
    const float* baseP; const float* baseS; float* out; const float* gate;
    __device__ __forceinline__ void operator()(const f32x4 (&acc)[2][2][4][2], const Unit& u, int wr, int wc, int fr, int fq) const {
        const int col0 = u.pn * BM + wc * 32 + 4 * fq;
#pragma unroll
        for (int ai = 0; ai < 2; ++ai)
#pragma unroll
            for (int m = 0; m < 4; ++m) { const int row = u.pm * BM + ai * HALF + wr * 64 + m * 16 + fr; const int bidx = row < 16384 ? (row >> 13) : 2 + ((row - 16384) >> 3);
                const float* b = (row < 16384 ? baseP : baseS) + (size_t)row * 1024 + col0; const float* g = gate + (size_t)bidx * 6144 + col0; float* o = out + (size_t)row * 1024 + col0;
#pragma unroll
                for (int bj = 0; bj < 2; ++bj)
#pragma unroll
                    for (int n = 0; n < 2; ++n) { const int c = bj * HALF + n * 16; const f32x4 bs = *(const f32x4*)(b + c), gv = *(const f32x4*)(g + c); *(f32x4*)(o + c) = bs + gv * acc[ai][bj][m][n]; } }
    }
};
template <class Epi, class Sched, bool ALIGN_EPI = false, bool SP2 = false>
__device__ __forceinline__ void gemm_phase(PG8_LAS unsigned char* lds, const Gemm g, const Sched& S, const Epi& E) {
    int tid_ = threadIdx.x; asm volatile("" : "+v"(tid_)); const int tid = tid_, wid = __builtin_amdgcn_readfirstlane(tid >> 6), lane = tid & 63, wr = wid >> 2, wc = wid & 3, fr = lane & 15, fq = lane >> 4;
    const int K = g.K, nt = K / BK;
    unsigned voffA[2], voffB[2];
#pragma unroll
    for (int i = 0; i < 2; ++i) { int R, C; stage_rc(tid * 16 + i * 8192, R, C); const int Rb = Epi::PERM ? ((R & ~31) + perm32(R & 31)) : R;
        voffA[i] = (unsigned)(R * K + C) * 2u; voffB[i] = (unsigned)(Rb * K + C) * 2u; }
    const size_t kstep = (size_t)(BK * 2);
    const size_t hstep = (size_t)HALF * K * 2;
    const size_t tstep = 2 * hstep;
    const unsigned ldsw = (unsigned)wid * 1024u;
    const int aoff = lds_byte(wr * 64 + fr, fq * 8), boff = lds_byte(wc * 32 + fr, fq * 8);
#define PG8_SA(b, h) (((b) * 2 + (h)) * HTB)
#define PG8_SB(b, h) ((4 + (b) * 2 + (h)) * HTB)
#define PG8_STAGE(bufoff, gbase, voff) do { _Pragma("unroll") for (int _i = 0; _i < 2; ++_i) \
        __builtin_amdgcn_global_load_lds((const unsigned*)((const char*)(gbase) + (voff)[_i]), (PG8_LAS unsigned*)(lds + (bufoff) + ldsw + _i * 8192), 16, 0, 0); } while (0)
#define PG8_LDA(dst, b, h) do { _Pragma("unroll") for (int m = 0; m < 4; ++m) _Pragma("unroll") for (int k = 0; k < 2; ++k) dst[m][k] = *(const PG8_LAS bf16x8*)(lds + PG8_SA(b, h) + aoff + m * 2048 + k * 1024); } while (0)
#define PG8_LDB(dst, b, h) do { _Pragma("unroll") for (int n = 0; n < 2; ++n) _Pragma("unroll") for (int k = 0; k < 2; ++k) dst[n][k] = *(const PG8_LAS bf16x8*)(lds + PG8_SB(b, h) + boff + n * 2048 + k * 1024); } while (0)
#define PG8_MMA(ai, bj, At, Bt) do { __builtin_amdgcn_s_setprio(1); _Pragma("unroll") for (int m = 0; m < 4; ++m) _Pragma("unroll") for (int n = 0; n < 2; ++n) _Pragma("unroll") for (int k = 0; k < 2; ++k) \
        acc[ai][bj][m][n] = __builtin_amdgcn_mfma_f32_16x16x32_bf16(Bt[n][k], At[m][k], acc[ai][bj][m][n], 0, 0, 0); __builtin_amdgcn_s_setprio(0); } while (0)
#define PG8_WAIT_V(n) asm volatile("s_waitcnt vmcnt(" #n ")" ::: "memory")
#define PG8_WAIT_L(n) asm volatile("s_waitcnt lgkmcnt(" #n ")" ::: "memory")
#define PG8_BAR __builtin_amdgcn_s_barrier()
#define PG8_SCHED __builtin_amdgcn_sched_barrier(0)
    Unit cur, nxt; int ui = 0;
    if (!S.next(0, cur)) return;
    f32x4 acc[2][2][4][2];
#pragma unroll
    for (int a = 0; a < 2; ++a)
#pragma unroll
        for (int b = 0; b < 2; ++b)
#pragma unroll
            for (int m = 0; m < 4; ++m)
#pragma unroll
                for (int n = 0; n < 2; ++n) acc[a][b][m][n] = (f32x4){0.f, 0.f, 0.f, 0.f};
    bf16x8 At[4][2], B0[2][2], B1[2][2];
    const char* cA = (const char*)g.A + (size_t)cur.pm * tstep; const char* cB = (const char*)g.Bt + (size_t)cur.pn * tstep;
    S.a_ready(cur);
    if constexpr (SP2) {
        PG8_STAGE(PG8_SB(0, 0), cB, voffB); PG8_STAGE(PG8_SB(0, 1), cB + hstep, voffB); PG8_STAGE(PG8_SA(0, 0), cA, voffA); PG8_STAGE(PG8_SA(0, 1), cA + hstep, voffA);
        if (wr == 1) PG8_BAR;
        PG8_WAIT_V(2); PG8_BAR;
        PG8_STAGE(PG8_SB(1, 0), cB + kstep, voffB); PG8_STAGE(PG8_SA(1, 0), cA + kstep, voffA); PG8_STAGE(PG8_SB(1, 1), cB + hstep + kstep, voffB);
        PG8_WAIT_V(6); PG8_BAR;
    } else {
        PG8_STAGE(PG8_SB(0, 0), cB, voffB); PG8_STAGE(PG8_SA(0, 0), cA, voffA); PG8_STAGE(PG8_SB(0, 1), cB + hstep, voffB); PG8_STAGE(PG8_SA(0, 1), cA + hstep, voffA);
        if (wr == 1) PG8_BAR;
        PG8_WAIT_V(4); PG8_BAR;
        PG8_STAGE(PG8_SB(1, 0), cB + kstep, voffB); PG8_STAGE(PG8_SA(1, 0), cA + kstep, voffA); PG8_STAGE(PG8_SB(1, 1), cB + hstep + kstep, voffB);
        PG8_WAIT_V(6); PG8_BAR;
    }
    for (;;) {
        const bool has_next = S.next(ui + 1, nxt);
        const char* nA = has_next ? (const char*)g.A + (size_t)nxt.pm * tstep : cA; const char* nB = has_next ? (const char*)g.Bt + (size_t)nxt.pn * tstep : cB;
        for (int t = 0; t < nt; t += 2) {
            const bool last = (t == nt - 2);
            const char* a1 = cA + (size_t)(t + 1) * kstep;
            const char* a2 = last ? nA : cA + (size_t)(t + 2) * kstep; const char* b2 = last ? nB : cB + (size_t)(t + 2) * kstep;
            const char* a3 = a2 + kstep; const char* b3 = b2 + kstep;
            if (last && has_next) S.a_ready(nxt);
            if constexpr (SP2) {
            PG8_LDB(B0, 0, 0); PG8_LDB(B1, 0, 1); PG8_SCHED; PG8_LDA(At, 0, 0); PG8_STAGE(PG8_SA(1, 1), a1 + hstep, voffA);
            PG8_WAIT_V(8); PG8_WAIT_L(0); PG8_BAR; PG8_MMA(0, 0, At, B0); PG8_MMA(0, 1, At, B1); PG8_BAR; PG8_SCHED;
            PG8_LDA(At, 0, 1); PG8_STAGE(PG8_SB(0, 0), b2, voffB); PG8_STAGE(PG8_SB(0, 1), b2 + hstep, voffB); PG8_STAGE(PG8_SA(0, 0), a2, voffA);
            PG8_WAIT_V(8); PG8_WAIT_L(0); PG8_BAR; PG8_MMA(1, 0, At, B0); PG8_MMA(1, 1, At, B1); PG8_BAR; PG8_SCHED;
            PG8_LDB(B0, 1, 0); PG8_LDB(B1, 1, 1); PG8_SCHED; PG8_LDA(At, 1, 0); PG8_STAGE(PG8_SA(0, 1), a2 + hstep, voffA);
            PG8_WAIT_V(8); PG8_WAIT_L(0); PG8_BAR; PG8_MMA(0, 0, At, B0); PG8_MMA(0, 1, At, B1); PG8_BAR; PG8_SCHED;
            PG8_LDA(At, 1, 1); PG8_STAGE(PG8_SB(1, 0), b3, voffB); PG8_STAGE(PG8_SB(1, 1), b3 + hstep, voffB); PG8_STAGE(PG8_SA(1, 0), a3, voffA);
            PG8_WAIT_V(8); PG8_WAIT_L(0); PG8_BAR; PG8_MMA(1, 0, At, B0); PG8_MMA(1, 1, At, B1); PG8_BAR; PG8_SCHED;
            } else {
            PG8_LDB(B0, 0, 0); PG8_SCHED; PG8_LDA(At, 0, 0); PG8_STAGE(PG8_SA(1, 1), a1 + hstep, voffA);
            PG8_WAIT_L(8); PG8_BAR; PG8_WAIT_L(0); PG8_MMA(0, 0, At, B0); PG8_BAR; PG8_SCHED;
            PG8_LDB(B1, 0, 1); PG8_STAGE(PG8_SB(0, 0), b2, voffB);
            PG8_BAR; PG8_WAIT_L(0); PG8_MMA(0, 1, At, B1); PG8_BAR;
            PG8_LDA(At, 0, 1); PG8_STAGE(PG8_SA(0, 0), a2, voffA);
            PG8_BAR; PG8_WAIT_L(0); PG8_MMA(1, 0, At, B0); PG8_BAR; PG8_SCHED;
            PG8_STAGE(PG8_SB(0, 1), b2 + hstep, voffB);
            PG8_WAIT_V(6); PG8_BAR; PG8_MMA(1, 1, At, B1); PG8_BAR;
            PG8_LDB(B0, 1, 0); PG8_SCHED; PG8_LDA(At, 1, 0); PG8_STAGE(PG8_SA(0, 1), a2 + hstep, voffA);
            PG8_WAIT_L(8); PG8_BAR; PG8_WAIT_L(0); PG8_MMA(0, 0, At, B0); PG8_BAR; PG8_SCHED;
            PG8_LDB(B1, 1, 1); PG8_STAGE(PG8_SB(1, 0), b3, voffB);
            PG8_BAR; PG8_WAIT_L(0); PG8_MMA(0, 1, At, B1); PG8_BAR;
            PG8_LDA(At, 1, 1); PG8_STAGE(PG8_SA(1, 0), a3, voffA);
            PG8_BAR; PG8_WAIT_L(0); PG8_MMA(1, 0, At, B0); PG8_BAR; PG8_SCHED;
            PG8_STAGE(PG8_SB(1, 1), b3 + hstep, voffB);
            PG8_WAIT_V(6); PG8_BAR; PG8_MMA(1, 1, At, B1); PG8_BAR;
            }
        }
        if constexpr (ALIGN_EPI) { if (wr == 0) PG8_BAR; }
        if constexpr (!Epi::AFTER_DRAIN) { E(acc, cur, wr, wc, fr, fq); S.done(cur); }
        if (!has_next) break;
#pragma unroll
        for (int a = 0; a < 2; ++a)
#pragma unroll
            for (int b = 0; b < 2; ++b)
#pragma unroll
                for (int m = 0; m < 4; ++m)
#pragma unroll
                    for (int n = 0; n < 2; ++n) acc[a][b][m][n] = (f32x4){0.f, 0.f, 0.f, 0.f};
        cur = nxt; cA = nA; cB = nB; ++ui;
        if constexpr (ALIGN_EPI) { if (wr == 1) PG8_BAR; }
    }
    PG8_WAIT_V(0);
    if constexpr (!ALIGN_EPI) { if (wr == 0) PG8_BAR; }
    PG8_BAR;
    if constexpr (Epi::AFTER_DRAIN) { E.fused(acc, cur, wr, wc, fr, fq, lds, wid, lane); S.done(cur); }
#undef PG8_SA
#undef PG8_SB
#undef PG8_STAGE
#undef PG8_LDA
#undef PG8_LDB
#undef PG8_MMA
#undef PG8_WAIT_V
#undef PG8_WAIT_L
#undef PG8_BAR
#undef PG8_SCHED
}
}
constexpr int NWAVES = 8;
constexpr int D = 1024, TP = 8192, MP = 16384, MS = 256, M = MP + MS, FF = 4096, NIN = 3328, NIN_REAL = 3088, NMODR = 34, MODW = 6144;
constexpr float NORM_EPS = 1e-6f;
constexpr float QSCALE = 0.125f * 1.4426950408889634f;
constexpr size_t OY = 0, OK_P = 17039360, OV_P = 25427968, OSG_P = 33816576, OK_S = 33882112, OV_S = 34013184, OSG_S = 34144256, OUT_TOTAL = 35192832;
constexpr size_t MiB = 1u << 20;
constexpr size_t WS_CTL = 0, CTL_ZERO_BYTES = 1 * MiB;
constexpr size_t WS_MOD = 1 * MiB, WS_WIN = 2 * MiB, WS_WO = 9 * MiB, WS_WUP = 11 * MiB, WS_WDN = 19 * MiB;
constexpr size_t WS_SLOC = 27 * MiB, WS_DSEG = 35 * MiB, WS_DPART = 36 * MiB, WS_DRTOT = 40 * MiB;
constexpr size_t WS_XN = 48 * MiB, WS_Q = 82 * MiB, WS_K = 99 * MiB, WS_V = 116 * MiB, WS_G = 133 * MiB, WS_MIX = 190 * MiB, WS_X1 = 224 * MiB, WS_H = 290 * MiB, WS_END = 421 * MiB;
static_assert(WS_WIN + (size_t)NIN * D * 2 <= WS_WO && WS_G + (size_t)M * 1792 * 2 <= WS_MIX && WS_MIX + (size_t)M * D * 2 <= WS_X1 && WS_X1 + (size_t)M * D * 4 <= WS_H && WS_H + (size_t)M * FF * 2 <= WS_END, "d_ws map");
static_assert(WS_XN + (size_t)M * D * 2 <= WS_Q && WS_Q + (size_t)M * 512 * 2 <= WS_K && WS_K + (size_t)M * 512 * 2 <= WS_V && WS_V + (size_t)M * 512 * 2 <= WS_G, "d_ws map 2");
constexpr int CW_BAR = 4096, CW_DEC = 16384;
constexpr int RING_BYTES = 139264, MISC_OFF = 146944, LDS_BYTES = 147456;

#define GAS __attribute__((address_space(1)))
#define LAS __attribute__((address_space(3)))
typedef unsigned short bf16;
typedef unsigned v4u __attribute__((ext_vector_type(4)));
typedef float f32x4 __attribute__((ext_vector_type(4)));
#define LDS_WAIT() asm volatile("s_waitcnt lgkmcnt(0)" ::: "memory")
__device__ __forceinline__ unsigned f2bf(float f) { unsigned u = __builtin_bit_cast(unsigned, f); return (u + 0x7fffu + ((u >> 16) & 1u)) >> 16; }
__device__ __forceinline__ unsigned pk2(float lo, float hi) { return f2bf(lo) | (f2bf(hi) << 16); }
#define XB_TMO      128
#define XB_XCNT(j)  (256  + 64 * (j))
#define XB_XSUB(j)  (1280 + 64 * (j))
#define XB_XGEN(j)  (2304 + 64 * (j))
#define XB_TOP      3328
#define XB_TOPGEN   3392
#define XCD_BAR_WORDS 3456
#define XB_SPIN_CAP (1u << 18)

__device__ __forceinline__ unsigned xb_ld(unsigned* p)              { return __hip_atomic_load(p, __ATOMIC_RELAXED, __HIP_MEMORY_SCOPE_AGENT); }
__device__ __forceinline__ unsigned xb_add(unsigned* p, unsigned v) { return __hip_atomic_fetch_add(p, v, __ATOMIC_RELAXED, __HIP_MEMORY_SCOPE_AGENT); }
__device__ __forceinline__ unsigned xb_xcc_id() { return (unsigned)__builtin_amdgcn_s_getreg((3 << 11) | 20) & 0xFu; }
#define XB_SPIN(cond, bar) do { unsigned _sp = 0; while (cond) { __builtin_amdgcn_s_sleep(1); \
    if ((++_sp & 255u) == 0u) { if (xb_ld(&(bar)[XB_TMO])) break; if (_sp > XB_SPIN_CAP) { atomicAdd(&(bar)[XB_TMO], 1u); break; } } } } while (0)

struct XcdBarrier {
    unsigned* bar; unsigned x;
    volatile LAS unsigned* st;
};

__device__ __forceinline__ XcdBarrier xcd_barrier_post(unsigned* bar, volatile LAS unsigned* st) {
    XcdBarrier b; b.bar = bar; b.x = xb_xcc_id(); b.st = st;
    if (threadIdx.x == 0) (void)xb_add(&bar[XB_XCNT(b.x)], 1u);
    return b;
}
__device__ __forceinline__ void xcd_barrier_complete(unsigned* bar, unsigned x, unsigned& nloc, unsigned& nx) {
    const unsigned G = gridDim.x * gridDim.y * gridDim.z;
    unsigned sum, cnt, mine, sp = 0u;
    for (;;) {
        sum = 0u; cnt = 0u; mine = 0u;
#pragma unroll
        for (unsigned j = 0; j < 16; ++j) { const unsigned c = xb_ld(&bar[XB_XCNT(j)]); sum += c; cnt += (c > 0u) ? 1u : 0u; mine = (j == x) ? c : mine; }
        if (sum == G) break;
        __builtin_amdgcn_s_sleep(1);
        if ((++sp & 255u) == 0u) { if (xb_ld(&bar[XB_TMO])) break; if (sp > XB_SPIN_CAP) { atomicAdd(&bar[XB_TMO], 1u); break; } }
    }
    nloc = mine > 0u ? mine : 1u; nx = cnt > 0u ? cnt : 1u;
}

__device__ __forceinline__ void xcd_barrier(const XcdBarrier& b) {
    asm volatile("s_waitcnt vmcnt(0)" ::: "memory");
    __syncthreads();
    if (threadIdx.x == 0) {
        unsigned* bar = b.bar;
        __builtin_amdgcn_s_waitcnt(0);
        unsigned nloc = b.st[0], nx = b.st[1];
        if (nloc == 0u) { xcd_barrier_complete(bar, b.x, nloc, nx); b.st[0] = nloc; b.st[1] = nx; }
        const unsigned old = xb_add(&bar[XB_XSUB(b.x)], 1u);
        const unsigned gen = old / nloc;
        if (old + 1u == (gen + 1u) * nloc) {
            __builtin_amdgcn_fence(__ATOMIC_RELEASE, "agent");
            asm volatile("s_waitcnt vmcnt(0)" ::: "memory");
            const unsigned og = xb_add(&bar[XB_TOP], 1u);
            const unsigned tg = og / nx;
            if (og + 1u == (tg + 1u) * nx) xb_add(&bar[XB_TOPGEN], 1u);
            else XB_SPIN(xb_ld(&bar[XB_TOPGEN]) == tg, bar);
            __builtin_amdgcn_fence(__ATOMIC_ACQUIRE, "agent");
            xb_add(&bar[XB_XGEN(b.x)], 1u);
            asm volatile("s_waitcnt vmcnt(0)" ::: "memory");
        } else {
            XB_SPIN(xb_ld(&bar[XB_XGEN(b.x)]) == gen, bar);
            __builtin_amdgcn_fence(__ATOMIC_ACQUIRE, "agent");
            asm volatile("s_waitcnt vmcnt(0)" ::: "memory");
        }
    }
    __syncthreads();
}
namespace sba {
using bf16x8=__attribute__((ext_vector_type(8)))short;
using s16x4=__attribute__((ext_vector_type(4)))short;
using f32x16=__attribute__((ext_vector_type(16)))float;
using u32x4=__attribute__((ext_vector_type(4)))unsigned;
typedef __hip_bfloat16 bf16;
constexpr int SEQ=8192,D=64,DM=512,OP=1024;
constexpr int NW=8,QBLK=32,QB=QBLK*NW,KVBLK=64;
constexpr int NSLOT=3,SLOTB=8192;
constexpr int LDS_K=0,LDS_V=NSLOT*SLOTB,LDS_OST=2*NSLOT*SLOTB,LDS_BYTES=LDS_OST+NW*4096;
__device__ __forceinline__ int crow(int r,int hi){return (r&3)+8*(r>>2)+4*hi;}
__device__ __forceinline__ void glds16(const void*gsrc,unsigned lds_dst){unsigned keep;
  asm volatile("s_mov_b32 %0, m0\n\ts_mov_b32 m0, %2\n\ts_nop 0\n\tglobal_load_lds_dwordx4 %1, off\n\ts_mov_b32 m0, %0":"=&s"(keep):"v"(gsrc),"s"(lds_dst):"memory");}
typedef float f32x2_t __attribute__((ext_vector_type(2))); typedef __bf16 bf16x2_t __attribute__((ext_vector_type(2)));
__device__ __forceinline__ unsigned cvtpk_s(float lo,float hi){f32x2_t v={lo,hi};bf16x2_t b=__builtin_convertvector(v,bf16x2_t);return __builtin_bit_cast(unsigned,b);}
typedef __attribute__((address_space(3))) const char* lds_cptr;
typedef short v4i16_t __attribute__((ext_vector_type(4)));
__device__ __forceinline__ s16x4 vtr(lds_cptr p){ return __builtin_bit_cast(s16x4,__builtin_amdgcn_ds_read_tr16_b64_v4i16((__attribute__((address_space(3))) v4i16_t*)p)); }
#define SBA_MFMA(a,b,c) __builtin_amdgcn_mfma_f32_32x32x16_bf16((a),(b),(c),0,0,0)
template<bool MASK> __device__ __forceinline__ void sb_weights(f32x16&c0,f32x16&c1,float&carry,int hi,int jb,int qrel){
  #pragma unroll
  for(int r=0;r<16;++r){
    float e0=__builtin_amdgcn_exp2f(c0[r]), e1=__builtin_amdgcn_exp2f(c1[r]);
    if(MASK){ const int kv=64*jb+crow(r,hi); if(kv>=qrel)e0=0.f; if(kv+32>=qrel)e1=0.f; }
    c0[r]=1.f+e0; c1[r]=1.f+e1; }
  float P2[8],P3[8],T[8];
  #pragma unroll
  for(int c=0;c<4;++c){ P2[c]=c0[4*c]*c0[4*c+1]; P3[c]=P2[c]*c0[4*c+2]; T[c]=__builtin_amdgcn_rcpf(P3[c]*c0[4*c+3]);
                        P2[4+c]=c1[4*c]*c1[4*c+1]; P3[4+c]=P2[4+c]*c1[4*c+2]; T[4+c]=__builtin_amdgcn_rcpf(P3[4+c]*c1[4*c+3]); }
  float Tl[8],Th[8];
  #pragma unroll
  for(int c=0;c<8;++c){ auto rr=__builtin_amdgcn_permlane32_swap(__float_as_uint(T[c]),__float_as_uint(T[c]),false,false); Tl[c]=__uint_as_float(rr[0]); Th[c]=__uint_as_float(rr[1]); }
  float E=carry;
  float off[8];
  #pragma unroll
  for(int c=7;c>=0;--c){ off[c]=hi?E:E*Th[c]; E=E*(Tl[c]*Th[c]); }
  carry=E;
  #pragma unroll
  for(int c=0;c<4;++c){
    { const float g=T[c]*off[c], R1=c0[4*c]*g, R2=P2[c]*g, R3=P3[c]*g; c0[4*c]=R1-g; c0[4*c+1]=R2-R1; c0[4*c+2]=R3-R2; c0[4*c+3]=off[c]-R3; }
    { const float g=T[4+c]*off[4+c], R1=c1[4*c]*g, R2=P2[4+c]*g, R3=P3[4+c]*g; c1[4*c]=R1-g; c1[4*c+1]=R2-R1; c1[4*c+2]=R3-R2; c1[4*c+3]=off[4+c]-R3; } }
}
__device__ __forceinline__ void pv(f32x16*o,lds_cptr vp,const f32x16&w0,const f32x16&w1){
  u32x4 pw[4];
  #pragma unroll
  for(int k=0;k<2;++k)
    #pragma unroll
    for(int j=0;j<4;++j){ pw[k][j]=cvtpk_s(w0[8*k+2*j],w0[8*k+2*j+1]); pw[2+k][j]=cvtpk_s(w1[8*k+2*j],w1[8*k+2*j+1]); }
  #pragma unroll
  for(int d0=0;d0<2;++d0)
    #pragma unroll
    for(int ks=0;ks<4;++ks){ const s16x4 lo=vtr(vp+d0*4096+ks*1024), hh=vtr(vp+d0*4096+ks*1024+512);
      const bf16x8 vf={lo[0],lo[1],lo[2],lo[3],hh[0],hh[1],hh[2],hh[3]};
      o[d0]=SBA_MFMA(__builtin_bit_cast(bf16x8,pw[ks]),vf,o[d0]); }
}
__device__ __forceinline__ void attn_unit(int b,int h,int qb,const bf16*Q,const bf16*__restrict__ K,const bf16*__restrict__ V,bf16*O,char*shm,float bias2){
  int tid_=threadIdx.x; asm volatile("":"+v"(tid_)); const int tid=tid_,lane=tid&63,r32=lane&31,hi=lane>>5; const int wid=__builtin_amdgcn_readfirstlane(tid>>6);
  const long rowbase=(long)b*SEQ; const int q0=qb*QB;
  const bf16*Qw=Q+(rowbase+q0+wid*QBLK)*DM+h*D;
  const bf16*Kh=K+rowbase*DM+h*D,*Vh=V+rowbase*DM+h*D;
  const unsigned lds0=(unsigned)(uintptr_t)shm;
  const bf16*ksrc=Kh+(long)lane*DM+wid*8;
  const bf16*vsrc=Vh+(long)(16*(wid&3)+(lane>>2))*DM+(wid>>2)*32+(lane&3)*8;
  const unsigned kdst=lds0+LDS_K+wid*1024, vdst=lds0+LDS_V+wid*1024;
  const int NT=(q0+QB)/KVBLK;
  #define DMA_KV(s_,slot_) do{ const long t_=(long)(NT-1-(s_))*KVBLK*DM; glds16(ksrc+t_,(unsigned)__builtin_amdgcn_readfirstlane(kdst+(slot_)*SLOTB)); glds16(vsrc+t_,(unsigned)__builtin_amdgcn_readfirstlane(vdst+(slot_)*SLOTB)); }while(0)
  bf16x8 qr[4];
  #pragma unroll
  for(int d0=0;d0<4;++d0)qr[d0]=*reinterpret_cast<const bf16x8*>(&Qw[(long)r32*DM+d0*16+hi*8]);
  DMA_KV(0,0); DMA_KV(1,1);
  const lds_cptr shm3=(lds_cptr)shm; const lds_cptr kp0=shm3+LDS_K+hi*1024+r32*16; const lds_cptr vp0=shm3+LDS_V+((lane>>4)&1)*32+(lane&3)*8+(4*hi+((lane&15)>>2))*64;
  f32x16 o[2];o[0]=f32x16{};o[1]=f32x16{}; f32x16 bv;
  #pragma unroll
  for(int r=0;r<16;++r)bv[r]=bias2;
  asm volatile("":"+v"(bv));
  float carry=1.f; const int qrel=wid*QBLK+r32;
  int slot=0;
  for(int s=0;s<NT;++s){
    if(s+1<NT) asm volatile("s_waitcnt vmcnt(2) lgkmcnt(0)\n\ts_barrier":::"memory"); else asm volatile("s_waitcnt vmcnt(0) lgkmcnt(0)\n\ts_barrier":::"memory");
    if(s+2<NT){ const int ns=(slot==0)?2:slot-1; DMA_KV(s+2,ns); }
    const lds_cptr kp=kp0+slot*SLOTB;
    f32x16 c0=bv,c1=bv;
    #pragma unroll
    for(int d0=0;d0<4;++d0){
      const bf16x8 k0=*(const __attribute__((address_space(3))) bf16x8*)(kp+d0*2048), k1=*(const __attribute__((address_space(3))) bf16x8*)(kp+d0*2048+512);
      c0=SBA_MFMA(k0,qr[d0],c0); c1=SBA_MFMA(k1,qr[d0],c1); }
    if(s<4) sb_weights<true>(c0,c1,carry,hi,3-s,qrel); else sb_weights<false>(c0,c1,carry,hi,0,0);
    pv(o,vp0+slot*SLOTB,c0,c1);
    slot=(slot==2)?0:slot+1;
  }
  #undef DMA_KV
  bf16*Ow=O+(rowbase+q0+wid*QBLK)*OP+h*D;
  { bf16*stg=(bf16*)(shm+LDS_OST)+wid*2048;
    #pragma unroll
    for(int r=0;r<16;++r){const int orow=crow(r,hi);
      #pragma unroll
      for(int d0=0;d0<2;++d0)stg[orow*64+d0*32+r32]=__float2bfloat16(o[d0][r]);}
    asm volatile("s_waitcnt lgkmcnt(0)":::"memory");
    #pragma unroll
    for(int i=0;i<4;++i){const int row=i*8+(lane>>3),ch=lane&7; const u32x4 v=*(const u32x4*)(stg+row*64+ch*8); *(u32x4*)(Ow+(long)row*OP+ch*8)=v;} }
  asm volatile("s_waitcnt vmcnt(0) lgkmcnt(0)\n\ts_barrier":::"memory");
}
}
namespace sb8 {
typedef sba::bf16 bf16; using sba::bf16x8; using sba::s16x4; using sba::f32x16; using sba::u32x4; using sba::lds_cptr; using sba::glds16; using sba::vtr;
constexpr int SEQ=sba::SEQ,D=sba::D,DM=sba::DM,OP=sba::OP,QBLK=sba::QBLK,QB=sba::QB,KVBLK=sba::KVBLK,NSLOT=sba::NSLOT,SLOTB=sba::SLOTB;
constexpr int LDS_K=sba::LDS_K,LDS_V=sba::LDS_V,LDS_OST=sba::LDS_OST;
__device__ __forceinline__ unsigned cvtpk_a(float lo,float hi){ unsigned r; asm("v_cvt_pk_bf16_f32 %0, %1, %2":"=v"(r):"v"(lo),"v"(hi)); return r; }
template<bool MASK> __device__ __forceinline__ void weights(f32x16&c0,f32x16&c1,float&carry,int hi,int thr){
  #pragma unroll
  for(int r=0;r<16;++r){ float e0=__builtin_amdgcn_exp2f(c0[r]), e1=__builtin_amdgcn_exp2f(c1[r]);
    if(MASK){ if(r>=thr)e0=0.f; if(32+r>=thr)e1=0.f; }
    c0[r]=e0; c1[r]=e1; }
  float q0=1.f+c0[0], q1=1.f+c1[0];
  #pragma unroll
  for(int r=1;r<16;++r){ const float e0=c0[r], e1=c1[r]; c0[r]=q0*e0; c1[r]=q1*e1; q0=__builtin_fmaf(q0,e0,q0); q1=__builtin_fmaf(q1,e1,q1); }
  const float t0=__builtin_amdgcn_rcpf(q0), t1=__builtin_amdgcn_rcpf(q1);
  auto s1=__builtin_amdgcn_permlane32_swap(__float_as_uint(t1),__float_as_uint(t1),false,false);
  auto s0=__builtin_amdgcn_permlane32_swap(__float_as_uint(t0),__float_as_uint(t0),false,false);
  const float t1l=__uint_as_float(s1[0]),t1h=__uint_as_float(s1[1]),t0l=__uint_as_float(s0[0]),t0h=__uint_as_float(s0[1]);
  const float off1=hi?carry:carry*t1h; const float E=carry*(t1l*t1h);
  const float off0=hi?E:E*t0h; carry=E*(t0l*t0h);
  const float g1=t1*off1, g0=t0*off0;
  #pragma unroll
  for(int r=0;r<16;++r){ c0[r]*=g0; c1[r]*=g1; }
}
__device__ __forceinline__ void pv_load(bf16x8*vf,lds_cptr vp){
  #pragma unroll
  for(int d0=0;d0<2;++d0)
    #pragma unroll
    for(int ks=0;ks<4;++ks){ const s16x4 lo=vtr(vp+d0*4096+(ks>>1)*2048+(ks&1)*512), hh=vtr(vp+d0*4096+(ks>>1)*2048+(ks&1)*512+256);
      vf[d0*4+ks]=(bf16x8){lo[0],lo[1],lo[2],lo[3],hh[0],hh[1],hh[2],hh[3]}; }
}
__device__ __forceinline__ void pv_mma(f32x16*o,const bf16x8*vf,const f32x16&w0,const f32x16&w1){
  u32x4 pw[4];
  #pragma unroll
  for(int k=0;k<2;++k)
    #pragma unroll
    for(int j=0;j<4;++j){ pw[k][j]=cvtpk_a(w0[8*k+2*j],w0[8*k+2*j+1]); pw[2+k][j]=cvtpk_a(w1[8*k+2*j],w1[8*k+2*j+1]); }
  #pragma unroll
  for(int ks=0;ks<4;++ks){ o[0]=SBA_MFMA(__builtin_bit_cast(bf16x8,pw[ks]),vf[ks],o[0]); o[1]=SBA_MFMA(__builtin_bit_cast(bf16x8,pw[ks]),vf[4+ks],o[1]); }
}
__device__ __forceinline__ void qk(f32x16&c0,f32x16&c1,lds_cptr kp,const bf16x8*qr,const f32x16&bv){
  bf16x8 kf[8];
  #pragma unroll
  for(int d0=0;d0<4;++d0){ kf[2*d0]=*(const __attribute__((address_space(3))) bf16x8*)(kp+d0*2048); kf[2*d0+1]=*(const __attribute__((address_space(3))) bf16x8*)(kp+d0*2048+512); }
  c0=SBA_MFMA(kf[0],qr[0],bv); c1=SBA_MFMA(kf[1],qr[0],bv);
  #pragma unroll
  for(int d0=1;d0<4;++d0){ c0=SBA_MFMA(kf[2*d0],qr[d0],c0); c1=SBA_MFMA(kf[2*d0+1],qr[d0],c1); }
}
__device__ __forceinline__ void attn_unit(int b,int h,int qb,const bf16*Q,const bf16*__restrict__ K,const bf16*__restrict__ V,bf16*O,char*shm,float bias2){
  int tid_=threadIdx.x; asm volatile("":"+v"(tid_)); const int tid=tid_,lane=tid&63,r32=lane&31,hi=lane>>5; const int wid=__builtin_amdgcn_readfirstlane(tid>>6);
  const long rowbase=(long)b*SEQ; const int q0=qb*QB;
  const bf16*Qw=Q+(rowbase+q0+wid*QBLK)*DM+h*D;
  const bf16*Kh=K+rowbase*DM+h*D,*Vh=V+rowbase*DM+h*D;
  const unsigned lds0=(unsigned)(uintptr_t)shm;
  const bf16*ksrc=Kh+(long)lane*DM+wid*8;
  const bf16*vsrc=Vh+(long)(16*(wid&3)+(lane>>2))*DM+(wid>>2)*32+(lane&3)*8;
  const unsigned kdst=lds0+LDS_K+wid*1024, vdst=lds0+LDS_V+wid*1024;
  const int NT=(q0+QB)/KVBLK;
  #define DMA8_K(s_,slot_) do{ const long t_=(long)(NT-1-(s_))*KVBLK*DM; glds16(ksrc+t_,(unsigned)__builtin_amdgcn_readfirstlane(kdst+(slot_)*SLOTB)); }while(0)
  #define DMA8_V(s_,slot_) do{ const long t_=(long)(NT-1-(s_))*KVBLK*DM; glds16(vsrc+t_,(unsigned)__builtin_amdgcn_readfirstlane(vdst+(slot_)*SLOTB)); }while(0)
  bf16x8 qr[4];
  #pragma unroll
  for(int d0=0;d0<4;++d0)qr[d0]=*reinterpret_cast<const bf16x8*>(&Qw[(long)r32*DM+d0*16+hi*8]);
  DMA8_K(0,0);
  DMA8_K(1,1); DMA8_V(0,0);
  DMA8_K(2,2); DMA8_V(1,1);
  const int kperm=16*((r32>>2)&1)+(r32&3)+4*(r32>>3);
  const lds_cptr shm3=(lds_cptr)shm; const lds_cptr kp0=shm3+LDS_K+hi*1024+kperm*16; const lds_cptr vp0=shm3+LDS_V+((lane>>4)&1)*32+(lane&3)*8+(16*hi+((lane&15)>>2))*64;
  f32x16 o[2];o[0]=f32x16{};o[1]=f32x16{}; f32x16 bv;
  #pragma unroll
  for(int r=0;r<16;++r)bv[r]=bias2;
  asm volatile("":"+v"(bv));
  float carry=1.f; const int qrel=wid*QBLK+r32;
  f32x16 a0,a1,b0,b1;
  asm volatile("s_waitcnt vmcnt(4) lgkmcnt(0)\n\ts_barrier":::"memory");
  qk(a0,a1,kp0,qr,bv);
  int ks1=1,vs0=0;
  #define STEP8(C0,C1,N0,N1,st_) do{ const int st=(st_); \
    if(st+2<NT) asm volatile("s_waitcnt vmcnt(2) lgkmcnt(0)\n\ts_barrier":::"memory"); else if(st+2==NT) asm volatile("s_waitcnt vmcnt(1) lgkmcnt(0)\n\ts_barrier":::"memory"); else asm volatile("s_waitcnt vmcnt(0) lgkmcnt(0)\n\ts_barrier":::"memory"); \
    { const int kfree=(ks1==0)?2:ks1-1; const int vfree=(vs0==0)?2:vs0-1; if(st+3<NT) DMA8_K(st+3,kfree); if(st+2<NT) DMA8_V(st+2,vfree); } \
    bf16x8 vf[8]; pv_load(vf,vp0+vs0*SLOTB); \
    if(st+1<NT) qk(N0,N1,kp0+ks1*SLOTB,qr,bv); \
    __builtin_amdgcn_sched_barrier(0); \
    if(st<4) weights<true>(C0,C1,carry,hi,qrel-64*(3-st)-16*hi); else weights<false>(C0,C1,carry,hi,0); \
    pv_mma(o,vf,C0,C1); \
    ks1=(ks1==2)?0:ks1+1; vs0=(vs0==2)?0:vs0+1; }while(0)
  for(int it=0;it<NT;it+=2){ STEP8(a0,a1,b0,b1,it); STEP8(b0,b1,a0,a1,it+1); }
  #undef STEP8
  #undef DMA8_K
  #undef DMA8_V
  bf16*Ow=O+(rowbase+q0+wid*QBLK)*OP+h*D;
  { bf16*stg=(bf16*)(shm+LDS_OST)+wid*2048;
    #pragma unroll
    for(int r=0;r<16;++r){const int orow=sba::crow(r,hi);
      #pragma unroll
      for(int d0=0;d0<2;++d0)stg[orow*64+d0*32+r32]=__float2bfloat16(o[d0][r]);}
    asm volatile("s_waitcnt lgkmcnt(0)":::"memory");
    #pragma unroll
    for(int i=0;i<4;++i){const int row=i*8+(lane>>3),ch=lane&7; const u32x4 v=*(const u32x4*)(stg+row*64+ch*8); *(u32x4*)(Ow+(long)row*OP+ch*8)=v;} }
  asm volatile("s_waitcnt vmcnt(0) lgkmcnt(0)\n\ts_barrier":::"memory");
}
}
namespace sbd {
using sba::bf16x8; using sba::f32x16; using sba::u32x4; using sba::bf16; using sba::crow; using sba::cvtpk_s;
typedef float f32x4 __attribute__((ext_vector_type(4)));
#define RLXA __ATOMIC_RELAXED, __HIP_MEMORY_SCOPE_AGENT
template<bool NEWK> __device__ __forceinline__ void weights32(f32x16&c,float&carry,int hi,int q){
  #pragma unroll
  for(int r=0;r<16;++r){ float e=__builtin_amdgcn_exp2f(c[r]);
    if(NEWK){ const int kv=crow(r,hi); if(kv>=8||kv>=q)e=0.f; }
    c[r]=1.f+e; }
  float P2[4],P3[4],T[4],Tl[4],Th[4],off[4];
  #pragma unroll
  for(int k=0;k<4;++k){ P2[k]=c[4*k]*c[4*k+1]; P3[k]=P2[k]*c[4*k+2]; T[k]=__builtin_amdgcn_rcpf(P3[k]*c[4*k+3]); }
  #pragma unroll
  for(int k=0;k<4;++k){ auto s=__builtin_amdgcn_permlane32_swap(__float_as_uint(T[k]),__float_as_uint(T[k]),false,false); Tl[k]=__uint_as_float(s[0]); Th[k]=__uint_as_float(s[1]); }
  float E=carry;
  #pragma unroll
  for(int k=3;k>=0;--k){ off[k]=hi?E:E*Th[k]; E=E*(Tl[k]*Th[k]); }
  carry=E;
  #pragma unroll
  for(int k=0;k<4;++k){ const float g=T[k]*off[k], R1=c[4*k]*g, R2=P2[k]*g, R3=P3[k]*g; c[4*k]=R1-g; c[4*k+1]=R2-R1; c[4*k+2]=R3-R2; c[4*k+3]=off[k]-R3; }
}
struct Raw { f32x4 k[8]; f32x4 v[8]; };
typedef unsigned u32x2v __attribute__((ext_vector_type(2)));
__device__ __forceinline__ void load_tile(Raw&R,__amdgpu_buffer_rsrc_t rk,__amdgpu_buffer_rsrc_t rv,unsigned ub,int kvo){
  #pragma unroll
  for(int i=0;i<8;++i) R.k[i]=__builtin_bit_cast(f32x4,__builtin_amdgcn_raw_buffer_load_b128(rk,kvo,(int)(ub+(unsigned)i*8192u),2));
  #pragma unroll
  for(int i=0;i<8;++i) R.v[i]=__builtin_bit_cast(f32x4,__builtin_amdgcn_raw_buffer_load_b128(rv,kvo,(int)(ub+(unsigned)i*8192u),2));
}
struct Frag { bf16x8 k[4]; bf16x8 v[4]; };
__device__ __forceinline__ void cvt_tile(Frag&F,const Raw&R,__attribute__((address_space(3))) char*kl,int kwo,int kro,int vwo,int vro){
  #pragma unroll
  for(int i=0;i<8;++i){ u32x2v p; p[0]=cvtpk_s(R.k[i][0],R.k[i][1]); p[1]=cvtpk_s(R.k[i][2],R.k[i][3]); *(__attribute__((address_space(3))) u32x2v*)(kl+kwo+i*576)=p;
                        u32x2v q; q[0]=cvtpk_s(R.v[i][0],R.v[i][1]); q[1]=cvtpk_s(R.v[i][2],R.v[i][3]); *(__attribute__((address_space(3))) u32x2v*)(kl+4608+vwo+i*256)=q; }
  #pragma unroll
  for(int d0=0;d0<4;++d0) F.k[d0]=*(const __attribute__((address_space(3))) bf16x8*)(kl+kro+32*d0);
  #pragma unroll
  for(int d0=0;d0<2;++d0)
    #pragma unroll
    for(int ks=0;ks<2;++ks){ const sba::s16x4 lo=sba::vtr((sba::lds_cptr)(kl+4608+vro+d0*2048+ks*1024)), hh=sba::vtr((sba::lds_cptr)(kl+4608+vro+d0*2048+ks*1024+512));
      F.v[d0*2+ks]=(bf16x8){lo[0],lo[1],lo[2],lo[3],hh[0],hh[1],hh[2],hh[3]}; }
}
template<bool NEWK> __device__ __forceinline__ void tile_step(const Frag&F,const bf16x8*qr,const float bias2,f32x16*o,float&carry,int hi,int q){
  f32x16 c;
  #pragma unroll
  for(int r=0;r<16;++r)c[r]=bias2;
  #pragma unroll
  for(int d0=0;d0<4;++d0) c=SBA_MFMA(F.k[d0],qr[d0],c);
  weights32<NEWK>(c,carry,hi,q);
  u32x4 pw[2];
  #pragma unroll
  for(int k=0;k<2;++k)
    #pragma unroll
    for(int j=0;j<4;++j) pw[k][j]=cvtpk_s(c[8*k+2*j],c[8*k+2*j+1]);
  #pragma unroll
  for(int d0=0;d0<2;++d0)
    #pragma unroll
    for(int ks=0;ks<2;++ks) o[d0]=SBA_MFMA(__builtin_bit_cast(bf16x8,pw[ks]),F.v[d0*2+ks],o[d0]);
}
__device__ __forceinline__ void decode_wave(int smp,int j,int h,const float*cache_k,const float*cache_v,const int*page_table,const bf16*Q,const bf16*Kn,const bf16*Vn,const float*b_sb,
                                            float*part,float*rtot,unsigned*cnt,bf16*MIX,__attribute__((address_space(3))) char*kl){
  int tid_=threadIdx.x; asm volatile("":"+v"(tid_)); const int lane=tid_&63,r32=lane&31,hi=lane>>5;
  const float bias2=b_sb[h]*1.4426950408889634f;
  const long srow=16384+8*smp;
  bf16x8 qr[4];
  #pragma unroll
  for(int d0=0;d0<4;++d0){ bf16x8 z={0,0,0,0,0,0,0,0}; if(r32<8) z=*reinterpret_cast<const bf16x8*>(Q+(srow+r32)*512+h*64+d0*16+hi*8); qr[d0]=z; }
  f32x16 o[2]; o[0]=f32x16{}; o[1]=f32x16{}; float carry=1.f;
  if(j==7){
    Frag F;
    #pragma unroll
    for(int d0=0;d0<4;++d0){ bf16x8 z={0,0,0,0,0,0,0,0}; if(r32<8) z=*reinterpret_cast<const bf16x8*>(Kn+(srow+r32)*512+h*64+d0*16+hi*8); F.k[d0]=z; }
    #pragma unroll
    for(int d0=0;d0<2;++d0){
      bf16x8 z={0,0,0,0,0,0,0,0};
      #pragma unroll
      for(int jj=0;jj<4;++jj) z[jj]=*reinterpret_cast<const short*>(Vn+(srow+4*hi+jj)*512+h*64+32*d0+r32);
      F.v[d0*2]=z; F.v[d0*2+1]=(bf16x8){0,0,0,0,0,0,0,0}; }
    tile_step<true>(F,qr,bias2,o,carry,hi,r32);
  }
  const int*pt=page_table+smp*64+8*j;
  Raw R; Frag F;
  const int kvo=(lane>>4)*2048+(lane&15)*16;
  const int kwo=(lane>>4)*144+(lane&15)*8, kro=r32*144+16*hi;
  const int vwo=((lane&15)>>3)*2048+(lane>>4)*64+(lane&7)*8, vro=((lane>>4)&1)*32+(lane&3)*8+(4*hi+((lane&15)>>2))*64;
  const __amdgpu_buffer_rsrc_t rk=__builtin_amdgcn_make_buffer_rsrc((void*)cache_k,0,671088640,0x00020000), rv=__builtin_amdgcn_make_buffer_rsrc((void*)cache_v,0,671088640,0x00020000);
  #define UOFF(tt) ((unsigned)__builtin_amdgcn_readfirstlane((int)(((((unsigned)pt[(tt)>>2]*128u+(unsigned)(((tt)&3)*32))*8u+(unsigned)h)*64u)*4u)))
  #define LOADT(R_,tt) load_tile(R_,rk,rv,UOFF(tt),kvo)
  LOADT(R,31); cvt_tile(F,R,kl,kwo,kro,vwo,vro);
  for(int tt=31;tt>=0;--tt){
    if(tt>0) LOADT(R,tt-1);
    tile_step<false>(F,qr,bias2,o,carry,hi,r32);
    if(tt>0) cvt_tile(F,R,kl,kwo,kro,vwo,vro);
  }
  #undef UOFF
  #undef LOADT
  const int unit=smp*8+j;
  int l2_=threadIdx.x; asm volatile("":"+v"(l2_)); const int lane2=l2_&63, r32b=lane2&31, hib=lane2>>5;
  unsigned*pp=(unsigned*)part+((size_t)unit*8+h)*512;
  #pragma unroll
  for(int r=0;r<4;++r)
    #pragma unroll
    for(int d0=0;d0<2;++d0) __hip_atomic_store(pp+(r+4*hib)*64+32*d0+r32b,__float_as_uint(o[d0][r]),RLXA);
  if(lane2<8) __hip_atomic_store((unsigned*)rtot+((size_t)unit*8+h)*8+lane2,__float_as_uint(carry),RLXA);
  asm volatile("s_waitcnt vmcnt(0)":::"memory");
  unsigned old=0u;
  if(lane2==0) old=__hip_atomic_fetch_add(cnt+64*(smp*8+h),1u,RLXA);
  old=(unsigned)__builtin_amdgcn_readfirstlane((int)old);
  if(old==7u){
    const int q=lane2>>3,dc=(lane2&7)*8; float acc[8];
    #pragma unroll
    for(int i=0;i<8;++i)acc[i]=0.f;
    float f=1.f;
    for(int jj=7;jj>=0;--jj){ const size_t u=(size_t)smp*8+jj; const unsigned*src=(const unsigned*)part+(u*8+h)*512+q*64+dc;
      #pragma unroll
      for(int i=0;i<8;++i) acc[i]+=f*__uint_as_float(__hip_atomic_load(src+i,RLXA));
      f*=__uint_as_float(__hip_atomic_load((const unsigned*)rtot+(u*8+h)*8+q,RLXA)); }
    u32x4 w; w[0]=cvtpk_s(acc[0],acc[1]); w[1]=cvtpk_s(acc[2],acc[3]); w[2]=cvtpk_s(acc[4],acc[5]); w[3]=cvtpk_s(acc[6],acc[7]);
    *(u32x4*)(MIX+(srow+q)*1024+h*64+dc)=w;
  }
}
}
namespace gla {
using sba::bf16; using sba::cvtpk_s;
typedef short bf16x8 __attribute__((ext_vector_type(8)));
typedef short bf16x4 __attribute__((ext_vector_type(4)));
typedef float f32x4 __attribute__((ext_vector_type(4)));
typedef unsigned u32x4 __attribute__((ext_vector_type(4)));
typedef unsigned u32x2 __attribute__((ext_vector_type(2)));
#define GLAS __attribute__((address_space(3)))
constexpr int GP=1792;
constexpr int L_QD=0,L_KI=9216,L_KET=18432,L_VT=27648,L_DEC=46080,L_EXR=46336,L_TOT=46592,L_SSQ=48640,L_END=50688;
#define GMFMA(a,b,c) __builtin_amdgcn_mfma_f32_16x16x32_bf16((a),(b),(c),0,0,0)
__device__ __forceinline__ float bf2f(short s){ return __uint_as_float(((unsigned)(unsigned short)s)<<16); }
__device__ __forceinline__ short f2bf(float f){ return (short)(cvtpk_s(f,0.f)&0xffffu); }
template<int MODE,bool FULL> __device__ __forceinline__ void chunk(const bf16*G,bf16*MIX,long m0,int ntok,int h,GLAS char*L,f32x4(&S)[4],const float(&wg)[16],float bg,float gain,float&dseg){
  int tid_=threadIdx.x; asm volatile("":"+v"(tid_)); const int tid=tid_,lane=tid&63,c=lane,fr=lane&15,fq=lane>>4; const int w=__builtin_amdgcn_readfirstlane(tid>>6); const int g=w;
  const short*Gs=(const short*)G;
  float bl[8]; float run=0.f;
  bf16x8 al0[8],al1[8]; short kraw[8],qraw[8],vraw[16];
  #pragma unroll
  for(int i=0;i<8;++i){ const int t=8*g+i; const bool ok=FULL||t<ntok; const long row=ok?(m0+t):m0; const bf16x8*ap=(const bf16x8*)(Gs+row*GP+1536); al0[i]=ap[0]; al1[i]=ap[1];
    kraw[i]=Gs[row*GP+256+64*h+c]; qraw[i]=(MODE==1)?Gs[row*GP+64*h+c]:(short)0; }
  #pragma unroll
  for(int i=0;i<16;++i){ const int t=16*(tid>>7)+i; const bool ok=FULL||t<ntok; const long row=ok?(m0+t):m0; vraw[i]=Gs[row*GP+512+128*h+(tid&127)]; }
  #pragma unroll
  for(int i=0;i<8;++i){ const int t=8*g+i; float la=0.f;
    if(FULL||t<ntok){ const bf16x8 a0=al0[i],a1=al1[i]; float x=bg;
      #pragma unroll
      for(int j=0;j<8;++j){ x+=bf2f(a0[j])*wg[j]; x+=bf2f(a1[j])*wg[8+j]; }
      la=(fminf(x,0.f)-__logf(1.f+__expf(-fabsf(x))))*0.0625f; }
    run+=la; bl[i]=run; }
  GLAS float*TOT=(GLAS float*)(L+L_TOT);
  TOT[g*64+c]=run;
  __syncthreads();
  float prefix=0.f,total=0.f;
  #pragma unroll
  for(int gg=0;gg<8;++gg){ const float v=TOT[gg*64+c]; total+=v; if(gg<g)prefix+=v; }
  const float bref=0.5f*total;
  float ke[8];
  #pragma unroll
  for(int i=0;i<8;++i){ const int t=8*g+i; const float b=prefix+bl[i]; float kk=0.f,qq=0.f;
    if(FULL||t<ntok){ kk=bf2f(kraw[i]); if(MODE==1) qq=bf2f(qraw[i]); }
    ke[i]=kk*__expf(total-b);
    if(MODE==1){ *(GLAS short*)(L+L_QD+t*144+c*2)=f2bf(qq*0.125f*__expf(b-bref)); *(GLAS short*)(L+L_KI+t*144+c*2)=f2bf(kk*__expf(bref-b)); } }
  { u32x4 p; p[0]=cvtpk_s(ke[0],ke[1]); p[1]=cvtpk_s(ke[2],ke[3]); p[2]=cvtpk_s(ke[4],ke[5]); p[3]=cvtpk_s(ke[6],ke[7]); *(GLAS u32x4*)(L+L_KET+c*144+g*16)=p; }
  if(g==0){ const float d=__expf(total); ((GLAS float*)(L+L_DEC))[c]=d; ((GLAS float*)(L+L_EXR))[c]=__expf(bref); dseg*=d; }
  { const int dv=tid&127,tg=tid>>7; float vv[16];
    #pragma unroll
    for(int i=0;i<16;++i){ const int t=16*tg+i; vv[i]=(FULL||t<ntok)?bf2f(vraw[i]):0.f; }
    u32x4 p0,p1;
    #pragma unroll
    for(int j=0;j<4;++j){ p0[j]=cvtpk_s(vv[2*j],vv[2*j+1]); p1[j]=cvtpk_s(vv[8+2*j],vv[8+2*j+1]); }
    *(GLAS u32x4*)(L+L_VT+dv*144+tg*32)=p0; *(GLAS u32x4*)(L+L_VT+dv*144+tg*32+16)=p1; }
  __syncthreads();
  const int dvl=16*w+fr;
  f32x4 O[4];
  if(MODE==1){
    f32x4 PT[4][4];
    #pragma unroll
    for(int st=0;st<4;++st)
      #pragma unroll
      for(int tt=0;tt<4;++tt){ f32x4 acc={0.f,0.f,0.f,0.f};
        if(st<=tt){
          #pragma unroll
          for(int kk=0;kk<2;++kk){ const bf16x8 a=*(GLAS const bf16x8*)(L+L_KI+(16*st+fr)*144+(32*kk+8*fq)*2), b=*(GLAS const bf16x8*)(L+L_QD+(16*tt+fr)*144+(32*kk+8*fq)*2); acc=GMFMA(a,b,acc); }
          if(st==tt){
            #pragma unroll
            for(int i=0;i<4;++i) if(4*fq+i>fr) acc[i]=0.f; } }
        PT[st][tt]=acc; }
    #pragma unroll
    for(int tt=0;tt<4;++tt){ O[tt]=(f32x4){0.f,0.f,0.f,0.f};
      #pragma unroll
      for(int pr=0;pr<2;++pr){ if(2*pr<=tt){
        u32x4 pa; pa[0]=cvtpk_s(PT[2*pr][tt][0],PT[2*pr][tt][1]); pa[1]=cvtpk_s(PT[2*pr][tt][2],PT[2*pr][tt][3]); pa[2]=cvtpk_s(PT[2*pr+1][tt][0],PT[2*pr+1][tt][1]); pa[3]=cvtpk_s(PT[2*pr+1][tt][2],PT[2*pr+1][tt][3]);
        const u32x2 b0=*(GLAS const u32x2*)(L+L_VT+dvl*144+(32*pr+4*fq)*2), b1=*(GLAS const u32x2*)(L+L_VT+dvl*144+(32*pr+16+4*fq)*2);
        const u32x4 pb={b0[0],b0[1],b1[0],b1[1]};
        O[tt]=GMFMA(__builtin_bit_cast(bf16x8,pa),__builtin_bit_cast(bf16x8,pb),O[tt]); } } }
    #pragma unroll
    for(int kk=0;kk<2;++kk){
      const f32x4 e0=*(GLAS const f32x4*)(L+L_EXR+(32*kk+4*fq)*4), e1=*(GLAS const f32x4*)(L+L_EXR+(32*kk+16+4*fq)*4);
      const f32x4 s0=S[2*kk]*e0, s1=S[2*kk+1]*e1;
      u32x4 pb; pb[0]=cvtpk_s(s0[0],s0[1]); pb[1]=cvtpk_s(s0[2],s0[3]); pb[2]=cvtpk_s(s1[0],s1[1]); pb[3]=cvtpk_s(s1[2],s1[3]);
      #pragma unroll
      for(int tt=0;tt<4;++tt){ const u32x2 a0=*(GLAS const u32x2*)(L+L_QD+(16*tt+fr)*144+(32*kk+4*fq)*2), a1=*(GLAS const u32x2*)(L+L_QD+(16*tt+fr)*144+(32*kk+16+4*fq)*2);
        const u32x4 pa={a0[0],a0[1],a1[0],a1[1]};
        O[tt]=GMFMA(__builtin_bit_cast(bf16x8,pa),__builtin_bit_cast(bf16x8,pb),O[tt]); } }
  }
  #pragma unroll
  for(int mt=0;mt<4;++mt){ const f32x4 d4=*(GLAS const f32x4*)(L+L_DEC+(16*mt+4*fq)*4); S[mt]=S[mt]*d4;
    #pragma unroll
    for(int kk=0;kk<2;++kk){ const bf16x8 a=*(GLAS const bf16x8*)(L+L_KET+(16*mt+fr)*144+(32*kk+8*fq)*2), b=*(GLAS const bf16x8*)(L+L_VT+dvl*144+(32*kk+8*fq)*2); S[mt]=GMFMA(a,b,S[mt]); } }
  if(MODE==1){
    GLAS float*SSQ=(GLAS float*)(L+L_SSQ);
    #pragma unroll
    for(int tt=0;tt<4;++tt)
      #pragma unroll
      for(int i=0;i<4;++i){ float ss=O[tt][i]*O[tt][i]; ss+=__shfl_xor(ss,1); ss+=__shfl_xor(ss,2); ss+=__shfl_xor(ss,4); ss+=__shfl_xor(ss,8); if(fr==0) SSQ[w*64+16*tt+4*fq+i]=ss; }
    short rraw[16];
    #pragma unroll
    for(int tt=0;tt<4;++tt)
      #pragma unroll
      for(int i=0;i<4;++i){ const int t=16*tt+4*fq+i; const long row=(FULL||t<ntok)?(m0+t):m0; rraw[4*tt+i]=Gs[row*GP+1024+128*h+dvl]; }
    __syncthreads();
    #pragma unroll
    for(int tt=0;tt<4;++tt)
      #pragma unroll
      for(int i=0;i<4;++i){ const int t=16*tt+4*fq+i; float tot=0.f;
        #pragma unroll
        for(int ww=0;ww<8;++ww) tot+=SSQ[ww*64+t];
        if(FULL||t<ntok){ const float rstd=rsqrtf(tot*(1.f/128.f)+1e-6f); const float rg=bf2f(rraw[4*tt+i]); const float sl=rg/(1.f+__expf(-rg));
          ((short*)MIX)[(m0+t)*1024+512+128*h+dvl]=f2bf(O[tt][i]*rstd*gain*sl); } }
  }
  __syncthreads();
}
__device__ __forceinline__ void load_consts(int h,const float*w_gate,const float*b_gate,const float*g_out,float(&wg)[16],float&bg,float&gain){
  const int lane=threadIdx.x&63, w=threadIdx.x>>6;
  #pragma unroll
  for(int j=0;j<16;++j) wg[j]=w_gate[j*256+64*h+lane];
  bg=b_gate[64*h+lane]; gain=g_out[16*w+(lane&15)];
}
__device__ __forceinline__ void pass1_unit(int unit,const bf16*G,const float*w_gate,const float*b_gate,const float*g_out,float*SLOC,float*DSEG,GLAS char*L){
  const int bh=unit>>5,sseg=unit&31,b=bh>>2,h=bh&3; const int tid=threadIdx.x;
  float wg[16],bg,gain; load_consts(h,w_gate,b_gate,g_out,wg,bg,gain);
  f32x4 S[4];
  #pragma unroll
  for(int mt=0;mt<4;++mt)S[mt]=(f32x4){0.f,0.f,0.f,0.f};
  float dseg=1.f; const long m0=(long)b*8192+256*sseg;
  for(int ch=0;ch<4;++ch) chunk<0,true>(G,nullptr,m0+64*ch,64,h,L,S,wg,bg,gain,dseg);
  f32x4*dst=(f32x4*)(SLOC+((size_t)unit*512+tid)*16);
  #pragma unroll
  for(int mt=0;mt<4;++mt)dst[mt]=S[mt];
  if(tid<64)DSEG[unit*64+tid]=dseg;
}
__device__ __forceinline__ void pass3_unit(int unit,const bf16*G,bf16*MIX,const float*w_gate,const float*b_gate,const float*g_out,const float*SLOC,const float*DSEG,float*sfin_base,GLAS char*L){
  const int bh=unit>>5,sseg=unit&31,b=bh>>2,h=bh&3; const int tid=threadIdx.x,lane=tid&63,fr=lane&15,fq=lane>>4,w=tid>>6;
  float wg[16],bg,gain; load_consts(h,w_gate,b_gate,g_out,wg,bg,gain);
  f32x4 S[4];
  #pragma unroll
  for(int mt=0;mt<4;++mt)S[mt]=(f32x4){0.f,0.f,0.f,0.f};
  #pragma unroll 4
  for(int j=0;j<sseg;++j){ const int uj=bh*32+j; const f32x4*src=(const f32x4*)(SLOC+((size_t)uj*512+tid)*16);
    #pragma unroll
    for(int mt=0;mt<4;++mt){ const f32x4 d4=*(const f32x4*)(DSEG+uj*64+16*mt+4*fq); S[mt]=S[mt]*d4+src[mt]; } }
  float dseg=1.f; const long m0=(long)b*8192+256*sseg;
  for(int ch=0;ch<4;++ch) chunk<1,true>(G,MIX,m0+64*ch,64,h,L,S,wg,bg,gain,dseg);
  if(sseg==31){ float*o=sfin_base+(size_t)bh*8192;
    #pragma unroll
    for(int mt=0;mt<4;++mt)
      #pragma unroll
      for(int i=0;i<4;++i) o[(16*mt+4*fq+i)*128+16*w+fr]=S[mt][i]; }
}
__device__ __forceinline__ void sample_unit(int unit,const bf16*G,bf16*MIX,const float*w_gate,const float*b_gate,const float*g_out,const float*s0,float*sout,GLAS char*L){
  const int smp=unit>>2,h=unit&3; const int tid=threadIdx.x,lane=tid&63,fr=lane&15,fq=lane>>4,w=tid>>6;
  float wg[16],bg,gain; load_consts(h,w_gate,b_gate,g_out,wg,bg,gain);
  f32x4 S[4]; const float*si=s0+(size_t)unit*8192; float*so=sout+(size_t)unit*8192;
  #pragma unroll
  for(int mt=0;mt<4;++mt)
    #pragma unroll
    for(int i=0;i<4;++i) S[mt][i]=si[(16*mt+4*fq+i)*128+16*w+fr];
  float dseg=1.f;
  chunk<1,false>(G,MIX,16384+8*(long)smp,8,h,L,S,wg,bg,gain,dseg);
  #pragma unroll
  for(int mt=0;mt<4;++mt)
    #pragma unroll
    for(int i=0;i<4;++i) so[(16*mt+4*fq+i)*128+16*w+fr]=S[mt][i];
}
}
namespace thin {
using sba::bf16x8; using sba::f32x16; using sba::crow;
template<int KS,class Epi> __device__ __forceinline__ void run(const unsigned short*A,int lda,const unsigned short*Bt,int ldb,int K,int ntn,int tile0,int ntiles,__attribute__((address_space(3))) float*red,const Epi&epi){
  int tid_=threadIdx.x; asm volatile("":"+v"(tid_)); const int lane=tid_&63,r32=lane&31,hi=lane>>5; const int w=__builtin_amdgcn_readfirstlane(tid_>>6);
  const int sub=w/KS,kp=w%KS,tile=tile0+sub; const bool live=tile<ntiles; const int tm=live?tile/ntn:0,tn=live?tile%ntn:0;
  const int klen=K/KS,k0=kp*klen;
  const unsigned short*ap=A+(size_t)(32*tm+r32)*lda+k0+8*hi; const unsigned short*bp=Bt+(size_t)(32*tn+r32)*ldb+k0+8*hi;
  f32x16 acc=f32x16{};
  if(live){
    #pragma unroll 8
    for(int k=0;k<klen;k+=16){ const bf16x8 a=*(const bf16x8*)(ap+k), b=*(const bf16x8*)(bp+k); acc=__builtin_amdgcn_mfma_f32_32x32x16_bf16(a,b,acc,0,0,0); } }
  #pragma unroll
  for(int r=0;r<16;++r) red[(w*16+r)*64+lane]=acc[r];
  __syncthreads();
  if(kp==0&&live){
    #pragma unroll
    for(int r=0;r<16;++r){ float v=0.f;
      #pragma unroll
      for(int p=0;p<KS;++p) v+=red[((sub*KS+p)*16+r)*64+lane];
      epi(32*tm+crow(r,hi),32*tn+r32,v); } }
  __syncthreads();
}
struct EpiResGateS { const float*base; float*out; const float*gate; int ld;
  __device__ __forceinline__ void operator()(int row,int col,float v)const{ const size_t o=(size_t)row*ld+col; out[o]=base[o]+gate[(size_t)(2+(row>>3))*6144+col]*v; } };
struct EpiRelu2S { unsigned short*H; int ld;
  __device__ __forceinline__ void operator()(int row,int col,float v)const{ const float a=fmaxf(v,0.f); H[(size_t)row*ld+col]=(unsigned short)(sba::cvtpk_s(a*a,0.f)&0xffffu); } };
}
__device__ __forceinline__ float wave_sum(float v) {
#pragma unroll
    for (int o = 1; o < 64; o <<= 1) v += __shfl_xor(v, o);
    return v;
}
__device__ __forceinline__ void p0_transpose_item(const float* W, int K, int Nreal, int Npad, bf16* WT, LAS float* scr, int item, int lane) {
    const int nblk = Npad / 32, kb = item / nblk, nb = item % nblk, k0 = 64 * kb, n0 = 32 * nb;
    const int n = n0 + (lane & 31);
#pragma unroll 8
    for (int i = 0; i < 32; ++i) { const int kk = 2 * i + (lane >> 5); scr[kk * 33 + (lane & 31)] = (n < Nreal) ? W[(size_t)(k0 + kk) * Nreal + n] : 0.f; }
    LDS_WAIT(); asm volatile("" ::: "memory");
    const int c = lane & 7;
#pragma unroll
    for (int j = 0; j < 4; ++j) { const int nn = (lane >> 3) + 8 * j; const LAS float* s = scr + (8 * c) * 33 + nn;
        v4u o; o.x = pk2(s[0 * 33], s[1 * 33]); o.y = pk2(s[2 * 33], s[3 * 33]); o.z = pk2(s[4 * 33], s[5 * 33]); o.w = pk2(s[6 * 33], s[7 * 33]);
        *(GAS v4u*)(WT + (size_t)(n0 + nn) * K + k0 + 8 * c) = o; }
    LDS_WAIT(); asm volatile("" ::: "memory");
}
__device__ __forceinline__ void norm_mod_row_bf16(int lane, const float* xrow, const float* gain, const float* sc, const float* sh, bf16* orow) {
    const f32x4* xr = (const f32x4*)xrow + lane; f32x4 v[4]; float s = 0.f;
#pragma unroll
    for (int j = 0; j < 4; ++j) { v[j] = xr[64 * j]; s += (v[j].x * v[j].x + v[j].y * v[j].y) + (v[j].z * v[j].z + v[j].w * v[j].w); }
    const float rstd = rsqrtf(wave_sum(s) * (1.f / D) + NORM_EPS);
    unsigned long long* o8 = (unsigned long long*)orow + lane;
#pragma unroll
    for (int j = 0; j < 4; ++j) { const f32x4 g = ((const f32x4*)gain)[lane + 64 * j], a = ((const f32x4*)sc)[lane + 64 * j], b = ((const f32x4*)sh)[lane + 64 * j];
        const f32x4 y = v[j] * rstd * g * (a + 1.f) + b;
        o8[64 * j] = (unsigned long long)pk2(y.x, y.y) | ((unsigned long long)pk2(y.z, y.w) << 32); }
}
__device__ __forceinline__ void norm_row_f32_inplace(int lane, float* xrow, const float* gain) {
    f32x4* xr = (f32x4*)xrow + lane; f32x4 v[4]; float s = 0.f;
#pragma unroll
    for (int j = 0; j < 4; ++j) { v[j] = xr[64 * j]; s += (v[j].x * v[j].x + v[j].y * v[j].y) + (v[j].z * v[j].z + v[j].w * v[j].w); }
    const float rstd = rsqrtf(wave_sum(s) * (1.f / D) + NORM_EPS);
#pragma unroll
    for (int j = 0; j < 4; ++j) { const f32x4 g = ((const f32x4*)gain)[lane + 64 * j]; xr[64 * j] = v[j] * rstd * g; }
}
__device__ __forceinline__ int bidx_of_row(int m) { return m < MP ? (m >> 13) : 2 + ((m - MP) >> 3); }

struct Args { const float* in[21]; const int* page_table; float* out; unsigned char* ws; };
static_assert(sizeof(Args) == 24 * 8, "Args has no padding");

__global__ void __launch_bounds__(NWAVES * 64, 2) mk_fwd(Args args) {
    extern __shared__ __attribute__((aligned(16))) unsigned char lds[];
    LAS unsigned char* L = (LAS unsigned char*)lds;
    volatile LAS unsigned* MISC = (volatile LAS unsigned*)(L + MISC_OFF);
    const int tid = threadIdx.x, lane = tid & 63, wave = __builtin_amdgcn_readfirstlane(tid >> 6);
    const int G = gridDim.x; const int bx = blockIdx.x; const int vcu = (G % 8 == 0) ? (bx % 8) * (G / 8) + bx / 8 : bx;
    unsigned char* ws = args.ws;
    unsigned* ctl = (unsigned*)(ws + WS_CTL);
    const float *x_prompt = args.in[0], *x_sample = args.in[1], *c_prompt = args.in[2], *c_sample = args.in[3], *cache_k = args.in[4], *cache_v = args.in[5], *state_gla = args.in[6];
    const float *w_ada = args.in[8], *b_ada = args.in[9], *g_mix = args.in[10], *w_in = args.in[11], *b_sb = args.in[12], *w_gate = args.in[13], *b_gate = args.in[14], *g_gla_out = args.in[15];
    const float *w_out = args.in[16], *g_ffn = args.in[17], *w_up = args.in[18], *w_down = args.in[19], *g_final = args.in[20];
    float* out = args.out;
    float* MOD = (float*)(ws + WS_MOD);
    bf16 *Win_t = (bf16*)(ws + WS_WIN), *Wo_t = (bf16*)(ws + WS_WO), *Wup_t = (bf16*)(ws + WS_WUP), *Wdn_t = (bf16*)(ws + WS_WDN);
    bf16 *XN = (bf16*)(ws + WS_XN), *QB = (bf16*)(ws + WS_Q), *KB = (bf16*)(ws + WS_K), *VB = (bf16*)(ws + WS_V), *GB = (bf16*)(ws + WS_G), *MIX = (bf16*)(ws + WS_MIX), *HB = (bf16*)(ws + WS_H);
    float* X1 = (float*)(ws + WS_X1);
    float *SLOC = (float*)(ws + WS_SLOC), *DSEG = (float*)(ws + WS_DSEG), *DPART = (float*)(ws + WS_DPART), *DRTOT = (float*)(ws + WS_DRTOT);
    for (int u = tid; u < (LDS_BYTES - MISC_OFF) / 4; u += NWAVES * 64) ((LAS unsigned*)(L + MISC_OFF))[u] = 0u;
    __syncthreads();
    XcdBarrier bar = xcd_barrier_post(ctl + CW_BAR, MISC + 8);
    const int gw = vcu * NWAVES + wave, NGW = G * NWAVES;

#ifdef PROBE_P0A
    for (int rep_ = 0; rep_ < 2; ++rep_) {
#else
    {
#endif
    if (vcu < 96) {
        LAS float* s = (LAS float*)L;
        for (int i = tid; i < NMODR * D; i += NWAVES * 64) { const int r = i >> 10, k = i & 1023; const float c = r < 2 ? c_prompt[r * D + k] : c_sample[(r - 2) * D + k]; s[k * NMODR + r] = c / (1.f + __expf(-c)); }
        __syncthreads();
        const int col = 64 * vcu + lane, k0 = 128 * wave;
        const __amdgpu_buffer_rsrc_t rw = __builtin_amdgcn_make_buffer_rsrc((void*)w_ada, 0, D * MODW * 4, 0x00020000);
        float acc[NMODR];
#pragma unroll
        for (int r = 0; r < NMODR; ++r) acc[r] = 0.f;
#pragma unroll 1
        for (int kb = 0; kb < 128; kb += 16) {
            float wv[16];
#pragma unroll
            for (int i = 0; i < 16; ++i) wv[i] = __uint_as_float(__builtin_amdgcn_raw_buffer_load_b32(rw, col * 4, (k0 + kb + i) * MODW * 4, 2));
#pragma unroll
            for (int i = 0; i < 16; ++i) { const int k = k0 + kb + i;
#pragma unroll
                for (int r = 0; r < NMODR; ++r) acc[r] += s[k * NMODR + r] * wv[i];
                if ((i & 1) == 1) { asm volatile("" ::: "memory"); __builtin_amdgcn_sched_barrier(0); } }
        }
        __syncthreads();
        LAS float* red = (LAS float*)L;
#pragma unroll
        for (int r = 0; r < NMODR; ++r) red[(wave * NMODR + r) * 64 + lane] = acc[r];
        __syncthreads();
        for (int o = tid; o < NMODR * 64; o += NWAVES * 64) { const int r = o >> 6, l = o & 63; float t = b_ada[64 * vcu + l];
#pragma unroll
            for (int w8 = 0; w8 < 8; ++w8) t += red[(w8 * NMODR + r) * 64 + l];
            MOD[r * MODW + 64 * vcu + l] = t; }
        __syncthreads();
    }
    {
        LAS float* scr = (LAS float*)(L + wave * 16384);
        constexpr int I_IN = (D / 64) * (NIN / 32), I_O = (D / 64) * (D / 32), I_UP = (D / 64) * (FF / 32), I_DN = (FF / 64) * (D / 32);
        constexpr int NITEMS = I_IN + I_O + I_UP + I_DN;
        const bool split = G > 96; const int tw = split ? (vcu - 96) * NWAVES + wave : gw, TNW = split ? (G - 96) * NWAVES : NGW;
        if (!split || vcu >= 96)
        for (int it = tw; it < NITEMS; it += TNW) {
            int r = it;
            if (r < I_IN) { p0_transpose_item(w_in, D, NIN_REAL, NIN, Win_t, scr, r, lane); continue; } r -= I_IN;
            if (r < I_O) { p0_transpose_item(w_out, D, D, D, Wo_t, scr, r, lane); continue; } r -= I_O;
            if (r < I_UP) { p0_transpose_item(w_up, D, FF, FF, Wup_t, scr, r, lane); continue; } r -= I_UP;
            p0_transpose_item(w_down, FF, D, D, Wdn_t, scr, r, lane);
        }
    }
    __syncthreads();
    }
    xcd_barrier(bar);
#ifdef PROBE_P0B
    for (int rep_ = 0; rep_ < 2; ++rep_)
#endif
    for (int m = gw; m < M; m += NGW) { const float* xr = m < MP ? x_prompt + (size_t)m * D : x_sample + (size_t)(m - MP) * D; const float* md = MOD + (size_t)bidx_of_row(m) * MODW;
        norm_mod_row_bf16(lane, xr, g_mix, md + 1024, md, XN + (size_t)m * D); }
    xcd_barrier(bar);
#ifdef PROBE_P1
    for (int rep_ = 0; rep_ < 2; ++rep_)
#endif
    {
        pg8::Gemm g{XN, Win_t, M, NIN, D}; pg8::StaticOrder S; S.init(M, NIN, G, bx);
        pg8::EpiInProj E{QB, KB, VB, GB, out + OK_P, out + OV_P, out + OK_S - (size_t)MP * 512, out + OV_S - (size_t)MP * 512, QSCALE};
        pg8::gemm_phase<pg8::EpiInProj, pg8::StaticOrder, true, true>(L, g, S, E);
    }
    xcd_barrier(bar);
#if defined(PROBE_GLA2) || defined(PROBE_GLA1)
    for (int rep_ = 0; rep_ < 2; ++rep_)
#endif
    for (int u = vcu; u < 256; u += G) gla::pass1_unit(u, (const gla::bf16*)GB, w_gate, b_gate, g_gla_out, SLOC, DSEG, (LAS char*)L);
    xcd_barrier(bar);
    for (int rep = 0; rep < 2; ++rep) {
        const bool do_sb = ((vcu & 1) == rep);
        if (do_sb) {
#ifdef PROBE_SB2
            for (int rep_ = 0; rep_ < 2; ++rep_)
#endif
            for (int v = vcu; v < 256; v += G) {
                const int bh = v >> 4, s = v & 15, b = bh >> 3, h = bh & 7; const float bias2 = b_sb[h] * 1.4426950408889634f;
                sb8::attn_unit(b, h, 31 - s, (const sba::bf16*)QB, (const sba::bf16*)KB, (const sba::bf16*)VB, (sba::bf16*)MIX, (char*)lds, bias2);
                sb8::attn_unit(b, h, s, (const sba::bf16*)QB, (const sba::bf16*)KB, (const sba::bf16*)VB, (sba::bf16*)MIX, (char*)lds, bias2);
            }
        } else {
#ifdef PROBE_DEC2
            for (int rep_ = 0; rep_ < 2; ++rep_)
#endif
            for (int u = vcu; u < 256; u += G)
                sbd::decode_wave(u >> 3, u & 7, wave, cache_k, cache_v, args.page_table, (const sba::bf16*)QB, (const sba::bf16*)KB, (const sba::bf16*)VB, b_sb, DPART, DRTOT, ctl + CW_DEC, (sba::bf16*)MIX, (LAS char*)L + wave * 9216);
            asm volatile("s_waitcnt vmcnt(0)" ::: "memory"); __syncthreads();
        }
    }
#if defined(PROBE_GLA2)
    for (int rep_ = 0; rep_ < 2; ++rep_)
#endif
    for (int u = vcu; u < 256; u += G) gla::pass3_unit(u, (const gla::bf16*)GB, (gla::bf16*)MIX, w_gate, b_gate, g_gla_out, SLOC, DSEG, out + OSG_P, (LAS char*)L);
    for (int u = vcu; u < 128; u += G) gla::sample_unit(u, (const gla::bf16*)GB, (gla::bf16*)MIX, w_gate, b_gate, g_gla_out, state_gla, out + OSG_S, (LAS char*)L);
    xcd_barrier(bar);
#ifdef PROBE_P3
    for (int rep_ = 0; rep_ < 2; ++rep_)
#endif
    {
        pg8::Gemm g{MIX, Wo_t, MP, D, D}; pg8::StaticOrder S; S.init(MP, D, G, bx);
        pg8::EpiResGate E{x_prompt, x_sample - (size_t)MP * D, X1, MOD + 2048};
        pg8::gemm_phase<pg8::EpiResGate, pg8::StaticOrder, true, true>(L, g, S, E);
        thin::EpiResGateS Es{x_sample, X1 + (size_t)MP * D, MOD + 2048, D};
        for (int t0 = vcu; t0 < 256; t0 += G) thin::run<8>(MIX + (size_t)MP * D, D, Wo_t, D, D, 32, t0, 256, (LAS float*)L, Es);
    }
    xcd_barrier(bar);
#ifdef PROBE_BAR10
    for (int rep_ = 0; rep_ < 10; ++rep_) xcd_barrier(bar);
#endif
#ifdef PROBE_P3B
    for (int rep_ = 0; rep_ < 2; ++rep_)
#endif
    for (int m = gw; m < M; m += NGW) { const float* md = MOD + (size_t)bidx_of_row(m) * MODW; norm_mod_row_bf16(lane, X1 + (size_t)m * D, g_ffn, md + 4096, md + 3072, XN + (size_t)m * D); }
    xcd_barrier(bar);
#ifdef PROBE_P4
    for (int rep_ = 0; rep_ < 2; ++rep_)
#endif
    {
        pg8::Gemm g{XN, Wup_t, MP, FF, D}; pg8::StaticOrder S; S.init(MP, FF, G, bx);
        pg8::EpiRelu2 E{HB, FF};
        pg8::gemm_phase<pg8::EpiRelu2, pg8::StaticOrder, true, true>(L, g, S, E);
        thin::EpiRelu2S Es{HB + (size_t)MP * FF, FF};
        for (int t0 = 4 * vcu; t0 < 1024; t0 += 4 * G) thin::run<2>(XN + (size_t)MP * D, D, Wup_t, D, D, 128, t0, 1024, (LAS float*)L, Es);
    }
    xcd_barrier(bar);
#ifdef PROBE_P5
    for (int rep_ = 0; rep_ < 2; ++rep_)
#endif
    {
        pg8::Gemm g{HB, Wdn_t, MP, D, FF}; pg8::StaticOrder S; S.init(MP, D, G, bx);
        pg8::EpiResGate E{X1, X1, out + OY, MOD + 5120};
        pg8::gemm_phase<pg8::EpiResGate, pg8::StaticOrder, true, true>(L, g, S, E);
        thin::EpiResGateS Es{X1 + (size_t)MP * D, out + OY + (size_t)MP * D, MOD + 5120, D};
        for (int t0 = vcu; t0 < 256; t0 += G) thin::run<8>(HB + (size_t)MP * FF, FF, Wdn_t, FF, FF, 32, t0, 256, (LAS float*)L, Es);
    }
    xcd_barrier(bar);
    for (int m = gw; m < M; m += NGW) norm_row_f32_inplace(lane, out + OY + (size_t)m * D, g_final);
}

extern "C" void kernel_launch(void* const* d_in, const int* in_sizes, int n_in, void* d_out, int out_size, void* d_ws, size_t ws_size, hipStream_t stream) {
    static int grid = 0;
    if (grid == 0) {
        if (n_in != 21 || (size_t)out_size != OUT_TOTAL || ws_size < WS_END) { fprintf(stderr, "kernel_launch: unexpected sizes: n_in %d out %d ws %zu\n", n_in, out_size, ws_size); grid = -1; return; }
        int dev = 0, cus = 0, per_cu = 0;
        if (hipGetDevice(&dev) != hipSuccess || hipDeviceGetAttribute(&cus, hipDeviceAttributeMultiprocessorCount, dev) != hipSuccess) { grid = -1; return; }
        if (hipFuncSetAttribute((const void*)mk_fwd, hipFuncAttributeMaxDynamicSharedMemorySize, LDS_BYTES) != hipSuccess) { fprintf(stderr, "kernel_launch: hipFuncSetAttribute failed\n"); grid = -1; return; }
        if (hipOccupancyMaxActiveBlocksPerMultiprocessor(&per_cu, (const void*)mk_fwd, NWAVES * 64, LDS_BYTES) != hipSuccess || per_cu < 1) { fprintf(stderr, "kernel_launch: occupancy query says %d\n", per_cu); }
        (void)hipGetLastError();
        grid = cus;
    }
    if (grid < 0) return;
    if (hipMemsetAsync((char*)d_ws + WS_CTL, 0, CTL_ZERO_BYTES, stream) != hipSuccess) return;
    Args a{};
    for (int i = 0; i < 21; ++i) a.in[i] = (const float*)d_in[i];
    a.page_table = (const int*)d_in[7]; a.out = (float*)d_out; a.ws = (unsigned char*)d_ws;
    hipLaunchKernelGGL(mk_fwd, dim3(grid), dim3(NWAVES * 64), LDS_BYTES, stream, a);
    const hipError_t le = hipPeekAtLastError();
    if (le != hipSuccess) fprintf(stderr, "kernel_launch: launch failed: %s\n", hipGetErrorName(le));
}
```

```cpp
#include <hip/hip_runtime.h>
#include <hip/hip_bf16.h>
#include <cstdio>
#include <cstdint>
namespace pg8 {
#define PG8_LAS __attribute__((address_space(3)))
typedef unsigned short bf16_t;
typedef short bf16x8 __attribute__((ext_vector_type(8)));
typedef float f32x4 __attribute__((ext_vector_type(4)));
typedef unsigned u32x4 __attribute__((ext_vector_type(4)));
constexpr int BM = 256, BK = 64, HALF = 128, HTB = HALF * BK * 2  , STAGE_BYTES = 8 * HTB, NXCD = 8, WGM = 8;

__host__ __device__ __forceinline__ int lds_byte(int r, int c) { const int st = (r >> 4) * 2 + (c >> 5), rr = r & 15, cc = c & 31, ob = rr * 64 + cc * 2; return st * 1024 + (ob ^ (((ob >> 9) & 1) << 5)); }
__host__ __device__ __forceinline__ void stage_rc(int b, int& R, int& C) { const int st = b / 1024, sb = b % 1024, swz = sb ^ (((sb >> 9) & 1) << 5); R = (st >> 1) * 16 + swz / 64; C = (st & 1) * 32 + (swz % 64) / 2; }
__host__ __device__ __forceinline__ int perm32(int rho) { const int n = rho >> 4, i = rho & 15; return 8 * (i >> 2) + 4 * n + (i & 3); }

struct Unit { int pm, pn; };
struct Gemm { const bf16_t* A; const bf16_t* Bt; int M, N, K; };

struct StaticOrder {
    int nM, nN, nwg, G, c;
    __host__ __device__ void init(int M, int N, int G_, int c_) { nM = M / BM; nN = N / BM; nwg = nM * nN; G = G_; c = c_; }
    __host__ __device__ bool next(int i, Unit& u) const {
        const long L = (long)i * G + c; if (L >= nwg) return false;
        int wgid = (int)L; { const int q = nwg / NXCD, r = nwg % NXCD, xcd = wgid % NXCD, off = wgid / NXCD; wgid = (xcd < r ? xcd * (q + 1) : r * (q + 1) + (xcd - r) * q) + off; }
        const int nig = WGM * nN, gid = wgid / nig, fm = gid * WGM, gsz = (nM - fm) < WGM ? (nM - fm) : WGM;
        u.pm = fm + ((wgid % nig) % gsz); u.pn = (wgid % nig) / gsz; return true;
    }
    __device__ __forceinline__ void a_ready(const Unit&) const {}
    __device__ __forceinline__ void done(const Unit&) const {}
};

__device__ __forceinline__ unsigned cvt_pk_bf16(float lo, float hi) { unsigned r; asm volatile("v_cvt_pk_bf16_f32 %0, %1, %2" : "=v"(r) : "v"(lo), "v"(hi)); return r; }

struct EpiInProj {
    static constexpr bool PERM = true, AFTER_DRAIN = false;
    bf16_t *Q, *K, *V, *G; float *kP, *vP, *kS, *vS; float qscale;
    __device__ __forceinline__ void operator()(const f32x4 (&acc)[2][2][4][2], const Unit& u, int wr, int wc, int fr, int fq) const {
        const int pn = u.pn, pm = u.pm;
        bf16_t* dst; int ldc, colbase; float sc = 1.f; float* fo = nullptr;
        if (pn < 2)      { dst = Q; ldc = 512; colbase = pn * 256; sc = qscale; }
        else if (pn < 4) { dst = K; ldc = 512; colbase = (pn - 2) * 256; fo = pm < 64 ? kP : kS; }
        else if (pn < 6) { dst = V; ldc = 512; colbase = (pn - 4) * 256; fo = pm < 64 ? vP : vS; }
        else             { dst = G; ldc = 1792; colbase = (pn - 6) * 256; }
        const int row0 = pm * BM + wr * 64 + fr, cl = colbase + wc * 32 + 8 * fq;
#pragma unroll
        for (int ai = 0; ai < 2; ++ai)
#pragma unroll
            for (int m = 0; m < 4; ++m) { const size_t row = (size_t)(row0 + ai * HALF + m * 16);
#pragma unroll
                for (int bj = 0; bj < 2; ++bj) { const f32x4 a0 = acc[ai][bj][m][0], a1 = acc[ai][bj][m][1]; const int col = cl + bj * HALF;
                    const f32x4 v0 = a0 * sc, v1 = a1 * sc; u32x4 w; w.x = cvt_pk_bf16(v0[0], v0[1]); w.y = cvt_pk_bf16(v0[2], v0[3]); w.z = cvt_pk_bf16(v1[0], v1[1]); w.w = cvt_pk_bf16(v1[2], v1[3]);
                    *(u32x4*)(dst + row * ldc + col) = w;
                    if (fo) { *(f32x4*)(fo + row * 512 + col) = a0; *(f32x4*)(fo + row * 512 + col + 4) = a1; } } }
    }
};
struct EpiRelu2 {
    static constexpr bool PERM = true, AFTER_DRAIN = false;
    bf16_t* O; int ldc;
    __device__ __forceinline__ void operator()(const f32x4 (&acc)[2][2][4][2], const Unit& u, int wr, int wc, int fr, int fq) const {
        const int row0 = u.pm * BM + wr * 64 + fr, col0 = u.pn * BM + wc * 32 + 8 * fq;
#pragma unroll
        for (int ai = 0; ai < 2; ++ai)
#pragma unroll
            for (int m = 0; m < 4; ++m) { bf16_t* rowp = O + (size_t)(row0 + ai * HALF + m * 16) * ldc + col0;
#pragma unroll
                for (int bj = 0; bj < 2; ++bj) { f32x4 v0 = acc[ai][bj][m][0], v1 = acc[ai][bj][m][1];
#pragma unroll
                    for (int e = 0; e < 4; ++e) { const float a = fmaxf(v0[e], 0.f), b = fmaxf(v1[e], 0.f); v0[e] = a * a; v1[e] = b * b; }
                    u32x4 w; w.x = cvt_pk_bf16(v0[0], v0[1]); w.y = cvt_pk_bf16(v0[2], v0[3]); w.z = cvt_pk_bf16(v1[0], v1[1]); w.w = cvt_pk_bf16(v1[2], v1[3]);
                    *(u32x4*)(rowp + bj * HALF) = w; } }
    }
};
struct EpiResGate {
    static constexpr bool PERM = false, AFTER_DRAIN = false;
    const float* baseP; const float* baseS; float* out; const float* gate;
    __device__ __forceinline__ void operator()(const f32x4 (&acc)[2][2][4][2], const Unit& u, int wr, int wc, int fr, int fq) const {
        const int col0 = u.pn * BM + wc * 32 + 4 * fq;
#pragma unroll
        for (int ai = 0; ai < 2; ++ai)
#pragma unroll
            for (int m = 0; m < 4; ++m) { const int row = u.pm * BM + ai * HALF + wr * 64 + m * 16 + fr; const int bidx = row < 16384 ? (row >> 13) : 2 + ((row - 16384) >> 3);
                const float* b = (row < 16384 ? baseP : baseS) + (size_t)row * 1024 + col0; const float* g = gate + (size_t)bidx * 6144 + col0; float* o = out + (size_t)row * 1024 + col0;
#pragma unroll
                for (int bj = 0; bj < 2; ++bj)
#pragma unroll
                    for (int n = 0; n < 2; ++n) { const int c = bj * HALF + n * 16; const f32x4 bs = *(const f32x4*)(b + c), gv = *(const f32x4*)(g + c); *(f32x4*)(o + c) = bs + gv * acc[ai][bj][m][n]; } }
    }
};
template <class Epi, class Sched, bool ALIGN_EPI = false, bool SP2 = false>
__device__ __forceinline__ void gemm_phase(PG8_LAS unsigned char* lds, const Gemm g, const Sched& S, const Epi& E) {
    int tid_ = threadIdx.x; asm volatile("" : "+v"(tid_)); const int tid = tid_, wid = __builtin_amdgcn_readfirstlane(tid >> 6), lane = tid & 63, wr = wid >> 2, wc = wid & 3, fr = lane & 15, fq = lane >> 4;
    const int K = g.K, nt = K / BK;
    unsigned voffA[2], voffB[2];
#pragma unroll
    for (int i = 0; i < 2; ++i) { int R, C; stage_rc(tid * 16 + i * 8192, R, C); const int Rb = Epi::PERM ? ((R & ~31) + perm32(R & 31)) : R;
        voffA[i] = (unsigned)(R * K + C) * 2u; voffB[i] = (unsigned)(Rb * K + C) * 2u; }
    const size_t kstep = (size_t)(BK * 2);
    const size_t hstep = (size_t)HALF * K * 2;
    const size_t tstep = 2 * hstep;
    const unsigned ldsw = (unsigned)wid * 1024u;
    const int aoff = lds_byte(wr * 64 + fr, fq * 8), boff = lds_byte(wc * 32 + fr, fq * 8);
#define PG8_SA(b, h) (((b) * 2 + (h)) * HTB)
#define PG8_SB(b, h) ((4 + (b) * 2 + (h)) * HTB)
#define PG8_STAGE(bufoff, gbase, voff) do { _Pragma("unroll") for (int _i = 0; _i < 2; ++_i) \
        __builtin_amdgcn_global_load_lds((const unsigned*)((const char*)(gbase) + (voff)[_i]), (PG8_LAS unsigned*)(lds + (bufoff) + ldsw + _i * 8192), 16, 0, 0); } while (0)
#define PG8_LDA(dst, b, h) do { _Pragma("unroll") for (int m = 0; m < 4; ++m) _Pragma("unroll") for (int k = 0; k < 2; ++k) dst[m][k] = *(const PG8_LAS bf16x8*)(lds + PG8_SA(b, h) + aoff + m * 2048 + k * 1024); } while (0)
#define PG8_LDB(dst, b, h) do { _Pragma("unroll") for (int n = 0; n < 2; ++n) _Pragma("unroll") for (int k = 0; k < 2; ++k) dst[n][k] = *(const PG8_LAS bf16x8*)(lds + PG8_SB(b, h) + boff + n * 2048 + k * 1024); } while (0)
#define PG8_MMA(ai, bj, At, Bt) do { __builtin_amdgcn_s_setprio(1); _Pragma("unroll") for (int m = 0; m < 4; ++m) _Pragma("unroll") for (int n = 0; n < 2; ++n) _Pragma("unroll") for (int k = 0; k < 2; ++k) \
        acc[ai][bj][m][n] = __builtin_amdgcn_mfma_f32_16x16x32_bf16(Bt[n][k], At[m][k], acc[ai][bj][m][n], 0, 0, 0); __builtin_amdgcn_s_setprio(0); } while (0)
#define PG8_WAIT_V(n) asm volatile("s_waitcnt vmcnt(" #n ")" ::: "memory")
#define PG8_WAIT_L(n) asm volatile("s_waitcnt lgkmcnt(" #n ")" ::: "memory")
#define PG8_BAR __builtin_amdgcn_s_barrier()
#define PG8_SCHED __builtin_amdgcn_sched_barrier(0)
    Unit cur, nxt; int ui = 0;
    if (!S.next(0, cur)) return;
    f32x4 acc[2][2][4][2];
#pragma unroll
    for (int a = 0; a < 2; ++a)
#pragma unroll
        for (int b = 0; b < 2; ++b)
#pragma unroll
            for (int m = 0; m < 4; ++m)
#pragma unroll
                for (int n = 0; n < 2; ++n) acc[a][b][m][n] = (f32x4){0.f, 0.f, 0.f, 0.f};
    bf16x8 At[4][2], B0[2][2], B1[2][2];
    const char* cA = (const char*)g.A + (size_t)cur.pm * tstep; const char* cB = (const char*)g.Bt + (size_t)cur.pn * tstep;
    S.a_ready(cur);
    if constexpr (SP2) {
        PG8_STAGE(PG8_SB(0, 0), cB, voffB); PG8_STAGE(PG8_SB(0, 1), cB + hstep, voffB); PG8_STAGE(PG8_SA(0, 0), cA, voffA); PG8_STAGE(PG8_SA(0, 1), cA + hstep, voffA);
        if (wr == 1) PG8_BAR;
        PG8_WAIT_V(2); PG8_BAR;
        PG8_STAGE(PG8_SB(1, 0), cB + kstep, voffB); PG8_STAGE(PG8_SA(1, 0), cA + kstep, voffA); PG8_STAGE(PG8_SB(1, 1), cB + hstep + kstep, voffB);
        PG8_WAIT_V(6); PG8_BAR;
    } else {
        PG8_STAGE(PG8_SB(0, 0), cB, voffB); PG8_STAGE(PG8_SA(0, 0), cA, voffA); PG8_STAGE(PG8_SB(0, 1), cB + hstep, voffB); PG8_STAGE(PG8_SA(0, 1), cA + hstep, voffA);
        if (wr == 1) PG8_BAR;
        PG8_WAIT_V(4); PG8_BAR;
        PG8_STAGE(PG8_SB(1, 0), cB + kstep, voffB); PG8_STAGE(PG8_SA(1, 0), cA + kstep, voffA); PG8_STAGE(PG8_SB(1, 1), cB + hstep + kstep, voffB);
        PG8_WAIT_V(6); PG8_BAR;
    }
    for (;;) {
        const bool has_next = S.next(ui + 1, nxt);
        const char* nA = has_next ? (const char*)g.A + (size_t)nxt.pm * tstep : cA; const char* nB = has_next ? (const char*)g.Bt + (size_t)nxt.pn * tstep : cB;
        for (int t = 0; t < nt; t += 2) {
            const bool last = (t == nt - 2);
            const char* a1 = cA + (size_t)(t + 1) * kstep;
            const char* a2 = last ? nA : cA + (size_t)(t + 2) * kstep; const char* b2 = last ? nB : cB + (size_t)(t + 2) * kstep;
            const char* a3 = a2 + kstep; const char* b3 = b2 + kstep;
            if (last && has_next) S.a_ready(nxt);
            if constexpr (SP2) {
            PG8_LDB(B0, 0, 0); PG8_LDB(B1, 0, 1); PG8_SCHED; PG8_LDA(At, 0, 0); PG8_STAGE(PG8_SA(1, 1), a1 + hstep, voffA);
            PG8_WAIT_V(8); PG8_WAIT_L(0); PG8_BAR; PG8_MMA(0, 0, At, B0); PG8_MMA(0, 1, At, B1); PG8_BAR; PG8_SCHED;
            PG8_LDA(At, 0, 1); PG8_STAGE(PG8_SB(0, 0), b2, voffB); PG8_STAGE(PG8_SB(0, 1), b2 + hstep, voffB); PG8_STAGE(PG8_SA(0, 0), a2, voffA);
            PG8_WAIT_V(8); PG8_WAIT_L(0); PG8_BAR; PG8_MMA(1, 0, At, B0); PG8_MMA(1, 1, At, B1); PG8_BAR; PG8_SCHED;
            PG8_LDB(B0, 1, 0); PG8_LDB(B1, 1, 1); PG8_SCHED; PG8_LDA(At, 1, 0); PG8_STAGE(PG8_SA(0, 1), a2 + hstep, voffA);
            PG8_WAIT_V(8); PG8_WAIT_L(0); PG8_BAR; PG8_MMA(0, 0, At, B0); PG8_MMA(0, 1, At, B1); PG8_BAR; PG8_SCHED;
            PG8_LDA(At, 1, 1); PG8_STAGE(PG8_SB(1, 0), b3, voffB); PG8_STAGE(PG8_SB(1, 1), b3 + hstep, voffB); PG8_STAGE(PG8_SA(1, 0), a3, voffA);
            PG8_WAIT_V(8); PG8_WAIT_L(0); PG8_BAR; PG8_MMA(1, 0, At, B0); PG8_MMA(1, 1, At, B1); PG8_BAR; PG8_SCHED;
            } else {
            PG8_LDB(B0, 0, 0); PG8_SCHED; PG8_LDA(At, 0, 0); PG8_STAGE(PG8_SA(1, 1), a1 + hstep, voffA);
            PG8_WAIT_L(8); PG8_BAR; PG8_WAIT_L(0); PG8_MMA(0, 0, At, B0); PG8_BAR; PG8_SCHED;
            PG8_LDB(B1, 0, 1); PG8_STAGE(PG8_SB(0, 0), b2, voffB);
            PG8_BAR; PG8_WAIT_L(0); PG8_MMA(0, 1, At, B1); PG8_BAR;
            PG8_LDA(At, 0, 1); PG8_STAGE(PG8_SA(0, 0), a2, voffA);
            PG8_BAR; PG8_WAIT_L(0); PG8_MMA(1, 0, At, B0); PG8_BAR; PG8_SCHED;
            PG8_STAGE(PG8_SB(0, 1), b2 + hstep, voffB);
            PG8_WAIT_V(6); PG8_BAR; PG8_MMA(1, 1, At, B1); PG8_BAR;
            PG8_LDB(B0, 1, 0); PG8_SCHED; PG8_LDA(At, 1, 0); PG8_STAGE(PG8_SA(0, 1), a2 + hstep, voffA);
            PG8_WAIT_L(8); PG8_BAR; PG8_WAIT_L(0); PG8_MMA(0, 0, At, B0); PG8_BAR; PG8_SCHED;
            PG8_LDB(B1, 1, 1); PG8_STAGE(PG8_SB(1, 0), b3, voffB);
            PG8_BAR; PG8_WAIT_L(0); PG8_MMA(0, 1, At, B1); PG8_BAR;
            PG8_LDA(At, 1, 1); PG8_STAGE(PG8_SA(1, 0), a3, voffA);
            PG8_BAR; PG8_WAIT_L(0); PG8_MMA(1, 0, At, B0); PG8_BAR; PG8_SCHED;
            PG8_STAGE(PG8_SB(1, 1), b3 + hstep, voffB);
            PG8_WAIT_V(6); PG8_BAR; PG8_MMA(1, 1, At, B1); PG8_BAR;
            }
        }
        if constexpr (ALIGN_EPI) { if (wr == 0) PG8_BAR; }
        if constexpr (!Epi::AFTER_DRAIN) { E(acc, cur, wr, wc, fr, fq); S.done(cur); }
        if (!has_next) break;
#pragma unroll
        for (int a = 0; a < 2; ++a)
#pragma unroll
            for (int b = 0; b < 2; ++b)
#pragma unroll
                for (int m = 0; m < 4; ++m)
#pragma unroll
                    for (int n = 0; n < 2; ++n) acc[a][b][m][n] = (f32x4){0.f, 0.f, 0.f, 0.f};
        cur = nxt; cA = nA; cB = nB; ++ui;
        if constexpr (ALIGN_EPI) { if (wr == 1) PG8_BAR; }
    }
    PG8_WAIT_V(0);
    if constexpr (!ALIGN_EPI) { if (wr == 0) PG8_BAR; }
    PG8_BAR;
    if constexpr (Epi::AFTER_DRAIN) { E.fused(acc, cur, wr, wc, fr, fq, lds, wid, lane); S.done(cur); }
#undef PG8_SA
#undef PG8_SB
#undef PG8_STAGE
#undef PG8_LDA
#undef PG8_LDB
#undef PG8_MMA
#undef PG8_WAIT_V
#undef PG8_WAIT_L
#undef PG8_BAR
#undef PG8_SCHED
}
}
constexpr int NWAVES = 8;
constexpr int D = 1024, TP = 8192, MP = 16384, MS = 256, M = MP + MS, FF = 4096, NIN = 3328, NIN_REAL = 3088, NMODR = 34, MODW = 6144;
constexpr float NORM_EPS = 1e-6f;
constexpr float QSCALE = 0.125f * 1.4426950408889634f;
constexpr size_t OY = 0, OK_P = 17039360, OV_P = 25427968, OSG_P = 33816576, OK_S = 33882112, OV_S = 34013184, OSG_S = 34144256, OUT_TOTAL = 35192832;
constexpr size_t MiB = 1u << 20;
constexpr size_t WS_CTL = 0, CTL_ZERO_BYTES = 1 * MiB;
constexpr size_t WS_MOD = 1 * MiB, WS_WIN = 2 * MiB, WS_WO = 9 * MiB, WS_WUP = 11 * MiB, WS_WDN = 19 * MiB;
constexpr size_t WS_SLOC = 27 * MiB, WS_DSEG = 35 * MiB, WS_DPART = 36 * MiB, WS_DRTOT = 40 * MiB;
constexpr size_t WS_XN = 48 * MiB, WS_Q = 82 * MiB, WS_K = 99 * MiB, WS_V = 116 * MiB, WS_G = 133 * MiB, WS_MIX = 190 * MiB, WS_X1 = 224 * MiB, WS_H = 290 * MiB, WS_END = 421 * MiB;
static_assert(WS_WIN + (size_t)NIN * D * 2 <= WS_WO && WS_G + (size_t)M * 1792 * 2 <= WS_MIX && WS_MIX + (size_t)M * D * 2 <= WS_X1 && WS_X1 + (size_t)M * D * 4 <= WS_H && WS_H + (size_t)M * FF * 2 <= WS_END, "d_ws map");
static_assert(WS_XN + (size_t)M * D * 2 <= WS_Q && WS_Q + (size_t)M * 512 * 2 <= WS_K && WS_K + (size_t)M * 512 * 2 <= WS_V && WS_V + (size_t)M * 512 * 2 <= WS_G, "d_ws map 2");
constexpr int CW_BAR = 4096, CW_DEC = 16384;
constexpr int RING_BYTES = 139264, MISC_OFF = 146944, LDS_BYTES = 147456;

#define GAS __attribute__((address_space(1)))
#define LAS __attribute__((address_space(3)))
typedef unsigned short bf16;
typedef unsigned v4u __attribute__((ext_vector_type(4)));
typedef float f32x4 __attribute__((ext_vector_type(4)));
#define LDS_WAIT() asm volatile("s_waitcnt lgkmcnt(0)" ::: "memory")
__device__ __forceinline__ unsigned f2bf(float f) { unsigned u = __builtin_bit_cast(unsigned, f); return (u + 0x7fffu + ((u >> 16) & 1u)) >> 16; }
__device__ __forceinline__ unsigned pk2(float lo, float hi) { return f2bf(lo) | (f2bf(hi) << 16); }
#define XB_TMO      128
#define XB_XCNT(j)  (256  + 64 * (j))
#define XB_XSUB(j)  (1280 + 64 * (j))
#define XB_XGEN(j)  (2304 + 64 * (j))
#define XB_TOP      3328
#define XB_TOPGEN   3392
#define XCD_BAR_WORDS 3456
#define XB_SPIN_CAP (1u << 18)

__device__ __forceinline__ unsigned xb_ld(unsigned* p)              { return __hip_atomic_load(p, __ATOMIC_RELAXED, __HIP_MEMORY_SCOPE_AGENT); }
__device__ __forceinline__ unsigned xb_add(unsigned* p, unsigned v) { return __hip_atomic_fetch_add(p, v, __ATOMIC_RELAXED, __HIP_MEMORY_SCOPE_AGENT); }
__device__ __forceinline__ unsigned xb_xcc_id() { return (unsigned)__builtin_amdgcn_s_getreg((3 << 11) | 20) & 0xFu; }
#define XB_SPIN(cond, bar) do { unsigned _sp = 0; while (cond) { __builtin_amdgcn_s_sleep(1); \
    if ((++_sp & 255u) == 0u) { if (xb_ld(&(bar)[XB_TMO])) break; if (_sp > XB_SPIN_CAP) { atomicAdd(&(bar)[XB_TMO], 1u); break; } } } } while (0)

struct XcdBarrier {
    unsigned* bar; unsigned x;
    volatile LAS unsigned* st;
};

__device__ __forceinline__ XcdBarrier xcd_barrier_post(unsigned* bar, volatile LAS unsigned* st) {
    XcdBarrier b; b.bar = bar; b.x = xb_xcc_id(); b.st = st;
    if (threadIdx.x == 0) (void)xb_add(&bar[XB_XCNT(b.x)], 1u);
    return b;
}
__device__ __forceinline__ void xcd_barrier_complete(unsigned* bar, unsigned x, unsigned& nloc, unsigned& nx) {
    const unsigned G = gridDim.x * gridDim.y * gridDim.z;
    unsigned sum, cnt, mine, sp = 0u;
    for (;;) {
        sum = 0u; cnt = 0u; mine = 0u;
#pragma unroll
        for (unsigned j = 0; j < 16; ++j) { const unsigned c = xb_ld(&bar[XB_XCNT(j)]); sum += c; cnt += (c > 0u) ? 1u : 0u; mine = (j == x) ? c : mine; }
        if (sum == G) break;
        __builtin_amdgcn_s_sleep(1);
        if ((++sp & 255u) == 0u) { if (xb_ld(&bar[XB_TMO])) break; if (sp > XB_SPIN_CAP) { atomicAdd(&bar[XB_TMO], 1u); break; } }
    }
    nloc = mine > 0u ? mine : 1u; nx = cnt > 0u ? cnt : 1u;
}

__device__ __forceinline__ void xcd_barrier(const XcdBarrier& b) {
    asm volatile("s_waitcnt vmcnt(0)" ::: "memory");
    __syncthreads();
    if (threadIdx.x == 0) {
        unsigned* bar = b.bar;
        __builtin_amdgcn_s_waitcnt(0);
        unsigned nloc = b.st[0], nx = b.st[1];
        if (nloc == 0u) { xcd_barrier_complete(bar, b.x, nloc, nx); b.st[0] = nloc; b.st[1] = nx; }
        const unsigned old = xb_add(&bar[XB_XSUB(b.x)], 1u);
        const unsigned gen = old / nloc;
        if (old + 1u == (gen + 1u) * nloc) {
            __builtin_amdgcn_fence(__ATOMIC_RELEASE, "agent");
            asm volatile("s_waitcnt vmcnt(0)" ::: "memory");
            const unsigned og = xb_add(&bar[XB_TOP], 1u);
            const unsigned tg = og / nx;
            if (og + 1u == (tg + 1u) * nx) xb_add(&bar[XB_TOPGEN], 1u);
            else XB_SPIN(xb_ld(&bar[XB_TOPGEN]) == tg, bar);
            __builtin_amdgcn_fence(__ATOMIC_ACQUIRE, "agent");
            xb_add(&bar[XB_XGEN(b.x)], 1u);
            asm volatile("s_waitcnt vmcnt(0)" ::: "memory");
        } else {
            XB_SPIN(xb_ld(&bar[XB_XGEN(b.x)]) == gen, bar);
            __builtin_amdgcn_fence(__ATOMIC_ACQUIRE, "agent");
            asm volatile("s_waitcnt vmcnt(0)" ::: "memory");
        }
    }
    __syncthreads();
}
namespace sba {
using bf16x8=__attribute__((ext_vector_type(8)))short;
using s16x4=__attribute__((ext_vector_type(4)))short;
using f32x16=__attribute__((ext_vector_type(16)))float;
using u32x4=__attribute__((ext_vector_type(4)))unsigned;
typedef __hip_bfloat16 bf16;
constexpr int SEQ=8192,D=64,DM=512,OP=1024;
constexpr int NW=8,QBLK=32,QB=QBLK*NW,KVBLK=64;
constexpr int NSLOT=3,SLOTB=8192;
constexpr int LDS_K=0,LDS_V=NSLOT*SLOTB,LDS_OST=2*NSLOT*SLOTB,LDS_BYTES=LDS_OST+NW*4096;
__device__ __forceinline__ int crow(int r,int hi){return (r&3)+8*(r>>2)+4*hi;}
__device__ __forceinline__ void glds16(const void*gsrc,unsigned lds_dst){unsigned keep;
  asm volatile("s_mov_b32 %0, m0\n\ts_mov_b32 m0, %2\n\ts_nop 0\n\tglobal_load_lds_dwordx4 %1, off\n\ts_mov_b32 m0, %0":"=&s"(keep):"v"(gsrc),"s"(lds_dst):"memory");}
typedef float f32x2_t __attribute__((ext_vector_type(2))); typedef __bf16 bf16x2_t __attribute__((ext_vector_type(2)));
__device__ __forceinline__ unsigned cvtpk_s(float lo,float hi){f32x2_t v={lo,hi};bf16x2_t b=__builtin_convertvector(v,bf16x2_t);return __builtin_bit_cast(unsigned,b);}
typedef __attribute__((address_space(3))) const char* lds_cptr;
typedef short v4i16_t __attribute__((ext_vector_type(4)));
__device__ __forceinline__ s16x4 vtr(lds_cptr p){ return __builtin_bit_cast(s16x4,__builtin_amdgcn_ds_read_tr16_b64_v4i16((__attribute__((address_space(3))) v4i16_t*)p)); }
#define SBA_MFMA(a,b,c) __builtin_amdgcn_mfma_f32_32x32x16_bf16((a),(b),(c),0,0,0)
template<bool MASK> __device__ __forceinline__ void sb_weights(f32x16&c0,f32x16&c1,float&carry,int hi,int jb,int qrel){
  #pragma unroll
  for(int r=0;r<16;++r){
    float e0=__builtin_amdgcn_exp2f(c0[r]), e1=__builtin_amdgcn_exp2f(c1[r]);
    if(MASK){ const int kv=64*jb+crow(r,hi); if(kv>=qrel)e0=0.f; if(kv+32>=qrel)e1=0.f; }
    c0[r]=1.f+e0; c1[r]=1.f+e1; }
  float P2[8],P3[8],T[8];
  #pragma unroll
  for(int c=0;c<4;++c){ P2[c]=c0[4*c]*c0[4*c+1]; P3[c]=P2[c]*c0[4*c+2]; T[c]=__builtin_amdgcn_rcpf(P3[c]*c0[4*c+3]);
                        P2[4+c]=c1[4*c]*c1[4*c+1]; P3[4+c]=P2[4+c]*c1[4*c+2]; T[4+c]=__builtin_amdgcn_rcpf(P3[4+c]*c1[4*c+3]); }
  float Tl[8],Th[8];
  #pragma unroll
  for(int c=0;c<8;++c){ auto rr=__builtin_amdgcn_permlane32_swap(__float_as_uint(T[c]),__float_as_uint(T[c]),false,false); Tl[c]=__uint_as_float(rr[0]); Th[c]=__uint_as_float(rr[1]); }
  float E=carry;
  float off[8];
  #pragma unroll
  for(int c=7;c>=0;--c){ off[c]=hi?E:E*Th[c]; E=E*(Tl[c]*Th[c]); }
  carry=E;
  #pragma unroll
  for(int c=0;c<4;++c){
    { const float g=T[c]*off[c], R1=c0[4*c]*g, R2=P2[c]*g, R3=P3[c]*g; c0[4*c]=R1-g; c0[4*c+1]=R2-R1; c0[4*c+2]=R3-R2; c0[4*c+3]=off[c]-R3; }
    { const float g=T[4+c]*off[4+c], R1=c1[4*c]*g, R2=P2[4+c]*g, R3=P3[4+c]*g; c1[4*c]=R1-g; c1[4*c+1]=R2-R1; c1[4*c+2]=R3-R2; c1[4*c+3]=off[4+c]-R3; } }
}
__device__ __forceinline__ void pv(f32x16*o,lds_cptr vp,const f32x16&w0,const f32x16&w1){
  u32x4 pw[4];
  #pragma unroll
  for(int k=0;k<2;++k)
    #pragma unroll
    for(int j=0;j<4;++j){ pw[k][j]=cvtpk_s(w0[8*k+2*j],w0[8*k+2*j+1]); pw[2+k][j]=cvtpk_s(w1[8*k+2*j],w1[8*k+2*j+1]); }
  #pragma unroll
  for(int d0=0;d0<2;++d0)
    #pragma unroll
    for(int ks=0;ks<4;++ks){ const s16x4 lo=vtr(vp+d0*4096+ks*1024), hh=vtr(vp+d0*4096+ks*1024+512);
      const bf16x8 vf={lo[0],lo[1],lo[2],lo[3],hh[0],hh[1],hh[2],hh[3]};
      o[d0]=SBA_MFMA(__builtin_bit_cast(bf16x8,pw[ks]),vf,o[d0]); }
}
__device__ __forceinline__ void attn_unit(int b,int h,int qb,const bf16*Q,const bf16*__restrict__ K,const bf16*__restrict__ V,bf16*O,char*shm,float bias2){
  int tid_=threadIdx.x; asm volatile("":"+v"(tid_)); const int tid=tid_,lane=tid&63,r32=lane&31,hi=lane>>5; const int wid=__builtin_amdgcn_readfirstlane(tid>>6);
  const long rowbase=(long)b*SEQ; const int q0=qb*QB;
  const bf16*Qw=Q+(rowbase+q0+wid*QBLK)*DM+h*D;
  const bf16*Kh=K+rowbase*DM+h*D,*Vh=V+rowbase*DM+h*D;
  const unsigned lds0=(unsigned)(uintptr_t)shm;
  const bf16*ksrc=Kh+(long)lane*DM+wid*8;
  const bf16*vsrc=Vh+(long)(16*(wid&3)+(lane>>2))*DM+(wid>>2)*32+(lane&3)*8;
  const unsigned kdst=lds0+LDS_K+wid*1024, vdst=lds0+LDS_V+wid*1024;
  const int NT=(q0+QB)/KVBLK;
  #define DMA_KV(s_,slot_) do{ const long t_=(long)(NT-1-(s_))*KVBLK*DM; glds16(ksrc+t_,(unsigned)__builtin_amdgcn_readfirstlane(kdst+(slot_)*SLOTB)); glds16(vsrc+t_,(unsigned)__builtin_amdgcn_readfirstlane(vdst+(slot_)*SLOTB)); }while(0)
  bf16x8 qr[4];
  #pragma unroll
  for(int d0=0;d0<4;++d0)qr[d0]=*reinterpret_cast<const bf16x8*>(&Qw[(long)r32*DM+d0*16+hi*8]);
  DMA_KV(0,0); DMA_KV(1,1);
  const lds_cptr shm3=(lds_cptr)shm; const lds_cptr kp0=shm3+LDS_K+hi*1024+r32*16; const lds_cptr vp0=shm3+LDS_V+((lane>>4)&1)*32+(lane&3)*8+(4*hi+((lane&15)>>2))*64;
  f32x16 o[2];o[0]=f32x16{};o[1]=f32x16{}; f32x16 bv;
  #pragma unroll
  for(int r=0;r<16;++r)bv[r]=bias2;
  asm volatile("":"+v"(bv));
  float carry=1.f; const int qrel=wid*QBLK+r32;
  int slot=0;
  for(int s=0;s<NT;++s){
    if(s+1<NT) asm volatile("s_waitcnt vmcnt(2) lgkmcnt(0)\n\ts_barrier":::"memory"); else asm volatile("s_waitcnt vmcnt(0) lgkmcnt(0)\n\ts_barrier":::"memory");
    if(s+2<NT){ const int ns=(slot==0)?2:slot-1; DMA_KV(s+2,ns); }
    const lds_cptr kp=kp0+slot*SLOTB;
    f32x16 c0=bv,c1=bv;
    #pragma unroll
    for(int d0=0;d0<4;++d0){
      const bf16x8 k0=*(const __attribute__((address_space(3))) bf16x8*)(kp+d0*2048), k1=*(const __attribute__((address_space(3))) bf16x8*)(kp+d0*2048+512);
      c0=SBA_MFMA(k0,qr[d0],c0); c1=SBA_MFMA(k1,qr[d0],c1); }
    if(s<4) sb_weights<true>(c0,c1,carry,hi,3-s,qrel); else sb_weights<false>(c0,c1,carry,hi,0,0);
    pv(o,vp0+slot*SLOTB,c0,c1);
    slot=(slot==2)?0:slot+1;
  }
  #undef DMA_KV
  bf16*Ow=O+(rowbase+q0+wid*QBLK)*OP+h*D;
  { bf16*stg=(bf16*)(shm+LDS_OST)+wid*2048;
    #pragma unroll
    for(int r=0;r<16;++r){const int orow=crow(r,hi);
      #pragma unroll
      for(int d0=0;d0<2;++d0)stg[orow*64+d0*32+r32]=__float2bfloat16(o[d0][r]);}
    asm volatile("s_waitcnt lgkmcnt(0)":::"memory");
    #pragma unroll
    for(int i=0;i<4;++i){const int row=i*8+(lane>>3),ch=lane&7; const u32x4 v=*(const u32x4*)(stg+row*64+ch*8); *(u32x4*)(Ow+(long)row*OP+ch*8)=v;} }
  asm volatile("s_waitcnt vmcnt(0) lgkmcnt(0)\n\ts_barrier":::"memory");
}
}
namespace sb8 {
typedef sba::bf16 bf16; using sba::bf16x8; using sba::s16x4; using sba::f32x16; using sba::u32x4; using sba::lds_cptr; using sba::glds16; using sba::vtr;
constexpr int SEQ=sba::SEQ,D=sba::D,DM=sba::DM,OP=sba::OP,QBLK=sba::QBLK,QB=sba::QB,KVBLK=sba::KVBLK,NSLOT=sba::NSLOT,SLOTB=sba::SLOTB;
constexpr int LDS_K=sba::LDS_K,LDS_V=sba::LDS_V,LDS_OST=sba::LDS_OST;
__device__ __forceinline__ unsigned cvtpk_a(float lo,float hi){ unsigned r; asm("v_cvt_pk_bf16_f32 %0, %1, %2":"=v"(r):"v"(lo),"v"(hi)); return r; }
template<bool MASK> __device__ __forceinline__ void weights(f32x16&c0,f32x16&c1,float&carry,int hi,int thr){
  #pragma unroll
  for(int r=0;r<16;++r){ float e0=__builtin_amdgcn_exp2f(c0[r]), e1=__builtin_amdgcn_exp2f(c1[r]);
    if(MASK){ if(r>=thr)e0=0.f; if(32+r>=thr)e1=0.f; }
    c0[r]=e0; c1[r]=e1; }
  float q0=1.f+c0[0], q1=1.f+c1[0];
  #pragma unroll
  for(int r=1;r<16;++r){ const float e0=c0[r], e1=c1[r]; c0[r]=q0*e0; c1[r]=q1*e1; q0=__builtin_fmaf(q0,e0,q0); q1=__builtin_fmaf(q1,e1,q1); }
  const float t0=__builtin_amdgcn_rcpf(q0), t1=__builtin_amdgcn_rcpf(q1);
  auto s1=__builtin_amdgcn_permlane32_swap(__float_as_uint(t1),__float_as_uint(t1),false,false);
  auto s0=__builtin_amdgcn_permlane32_swap(__float_as_uint(t0),__float_as_uint(t0),false,false);
  const float t1l=__uint_as_float(s1[0]),t1h=__uint_as_float(s1[1]),t0l=__uint_as_float(s0[0]),t0h=__uint_as_float(s0[1]);
  const float off1=hi?carry:carry*t1h; const float E=carry*(t1l*t1h);
  const float off0=hi?E:E*t0h; carry=E*(t0l*t0h);
  const float g1=t1*off1, g0=t0*off0;
  #pragma unroll
  for(int r=0;r<16;++r){ c0[r]*=g0; c1[r]*=g1; }
}
__device__ __forceinline__ void pv_load(bf16x8*vf,lds_cptr vp){
  #pragma unroll
  for(int d0=0;d0<2;++d0)
    #pragma unroll
    for(int ks=0;ks<4;++ks){ const s16x4 lo=vtr(vp+d0*4096+(ks>>1)*2048+(ks&1)*512), hh=vtr(vp+d0*4096+(ks>>1)*2048+(ks&1)*512+256);
      vf[d0*4+ks]=(bf16x8){lo[0],lo[1],lo[2],lo[3],hh[0],hh[1],hh[2],hh[3]}; }
}
__device__ __forceinline__ void pv_mma(f32x16*o,const bf16x8*vf,const f32x16&w0,const f32x16&w1){
  u32x4 pw[4];
  #pragma unroll
  for(int k=0;k<2;++k)
    #pragma unroll
    for(int j=0;j<4;++j){ pw[k][j]=cvtpk_a(w0[8*k+2*j],w0[8*k+2*j+1]); pw[2+k][j]=cvtpk_a(w1[8*k+2*j],w1[8*k+2*j+1]); }
  #pragma unroll
  for(int ks=0;ks<4;++ks){ o[0]=SBA_MFMA(__builtin_bit_cast(bf16x8,pw[ks]),vf[ks],o[0]); o[1]=SBA_MFMA(__builtin_bit_cast(bf16x8,pw[ks]),vf[4+ks],o[1]); }
}
__device__ __forceinline__ void qk(f32x16&c0,f32x16&c1,lds_cptr kp,const bf16x8*qr,const f32x16&bv){
  bf16x8 kf[8];
  #pragma unroll
  for(int d0=0;d0<4;++d0){ kf[2*d0]=*(const __attribute__((address_space(3))) bf16x8*)(kp+d0*2048); kf[2*d0+1]=*(const __attribute__((address_space(3))) bf16x8*)(kp+d0*2048+512); }
  c0=SBA_MFMA(kf[0],qr[0],bv); c1=SBA_MFMA(kf[1],qr[0],bv);
  #pragma unroll
  for(int d0=1;d0<4;++d0){ c0=SBA_MFMA(kf[2*d0],qr[d0],c0); c1=SBA_MFMA(kf[2*d0+1],qr[d0],c1); }
}
__device__ __forceinline__ void attn_unit(int b,int h,int qb,const bf16*Q,const bf16*__restrict__ K,const bf16*__restrict__ V,bf16*O,char*shm,float bias2){
  int tid_=threadIdx.x; asm volatile("":"+v"(tid_)); const int tid=tid_,lane=tid&63,r32=lane&31,hi=lane>>5; const int wid=__builtin_amdgcn_readfirstlane(tid>>6);
  const long rowbase=(long)b*SEQ; const int q0=qb*QB;
  const bf16*Qw=Q+(rowbase+q0+wid*QBLK)*DM+h*D;
  const bf16*Kh=K+rowbase*DM+h*D,*Vh=V+rowbase*DM+h*D;
  const unsigned lds0=(unsigned)(uintptr_t)shm;
  const bf16*ksrc=Kh+(long)lane*DM+wid*8;
  const bf16*vsrc=Vh+(long)(16*(wid&3)+(lane>>2))*DM+(wid>>2)*32+(lane&3)*8;
  const unsigned kdst=lds0+LDS_K+wid*1024, vdst=lds0+LDS_V+wid*1024;
  const int NT=(q0+QB)/KVBLK;
  #define DMA8_K(s_,slot_) do{ const long t_=(long)(NT-1-(s_))*KVBLK*DM; glds16(ksrc+t_,(unsigned)__builtin_amdgcn_readfirstlane(kdst+(slot_)*SLOTB)); }while(0)
  #define DMA8_V(s_,slot_) do{ const long t_=(long)(NT-1-(s_))*KVBLK*DM; glds16(vsrc+t_,(unsigned)__builtin_amdgcn_readfirstlane(vdst+(slot_)*SLOTB)); }while(0)
  bf16x8 qr[4];
  #pragma unroll
  for(int d0=0;d0<4;++d0)qr[d0]=*reinterpret_cast<const bf16x8*>(&Qw[(long)r32*DM+d0*16+hi*8]);
  DMA8_K(0,0);
  DMA8_K(1,1); DMA8_V(0,0);
  DMA8_K(2,2); DMA8_V(1,1);
  const int kperm=16*((r32>>2)&1)+(r32&3)+4*(r32>>3);
  const lds_cptr shm3=(lds_cptr)shm; const lds_cptr kp0=shm3+LDS_K+hi*1024+kperm*16; const lds_cptr vp0=shm3+LDS_V+((lane>>4)&1)*32+(lane&3)*8+(16*hi+((lane&15)>>2))*64;
  f32x16 o[2];o[0]=f32x16{};o[1]=f32x16{}; f32x16 bv;
  #pragma unroll
  for(int r=0;r<16;++r)bv[r]=bias2;
  asm volatile("":"+v"(bv));
  float carry=1.f; const int qrel=wid*QBLK+r32;
  f32x16 a0,a1,b0,b1;
  asm volatile("s_waitcnt vmcnt(4) lgkmcnt(0)\n\ts_barrier":::"memory");
  qk(a0,a1,kp0,qr,bv);
  int ks1=1,vs0=0;
  #define STEP8(C0,C1,N0,N1,st_) do{ const int st=(st_); \
    if(st+2<NT) asm volatile("s_waitcnt vmcnt(2) lgkmcnt(0)\n\ts_barrier":::"memory"); else if(st+2==NT) asm volatile("s_waitcnt vmcnt(1) lgkmcnt(0)\n\ts_barrier":::"memory"); else asm volatile("s_waitcnt vmcnt(0) lgkmcnt(0)\n\ts_barrier":::"memory"); \
    { const int kfree=(ks1==0)?2:ks1-1; const int vfree=(vs0==0)?2:vs0-1; if(st+3<NT) DMA8_K(st+3,kfree); if(st+2<NT) DMA8_V(st+2,vfree); } \
    bf16x8 vf[8]; pv_load(vf,vp0+vs0*SLOTB); \
    if(st+1<NT) qk(N0,N1,kp0+ks1*SLOTB,qr,bv); \
    __builtin_amdgcn_sched_barrier(0); \
    if(st<4) weights<true>(C0,C1,carry,hi,qrel-64*(3-st)-16*hi); else weights<false>(C0,C1,carry,hi,0); \
    pv_mma(o,vf,C0,C1); \
    ks1=(ks1==2)?0:ks1+1; vs0=(vs0==2)?0:vs0+1; }while(0)
  for(int it=0;it<NT;it+=2){ STEP8(a0,a1,b0,b1,it); STEP8(b0,b1,a0,a1,it+1); }
  #undef STEP8
  #undef DMA8_K
  #undef DMA8_V
  bf16*Ow=O+(rowbase+q0+wid*QBLK)*OP+h*D;
  { bf16*stg=(bf16*)(shm+LDS_OST)+wid*2048;
    #pragma unroll
    for(int r=0;r<16;++r){const int orow=sba::crow(r,hi);
      #pragma unroll
      for(int d0=0;d0<2;++d0)stg[orow*64+d0*32+r32]=__float2bfloat16(o[d0][r]);}
    asm volatile("s_waitcnt lgkmcnt(0)":::"memory");
    #pragma unroll
    for(int i=0;i<4;++i){const int row=i*8+(lane>>3),ch=lane&7; const u32x4 v=*(const u32x4*)(stg+row*64+ch*8); *(u32x4*)(Ow+(long)row*OP+ch*8)=v;} }
  asm volatile("s_waitcnt vmcnt(0) lgkmcnt(0)\n\ts_barrier":::"memory");
}
}
namespace sbd {
using sba::bf16x8; using sba::f32x16; using sba::u32x4; using sba::bf16; using sba::crow; using sba::cvtpk_s;
typedef float f32x4 __attribute__((ext_vector_type(4)));
#define RLXA __ATOMIC_RELAXED, __HIP_MEMORY_SCOPE_AGENT
template<bool NEWK> __device__ __forceinline__ void weights32(f32x16&c,float&carry,int hi,int q){
  #pragma unroll
  for(int r=0;r<16;++r){ float e=__builtin_amdgcn_exp2f(c[r]);
    if(NEWK){ const int kv=crow(r,hi); if(kv>=8||kv>=q)e=0.f; }
    c[r]=1.f+e; }
  float P2[4],P3[4],T[4],Tl[4],Th[4],off[4];
  #pragma unroll
  for(int k=0;k<4;++k){ P2[k]=c[4*k]*c[4*k+1]; P3[k]=P2[k]*c[4*k+2]; T[k]=__builtin_amdgcn_rcpf(P3[k]*c[4*k+3]); }
  #pragma unroll
  for(int k=0;k<4;++k){ auto s=__builtin_amdgcn_permlane32_swap(__float_as_uint(T[k]),__float_as_uint(T[k]),false,false); Tl[k]=__uint_as_float(s[0]); Th[k]=__uint_as_float(s[1]); }
  float E=carry;
  #pragma unroll
  for(int k=3;k>=0;--k){ off[k]=hi?E:E*Th[k]; E=E*(Tl[k]*Th[k]); }
  carry=E;
  #pragma unroll
  for(int k=0;k<4;++k){ const float g=T[k]*off[k], R1=c[4*k]*g, R2=P2[k]*g, R3=P3[k]*g; c[4*k]=R1-g; c[4*k+1]=R2-R1; c[4*k+2]=R3-R2; c[4*k+3]=off[k]-R3; }
}
struct Raw { f32x4 k[8]; f32x4 v[8]; };
typedef unsigned u32x2v __attribute__((ext_vector_type(2)));
__device__ __forceinline__ void load_tile(Raw&R,__amdgpu_buffer_rsrc_t rk,__amdgpu_buffer_rsrc_t rv,unsigned ub,int kvo){
  #pragma unroll
  for(int i=0;i<8;++i) R.k[i]=__builtin_bit_cast(f32x4,__builtin_amdgcn_raw_buffer_load_b128(rk,kvo,(int)(ub+(unsigned)i*8192u),2));
  #pragma unroll
  for(int i=0;i<8;++i) R.v[i]=__builtin_bit_cast(f32x4,__builtin_amdgcn_raw_buffer_load_b128(rv,kvo,(int)(ub+(unsigned)i*8192u),2));
}
struct Frag { bf16x8 k[4]; bf16x8 v[4]; };
__device__ __forceinline__ void cvt_tile(Frag&F,const Raw&R,__attribute__((address_space(3))) char*kl,int kwo,int kro,int vwo,int vro){
  #pragma unroll
  for(int i=0;i<8;++i){ u32x2v p; p[0]=cvtpk_s(R.k[i][0],R.k[i][1]); p[1]=cvtpk_s(R.k[i][2],R.k[i][3]); *(__attribute__((address_space(3))) u32x2v*)(kl+kwo+i*576)=p;
                        u32x2v q; q[0]=cvtpk_s(R.v[i][0],R.v[i][1]); q[1]=cvtpk_s(R.v[i][2],R.v[i][3]); *(__attribute__((address_space(3))) u32x2v*)(kl+4608+vwo+i*256)=q; }
  #pragma unroll
  for(int d0=0;d0<4;++d0) F.k[d0]=*(const __attribute__((address_space(3))) bf16x8*)(kl+kro+32*d0);
  #pragma unroll
  for(int d0=0;d0<2;++d0)
    #pragma unroll
    for(int ks=0;ks<2;++ks){ const sba::s16x4 lo=sba::vtr((sba::lds_cptr)(kl+4608+vro+d0*2048+ks*1024)), hh=sba::vtr((sba::lds_cptr)(kl+4608+vro+d0*2048+ks*1024+512));
      F.v[d0*2+ks]=(bf16x8){lo[0],lo[1],lo[2],lo[3],hh[0],hh[1],hh[2],hh[3]}; }
}
template<bool NEWK> __device__ __forceinline__ void tile_step(const Frag&F,const __attribute__((address_space(3))) char*ql,const float bias2,f32x16*o,float&carry,int hi,int q){
  f32x16 c;
  #pragma unroll
  for(int r=0;r<16;++r)c[r]=bias2;
  unsigned qo=(unsigned)(uintptr_t)ql; asm volatile("":"+v"(qo));
  #pragma unroll
  for(int d0=0;d0<4;++d0){ const bf16x8 qf=*(const __attribute__((address_space(3))) bf16x8*)(uintptr_t)(qo+d0*1024); c=SBA_MFMA(F.k[d0],qf,c); }
  weights32<NEWK>(c,carry,hi,q);
  u32x4 pw[2];
  #pragma unroll
  for(int k=0;k<2;++k)
    #pragma unroll
    for(int j=0;j<4;++j) pw[k][j]=cvtpk_s(c[8*k+2*j],c[8*k+2*j+1]);
  #pragma unroll
  for(int d0=0;d0<2;++d0)
    #pragma unroll
    for(int ks=0;ks<2;++ks) o[d0]=SBA_MFMA(__builtin_bit_cast(bf16x8,pw[ks]),F.v[d0*2+ks],o[d0]);
}
__device__ __forceinline__ void decode_wave(int smp,int j,int h,const float*cache_k,const float*cache_v,const int*page_table,const bf16*Q,const bf16*Kn,const bf16*Vn,const float*b_sb,
                                            float*part,float*rtot,unsigned*cnt,bf16*MIX,__attribute__((address_space(3))) char*kl){
  int tid_=threadIdx.x; asm volatile("":"+v"(tid_)); const int lane=tid_&63,r32=lane&31,hi=lane>>5;
  const float bias2=b_sb[h]*1.4426950408889634f;
  const long srow=16384+8*smp;
  const __attribute__((address_space(3))) char*ql=kl+8704+lane*16;
  #pragma unroll
  for(int d0=0;d0<4;++d0){ bf16x8 z={0,0,0,0,0,0,0,0}; if(r32<8) z=*reinterpret_cast<const bf16x8*>(Q+(srow+r32)*512+h*64+d0*16+hi*8); *(__attribute__((address_space(3))) bf16x8*)(kl+8704+lane*16+d0*1024)=z; }
  f32x16 o[2]; o[0]=f32x16{}; o[1]=f32x16{}; float carry=1.f;
  if(j==7){
    Frag F;
    #pragma unroll
    for(int d0=0;d0<4;++d0){ bf16x8 z={0,0,0,0,0,0,0,0}; if(r32<8) z=*reinterpret_cast<const bf16x8*>(Kn+(srow+r32)*512+h*64+d0*16+hi*8); F.k[d0]=z; }
    #pragma unroll
    for(int d0=0;d0<2;++d0){
      bf16x8 z={0,0,0,0,0,0,0,0};
      #pragma unroll
      for(int jj=0;jj<4;++jj) z[jj]=*reinterpret_cast<const short*>(Vn+(srow+4*hi+jj)*512+h*64+32*d0+r32);
      F.v[d0*2]=z; F.v[d0*2+1]=(bf16x8){0,0,0,0,0,0,0,0}; }
    tile_step<true>(F,ql,bias2,o,carry,hi,r32);
  }
  const int*pt=page_table+smp*64+8*j;
  Raw R; Frag F;
  const int kvo=(lane>>4)*2048+(lane&15)*16;
  const int kwo=(lane>>4)*144+(lane&15)*8, kro=r32*144+16*hi;
  const int vwo=((lane&15)>>3)*2048+(lane>>4)*64+(lane&7)*8, vro=((lane>>4)&1)*32+(lane&3)*8+(4*hi+((lane&15)>>2))*64;
  const __amdgpu_buffer_rsrc_t rk=__builtin_amdgcn_make_buffer_rsrc((void*)cache_k,0,671088640,0x00020000), rv=__builtin_amdgcn_make_buffer_rsrc((void*)cache_v,0,671088640,0x00020000);
  #define UOFF(tt) ((unsigned)__builtin_amdgcn_readfirstlane((int)(((((unsigned)pt[(tt)>>2]*128u+(unsigned)(((tt)&3)*32))*8u+(unsigned)h)*64u)*4u)))
  #define LOADT(R_,tt) load_tile(R_,rk,rv,UOFF(tt),kvo)
  Raw R1;
  LOADT(R,31); LOADT(R1,30);
  for(int tt=31;tt>0;tt-=2){
    cvt_tile(F,R,kl,kwo,kro,vwo,vro); if(tt>=2) LOADT(R,tt-2);
    tile_step<false>(F,ql,bias2,o,carry,hi,r32);
    cvt_tile(F,R1,kl,kwo,kro,vwo,vro); if(tt>=3) LOADT(R1,tt-3);
    tile_step<false>(F,ql,bias2,o,carry,hi,r32);
  }
  #undef UOFF
  #undef LOADT
  const int unit=smp*8+j;
  int l2_=threadIdx.x; asm volatile("":"+v"(l2_)); const int lane2=l2_&63, r32b=lane2&31, hib=lane2>>5;
  unsigned*pp=(unsigned*)part+((size_t)unit*8+h)*512;
  #pragma unroll
  for(int r=0;r<4;++r)
    #pragma unroll
    for(int d0=0;d0<2;++d0) __hip_atomic_store(pp+(r+4*hib)*64+32*d0+r32b,__float_as_uint(o[d0][r]),RLXA);
  if(lane2<8) __hip_atomic_store((unsigned*)rtot+((size_t)unit*8+h)*8+lane2,__float_as_uint(carry),RLXA);
  asm volatile("s_waitcnt vmcnt(0)":::"memory");
  unsigned old=0u;
  if(lane2==0) old=__hip_atomic_fetch_add(cnt+64*(smp*8+h),1u,RLXA);
  old=(unsigned)__builtin_amdgcn_readfirstlane((int)old);
  if(old==7u){
    const int q=lane2>>3,dc=(lane2&7)*8; float acc[8];
    #pragma unroll
    for(int i=0;i<8;++i)acc[i]=0.f;
    float f=1.f;
    for(int jj=7;jj>=0;--jj){ const size_t u=(size_t)smp*8+jj; const unsigned*src=(const unsigned*)part+(u*8+h)*512+q*64+dc;
      #pragma unroll
      for(int i=0;i<8;++i) acc[i]+=f*__uint_as_float(__hip_atomic_load(src+i,RLXA));
      f*=__uint_as_float(__hip_atomic_load((const unsigned*)rtot+(u*8+h)*8+q,RLXA)); }
    u32x4 w; w[0]=cvtpk_s(acc[0],acc[1]); w[1]=cvtpk_s(acc[2],acc[3]); w[2]=cvtpk_s(acc[4],acc[5]); w[3]=cvtpk_s(acc[6],acc[7]);
    *(u32x4*)(MIX+(srow+q)*1024+h*64+dc)=w;
  }
}
}
namespace gla {
using sba::bf16; using sba::cvtpk_s;
typedef short bf16x8 __attribute__((ext_vector_type(8)));
typedef short bf16x4 __attribute__((ext_vector_type(4)));
typedef float f32x4 __attribute__((ext_vector_type(4)));
typedef unsigned u32x4 __attribute__((ext_vector_type(4)));
typedef unsigned u32x2 __attribute__((ext_vector_type(2)));
#define GLAS __attribute__((address_space(3)))
constexpr int GP=1792;
constexpr int L_QD=0,L_KI=9216,L_KET=18432,L_VT=27648,L_DEC=46080,L_EXR=46336,L_TOT=46592,L_SSQ=48640,L_END=50688;
#define GMFMA(a,b,c) __builtin_amdgcn_mfma_f32_16x16x32_bf16((a),(b),(c),0,0,0)
__device__ __forceinline__ float bf2f(short s){ return __uint_as_float(((unsigned)(unsigned short)s)<<16); }
__device__ __forceinline__ short f2bf(float f){ return (short)(cvtpk_s(f,0.f)&0xffffu); }
template<int MODE,bool FULL> __device__ __forceinline__ void chunk(const bf16*G,bf16*MIX,long m0,int ntok,int h,GLAS char*L,f32x4(&S)[4],const float(&wg)[16],float bg,float gain,float&dseg){
  int tid_=threadIdx.x; asm volatile("":"+v"(tid_)); const int tid=tid_,lane=tid&63,c=lane,fr=lane&15,fq=lane>>4; const int w=__builtin_amdgcn_readfirstlane(tid>>6); const int g=w;
  const short*Gs=(const short*)G;
  float bl[8]; float run=0.f;
  bf16x8 al0[8],al1[8]; short kraw[8],qraw[8],vraw[16];
  #pragma unroll
  for(int i=0;i<8;++i){ const int t=8*g+i; const bool ok=FULL||t<ntok; const long row=ok?(m0+t):m0; const bf16x8*ap=(const bf16x8*)(Gs+row*GP+1536); al0[i]=ap[0]; al1[i]=ap[1];
    kraw[i]=Gs[row*GP+256+64*h+c]; qraw[i]=(MODE==1)?Gs[row*GP+64*h+c]:(short)0; }
  #pragma unroll
  for(int i=0;i<16;++i){ const int t=16*(tid>>7)+i; const bool ok=FULL||t<ntok; const long row=ok?(m0+t):m0; vraw[i]=Gs[row*GP+512+128*h+(tid&127)]; }
  #pragma unroll
  for(int i=0;i<8;++i){ const int t=8*g+i; float la=0.f;
    if(FULL||t<ntok){ const bf16x8 a0=al0[i],a1=al1[i]; float x=bg;
      #pragma unroll
      for(int j=0;j<8;++j){ x+=bf2f(a0[j])*wg[j]; x+=bf2f(a1[j])*wg[8+j]; }
      la=(fminf(x,0.f)-__logf(1.f+__expf(-fabsf(x))))*0.0625f; }
    run+=la; bl[i]=run; }
  GLAS float*TOT=(GLAS float*)(L+L_TOT);
  TOT[g*64+c]=run;
  __syncthreads();
  float prefix=0.f,total=0.f;
  #pragma unroll
  for(int gg=0;gg<8;++gg){ const float v=TOT[gg*64+c]; total+=v; if(gg<g)prefix+=v; }
  const float bref=0.5f*total;
  float ke[8];
  #pragma unroll
  for(int i=0;i<8;++i){ const int t=8*g+i; const float b=prefix+bl[i]; float kk=0.f,qq=0.f;
    if(FULL||t<ntok){ kk=bf2f(kraw[i]); if(MODE==1) qq=bf2f(qraw[i]); }
    ke[i]=kk*__expf(total-b);
    if(MODE==1){ *(GLAS short*)(L+L_QD+t*144+c*2)=f2bf(qq*0.125f*__expf(b-bref)); *(GLAS short*)(L+L_KI+t*144+c*2)=f2bf(kk*__expf(bref-b)); } }
  { u32x4 p; p[0]=cvtpk_s(ke[0],ke[1]); p[1]=cvtpk_s(ke[2],ke[3]); p[2]=cvtpk_s(ke[4],ke[5]); p[3]=cvtpk_s(ke[6],ke[7]); *(GLAS u32x4*)(L+L_KET+c*144+g*16)=p; }
  if(g==0){ const float d=__expf(total); ((GLAS float*)(L+L_DEC))[c]=d; ((GLAS float*)(L+L_EXR))[c]=__expf(bref); dseg*=d; }
  { const int dv=tid&127,tg=tid>>7; float vv[16];
    #pragma unroll
    for(int i=0;i<16;++i){ const int t=16*tg+i; vv[i]=(FULL||t<ntok)?bf2f(vraw[i]):0.f; }
    u32x4 p0,p1;
    #pragma unroll
    for(int j=0;j<4;++j){ p0[j]=cvtpk_s(vv[2*j],vv[2*j+1]); p1[j]=cvtpk_s(vv[8+2*j],vv[8+2*j+1]); }
    *(GLAS u32x4*)(L+L_VT+dv*144+tg*32)=p0; *(GLAS u32x4*)(L+L_VT+dv*144+tg*32+16)=p1; }
  __syncthreads();
  const int dvl=16*w+fr;
  f32x4 O[4];
  if(MODE==1){
    f32x4 PT[4][4];
    #pragma unroll
    for(int st=0;st<4;++st)
      #pragma unroll
      for(int tt=0;tt<4;++tt){ f32x4 acc={0.f,0.f,0.f,0.f};
        if(st<=tt){
          #pragma unroll
          for(int kk=0;kk<2;++kk){ const bf16x8 a=*(GLAS const bf16x8*)(L+L_KI+(16*st+fr)*144+(32*kk+8*fq)*2), b=*(GLAS const bf16x8*)(L+L_QD+(16*tt+fr)*144+(32*kk+8*fq)*2); acc=GMFMA(a,b,acc); }
          if(st==tt){
            #pragma unroll
            for(int i=0;i<4;++i) if(4*fq+i>fr) acc[i]=0.f; } }
        PT[st][tt]=acc; }
    #pragma unroll
    for(int tt=0;tt<4;++tt){ O[tt]=(f32x4){0.f,0.f,0.f,0.f};
      #pragma unroll
      for(int pr=0;pr<2;++pr){ if(2*pr<=tt){
        u32x4 pa; pa[0]=cvtpk_s(PT[2*pr][tt][0],PT[2*pr][tt][1]); pa[1]=cvtpk_s(PT[2*pr][tt][2],PT[2*pr][tt][3]); pa[2]=cvtpk_s(PT[2*pr+1][tt][0],PT[2*pr+1][tt][1]); pa[3]=cvtpk_s(PT[2*pr+1][tt][2],PT[2*pr+1][tt][3]);
        const u32x2 b0=*(GLAS const u32x2*)(L+L_VT+dvl*144+(32*pr+4*fq)*2), b1=*(GLAS const u32x2*)(L+L_VT+dvl*144+(32*pr+16+4*fq)*2);
        const u32x4 pb={b0[0],b0[1],b1[0],b1[1]};
        O[tt]=GMFMA(__builtin_bit_cast(bf16x8,pa),__builtin_bit_cast(bf16x8,pb),O[tt]); } } }
    #pragma unroll
    for(int kk=0;kk<2;++kk){
      const f32x4 e0=*(GLAS const f32x4*)(L+L_EXR+(32*kk+4*fq)*4), e1=*(GLAS const f32x4*)(L+L_EXR+(32*kk+16+4*fq)*4);
      const f32x4 s0=S[2*kk]*e0, s1=S[2*kk+1]*e1;
      u32x4 pb; pb[0]=cvtpk_s(s0[0],s0[1]); pb[1]=cvtpk_s(s0[2],s0[3]); pb[2]=cvtpk_s(s1[0],s1[1]); pb[3]=cvtpk_s(s1[2],s1[3]);
      #pragma unroll
      for(int tt=0;tt<4;++tt){ const u32x2 a0=*(GLAS const u32x2*)(L+L_QD+(16*tt+fr)*144+(32*kk+4*fq)*2), a1=*(GLAS const u32x2*)(L+L_QD+(16*tt+fr)*144+(32*kk+16+4*fq)*2);
        const u32x4 pa={a0[0],a0[1],a1[0],a1[1]};
        O[tt]=GMFMA(__builtin_bit_cast(bf16x8,pa),__builtin_bit_cast(bf16x8,pb),O[tt]); } }
  }
  #pragma unroll
  for(int mt=0;mt<4;++mt){ const f32x4 d4=*(GLAS const f32x4*)(L+L_DEC+(16*mt+4*fq)*4); S[mt]=S[mt]*d4;
    #pragma unroll
    for(int kk=0;kk<2;++kk){ const bf16x8 a=*(GLAS const bf16x8*)(L+L_KET+(16*mt+fr)*144+(32*kk+8*fq)*2), b=*(GLAS const bf16x8*)(L+L_VT+dvl*144+(32*kk+8*fq)*2); S[mt]=GMFMA(a,b,S[mt]); } }
  if(MODE==1){
    GLAS float*SSQ=(GLAS float*)(L+L_SSQ);
    #pragma unroll
    for(int tt=0;tt<4;++tt)
      #pragma unroll
      for(int i=0;i<4;++i){ float ss=O[tt][i]*O[tt][i]; ss+=__shfl_xor(ss,1); ss+=__shfl_xor(ss,2); ss+=__shfl_xor(ss,4); ss+=__shfl_xor(ss,8); if(fr==0) SSQ[w*64+16*tt+4*fq+i]=ss; }
    short rraw[16];
    #pragma unroll
    for(int tt=0;tt<4;++tt)
      #pragma unroll
      for(int i=0;i<4;++i){ const int t=16*tt+4*fq+i; const long row=(FULL||t<ntok)?(m0+t):m0; rraw[4*tt+i]=Gs[row*GP+1024+128*h+dvl]; }
    __syncthreads();
    #pragma unroll
    for(int tt=0;tt<4;++tt)
      #pragma unroll
      for(int i=0;i<4;++i){ const int t=16*tt+4*fq+i; float tot=0.f;
        #pragma unroll
        for(int ww=0;ww<8;++ww) tot+=SSQ[ww*64+t];
        if(FULL||t<ntok){ const float rstd=rsqrtf(tot*(1.f/128.f)+1e-6f); const float rg=bf2f(rraw[4*tt+i]); const float sl=rg/(1.f+__expf(-rg));
          ((short*)MIX)[(m0+t)*1024+512+128*h+dvl]=f2bf(O[tt][i]*rstd*gain*sl); } }
  }
  __syncthreads();
}
__device__ __forceinline__ void load_consts(int h,const float*w_gate,const float*b_gate,const float*g_out,float(&wg)[16],float&bg,float&gain){
  const int lane=threadIdx.x&63, w=threadIdx.x>>6;
  #pragma unroll
  for(int j=0;j<16;++j) wg[j]=w_gate[j*256+64*h+lane];
  bg=b_gate[64*h+lane]; gain=g_out[16*w+(lane&15)];
}
__device__ __forceinline__ void pass1_unit(int unit,const bf16*G,const float*w_gate,const float*b_gate,const float*g_out,float*SLOC,float*DSEG,GLAS char*L){
  const int bh=unit>>5,sseg=unit&31,b=bh>>2,h=bh&3; const int tid=threadIdx.x;
  float wg[16],bg,gain; load_consts(h,w_gate,b_gate,g_out,wg,bg,gain);
  f32x4 S[4];
  #pragma unroll
  for(int mt=0;mt<4;++mt)S[mt]=(f32x4){0.f,0.f,0.f,0.f};
  float dseg=1.f; const long m0=(long)b*8192+256*sseg;
  for(int ch=0;ch<4;++ch) chunk<0,true>(G,nullptr,m0+64*ch,64,h,L,S,wg,bg,gain,dseg);
  f32x4*dst=(f32x4*)(SLOC+((size_t)unit*512+tid)*16);
  #pragma unroll
  for(int mt=0;mt<4;++mt)dst[mt]=S[mt];
  if(tid<64)DSEG[unit*64+tid]=dseg;
}
__device__ __forceinline__ void pass3_unit(int unit,const bf16*G,bf16*MIX,const float*w_gate,const float*b_gate,const float*g_out,const float*SLOC,const float*DSEG,float*sfin_base,GLAS char*L){
  const int bh=unit>>5,sseg=unit&31,b=bh>>2,h=bh&3; const int tid=threadIdx.x,lane=tid&63,fr=lane&15,fq=lane>>4,w=tid>>6;
  float wg[16],bg,gain; load_consts(h,w_gate,b_gate,g_out,wg,bg,gain);
  f32x4 S[4];
  #pragma unroll
  for(int mt=0;mt<4;++mt)S[mt]=(f32x4){0.f,0.f,0.f,0.f};
  #pragma unroll 4
  for(int j=0;j<sseg;++j){ const int uj=bh*32+j; const f32x4*src=(const f32x4*)(SLOC+((size_t)uj*512+tid)*16);
    #pragma unroll
    for(int mt=0;mt<4;++mt){ const f32x4 d4=*(const f32x4*)(DSEG+uj*64+16*mt+4*fq); S[mt]=S[mt]*d4+src[mt]; } }
  float dseg=1.f; const long m0=(long)b*8192+256*sseg;
  for(int ch=0;ch<4;++ch) chunk<1,true>(G,MIX,m0+64*ch,64,h,L,S,wg,bg,gain,dseg);
  if(sseg==31){ float*o=sfin_base+(size_t)bh*8192;
    #pragma unroll
    for(int mt=0;mt<4;++mt)
      #pragma unroll
      for(int i=0;i<4;++i) o[(16*mt+4*fq+i)*128+16*w+fr]=S[mt][i]; }
}
__device__ __forceinline__ void sample_unit(int unit,const bf16*G,bf16*MIX,const float*w_gate,const float*b_gate,const float*g_out,const float*s0,float*sout,GLAS char*L){
  const int smp=unit>>2,h=unit&3; const int tid=threadIdx.x,lane=tid&63,fr=lane&15,fq=lane>>4,w=tid>>6;
  float wg[16],bg,gain; load_consts(h,w_gate,b_gate,g_out,wg,bg,gain);
  f32x4 S[4]; const float*si=s0+(size_t)unit*8192; float*so=sout+(size_t)unit*8192;
  #pragma unroll
  for(int mt=0;mt<4;++mt)
    #pragma unroll
    for(int i=0;i<4;++i) S[mt][i]=si[(16*mt+4*fq+i)*128+16*w+fr];
  float dseg=1.f;
  chunk<1,false>(G,MIX,16384+8*(long)smp,8,h,L,S,wg,bg,gain,dseg);
  #pragma unroll
  for(int mt=0;mt<4;++mt)
    #pragma unroll
    for(int i=0;i<4;++i) so[(16*mt+4*fq+i)*128+16*w+fr]=S[mt][i];
}
}
namespace thin {
using sba::bf16x8; using sba::f32x16; using sba::crow;
template<int KS,class Epi> __device__ __forceinline__ void run(const unsigned short*A,int lda,const unsigned short*Bt,int ldb,int K,int ntn,int tile0,int ntiles,__attribute__((address_space(3))) char*lds,const Epi&epi){
  typedef unsigned u32x4t __attribute__((ext_vector_type(4)));
  int tid_=threadIdx.x; asm volatile("":"+v"(tid_)); const int lane=tid_&63,r32=lane&31,hi=lane>>5; const int w=__builtin_amdgcn_readfirstlane(tid_>>6);
  const int sub=w/KS,kp=w%KS,tile=tile0+sub; const bool live=tile<ntiles; const int tm=live?tile/ntn:0,tn=live?tile%ntn:0;
  const int klen=K/KS,k0=kp*klen;
  __attribute__((address_space(3))) char*sa=lds+w*9216; __attribute__((address_space(3))) char*sb=sa+4608;
  __attribute__((address_space(3))) float*red=(__attribute__((address_space(3))) float*)(lds+73728);
  const int lrow=lane>>3,lch=lane&7;
  const unsigned short*ap=A+(size_t)(32*tm+lrow)*lda+k0+8*lch; const unsigned short*bp=Bt+(size_t)(32*tn+lrow)*ldb+k0+8*lch;
  const int wo=lrow*144+lch*16, ro=r32*144+16*hi;
  f32x16 acc=f32x16{};
  if(live){
    u32x4t ra[4],rb[4];
    #pragma unroll
    for(int i=0;i<4;++i){ ra[i]=*(const u32x4t*)(ap+(size_t)8*i*lda); rb[i]=*(const u32x4t*)(bp+(size_t)8*i*ldb); }
    for(int k=0;k<klen;k+=64){
      #pragma unroll
      for(int i=0;i<4;++i){ *(__attribute__((address_space(3))) u32x4t*)(sa+wo+i*1152)=ra[i]; *(__attribute__((address_space(3))) u32x4t*)(sb+wo+i*1152)=rb[i]; }
      if(k+64<klen){
        #pragma unroll
        for(int i=0;i<4;++i){ ra[i]=*(const u32x4t*)(ap+(size_t)8*i*lda+k+64); rb[i]=*(const u32x4t*)(bp+(size_t)8*i*ldb+k+64); } }
      #pragma unroll
      for(int kk=0;kk<4;++kk){ const bf16x8 a=*(const __attribute__((address_space(3))) bf16x8*)(sa+ro+32*kk), b=*(const __attribute__((address_space(3))) bf16x8*)(sb+ro+32*kk);
        acc=__builtin_amdgcn_mfma_f32_32x32x16_bf16(a,b,acc,0,0,0); }
    } }
  #pragma unroll
  for(int r=0;r<16;++r) red[(w*16+r)*64+lane]=acc[r];
  __syncthreads();
  if(kp==0&&live){
    #pragma unroll
    for(int r=0;r<16;++r){ float v=0.f;
      #pragma unroll
      for(int p=0;p<KS;++p) v+=red[((sub*KS+p)*16+r)*64+lane];
      epi(32*tm+crow(r,hi),32*tn+r32,v); } }
  __syncthreads();
}
struct EpiResGateS { const float*base; float*out; const float*gate; int ld;
  __device__ __forceinline__ void operator()(int row,int col,float v)const{ const size_t o=(size_t)row*ld+col; out[o]=base[o]+gate[(size_t)(2+(row>>3))*6144+col]*v; } };
struct EpiRelu2S { unsigned short*H; int ld;
  __device__ __forceinline__ void operator()(int row,int col,float v)const{ const float a=fmaxf(v,0.f); H[(size_t)row*ld+col]=(unsigned short)(sba::cvtpk_s(a*a,0.f)&0xffffu); } };
struct EpiALow { unsigned short*G;
  __device__ __forceinline__ void operator()(int row,int col,float v)const{ if(col<16) G[(size_t)row*1792+1536+col]=(unsigned short)(sba::cvtpk_s(v,0.f)&0xffffu); } };
struct EpiInProjS { unsigned short*Q,*K,*V,*G; float*kS,*vS; float qscale;
  __device__ __forceinline__ void operator()(int row,int col,float v)const{
    if(col<512) Q[(size_t)row*512+col]=(unsigned short)(sba::cvtpk_s(v*qscale,0.f)&0xffffu);
    else if(col<1024){ K[(size_t)row*512+col-512]=(unsigned short)(sba::cvtpk_s(v,0.f)&0xffffu); kS[(size_t)row*512+col-512]=v; }
    else if(col<1536){ V[(size_t)row*512+col-1024]=(unsigned short)(sba::cvtpk_s(v,0.f)&0xffffu); vS[(size_t)row*512+col-1024]=v; }
    else G[(size_t)row*1792+col-1536]=(unsigned short)(sba::cvtpk_s(v,0.f)&0xffffu); } };
}
__device__ __forceinline__ float wave_sum(float v) {
#pragma unroll
    for (int o = 1; o < 64; o <<= 1) v += __shfl_xor(v, o);
    return v;
}
__device__ __forceinline__ void p0_transpose_item(const float* W, int K, int Nreal, int Npad, bf16* WT, LAS float* scr, int item, int lane) {
    const int nblk = Npad / 32, kb = item / nblk, nb = item % nblk, k0 = 64 * kb, n0 = 32 * nb;
    const int n = n0 + (lane & 31);
#pragma unroll 8
    for (int i = 0; i < 32; ++i) { const int kk = 2 * i + (lane >> 5); scr[kk * 33 + (lane & 31)] = (n < Nreal) ? W[(size_t)(k0 + kk) * Nreal + n] : 0.f; }
    LDS_WAIT(); asm volatile("" ::: "memory");
    const int c = lane & 7;
#pragma unroll
    for (int j = 0; j < 4; ++j) { const int nn = (lane >> 3) + 8 * j; const LAS float* s = scr + (8 * c) * 33 + nn;
        v4u o; o.x = pk2(s[0 * 33], s[1 * 33]); o.y = pk2(s[2 * 33], s[3 * 33]); o.z = pk2(s[4 * 33], s[5 * 33]); o.w = pk2(s[6 * 33], s[7 * 33]);
        *(GAS v4u*)(WT + (size_t)(n0 + nn) * K + k0 + 8 * c) = o; }
    LDS_WAIT(); asm volatile("" ::: "memory");
}
__device__ __forceinline__ void norm_mod_row_bf16(int lane, const float* xrow, const float* gain, const float* sc, const float* sh, bf16* orow) {
    const f32x4* xr = (const f32x4*)xrow + lane; f32x4 v[4]; float s = 0.f;
#pragma unroll
    for (int j = 0; j < 4; ++j) { v[j] = xr[64 * j]; s += (v[j].x * v[j].x + v[j].y * v[j].y) + (v[j].z * v[j].z + v[j].w * v[j].w); }
    const float rstd = rsqrtf(wave_sum(s) * (1.f / D) + NORM_EPS);
    unsigned long long* o8 = (unsigned long long*)orow + lane;
#pragma unroll
    for (int j = 0; j < 4; ++j) { const f32x4 g = ((const f32x4*)gain)[lane + 64 * j], a = ((const f32x4*)sc)[lane + 64 * j], b = ((const f32x4*)sh)[lane + 64 * j];
        const f32x4 y = v[j] * rstd * g * (a + 1.f) + b;
        o8[64 * j] = (unsigned long long)pk2(y.x, y.y) | ((unsigned long long)pk2(y.z, y.w) << 32); }
}
__device__ __forceinline__ void norm_row_f32_inplace(int lane, float* xrow, const float* gain) {
    f32x4* xr = (f32x4*)xrow + lane; f32x4 v[4]; float s = 0.f;
#pragma unroll
    for (int j = 0; j < 4; ++j) { v[j] = xr[64 * j]; s += (v[j].x * v[j].x + v[j].y * v[j].y) + (v[j].z * v[j].z + v[j].w * v[j].w); }
    const float rstd = rsqrtf(wave_sum(s) * (1.f / D) + NORM_EPS);
#pragma unroll
    for (int j = 0; j < 4; ++j) { const f32x4 g = ((const f32x4*)gain)[lane + 64 * j]; xr[64 * j] = v[j] * rstd * g; }
}
__device__ __forceinline__ int bidx_of_row(int m) { return m < MP ? (m >> 13) : 2 + ((m - MP) >> 3); }

struct Args { const float* in[21]; const int* page_table; float* out; unsigned char* ws; };
static_assert(sizeof(Args) == 24 * 8, "Args has no padding");

__global__ void __launch_bounds__(NWAVES * 64, 2) mk_fwd(Args args) {
    extern __shared__ __attribute__((aligned(16))) unsigned char lds[];
    LAS unsigned char* L = (LAS unsigned char*)lds;
    volatile LAS unsigned* MISC = (volatile LAS unsigned*)(L + MISC_OFF);
    const int tid = threadIdx.x, lane = tid & 63, wave = __builtin_amdgcn_readfirstlane(tid >> 6);
    const int G = gridDim.x; const int bx = blockIdx.x; const int vcu = (G % 8 == 0) ? (bx % 8) * (G / 8) + bx / 8 : bx;
    unsigned char* ws = args.ws;
    unsigned* ctl = (unsigned*)(ws + WS_CTL);
    const float *x_prompt = args.in[0], *x_sample = args.in[1], *c_prompt = args.in[2], *c_sample = args.in[3], *cache_k = args.in[4], *cache_v = args.in[5], *state_gla = args.in[6];
    const float *w_ada = args.in[8], *b_ada = args.in[9], *g_mix = args.in[10], *w_in = args.in[11], *b_sb = args.in[12], *w_gate = args.in[13], *b_gate = args.in[14], *g_gla_out = args.in[15];
    const float *w_out = args.in[16], *g_ffn = args.in[17], *w_up = args.in[18], *w_down = args.in[19], *g_final = args.in[20];
    float* out = args.out;
    float* MOD = (float*)(ws + WS_MOD);
    bf16 *Win_t = (bf16*)(ws + WS_WIN), *Wo_t = (bf16*)(ws + WS_WO), *Wup_t = (bf16*)(ws + WS_WUP), *Wdn_t = (bf16*)(ws + WS_WDN);
    bf16 *XN = (bf16*)(ws + WS_XN), *QB = (bf16*)(ws + WS_Q), *KB = (bf16*)(ws + WS_K), *VB = (bf16*)(ws + WS_V), *GB = (bf16*)(ws + WS_G), *MIX = (bf16*)(ws + WS_MIX), *HB = (bf16*)(ws + WS_H);
    float* X1 = (float*)(ws + WS_X1);
    float *SLOC = (float*)(ws + WS_SLOC), *DSEG = (float*)(ws + WS_DSEG), *DPART = (float*)(ws + WS_DPART), *DRTOT = (float*)(ws + WS_DRTOT);
    for (int u = tid; u < (LDS_BYTES - MISC_OFF) / 4; u += NWAVES * 64) ((LAS unsigned*)(L + MISC_OFF))[u] = 0u;
    __syncthreads();
    XcdBarrier bar = xcd_barrier_post(ctl + CW_BAR, MISC + 8);
    const int gw = vcu * NWAVES + wave, NGW = G * NWAVES;

#ifdef PROBE_P0A
    for (int rep_ = 0; rep_ < 2; ++rep_) {
#else
    {
#endif
    if (vcu < 96) {
        LAS float* s = (LAS float*)L;
        for (int i = tid; i < NMODR * D; i += NWAVES * 64) { const int r = i >> 10, k = i & 1023; const float c = r < 2 ? c_prompt[r * D + k] : c_sample[(r - 2) * D + k]; s[k * NMODR + r] = c / (1.f + __expf(-c)); }
        __syncthreads();
        const int col = 64 * vcu + lane, k0 = 128 * wave;
        const __amdgpu_buffer_rsrc_t rw = __builtin_amdgcn_make_buffer_rsrc((void*)w_ada, 0, D * MODW * 4, 0x00020000);
        float acc[NMODR];
#pragma unroll
        for (int r = 0; r < NMODR; ++r) acc[r] = 0.f;
#pragma unroll 1
        for (int kb = 0; kb < 128; kb += 16) {
            float wv[16];
#pragma unroll
            for (int i = 0; i < 16; ++i) wv[i] = __uint_as_float(__builtin_amdgcn_raw_buffer_load_b32(rw, col * 4, (k0 + kb + i) * MODW * 4, 2));
#pragma unroll
            for (int i = 0; i < 16; ++i) { const int k = k0 + kb + i;
#pragma unroll
                for (int r = 0; r < NMODR; ++r) acc[r] += s[k * NMODR + r] * wv[i];
                if ((i & 1) == 1) { asm volatile("" ::: "memory"); __builtin_amdgcn_sched_barrier(0); } }
        }
        __syncthreads();
        LAS float* red = (LAS float*)L;
#pragma unroll
        for (int r = 0; r < NMODR; ++r) red[(wave * NMODR + r) * 64 + lane] = acc[r];
        __syncthreads();
        for (int o = tid; o < NMODR * 64; o += NWAVES * 64) { const int r = o >> 6, l = o & 63; float t = b_ada[64 * vcu + l];
#pragma unroll
            for (int w8 = 0; w8 < 8; ++w8) t += red[(w8 * NMODR + r) * 64 + l];
            MOD[r * MODW + 64 * vcu + l] = t; }
        __syncthreads();
    }
    {
        LAS float* scr = (LAS float*)(L + wave * 16384);
        constexpr int I_IN = (D / 64) * (NIN / 32), I_O = (D / 64) * (D / 32), I_UP = (D / 64) * (FF / 32), I_DN = (FF / 64) * (D / 32);
        constexpr int NITEMS = I_IN + I_O + I_UP + I_DN;
        const bool split = G > 96; const int tw = split ? (vcu - 96) * NWAVES + wave : gw, TNW = split ? (G - 96) * NWAVES : NGW;
        if (!split || vcu >= 96)
        for (int it = tw; it < NITEMS; it += TNW) {
            int r = it;
            if (r < I_IN) { p0_transpose_item(w_in, D, NIN_REAL, NIN, Win_t, scr, r, lane); continue; } r -= I_IN;
            if (r < I_O) { p0_transpose_item(w_out, D, D, D, Wo_t, scr, r, lane); continue; } r -= I_O;
            if (r < I_UP) { p0_transpose_item(w_up, D, FF, FF, Wup_t, scr, r, lane); continue; } r -= I_UP;
            p0_transpose_item(w_down, FF, D, D, Wdn_t, scr, r, lane);
        }
    }
    __syncthreads();
    }
    xcd_barrier(bar);
#ifdef PROBE_P0B
    for (int rep_ = 0; rep_ < 2; ++rep_)
#endif
    for (int m = gw; m < M; m += NGW) { const float* xr = m < MP ? x_prompt + (size_t)m * D : x_sample + (size_t)(m - MP) * D; const float* md = MOD + (size_t)bidx_of_row(m) * MODW;
        norm_mod_row_bf16(lane, xr, g_mix, md + 1024, md, XN + (size_t)m * D); }
    xcd_barrier(bar);
#ifdef PROBE_P1
    for (int rep_ = 0; rep_ < 2; ++rep_)
#endif
    {
        pg8::Gemm g{XN, Win_t, MP, 3072, D}; pg8::StaticOrder S; S.init(MP, 3072, G, bx);
        pg8::EpiInProj E{QB, KB, VB, GB, out + OK_P, out + OV_P, out + OK_S - (size_t)MP * 512, out + OV_S - (size_t)MP * 512, QSCALE};
        pg8::gemm_phase<pg8::EpiInProj, pg8::StaticOrder, true, true>(L, g, S, E);
        thin::EpiALow Ea{GB};
        for (int t0 = 4 * vcu; t0 < 512; t0 += 4 * G) thin::run<2>(XN, D, Win_t + (size_t)3072 * D, D, D, 1, t0, 512, (LAS char*)L, Ea);
        thin::EpiInProjS Es{QB + (size_t)MP * 512, KB + (size_t)MP * 512, VB + (size_t)MP * 512, GB + (size_t)MP * 1792, out + OK_S, out + OV_S, QSCALE};
        for (int t0 = 4 * vcu; t0 < 776; t0 += 4 * G) thin::run<2>(XN + (size_t)MP * D, D, Win_t, D, D, 97, t0, 776, (LAS char*)L, Es);
    }
    xcd_barrier(bar);
#if defined(PROBE_GLA2) || defined(PROBE_GLA1)
    for (int rep_ = 0; rep_ < 2; ++rep_)
#endif
    for (int u = vcu; u < 256; u += G) gla::pass1_unit(u, (const gla::bf16*)GB, w_gate, b_gate, g_gla_out, SLOC, DSEG, (LAS char*)L);
    xcd_barrier(bar);
    for (int rep = 0; rep < 2; ++rep) {
        const bool do_sb = ((vcu & 1) == rep);
        if (do_sb) {
#ifdef PROBE_SB2
            for (int rep_ = 0; rep_ < 2; ++rep_)
#endif
            for (int v = vcu; v < 256; v += G) {
                const int bh = v >> 4, s = v & 15, b = bh >> 3, h = bh & 7; const float bias2 = b_sb[h] * 1.4426950408889634f;
                sb8::attn_unit(b, h, 31 - s, (const sba::bf16*)QB, (const sba::bf16*)KB, (const sba::bf16*)VB, (sba::bf16*)MIX, (char*)lds, bias2);
                sb8::attn_unit(b, h, s, (const sba::bf16*)QB, (const sba::bf16*)KB, (const sba::bf16*)VB, (sba::bf16*)MIX, (char*)lds, bias2);
            }
        } else {
#ifdef PROBE_DEC2
            for (int rep_ = 0; rep_ < 2; ++rep_)
#endif
            for (int u = vcu; u < 256; u += G)
                sbd::decode_wave(u >> 3, u & 7, wave, cache_k, cache_v, args.page_table, (const sba::bf16*)QB, (const sba::bf16*)KB, (const sba::bf16*)VB, b_sb, DPART, DRTOT, ctl + CW_DEC, (sba::bf16*)MIX, (LAS char*)L + wave * 12800);
            asm volatile("s_waitcnt vmcnt(0)" ::: "memory"); __syncthreads();
        }
    }
#if defined(PROBE_GLA2)
    for (int rep_ = 0; rep_ < 2; ++rep_)
#endif
    for (int u = vcu; u < 256; u += G) gla::pass3_unit(u, (const gla::bf16*)GB, (gla::bf16*)MIX, w_gate, b_gate, g_gla_out, SLOC, DSEG, out + OSG_P, (LAS char*)L);
    for (int u = vcu; u < 128; u += G) gla::sample_unit(u, (const gla::bf16*)GB, (gla::bf16*)MIX, w_gate, b_gate, g_gla_out, state_gla, out + OSG_S, (LAS char*)L);
    xcd_barrier(bar);
#ifdef PROBE_P3
    for (int rep_ = 0; rep_ < 2; ++rep_)
#endif
    {
        pg8::Gemm g{MIX, Wo_t, MP, D, D}; pg8::StaticOrder S; S.init(MP, D, G, bx);
        pg8::EpiResGate E{x_prompt, x_sample - (size_t)MP * D, X1, MOD + 2048};
        pg8::gemm_phase<pg8::EpiResGate, pg8::StaticOrder, true, true>(L, g, S, E);
        thin::EpiResGateS Es{x_sample, X1 + (size_t)MP * D, MOD + 2048, D};
        for (int t0 = vcu; t0 < 256; t0 += G) thin::run<8>(MIX + (size_t)MP * D, D, Wo_t, D, D, 32, t0, 256, (LAS char*)L, Es);
    }
    xcd_barrier(bar);
#ifdef PROBE_BAR10
    for (int rep_ = 0; rep_ < 10; ++rep_) xcd_barrier(bar);
#endif
#ifdef PROBE_P3B
    for (int rep_ = 0; rep_ < 2; ++rep_)
#endif
    for (int m = gw; m < M; m += NGW) { const float* md = MOD + (size_t)bidx_of_row(m) * MODW; norm_mod_row_bf16(lane, X1 + (size_t)m * D, g_ffn, md + 4096, md + 3072, XN + (size_t)m * D); }
    xcd_barrier(bar);
#ifdef PROBE_P4
    for (int rep_ = 0; rep_ < 2; ++rep_)
#endif
    {
        pg8::Gemm g{XN, Wup_t, MP, FF, D}; pg8::StaticOrder S; S.init(MP, FF, G, bx);
        pg8::EpiRelu2 E{HB, FF};
        pg8::gemm_phase<pg8::EpiRelu2, pg8::StaticOrder, true, true>(L, g, S, E);
        thin::EpiRelu2S Es{HB + (size_t)MP * FF, FF};
        for (int t0 = 4 * vcu; t0 < 1024; t0 += 4 * G) thin::run<2>(XN + (size_t)MP * D, D, Wup_t, D, D, 128, t0, 1024, (LAS char*)L, Es);
    }
    xcd_barrier(bar);
#ifdef PROBE_P5
    for (int rep_ = 0; rep_ < 2; ++rep_)
#endif
    {
        pg8::Gemm g{HB, Wdn_t, MP, D, FF}; pg8::StaticOrder S; S.init(MP, D, G, bx);
        pg8::EpiResGate E{X1, X1, out + OY, MOD + 5120};
        pg8::gemm_phase<pg8::EpiResGate, pg8::StaticOrder, true, true>(L, g, S, E);
        thin::EpiResGateS Es{X1 + (size_t)MP * D, out + OY + (size_t)MP * D, MOD + 5120, D};
        for (int t0 = vcu; t0 < 256; t0 += G) thin::run<8>(HB + (size_t)MP * FF, FF, Wdn_t, FF, FF, 32, t0, 256, (LAS char*)L, Es);
    }
    xcd_barrier(bar);
    for (int m = gw; m < M; m += NGW) norm_row_f32_inplace(lane, out + OY + (size_t)m * D, g_final);
}

extern "C" void kernel_launch(void* const* d_in, const int* in_sizes, int n_in, void* d_out, int out_size, void* d_ws, size_t ws_size, hipStream_t stream) {
    static int grid = 0;
    if (grid == 0) {
        if (n_in != 21 || (size_t)out_size != OUT_TOTAL || ws_size < WS_END) { fprintf(stderr, "kernel_launch: unexpected sizes: n_in %d out %d ws %zu\n", n_in, out_size, ws_size); grid = -1; return; }
        int dev = 0, cus = 0, per_cu = 0;
        if (hipGetDevice(&dev) != hipSuccess || hipDeviceGetAttribute(&cus, hipDeviceAttributeMultiprocessorCount, dev) != hipSuccess) { grid = -1; return; }
        if (hipFuncSetAttribute((const void*)mk_fwd, hipFuncAttributeMaxDynamicSharedMemorySize, LDS_BYTES) != hipSuccess) { fprintf(stderr, "kernel_launch: hipFuncSetAttribute failed\n"); grid = -1; return; }
        if (hipOccupancyMaxActiveBlocksPerMultiprocessor(&per_cu, (const void*)mk_fwd, NWAVES * 64, LDS_BYTES) != hipSuccess || per_cu < 1) { fprintf(stderr, "kernel_launch: occupancy query says %d\n", per_cu); }
        (void)hipGetLastError();
        grid = cus;
    }
    if (grid < 0) return;
    if (hipMemsetAsync((char*)d_ws + WS_CTL, 0, CTL_ZERO_BYTES, stream) != hipSuccess) return;
    Args a{};
    for (int i = 0; i < 21; ++i) a.in[i] = (const float*)d_in[i];
    a.page_table = (const int*)d_in[7]; a.out = (float*)d_out; a.ws = (unsigned char*)d_ws;
    hipLaunchKernelGGL(mk_fwd, dim3(grid), dim3(NWAVES * 64), LDS_BYTES, stream, a);
    const hipError_t le = hipPeekAtLastError();
    if (le != hipSuccess) fprintf(stderr, "kernel_launch: launch failed: %s\n", hipGetErrorName(le));
}
```
